# Optimizing an MI355X kernel written in HIP

```python
import jax, jax.numpy as jnp
from jax import lax
import numpy as np

D_MODEL = 1024
BATCH = 1
SEQ = 16384
DEPTH = 1
DEC_BATCH = 16
DEC_SEQ = 2048
PAST_LEN = 128

HEAD_DIM = 64
N_HEADS_A = 8
N_HEADS_B = 8
N_KV_B = 2
WIDTH_A = N_HEADS_A * HEAD_DIM
WIDTH_B = N_HEADS_B * HEAD_DIM
KV_WIDTH_B = N_KV_B * HEAD_DIM
MIX_WIDTH = WIDTH_A + WIDTH_B
IN_WIDTH = 3 * WIDTH_A + WIDTH_B + 2 * KV_WIDTH_B
DILATED_CONFIGS = ((128, 1), (512, 4), (2048, 16))
WINDOW_B = 128
D_FF = 2816
CONV_WIDTH = 3
EPS = 1e-6
NEG_INF = -1e30

kernel_name = 'hymba_dilated_swa_convffn_encoder'


def alibi_slopes():
    n = N_HEADS_A + N_HEADS_B
    h = np.arange(1, n + 1, dtype=np.float32)
    s = np.exp2(-8.0 * h / n).astype(np.float32)
    return jnp.asarray(s[N_HEADS_B:]), jnp.asarray(s[:N_HEADS_B])


def rms_norm(x, g):
    xf = x.astype(jnp.float32)
    y = xf * lax.rsqrt(jnp.mean(xf * xf, axis=-1, keepdims=True) + EPS)
    return (y * g.astype(jnp.float32)).astype(x.dtype)


def banded_attention(q, k, v, key_valid, radius, dist_scale, slopes, sink=None):
    n, L, G, R, dh = q.shape
    blk = radius
    nb = -(-L // blk)
    pad = nb * blk - L
    q = jnp.pad(q, ((0, 0), (0, pad), (0, 0), (0, 0), (0, 0)))
    kv_pad = ((0, 0), (blk, pad + blk), (0, 0), (0, 0))
    k = jnp.pad(k, kv_pad)
    v = jnp.pad(v, kv_pad)
    valid = jnp.pad(key_valid, ((0, 0), (blk, pad + blk)))

    def windows(a):
        a = a.reshape((n, nb + 2, blk) + a.shape[2:])
        return jnp.concatenate([a[:, :-2], a[:, 1:-1], a[:, 2:]], axis=2)

    kw, vw, mw = windows(k), windows(v), windows(valid)
    qb = q.reshape(n, nb, blk, G, R, dh)
    s = jnp.einsum('nbqgrd,nbkgd->nbgrqk', qb, kw).astype(jnp.float32) * (dh ** -0.5)
    rel = jnp.arange(3 * blk)[None, :] - blk - jnp.arange(blk)[:, None]
    dist = jnp.abs(rel).astype(jnp.float32) * dist_scale
    s = s - slopes.astype(jnp.float32)[:, :, None, None] * dist
    allowed = (jnp.abs(rel) <= radius)[None, None, None, None] & mw[:, :, None, None, None, :]
    s = jnp.where(allowed, s, NEG_INF)
    m = jnp.max(s, axis=-1)
    if sink is not None:
        sk = sink.astype(jnp.float32)[None, None, :, :, None]
        m = jnp.maximum(m, sk)
    p = jnp.exp(s - m[..., None])
    denom = jnp.sum(p, axis=-1)
    if sink is not None:
        denom = denom + jnp.exp(sk - m)
    o = jnp.einsum('nbgrqk,nbkgd->nbqgrd', p.astype(v.dtype), vw).astype(jnp.float32)
    denom_t = jnp.transpose(denom, (0, 1, 4, 2, 3))
    m_t = jnp.transpose(m, (0, 1, 4, 2, 3))
    o = o / denom_t[..., None]
    lse = m_t + jnp.log(denom_t)
    o = o.reshape(n, nb * blk, G, R, dh)[:, :L]
    lse = lse.reshape(n, nb * blk, G, R)[:, :L]
    return o, lse


def dilated_attention(q, k, v, slopes):
    b, S, H, dh = q.shape
    outs, lses = [], []
    for window, d in DILATED_CONFIGS:
        radius = window // (2 * d)
        Sd = -(-S // d) * d
        pad = ((0, 0), (0, Sd - S), (0, 0), (0, 0))

        def split(a):
            a = a.reshape((b, Sd // d, d) + a.shape[2:])
            a = jnp.swapaxes(a, 1, 2)
            return a.reshape((b * d, Sd // d) + a.shape[3:])

        def merge(a):
            a = a.reshape((b, d, Sd // d) + a.shape[2:])
            a = jnp.swapaxes(a, 1, 2)
            return a.reshape((b, Sd) + a.shape[3:])[:, :S]

        valid = jnp.broadcast_to(jnp.arange(Sd) < S, (b, Sd))
        qs = split(jnp.pad(q, pad))[:, :, :, None]
        ks = split(jnp.pad(k, pad))
        vs = split(jnp.pad(v, pad))
        o, lse = banded_attention(qs, ks, vs, split(valid), radius, float(d), slopes[:, None])
        outs.append(merge(o[:, :, :, 0]))
        lses.append(merge(lse[:, :, :, 0]))
    w = jax.nn.softmax(jnp.stack(lses, axis=0), axis=0)
    return jnp.sum(w[..., None] * jnp.stack(outs, axis=0), axis=0)


def encoder_layer(x, norm1, w_in, q_norm_a, k_norm_a, q_norm_b, k_norm_b, sink_b,
                  out_norm_a, out_norm_b, w_out, norm2, w_up, conv_w, conv_b, w_down):
    b, S, _ = x.shape
    slopes_a, slopes_b = alibi_slopes()
    h = rms_norm(x, norm1)
    proj = h @ w_in
    cuts = [WIDTH_A, 2 * WIDTH_A, 3 * WIDTH_A, 3 * WIDTH_A + WIDTH_B, 3 * WIDTH_A + WIDTH_B + KV_WIDTH_B]
    qa, ka, va, qb, kb, vb = jnp.split(proj, cuts, axis=-1)

    qa = rms_norm(qa.reshape(b, S, N_HEADS_A, HEAD_DIM), q_norm_a)
    ka = rms_norm(ka.reshape(b, S, N_HEADS_A, HEAD_DIM), k_norm_a)
    va = va.reshape(b, S, N_HEADS_A, HEAD_DIM)
    ya = dilated_attention(qa, ka, va, slopes_a).astype(x.dtype).reshape(b, S, WIDTH_A)

    rep = N_HEADS_B // N_KV_B
    qb = rms_norm(qb.reshape(b, S, N_KV_B, rep, HEAD_DIM), q_norm_b)
    kb = rms_norm(kb.reshape(b, S, N_KV_B, HEAD_DIM), k_norm_b)
    vb = vb.reshape(b, S, N_KV_B, HEAD_DIM)
    valid = jnp.ones((b, S), dtype=bool)
    yb, _ = banded_attention(qb, kb, vb, valid, WINDOW_B, 1.0,
                             slopes_b.reshape(N_KV_B, rep), sink_b.reshape(N_KV_B, rep))
    yb = yb.astype(x.dtype).reshape(b, S, WIDTH_B)

    y = jnp.concatenate([rms_norm(ya, out_norm_a), rms_norm(yb, out_norm_b)], axis=-1)
    x = x + y @ w_out

    u = rms_norm(x, norm2) @ w_up
    half = CONV_WIDTH // 2
    up = jnp.pad(u, ((0, 0), (half, half), (0, 0)))
    c = conv_b
    for j in range(CONV_WIDTH):
        c = c + up[:, j:j + S] * conv_w[j]
    gate, val = jnp.split(c, 2, axis=-1)
    return x + (jax.nn.silu(gate) * val) @ w_down


def setup_inputs(seed: int = 0) -> dict:
    key = jax.random.key(seed)
    ks = jax.random.split(key, 20)
    f32 = jnp.float32

    def nrm(k, shape, scale):
        return jax.random.normal(k, shape, f32) * scale

    def gain(k, shape):
        return 1.0 + 0.02 * jax.random.normal(k, shape, f32)

    return {
        'x_prompt': nrm(ks[0], (BATCH, SEQ, D_MODEL), 1.0),
        'x_sample': nrm(ks[1], (DEC_BATCH, DEC_SEQ, D_MODEL), 1.0),
        'norm1': gain(ks[2], (DEPTH, D_MODEL)),
        'w_in': nrm(ks[3], (DEPTH, D_MODEL, IN_WIDTH), D_MODEL ** -0.5),
        'q_norm_a': gain(ks[4], (DEPTH, HEAD_DIM)),
        'k_norm_a': gain(ks[5], (DEPTH, HEAD_DIM)),
        'q_norm_b': gain(ks[6], (DEPTH, HEAD_DIM)),
        'k_norm_b': gain(ks[7], (DEPTH, HEAD_DIM)),
        'sink_b': nrm(ks[8], (DEPTH, N_HEADS_B), 0.1),
        'out_norm_a': gain(ks[9], (DEPTH, WIDTH_A)),
        'out_norm_b': gain(ks[10], (DEPTH, WIDTH_B)),
        'w_out': nrm(ks[11], (DEPTH, MIX_WIDTH, D_MODEL), MIX_WIDTH ** -0.5),
        'norm2': gain(ks[12], (DEPTH, D_MODEL)),
        'w_up': nrm(ks[13], (DEPTH, D_MODEL, 2 * D_FF), D_MODEL ** -0.5),
        'conv_w': nrm(ks[14], (DEPTH, CONV_WIDTH, 2 * D_FF), CONV_WIDTH ** -0.5),
        'conv_b': nrm(ks[15], (DEPTH, 2 * D_FF), 0.02),
        'w_down': nrm(ks[16], (DEPTH, D_FF, D_MODEL), D_FF ** -0.5),
    }


def reference(x_prompt, x_sample, norm1, w_in, q_norm_a, k_norm_a, q_norm_b, k_norm_b, sink_b,
              out_norm_a, out_norm_b, w_out, norm2, w_up, conv_w, conv_b, w_down):
    y_prompt = x_prompt
    y_sample = x_sample
    for l in range(DEPTH):
        layer_args = (norm1[l], w_in[l], q_norm_a[l], k_norm_a[l], q_norm_b[l], k_norm_b[l], sink_b[l],
                      out_norm_a[l], out_norm_b[l], w_out[l], norm2[l], w_up[l], conv_w[l], conv_b[l], w_down[l])
        y_prompt = encoder_layer(y_prompt, *layer_args)
        y_sample = encoder_layer(y_sample, *layer_args)
    return (y_prompt, y_sample)
```

```cpp
#include <hip/hip_runtime.h>
#include <hip/hip_cooperative_groups.h>
#include <cstdio>
#include <cstdint>
namespace cg = cooperative_groups;
namespace pg8 {
#define PG8_LAS __attribute__((address_space(3)))
typedef unsigned short bf16_t;
typedef short bf16x8 __attribute__((ext_vector_type(8)));
typedef float f32x4 __attribute__((ext_vector_type(4)));
typedef unsigned u32x4 __attribute__((ext_vector_type(4)));
constexpr int BM = 256, BK = 64, HALF = 128, HTB = HALF * BK * 2  , STAGE_BYTES = 8 * HTB, NXCD = 8, WGM = 8;

__host__ __device__ __forceinline__ int lds_byte(int r, int c) { const int st = (r >> 4) * 2 + (c >> 5), rr = r & 15, cc = c & 31, ob = rr * 64 + cc * 2; return st * 1024 + (ob ^ (((ob >> 9) & 1) << 5)); }
__host__ __device__ __forceinline__ void stage_rc(int b, int& R, int& C) { const int st = b / 1024, sb = b % 1024, swz = sb ^ (((sb >> 9) & 1) << 5); R = (st >> 1) * 16 + swz / 64; C = (st & 1) * 32 + (swz % 64) / 2; }
__host__ __device__ __forceinline__ int perm32(int rho) { const int n = rho >> 4, i = rho & 15; return 8 * (i >> 2) + 4 * n + (i & 3); }

struct Unit { int pm, pn; };
struct Gemm { const bf16_t* A; const bf16_t* Bt; int M, N, K; int a_tile_rows; };

struct StaticOrder {
    int nM, nN, nwg, G, c;
    __host__ __device__ void init(int M, int N, int G_, int c_) { nM = M / BM; nN = N / BM; nwg = nM * nN; G = G_; c = c_; }
    __host__ __device__ bool next(int i, Unit& u) const {
        const long L = (long)i * G + c; if (L >= nwg) return false;
        int wgid = (int)L; { const int q = nwg / NXCD, r = nwg % NXCD, xcd = wgid % NXCD, off = wgid / NXCD; wgid = (xcd < r ? xcd * (q + 1) : r * (q + 1) + (xcd - r) * q) + off; }
        const int nig = WGM * nN, gid = wgid / nig, fm = gid * WGM, gsz = (nM - fm) < WGM ? (nM - fm) : WGM;
        u.pm = fm + ((wgid % nig) % gsz); u.pn = (wgid % nig) / gsz; return true;
    }
    __device__ __forceinline__ void a_ready(const Unit&) const {}
    __device__ __forceinline__ void done(const Unit&) const {}
};

__device__ __forceinline__ unsigned cvt_pk_bf16(float lo, float hi) { unsigned r; asm volatile("v_cvt_pk_bf16_f32 %0, %1, %2" : "=v"(r) : "v"(lo), "v"(hi)); return r; }
typedef float f32x2 __attribute__((ext_vector_type(2))); typedef __bf16 bf16x2_t __attribute__((ext_vector_type(2)));
__device__ __forceinline__ unsigned cvtpk(float lo, float hi) { f32x2 v = {lo, hi}; bf16x2_t b = __builtin_convertvector(v, bf16x2_t); return __builtin_bit_cast(unsigned, b); }
constexpr int MTOK = 49152, MPROMPT = 16384, DMODEL = 1024, DFF_ = 2816;
__device__ __forceinline__ u32x4 pack8(const f32x4 a, const f32x4 b) { u32x4 w; w.x = cvtpk(a[0], a[1]); w.y = cvtpk(a[2], a[3]); w.z = cvtpk(b[0], b[1]); w.w = cvtpk(b[2], b[3]); return w; }

struct EpiProj {
    static constexpr bool PERM = true, AFTER_DRAIN = false;
    bf16_t* O; int ldc;
    __device__ __forceinline__ void operator()(f32x4 (&acc)[2][2][4][2], const Unit& u, int wr, int wc, int fr, int fq, int wid, int lane) const {
        const int row0 = u.pm * BM + wr * 64 + fr, col0 = u.pn * BM + wc * 32 + 8 * fq;
#pragma unroll
        for (int ai = 0; ai < 2; ++ai)
#pragma unroll
            for (int m = 0; m < 4; ++m) { bf16_t* rowp = O + (size_t)(row0 + ai * HALF + m * 16) * ldc + col0;
#pragma unroll
                for (int bj = 0; bj < 2; ++bj) *(u32x4*)(rowp + bj * HALF) = pack8(acc[ai][bj][m][0], acc[ai][bj][m][1]); }
    }
};
struct EpiOut {
    static constexpr bool PERM = true, AFTER_DRAIN = false;
    const float* xp; const float* xs; float* out; bf16_t* xb; float* ssq;
    __device__ __forceinline__ void operator()(f32x4 (&acc)[2][2][4][2], const Unit& u, int wr, int wc, int fr, int fq, int wid, int lane) const {
        const int col0 = u.pn * BM + wc * 32 + 8 * fq;
#pragma unroll
        for (int ai = 0; ai < 2; ++ai)
#pragma unroll
            for (int m = 0; m < 4; ++m) { const int gr = u.pm * BM + ai * HALF + wr * 64 + m * 16 + fr;
                const float* xr = (gr < MPROMPT ? xp + (size_t)gr * DMODEL : xs + (size_t)(gr - MPROMPT) * DMODEL) + col0;
                float s = 0.f;
#pragma unroll
                for (int bj = 0; bj < 2; ++bj) { f32x4 a = *(const f32x4*)(xr + bj * HALF), b = *(const f32x4*)(xr + bj * HALF + 4);
                    a += acc[ai][bj][m][0]; b += acc[ai][bj][m][1];
                    s += (a[0] * a[0] + a[1] * a[1]) + (a[2] * a[2] + a[3] * a[3]) + (b[0] * b[0] + b[1] * b[1]) + (b[2] * b[2] + b[3] * b[3]);
                    float* o = out + (size_t)gr * DMODEL + col0 + bj * HALF; *(f32x4*)o = a; *(f32x4*)(o + 4) = b;
                    *(u32x4*)(xb + (size_t)gr * DMODEL + col0 + bj * HALF) = pack8(a, b); }
                s += __shfl_xor(s, 16); s += __shfl_xor(s, 32);
                if (fq == 0) unsafeAtomicAdd(ssq + gr, s);
                asm volatile("" ::: "memory"); }
    }
};
struct EpiDown {
    static constexpr bool PERM = true, AFTER_DRAIN = false;
    float* out;
    __device__ __forceinline__ void operator()(f32x4 (&acc)[2][2][4][2], const Unit& u, int wr, int wc, int fr, int fq, int wid, int lane) const {
        const int col0 = u.pn * BM + wc * 32 + 8 * fq;
#pragma unroll
        for (int ai = 0; ai < 2; ++ai)
#pragma unroll
            for (int m = 0; m < 4; ++m) { const int gr = u.pm * BM + ai * HALF + wr * 64 + m * 16 + fr;
                float* o = out + (size_t)gr * DMODEL + col0;
#pragma unroll
                for (int bj = 0; bj < 2; ++bj) { f32x4 a = *(const f32x4*)(o + bj * HALF), b = *(const f32x4*)(o + bj * HALF + 4);
                    a += acc[ai][bj][m][0]; b += acc[ai][bj][m][1]; *(f32x4*)(o + bj * HALF) = a; *(f32x4*)(o + bj * HALF + 4) = b; }
                asm volatile("" ::: "memory"); }
    }
};
__device__ __forceinline__ bool seq_first(int gr) { return gr == 0 || (gr >= MPROMPT && (gr & 2047) == 0); }
__device__ __forceinline__ bool seq_last(int gr) { return gr >= MPROMPT - 1 && (gr & 2047) == 2047; }
struct EpiUp {
    static constexpr bool PERM = true, AFTER_DRAIN = false;
    bf16_t* H; const float* ssq; const float* cw; const float* cb; PG8_LAS float* xch;
    __device__ __forceinline__ void operator()(f32x4 (&acc)[2][2][4][2], const Unit& u, int wr, int wc, int fr, int fq, int wid, int lane) const {
        const int lr0 = wr * 64 + fr, gr0 = 254 * u.pm - 1 + lr0;
#pragma unroll
        for (int ai = 0; ai < 2; ++ai)
#pragma unroll
            for (int m = 0; m < 4; ++m) { int gr = gr0 + ai * HALF + m * 16; gr = gr < 0 ? 0 : (gr > MTOK - 1 ? MTOK - 1 : gr);
                const float rs = __builtin_amdgcn_rsqf(ssq[gr] * (1.0f / DMODEL) + 1e-6f);
#pragma unroll
                for (int bj = 0; bj < 2; ++bj)
#pragma unroll
                    for (int n = 0; n < 2; ++n) acc[ai][bj][m][n] *= rs; }
#pragma unroll
        for (int ai = 0; ai < 2; ++ai) {
            if (fr == 0) { PG8_LAS float* p = xch + ((wid * 2 + ai) * 2 + 0) * 64 + 8 * fq;
#pragma unroll
                for (int bj = 0; bj < 2; ++bj)
#pragma unroll
                    for (int n = 0; n < 2; ++n) *(PG8_LAS f32x4*)(p + bj * 32 + 4 * n) = acc[ai][bj][0][n]; }
            if (fr == 15) { PG8_LAS float* p = xch + ((wid * 2 + ai) * 2 + 1) * 64 + 8 * fq;
#pragma unroll
                for (int bj = 0; bj < 2; ++bj)
#pragma unroll
                    for (int n = 0; n < 2; ++n) *(PG8_LAS f32x4*)(p + bj * 32 + 4 * n) = acc[ai][bj][3][n]; }
        }
        asm volatile("s_waitcnt lgkmcnt(0)" ::: "memory"); __builtin_amdgcn_s_barrier(); asm volatile("" ::: "memory");
        const int ow = (1 - wr) * 4 + wc;
        const int srcP = ((lane & 48) | ((fr + 15) & 15)) * 4, srcN = ((lane & 48) | ((fr + 1) & 15)) * 4;
        const int ch0 = 128 * u.pn + 32 * wc + 8 * fq;
#pragma unroll
        for (int n = 0; n < 2; ++n) {
            f32x4 w0[2], w1[2], w2[2], bb[2];
#pragma unroll
            for (int bj = 0; bj < 2; ++bj) { const int ch = ch0 + 4 * n + bj * DFF_;
                w0[bj] = *(const f32x4*)(cw + ch); w1[bj] = *(const f32x4*)(cw + 2 * DFF_ + ch); w2[bj] = *(const f32x4*)(cw + 4 * DFF_ + ch); bb[bj] = *(const f32x4*)(cb + ch); }
#pragma unroll
            for (int ai = 0; ai < 2; ++ai) {
                const int aiT = wr == 1 ? ai : ai - 1, aiB = wr == 0 ? ai : ai + 1;
#pragma unroll
                for (int m = 0; m < 4; ++m) {
                    const int lr = lr0 + ai * HALF + m * 16, gr = gr0 + ai * HALF + m * 16;
                    const bool first = seq_first(gr), last = seq_last(gr);
                    f32x4 c[2];
#pragma unroll
                    for (int bj = 0; bj < 2; ++bj) {
                        const f32x4 cur = acc[ai][bj][m][n];
                        f32x4 pv, nx;
#pragma unroll
                        for (int e = 0; e < 4; ++e) {
                            const float sP = (m > 0 && fr == 15) ? acc[ai][bj][m > 0 ? m - 1 : 0][n][e] : cur[e];
                            const float sN = (m < 3 && fr == 0) ? acc[ai][bj][m < 3 ? m + 1 : 3][n][e] : cur[e];
                            pv[e] = __builtin_bit_cast(float, __builtin_amdgcn_ds_bpermute(srcP, __builtin_bit_cast(int, sP)));
                            nx[e] = __builtin_bit_cast(float, __builtin_amdgcn_ds_bpermute(srcN, __builtin_bit_cast(int, sN))); }
                        if (m == 0) { const f32x4 top = (aiT >= 0) ? *(const PG8_LAS f32x4*)(xch + ((ow * 2 + (aiT < 0 ? 0 : aiT)) * 2 + 1) * 64 + 8 * fq + bj * 32 + 4 * n) : (f32x4){0.f, 0.f, 0.f, 0.f}; if (fr == 0) pv = top; }
                        if (m == 3) { const f32x4 bot = (aiB <= 1) ? *(const PG8_LAS f32x4*)(xch + ((ow * 2 + (aiB > 1 ? 1 : aiB)) * 2 + 0) * 64 + 8 * fq + bj * 32 + 4 * n) : (f32x4){0.f, 0.f, 0.f, 0.f}; if (fr == 15) nx = bot; }
                        if (first) pv = (f32x4){0.f, 0.f, 0.f, 0.f};
                        if (last) nx = (f32x4){0.f, 0.f, 0.f, 0.f};
                        c[bj] = bb[bj] + w0[bj] * pv + w1[bj] * cur + w2[bj] * nx;
                    }
                    f32x4 hv;
#pragma unroll
                    for (int e = 0; e < 4; ++e) { const float g = c[0][e]; hv[e] = g * __builtin_amdgcn_rcpf(1.0f + __builtin_amdgcn_exp2f(-1.4426950408889634f * g)) * c[1][e]; }
                    f32x2 pk; pk.x = __builtin_bit_cast(float, cvtpk(hv[0], hv[1])); pk.y = __builtin_bit_cast(float, cvtpk(hv[2], hv[3]));
                    if (lr >= 1 && lr <= 254 && gr < MTOK) *(f32x2*)(H + (size_t)gr * DFF_ + ch0 + 4 * n) = pk;
                    asm volatile("" ::: "memory");
                }
            }
        }
    }
};
template <class Epi, class Sched, bool ALIGN_EPI = false, bool SP2 = false>
__device__ __forceinline__ void gemm_phase(PG8_LAS unsigned char* lds, const Gemm g, const Sched& S, const Epi& E) {
    const int tid = threadIdx.x, wid = __builtin_amdgcn_readfirstlane(tid >> 6), lane = tid & 63, wr = wid >> 2, wc = wid & 3, fr = lane & 15, fq = lane >> 4;
    const int K = g.K, nt = K / BK;
    unsigned voffA[2], voffB[2];
#pragma unroll
    for (int i = 0; i < 2; ++i) { int R, C; stage_rc(tid * 16 + i * 8192, R, C); const int Rb = Epi::PERM ? ((R & ~31) + perm32(R & 31)) : R;
        voffA[i] = (unsigned)(R * K + C) * 2u; voffB[i] = (unsigned)(Rb * K + C) * 2u; }
    const size_t kstep = (size_t)(BK * 2);
    const size_t hstep = (size_t)HALF * K * 2;
    const size_t tstep = 2 * hstep; const size_t tstepA = (size_t)g.a_tile_rows * K * 2;
    const unsigned ldsw = (unsigned)wid * 1024u;
    const int aoff = lds_byte(wr * 64 + fr, fq * 8), boff = lds_byte(wc * 32 + fr, fq * 8);
#define PG8_SA(b, h) (((b) * 2 + (h)) * HTB)
#define PG8_SB(b, h) ((4 + (b) * 2 + (h)) * HTB)
#define PG8_STAGE(bufoff, gbase, voff) do { _Pragma("unroll") for (int _i = 0; _i < 2; ++_i) \
        __builtin_amdgcn_global_load_lds((const unsigned*)((const char*)(gbase) + (voff)[_i]), (PG8_LAS unsigned*)(lds + (bufoff) + ldsw + _i * 8192), 16, 0, 0); } while (0)
#define PG8_LDA(dst, b, h) do { _Pragma("unroll") for (int m = 0; m < 4; ++m) _Pragma("unroll") for (int k = 0; k < 2; ++k) dst[m][k] = *(const PG8_LAS bf16x8*)(lds + PG8_SA(b, h) + aoff + m * 2048 + k * 1024); } while (0)
#define PG8_LDB(dst, b, h) do { _Pragma("unroll") for (int n = 0; n < 2; ++n) _Pragma("unroll") for (int k = 0; k < 2; ++k) dst[n][k] = *(const PG8_LAS bf16x8*)(lds + PG8_SB(b, h) + boff + n * 2048 + k * 1024); } while (0)
#define PG8_MMA(ai, bj, At, Bt) do { __builtin_amdgcn_s_setprio(1); _Pragma("unroll") for (int m = 0; m < 4; ++m) _Pragma("unroll") for (int n = 0; n < 2; ++n) _Pragma("unroll") for (int k = 0; k < 2; ++k) \
        acc[ai][bj][m][n] = __builtin_amdgcn_mfma_f32_16x16x32_bf16(Bt[n][k], At[m][k], acc[ai][bj][m][n], 0, 0, 0); __builtin_amdgcn_s_setprio(0); } while (0)
#define PG8_WAIT_V(n) asm volatile("s_waitcnt vmcnt(" #n ")" ::: "memory")
#define PG8_WAIT_L(n) asm volatile("s_waitcnt lgkmcnt(" #n ")" ::: "memory")
#define PG8_BAR __builtin_amdgcn_s_barrier()
#define PG8_SCHED __builtin_amdgcn_sched_barrier(0)
    Unit cur, nxt; int ui = 0;
    if (!S.next(0, cur)) return;
    f32x4 acc[2][2][4][2];
#pragma unroll
    for (int a = 0; a < 2; ++a)
#pragma unroll
        for (int b = 0; b < 2; ++b)
#pragma unroll
            for (int m = 0; m < 4; ++m)
#pragma unroll
                for (int n = 0; n < 2; ++n) acc[a][b][m][n] = (f32x4){0.f, 0.f, 0.f, 0.f};
    bf16x8 At[4][2], B0[2][2], B1[2][2];
    const char* cA = (const char*)g.A + (size_t)cur.pm * tstepA; const char* cB = (const char*)g.Bt + (size_t)cur.pn * tstep;
    S.a_ready(cur);
    if constexpr (SP2) {
        PG8_STAGE(PG8_SB(0, 0), cB, voffB); PG8_STAGE(PG8_SB(0, 1), cB + hstep, voffB); PG8_STAGE(PG8_SA(0, 0), cA, voffA); PG8_STAGE(PG8_SA(0, 1), cA + hstep, voffA);
        if (wr == 1) PG8_BAR;
        PG8_WAIT_V(2); PG8_BAR;
        PG8_STAGE(PG8_SB(1, 0), cB + kstep, voffB); PG8_STAGE(PG8_SA(1, 0), cA + kstep, voffA); PG8_STAGE(PG8_SB(1, 1), cB + hstep + kstep, voffB);
        PG8_WAIT_V(6); PG8_BAR;
    } else {
        PG8_STAGE(PG8_SB(0, 0), cB, voffB); PG8_STAGE(PG8_SA(0, 0), cA, voffA); PG8_STAGE(PG8_SB(0, 1), cB + hstep, voffB); PG8_STAGE(PG8_SA(0, 1), cA + hstep, voffA);
        if (wr == 1) PG8_BAR;
        PG8_WAIT_V(4); PG8_BAR;
        PG8_STAGE(PG8_SB(1, 0), cB + kstep, voffB); PG8_STAGE(PG8_SA(1, 0), cA + kstep, voffA); PG8_STAGE(PG8_SB(1, 1), cB + hstep + kstep, voffB);
        PG8_WAIT_V(6); PG8_BAR;
    }
    for (;;) {
        const bool has_next = S.next(ui + 1, nxt);
        const char* nA = has_next ? (const char*)g.A + (size_t)nxt.pm * tstepA : cA; const char* nB = has_next ? (const char*)g.Bt + (size_t)nxt.pn * tstep : cB;
        for (int t = 0; t < nt; t += 2) {
            const bool last = (t == nt - 2);
            const char* a1 = cA + (size_t)(t + 1) * kstep;
            const char* a2 = last ? nA : cA + (size_t)(t + 2) * kstep; const char* b2 = last ? nB : cB + (size_t)(t + 2) * kstep;
            const char* a3 = a2 + kstep; const char* b3 = b2 + kstep;
            if (last && has_next) S.a_ready(nxt);
            if constexpr (SP2) {
            PG8_LDB(B0, 0, 0); PG8_LDB(B1, 0, 1); PG8_SCHED; PG8_LDA(At, 0, 0); PG8_STAGE(PG8_SA(1, 1), a1 + hstep, voffA);
            PG8_WAIT_V(8); PG8_WAIT_L(0); PG8_BAR; PG8_MMA(0, 0, At, B0); PG8_MMA(0, 1, At, B1); PG8_BAR; PG8_SCHED;
            PG8_LDA(At, 0, 1); PG8_STAGE(PG8_SB(0, 0), b2, voffB); PG8_STAGE(PG8_SB(0, 1), b2 + hstep, voffB); PG8_STAGE(PG8_SA(0, 0), a2, voffA);
            PG8_WAIT_V(8); PG8_WAIT_L(0); PG8_BAR; PG8_MMA(1, 0, At, B0); PG8_MMA(1, 1, At, B1); PG8_BAR; PG8_SCHED;
            PG8_LDB(B0, 1, 0); PG8_LDB(B1, 1, 1); PG8_SCHED; PG8_LDA(At, 1, 0); PG8_STAGE(PG8_SA(0, 1), a2 + hstep, voffA);
            PG8_WAIT_V(8); PG8_WAIT_L(0); PG8_BAR; PG8_MMA(0, 0, At, B0); PG8_MMA(0, 1, At, B1); PG8_BAR; PG8_SCHED;
            PG8_LDA(At, 1, 1); PG8_STAGE(PG8_SB(1, 0), b3, voffB); PG8_STAGE(PG8_SB(1, 1), b3 + hstep, voffB); PG8_STAGE(PG8_SA(1, 0), a3, voffA);
            PG8_WAIT_V(8); PG8_WAIT_L(0); PG8_BAR; PG8_MMA(1, 0, At, B0); PG8_MMA(1, 1, At, B1); PG8_BAR; PG8_SCHED;
            } else {
            PG8_LDB(B0, 0, 0); PG8_SCHED; PG8_LDA(At, 0, 0); PG8_STAGE(PG8_SA(1, 1), a1 + hstep, voffA);
            PG8_WAIT_L(8); PG8_BAR; PG8_WAIT_L(0); PG8_MMA(0, 0, At, B0); PG8_BAR; PG8_SCHED;
            PG8_LDB(B1, 0, 1); PG8_STAGE(PG8_SB(0, 0), b2, voffB);
            PG8_BAR; PG8_WAIT_L(0); PG8_MMA(0, 1, At, B1); PG8_BAR;
            PG8_LDA(At, 0, 1); PG8_STAGE(PG8_SA(0, 0), a2, voffA);
            PG8_BAR; PG8_WAIT_L(0); PG8_MMA(1, 0, At, B0); PG8_BAR; PG8_SCHED;
            PG8_STAGE(PG8_SB(0, 1), b2 + hstep, voffB);
            PG8_WAIT_V(6); PG8_BAR; PG8_MMA(1, 1, At, B1); PG8_BAR;
            PG8_LDB(B0, 1, 0); PG8_SCHED; PG8_LDA(At, 1, 0); PG8_STAGE(PG8_SA(0, 1), a2 + hstep, voffA);
            PG8_WAIT_L(8); PG8_BAR; PG8_WAIT_L(0); PG8_MMA(0, 0, At, B0); PG8_BAR; PG8_SCHED;
            PG8_LDB(B1, 1, 1); PG8_STAGE(PG8_SB(1, 0), b3, voffB);
            PG8_BAR; PG8_WAIT_L(0); PG8_MMA(0, 1, At, B1); PG8_BAR;
            PG8_LDA(At, 1, 1); PG8_STAGE(PG8_SA(1, 0), a3, voffA);
            PG8_BAR; PG8_WAIT_L(0); PG8_MMA(1, 0, At, B0); PG8_BAR; PG8_SCHED;
            PG8_STAGE(PG8_SB(1, 1), b3 + hstep, voffB);
            PG8_WAIT_V(6); PG8_BAR; PG8_MMA(1, 1, At, B1); PG8_BAR;
            }
        }
        if constexpr (ALIGN_EPI) { if (wr == 0) PG8_BAR; }
        if constexpr (!Epi::AFTER_DRAIN) { E(acc, cur, wr, wc, fr, fq, wid, lane); S.done(cur); }
        if (!has_next) break;
#pragma unroll
        for (int a = 0; a < 2; ++a)
#pragma unroll
            for (int b = 0; b < 2; ++b)
#pragma unroll
                for (int m = 0; m < 4; ++m)
#pragma unroll
                    for (int n = 0; n < 2; ++n) acc[a][b][m][n] = (f32x4){0.f, 0.f, 0.f, 0.f};
        cur = nxt; cA = nA; cB = nB; ++ui;
        if constexpr (ALIGN_EPI) { if (wr == 1) PG8_BAR; }
    }
    PG8_WAIT_V(0);
    if constexpr (!ALIGN_EPI) { if (wr == 0) PG8_BAR; }
    PG8_BAR;
    if constexpr (Epi::AFTER_DRAIN) { E.fused(acc, cur, wr, wc, fr, fq, lds, wid, lane); S.done(cur); }
#undef PG8_SA
#undef PG8_SB
#undef PG8_STAGE
#undef PG8_LDA
#undef PG8_LDB
#undef PG8_MMA
#undef PG8_WAIT_V
#undef PG8_WAIT_L
#undef PG8_BAR
#undef PG8_SCHED
}
}
#ifndef PG8_SP2
#define PG8_SP2 true
#endif
#ifndef PG8_ALIGN
#define PG8_ALIGN true
#endif

constexpr int NWAVES = 8;
constexpr int DM = 1024, M = 49152, MP = 16384, INW = 2304, DFF = 2816, UPW = 5632;
constexpr int QA_OFF = 0, KA_OFF = 512, VA_OFF = 1024, QB_OFF = 1536, KB_OFF = 2048, VB_OFF = 2176;
constexpr int UP_TILES_M = 194;
constexpr float EPS = 1e-6f, LOG2E = 1.4426950408889634f;

constexpr size_t MiB = 1u << 20;
constexpr size_t WS_SSQ = 0;
constexpr size_t WS_WIN = 2 * MiB, WS_WOUT = 7 * MiB, WS_WUP = 9 * MiB, WS_WDN = 20 * MiB;
constexpr size_t WS_XN = 32 * MiB;
constexpr size_t WS_PROJ = 130 * MiB;
constexpr size_t WS_OA = 346 * MiB;
constexpr size_t WS_H = 226 * MiB;
constexpr size_t WS_LA = 490 * MiB;
constexpr size_t WS_END = 496 * MiB;
static_assert(WS_XN + (size_t)(M + 256) * DM * 2 <= WS_PROJ && WS_PROJ + (size_t)M * INW * 2 <= WS_OA && WS_OA + 3 * (size_t)M * 512 * 2 <= WS_LA && WS_H + (size_t)M * DFF * 2 <= WS_LA && WS_PROJ + (size_t)M * DM * 2 <= WS_H, "d_ws map");

constexpr int RING_BYTES = 131072, XCH_OFF = RING_BYTES, LDS_BYTES = 147456;

#define LAS __attribute__((address_space(3)))
typedef unsigned short bf16;
typedef unsigned v4u __attribute__((ext_vector_type(4)));
typedef float f32x4 __attribute__((ext_vector_type(4)));
typedef float f32x16 __attribute__((ext_vector_type(16)));
typedef short bf16x8 __attribute__((ext_vector_type(8)));
typedef short s16x4 __attribute__((ext_vector_type(4)));
using pg8::cvtpk;
__device__ __forceinline__ float bf_lo(unsigned w) { return __uint_as_float(w << 16); }
__device__ __forceinline__ float bf_hi(unsigned w) { return __uint_as_float(w & 0xffff0000u); }
__device__ __forceinline__ float wave_sum(float v) {
#pragma unroll
    for (int o = 1; o < 64; o <<= 1) v += __shfl_xor(v, o);
    return v;
}
__device__ __forceinline__ float wave_max(float v) {
#pragma unroll
    for (int o = 1; o < 64; o <<= 1) v = fmaxf(v, __shfl_xor(v, o));
    return v;
}

template <int MAP  >
__device__ __forceinline__ void p0_transpose_item(const float* W, int K, int N, bf16* WT, const float* kgain, LAS float* scr, int item, int lane) {
    const int nblk = N / 32, kb = item / nblk, nb = item % nblk, k0 = 64 * kb, n0 = 32 * nb;
#pragma unroll 8
    for (int i = 0; i < 32; ++i) { const int kk = 2 * i + (lane >> 5); float v = W[(size_t)(k0 + kk) * N + n0 + (lane & 31)]; if (kgain) v *= kgain[k0 + kk]; scr[kk * 33 + (lane & 31)] = v; }
    asm volatile("s_waitcnt lgkmcnt(0)" ::: "memory");
    const int c = lane & 7;
    int r0 = n0;
    if (MAP == 1) r0 = n0 < DFF ? ((n0 >> 7) * 256 + (n0 & 127)) : ((((n0 - DFF) >> 7) * 256) + 128 + ((n0 - DFF) & 127));
#pragma unroll
    for (int j = 0; j < 4; ++j) { const int n = (lane >> 3) + 8 * j; const LAS float* s = scr + (8 * c) * 33 + n;
        v4u o; o.x = cvtpk(s[0 * 33], s[1 * 33]); o.y = cvtpk(s[2 * 33], s[3 * 33]); o.z = cvtpk(s[4 * 33], s[5 * 33]); o.w = cvtpk(s[6 * 33], s[7 * 33]);
        *(v4u*)(WT + (size_t)(r0 + n) * K + k0 + 8 * c) = o; }
    asm volatile("s_waitcnt lgkmcnt(0)" ::: "memory");
}
__device__ __forceinline__ void rms_row_to_bf16(const float* xrow, const float* g, bf16* orow, int lane) {
    const f32x4* xr = (const f32x4*)xrow + lane; const f32x4* gr = (const f32x4*)g + lane;
    f32x4 v[4]; float s = 0.f;
#pragma unroll
    for (int j = 0; j < 4; ++j) { v[j] = xr[64 * j]; s += (v[j].x * v[j].x + v[j].y * v[j].y) + (v[j].z * v[j].z + v[j].w * v[j].w); }
    const float rstd = __builtin_amdgcn_rsqf(wave_sum(s) * (1.f / DM) + EPS);
    unsigned long long* o8 = (unsigned long long*)orow + lane;
#pragma unroll
    for (int j = 0; j < 4; ++j) { const f32x4 gg = gr[64 * j]; o8[64 * j] = (unsigned long long)cvtpk(v[j].x * rstd * gg.x, v[j].y * rstd * gg.y) | ((unsigned long long)cvtpk(v[j].z * rstd * gg.z, v[j].w * rstd * gg.w) << 32); }
}

template <int NKEYS, int NTHR>
__device__ __forceinline__ void stage_kv(LAS unsigned char* Kl, LAS unsigned char* Vl, const bf16* proj, int kcol, int vcol, int tok0, int dshift, int kidx0, int Ls, const float* gk, int t) {
    constexpr int NIT = NKEYS * 8 / NTHR;
    const int c = t & 7;
    const f32x4 g0 = *(const f32x4*)(gk + 8 * c), g1 = *(const f32x4*)(gk + 8 * c + 4);
    v4u kr[NIT], vr[NIT];
#pragma unroll
    for (int it = 0; it < NIT; ++it) { const int rho = (it * NTHR + t) >> 3, kidx = kidx0 + rho; const bool ok = (unsigned)kidx < (unsigned)Ls;
        const bf16* rowp = proj + (size_t)(tok0 + ((ok ? kidx : 0) << dshift)) * INW + 8 * c;
        kr[it] = *(const v4u*)(rowp + kcol); vr[it] = *(const v4u*)(rowp + vcol);
        if (!ok) { kr[it] = (v4u){0u, 0u, 0u, 0u}; vr[it] = (v4u){0u, 0u, 0u, 0u}; } }
#pragma unroll
    for (int it = 0; it < NIT; ++it) { const int rho = (it * NTHR + t) >> 3;
        float f[8] = {bf_lo(kr[it].x), bf_hi(kr[it].x), bf_lo(kr[it].y), bf_hi(kr[it].y), bf_lo(kr[it].z), bf_hi(kr[it].z), bf_lo(kr[it].w), bf_hi(kr[it].w)};
        float ss = (f[0] * f[0] + f[1] * f[1]) + (f[2] * f[2] + f[3] * f[3]) + (f[4] * f[4] + f[5] * f[5]) + (f[6] * f[6] + f[7] * f[7]);
        ss += __shfl_xor(ss, 1); ss += __shfl_xor(ss, 2); ss += __shfl_xor(ss, 4);
        const float rs = __builtin_amdgcn_rsqf(ss * (1.f / 64.f) + EPS);
        v4u o; o.x = cvtpk(f[0] * rs * g0.x, f[1] * rs * g0.y); o.y = cvtpk(f[2] * rs * g0.z, f[3] * rs * g0.w); o.z = cvtpk(f[4] * rs * g1.x, f[5] * rs * g1.y); o.w = cvtpk(f[6] * rs * g1.z, f[7] * rs * g1.w);
        *(LAS v4u*)(Kl + rho * 128 + 16 * (c ^ ((rho >> 1) & 7))) = o;
        *(LAS v4u*)(Vl + (c >> 2) * (NKEYS * 64) + rho * 64 + (c & 3) * 16) = vr[it]; }
}
__device__ __forceinline__ void load_q(bf16x8 (&qf)[4], const bf16* qrow  , const float* gq, int lane) {
    const int hi = lane >> 5;
    v4u raw[4]; float ss = 0.f;
#pragma unroll
    for (int d0 = 0; d0 < 4; ++d0) { raw[d0] = *(const v4u*)(qrow + 16 * d0 + 8 * hi);
        const float a0 = bf_lo(raw[d0].x), a1 = bf_hi(raw[d0].x), a2 = bf_lo(raw[d0].y), a3 = bf_hi(raw[d0].y), a4 = bf_lo(raw[d0].z), a5 = bf_hi(raw[d0].z), a6 = bf_lo(raw[d0].w), a7 = bf_hi(raw[d0].w);
        ss += (a0 * a0 + a1 * a1) + (a2 * a2 + a3 * a3) + (a4 * a4 + a5 * a5) + (a6 * a6 + a7 * a7); }
    ss += __shfl_xor(ss, 32);
    const float rs = __builtin_amdgcn_rsqf(ss * (1.f / 64.f) + EPS) * (0.125f * LOG2E);
#pragma unroll
    for (int d0 = 0; d0 < 4; ++d0) { const f32x4 g0 = *(const f32x4*)(gq + 16 * d0 + 8 * hi), g1 = *(const f32x4*)(gq + 16 * d0 + 8 * hi + 4);
        v4u o; o.x = cvtpk(bf_lo(raw[d0].x) * rs * g0.x, bf_hi(raw[d0].x) * rs * g0.y); o.y = cvtpk(bf_lo(raw[d0].y) * rs * g0.z, bf_hi(raw[d0].y) * rs * g0.w);
        o.z = cvtpk(bf_lo(raw[d0].z) * rs * g1.x, bf_hi(raw[d0].z) * rs * g1.y); o.w = cvtpk(bf_lo(raw[d0].w) * rs * g1.z, bf_hi(raw[d0].w) * rs * g1.w);
        qf[d0] = __builtin_bit_cast(bf16x8, o); }
}
typedef short v4i16_t __attribute__((ext_vector_type(4)));
__device__ __forceinline__ s16x4 vtr(const LAS unsigned char* p) { return __builtin_bit_cast(s16x4, __builtin_amdgcn_ds_read_tr16_b64_v4i16((LAS v4i16_t*)p)); }
template <int NT, int R>
__device__ __forceinline__ void attn_task(const LAS unsigned char* Kl, const LAS unsigned char* Vl, int vhs, int row0, int kidx_t0, int Ls, const bf16x8 (&qf)[4], float slope2, float negM, f32x16 (&o)[2], float& l, int lane) {
    const int q = lane & 31, hi = lane >> 5;
    const int vlane = (4 * hi + ((lane & 15) >> 2)) * 64 + (16 * ((lane >> 4) & 1) + 4 * (lane & 3)) * 2;
#pragma unroll 1
    for (int j = 0; j < NT; ++j) {
        const int rb = row0 + 32 * j, krow = rb + q, sw = (krow >> 1) & 7;
        const LAS unsigned char* kp = Kl + krow * 128;
        f32x16 s = {0.f, 0.f, 0.f, 0.f, 0.f, 0.f, 0.f, 0.f, 0.f, 0.f, 0.f, 0.f, 0.f, 0.f, 0.f, 0.f};
#pragma unroll
        for (int d0 = 0; d0 < 4; ++d0) { const bf16x8 kf = *(const LAS bf16x8*)(kp + 16 * ((2 * d0 + hi) ^ sw)); s = __builtin_amdgcn_mfma_f32_32x32x16_bf16(kf, qf[d0], s, 0, 0, 0); }
        float pr[16];
#pragma unroll
        for (int r = 0; r < 16; ++r) { const int cr = (r & 3) + 8 * (r >> 2) + 4 * hi, rel = 32 * j + cr - R - q, kidx = kidx_t0 + 32 * j + cr;
            const int arel = rel < 0 ? -rel : rel;
            const float t = s[r] - slope2 * (float)arel + negM;
            const bool ok = (arel <= R) && ((unsigned)kidx < (unsigned)Ls);
            const float p = ok ? __builtin_amdgcn_exp2f(t) : 0.f; l += p; pr[r] = p; }
        v4u w0, w1; w0.x = cvtpk(pr[0], pr[1]); w0.y = cvtpk(pr[2], pr[3]); w0.z = cvtpk(pr[4], pr[5]); w0.w = cvtpk(pr[6], pr[7]);
        w1.x = cvtpk(pr[8], pr[9]); w1.y = cvtpk(pr[10], pr[11]); w1.z = cvtpk(pr[12], pr[13]); w1.w = cvtpk(pr[14], pr[15]);
        const bf16x8 pa0 = __builtin_bit_cast(bf16x8, w0), pa1 = __builtin_bit_cast(bf16x8, w1);
        const LAS unsigned char* vp = Vl + rb * 64 + vlane;
#pragma unroll
        for (int dh = 0; dh < 2; ++dh)
#pragma unroll
            for (int s2 = 0; s2 < 2; ++s2) { const LAS unsigned char* vq = vp + dh * vhs + s2 * 16 * 64; const s16x4 lo = vtr(vq), h4 = vtr(vq + 8 * 64);
                const bf16x8 vf = (bf16x8){lo[0], lo[1], lo[2], lo[3], h4[0], h4[1], h4[2], h4[3]};
                o[dh] = __builtin_amdgcn_mfma_f32_32x32x16_bf16(s2 ? pa1 : pa0, vf, o[dh], 0, 0, 0); }
    }
}
__device__ __forceinline__ void store_partial(const f32x16 (&o)[2], float l, bf16* OB, float* LB, int tokq0, int dshift, int h, int lane) {
    const int hi = lane >> 5, d = lane & 31;
    l += __shfl_xor(l, 32);
    if (hi == 0) LB[(size_t)(tokq0 + (d << dshift)) * 8 + h] = l;
#pragma unroll
    for (int r = 0; r < 16; ++r) { const int qq = (r & 3) + 8 * (r >> 2) + 4 * hi; bf16* p = OB + (size_t)(tokq0 + (qq << dshift)) * 512 + h * 64 + d;
        p[0] = (bf16)(cvtpk(o[0][r], 0.f) & 0xffffu); p[32] = (bf16)(cvtpk(o[1][r], 0.f) & 0xffffu); }
}

struct Args { const float* in[17]; float* out; unsigned char* ws; };
__global__ void __launch_bounds__(NWAVES * 64, 2) fwd_megakernel(Args args) {
    extern __shared__ __attribute__((aligned(16))) unsigned char lds_raw[];
    cg::grid_group grid = cg::this_grid();
    LAS unsigned char* lds = (LAS unsigned char*)lds_raw;
    const int tid = threadIdx.x, lane = tid & 63, wave = __builtin_amdgcn_readfirstlane(tid >> 6);
    const int G = gridDim.x, bx = blockIdx.x;
    unsigned char* ws = args.ws;
    const float* xp = args.in[0]; const float* xs = args.in[1]; const float* norm1 = args.in[2]; const float* w_in = args.in[3];
    const float* qna = args.in[4]; const float* kna = args.in[5]; const float* qnb = args.in[6]; const float* knb = args.in[7]; const float* sinkb = args.in[8];
    const float* ona = args.in[9]; const float* onb = args.in[10]; const float* w_out = args.in[11]; const float* norm2 = args.in[12]; const float* w_up = args.in[13];
    const float* conv_w = args.in[14]; const float* conv_b = args.in[15]; const float* w_down = args.in[16];
    float* out = args.out;
    float* SSQ = (float*)(ws + WS_SSQ);
    bf16* WIN = (bf16*)(ws + WS_WIN); bf16* WOUT = (bf16*)(ws + WS_WOUT); bf16* WUP = (bf16*)(ws + WS_WUP); bf16* WDN = (bf16*)(ws + WS_WDN);
    bf16* XN = (bf16*)(ws + WS_XN) + DM;
    bf16* PROJ = (bf16*)(ws + WS_PROJ); bf16* Y = (bf16*)(ws + WS_PROJ);
    bf16* OA = (bf16*)(ws + WS_OA); bf16* OB = (bf16*)(ws + WS_XN) + DM; bf16* HB = (bf16*)(ws + WS_H);
    float* LA = (float*)(ws + WS_LA); float* LBp = LA + 3 * (size_t)M * 8;
    const int gw = bx * NWAVES + wave, NGW = G * NWAVES;

    {
        LAS float* scr = (LAS float*)(lds + wave * 16384);
        constexpr int I_IN = (DM / 64) * (INW / 32), I_OUT = (DM / 64) * (DM / 32), I_UP = (DM / 64) * (UPW / 32), I_DN = (DFF / 64) * (DM / 32);
        for (int it = gw; it < I_IN + I_OUT + I_UP + I_DN; it += NGW) {
            int r = it;
            if (r < I_IN) { p0_transpose_item<0>(w_in, DM, INW, WIN, nullptr, scr, r, lane); continue; } r -= I_IN;
            if (r < I_OUT) { p0_transpose_item<0>(w_out, DM, DM, WOUT, nullptr, scr, r, lane); continue; } r -= I_OUT;
            if (r < I_UP) { p0_transpose_item<1>(w_up, DM, UPW, WUP, norm2, scr, r, lane); continue; } r -= I_UP;
            p0_transpose_item<0>(w_down, DFF, DM, WDN, nullptr, scr, r, lane);
        }
        for (int m = gw; m < M; m += NGW) rms_row_to_bf16(m < MP ? xp + (size_t)m * DM : xs + (size_t)(m - MP) * DM, norm1, XN + (size_t)m * DM, lane);
        for (int i = bx * 512 + tid; i < M; i += G * 512) SSQ[i] = 0.f;
    }
    grid.sync();

    {
        pg8::Gemm g{XN, WIN, M, INW, DM, 256}; pg8::StaticOrder S; S.init(M, INW, G, bx);
        pg8::EpiProj E{PROJ, INW};
        pg8::gemm_phase<pg8::EpiProj, pg8::StaticOrder, PG8_ALIGN, PG8_SP2>(lds, g, S, E);
    }
    grid.sync();

    {
        const float gqa = fabsf(qna[lane]), gka = fabsf(kna[lane]);
        const float negMa = -8.0f * wave_max(gqa) * wave_max(gka) * LOG2E;
        const int half = wave >> 2, w4 = wave & 3, th = tid & 255;
        LAS unsigned char* Kl = lds + half * 65536; LAS unsigned char* Vl = Kl + 32768;
        for (int u = bx; u < 4608; u += G) {
            const int su = 2 * u + half, c = su / 3072, rem = su % 3072, h = rem / 384, gch = rem % 384;
            const int dshift = 2 * c;
            int seq0, S, lc; if (gch < 128) { seq0 = 0; S = 16384; lc = gch; } else { seq0 = MP + 2048 * ((gch - 128) >> 4); S = 2048; lc = (gch - 128) & 15; }
            const int Ls = S >> dshift, nch = Ls >> 7, res = lc / nch, cc = lc % nch;
            const int tok0 = seq0 + res;
            __syncthreads();
            stage_kv<256, 256>(Kl, Vl, PROJ, KA_OFF + h * 64, VA_OFF + h * 64, tok0, dshift, 128 * cc - 64, Ls, kna, th);
            const int iq0 = 128 * cc + 32 * w4;
            bf16x8 qf[4];
            load_q(qf, PROJ + (size_t)(tok0 + ((iq0 + (lane & 31)) << dshift)) * INW + QA_OFF + h * 64, qna, lane);
            __syncthreads();
            f32x16 o[2]; float l = 0.f;
#pragma unroll
            for (int r = 0; r < 16; ++r) { o[0][r] = 0.f; o[1][r] = 0.f; }
            const float slope2 = exp2f(-0.5f * (float)(h + 9)) * (float)(1 << dshift) * LOG2E;
            attn_task<5, 64>(Kl, Vl, 256 * 64, 32 * w4, iq0 - 64, Ls, qf, slope2, negMa, o, l, lane);
            store_partial(o, l, OA + (size_t)c * M * 512, LA + (size_t)c * M * 8, tok0 + (iq0 << dshift), dshift, h, lane);
        }
        const float gqb = fabsf(qnb[lane]), gkb = fabsf(knb[lane]);
        const float negMb = -8.0f * wave_max(gqb) * wave_max(gkb) * LOG2E;
        LAS unsigned char* Kb = lds; LAS unsigned char* Vb = lds + 40960;
        for (int u = bx; u < 1536; u += G) {
            const int g2 = u / 768, cb = u % 768;
            int seq0, S, lcb; if (cb < 256) { seq0 = 0; S = 16384; lcb = cb; } else { seq0 = MP + 2048 * ((cb - 256) >> 5); S = 2048; lcb = (cb - 256) & 31; }
            __syncthreads();
            stage_kv<320, 512>(Kb, Vb, PROJ, KB_OFF + g2 * 64, VB_OFF + g2 * 64, seq0, 0, 64 * lcb - 128, S, knb, tid);
            const int hb = 4 * g2 + (wave >> 1), iq0 = 64 * lcb + 32 * (wave & 1);
            bf16x8 qf[4];
            load_q(qf, PROJ + (size_t)(seq0 + iq0 + (lane & 31)) * INW + QB_OFF + hb * 64, qnb, lane);
            __syncthreads();
            f32x16 o[2]; float l = 0.f;
#pragma unroll
            for (int r = 0; r < 16; ++r) { o[0][r] = 0.f; o[1][r] = 0.f; }
            const float slope2 = exp2f(-0.5f * (float)(hb + 1)) * LOG2E;
            attn_task<9, 128>(Kb, Vb, 320 * 64, 32 * (wave & 1), iq0 - 128, S, qf, slope2, negMb, o, l, lane);
            store_partial(o, l, OB, LBp, seq0 + iq0, 0, hb, lane);
        }
        grid.sync();
        for (int m = gw; m < M; m += NGW) {
            const int hh = lane >> 3;
            float ya[8], yb[8];
            {
                float la = 0.f; float acc8[8] = {0.f, 0.f, 0.f, 0.f, 0.f, 0.f, 0.f, 0.f};
#pragma unroll
                for (int c = 0; c < 3; ++c) { const v4u w = *(const v4u*)(OA + ((size_t)c * M + m) * 512 + 8 * lane); la += LA[((size_t)c * M + m) * 8 + hh];
                    acc8[0] += bf_lo(w.x); acc8[1] += bf_hi(w.x); acc8[2] += bf_lo(w.y); acc8[3] += bf_hi(w.y); acc8[4] += bf_lo(w.z); acc8[5] += bf_hi(w.z); acc8[6] += bf_lo(w.w); acc8[7] += bf_hi(w.w); }
                const float inv = 1.0f / la;
#pragma unroll
                for (int i = 0; i < 8; ++i) ya[i] = acc8[i] * inv;
            }
            {
                const v4u w = *(const v4u*)(OB + (size_t)m * 512 + 8 * lane);
                const float lb = LBp[(size_t)m * 8 + hh] + __builtin_amdgcn_exp2f(sinkb[hh] * LOG2E + negMb);
                const float inv = 1.0f / lb;
                yb[0] = bf_lo(w.x) * inv; yb[1] = bf_hi(w.x) * inv; yb[2] = bf_lo(w.y) * inv; yb[3] = bf_hi(w.y) * inv; yb[4] = bf_lo(w.z) * inv; yb[5] = bf_hi(w.z) * inv; yb[6] = bf_lo(w.w) * inv; yb[7] = bf_hi(w.w) * inv;
            }
            float sa = 0.f, sb = 0.f;
#pragma unroll
            for (int i = 0; i < 8; ++i) { sa += ya[i] * ya[i]; sb += yb[i] * yb[i]; }
            const float ra = __builtin_amdgcn_rsqf(wave_sum(sa) * (1.f / 512.f) + EPS), rb = __builtin_amdgcn_rsqf(wave_sum(sb) * (1.f / 512.f) + EPS);
            const f32x4 ga0 = *(const f32x4*)(ona + 8 * lane), ga1 = *(const f32x4*)(ona + 8 * lane + 4), gb0 = *(const f32x4*)(onb + 8 * lane), gb1 = *(const f32x4*)(onb + 8 * lane + 4);
            v4u oa, ob;
            oa.x = cvtpk(ya[0] * ra * ga0.x, ya[1] * ra * ga0.y); oa.y = cvtpk(ya[2] * ra * ga0.z, ya[3] * ra * ga0.w); oa.z = cvtpk(ya[4] * ra * ga1.x, ya[5] * ra * ga1.y); oa.w = cvtpk(ya[6] * ra * ga1.z, ya[7] * ra * ga1.w);
            ob.x = cvtpk(yb[0] * rb * gb0.x, yb[1] * rb * gb0.y); ob.y = cvtpk(yb[2] * rb * gb0.z, yb[3] * rb * gb0.w); ob.z = cvtpk(yb[4] * rb * gb1.x, yb[5] * rb * gb1.y); ob.w = cvtpk(yb[6] * rb * gb1.z, yb[7] * rb * gb1.w);
            *(v4u*)(Y + (size_t)m * DM + 8 * lane) = oa; *(v4u*)(Y + (size_t)m * DM + 512 + 8 * lane) = ob;
        }
    }
    grid.sync();

    {
        pg8::Gemm g{Y, WOUT, M, DM, DM, 256}; pg8::StaticOrder S; S.init(M, DM, G, bx);
        pg8::EpiOut E{xp, xs, out, XN, SSQ};
        pg8::gemm_phase<pg8::EpiOut, pg8::StaticOrder, PG8_ALIGN, PG8_SP2>(lds, g, S, E);
    }
    grid.sync();

    {
        pg8::Gemm g{XN - DM, WUP, UP_TILES_M * 256, UPW, DM, 254}; pg8::StaticOrder S; S.init(UP_TILES_M * 256, UPW, G, bx);
        pg8::EpiUp E{HB, SSQ, conv_w, conv_b, (LAS float*)(lds + XCH_OFF)};
        pg8::gemm_phase<pg8::EpiUp, pg8::StaticOrder, true, PG8_SP2>(lds, g, S, E);
    }
    grid.sync();

    {
        pg8::Gemm g{HB, WDN, M, DM, DFF, 256}; pg8::StaticOrder S; S.init(M, DM, G, bx);
        pg8::EpiDown E{out};
        pg8::gemm_phase<pg8::EpiDown, pg8::StaticOrder, PG8_ALIGN, PG8_SP2>(lds, g, S, E);
    }
}

extern "C" void kernel_launch(void* const* d_in, const int* in_sizes, int n_in, void* d_out, int out_size, void* d_ws, size_t ws_size, hipStream_t stream) {
    static int grid = 0;
    if (grid == 0) {
        if (n_in != 17 || out_size != M * DM || ws_size < WS_END) { fprintf(stderr, "kernel_launch: unexpected shapes (n_in %d out %d ws %zu)\n", n_in, out_size, ws_size); grid = -1; return; }
        int dev = 0, cus = 0, per_cu = 0;
        hipGetDevice(&dev); hipDeviceGetAttribute(&cus, hipDeviceAttributeMultiprocessorCount, dev);
        if (hipFuncSetAttribute((const void*)fwd_megakernel, hipFuncAttributeMaxDynamicSharedMemorySize, LDS_BYTES) != hipSuccess) { fprintf(stderr, "kernel_launch: hipFuncSetAttribute failed\n"); grid = -1; return; }
        if (hipOccupancyMaxActiveBlocksPerMultiprocessor(&per_cu, (const void*)fwd_megakernel, NWAVES * 64, LDS_BYTES) != hipSuccess || per_cu < 1) { fprintf(stderr, "kernel_launch: occupancy query says %d\n", per_cu); per_cu = 1; }
        (void)hipGetLastError();
        grid = cus;
        fprintf(stderr, "kernel_launch: grid %d (per_cu %d)\n", grid, per_cu);
    }
    if (grid < 0) return;
    Args a{};
    for (int i = 0; i < 17; ++i) a.in[i] = (const float*)d_in[i];
    a.out = (float*)d_out; a.ws = (unsigned char*)d_ws;
    void* kargs[] = {&a};
    hipError_t e = hipLaunchCooperativeKernel((const void*)fwd_megakernel, dim3(grid), dim3(NWAVES * 64), kargs, LDS_BYTES, stream);
    if (e != hipSuccess) fprintf(stderr, "kernel_launch: cooperative launch failed: %s\n", hipGetErrorString(e));
}
```

```cpp
#include <hip/hip_runtime.h>
#include <hip/hip_cooperative_groups.h>
#include <cstdio>
#include <cstdint>
namespace cg = cooperative_groups;
namespace pg8 {
#define PG8_LAS __attribute__((address_space(3)))
typedef unsigned short bf16_t;
typedef short bf16x8 __attribute__((ext_vector_type(8)));
typedef float f32x4 __attribute__((ext_vector_type(4)));
typedef unsigned u32x4 __attribute__((ext_vector_type(4)));
constexpr int BM = 256, BK = 64, HALF = 128, HTB = HALF * BK * 2  , STAGE_BYTES = 8 * HTB, NXCD = 8, WGM = 8;

__host__ __device__ __forceinline__ int lds_byte(int r, int c) { const int st = (r >> 4) * 2 + (c >> 5), rr = r & 15, cc = c & 31, ob = rr * 64 + cc * 2; return st * 1024 + (ob ^ (((ob >> 9) & 1) << 5)); }
__host__ __device__ __forceinline__ void stage_rc(int b, int& R, int& C) { const int st = b / 1024, sb = b % 1024, swz = sb ^ (((sb >> 9) & 1) << 5); R = (st >> 1) * 16 + swz / 64; C = (st & 1) * 32 + (swz % 64) / 2; }
__host__ __device__ __forceinline__ int perm32(int rho) { const int n = rho >> 4, i = rho & 15; return 8 * (i >> 2) + 4 * n + (i & 3); }

struct Unit { int pm, pn; };
struct Gemm { const bf16_t* A; const bf16_t* Bt; int M, N, K; int a_tile_rows; };

struct StaticOrder {
    int nM, nN, nwg, G, c;
    __host__ __device__ void init(int M, int N, int G_, int c_) { nM = M / BM; nN = N / BM; nwg = nM * nN; G = G_; c = c_; }
    __host__ __device__ bool next(int i, Unit& u) const {
        const long L = (long)i * G + c; if (L >= nwg) return false;
        int wgid = (int)L; { const int q = nwg / NXCD, r = nwg % NXCD, xcd = wgid % NXCD, off = wgid / NXCD; wgid = (xcd < r ? xcd * (q + 1) : r * (q + 1) + (xcd - r) * q) + off; }
        const int nig = WGM * nN, gid = wgid / nig, fm = gid * WGM, gsz = (nM - fm) < WGM ? (nM - fm) : WGM;
        u.pm = fm + ((wgid % nig) % gsz); u.pn = (wgid % nig) / gsz; return true;
    }
    __device__ __forceinline__ void a_ready(const Unit&) const {}
    __device__ __forceinline__ void done(const Unit&) const {}
};

__device__ __forceinline__ unsigned cvt_pk_bf16(float lo, float hi) { unsigned r; asm volatile("v_cvt_pk_bf16_f32 %0, %1, %2" : "=v"(r) : "v"(lo), "v"(hi)); return r; }
typedef float f32x2 __attribute__((ext_vector_type(2))); typedef __bf16 bf16x2_t __attribute__((ext_vector_type(2)));
__device__ __forceinline__ unsigned cvtpk(float lo, float hi) { f32x2 v = {lo, hi}; bf16x2_t b = __builtin_convertvector(v, bf16x2_t); return __builtin_bit_cast(unsigned, b); }
constexpr int MTOK = 49152, MPROMPT = 16384, DMODEL = 1024, DFF_ = 2816;
__device__ __forceinline__ u32x4 pack8(const f32x4 a, const f32x4 b) { u32x4 w; w.x = cvtpk(a[0], a[1]); w.y = cvtpk(a[2], a[3]); w.z = cvtpk(b[0], b[1]); w.w = cvtpk(b[2], b[3]); return w; }

struct EpiProj {
    static constexpr bool PERM = true, AFTER_DRAIN = false;
    bf16_t* O; int ldc;
    __device__ __forceinline__ void operator()(f32x4 (&acc)[2][2][4][2], const Unit& u, int wr, int wc, int fr, int fq, int wid, int lane) const {
        const int row0 = u.pm * BM + wr * 64 + fr, col0 = u.pn * BM + wc * 32 + 8 * fq;
#pragma unroll
        for (int ai = 0; ai < 2; ++ai)
#pragma unroll
            for (int m = 0; m < 4; ++m) { bf16_t* rowp = O + (size_t)(row0 + ai * HALF + m * 16) * ldc + col0;
#pragma unroll
                for (int bj = 0; bj < 2; ++bj) *(u32x4*)(rowp + bj * HALF) = pack8(acc[ai][bj][m][0], acc[ai][bj][m][1]); }
    }
};
struct EpiOut {
    static constexpr bool PERM = true, AFTER_DRAIN = false;
    const float* xp; const float* xs; float* out; bf16_t* xb; float* ssq;
    __device__ __forceinline__ void operator()(f32x4 (&acc)[2][2][4][2], const Unit& u, int wr, int wc, int fr, int fq, int wid, int lane) const {
        const int col0 = u.pn * BM + wc * 32 + 8 * fq;
#pragma unroll
        for (int ai = 0; ai < 2; ++ai)
#pragma unroll
            for (int m = 0; m < 4; ++m) { const int gr = u.pm * BM + ai * HALF + wr * 64 + m * 16 + fr;
                const float* xr = (gr < MPROMPT ? xp + (size_t)gr * DMODEL : xs + (size_t)(gr - MPROMPT) * DMODEL) + col0;
                float s = 0.f;
#pragma unroll
                for (int bj = 0; bj < 2; ++bj) { f32x4 a = *(const f32x4*)(xr + bj * HALF), b = *(const f32x4*)(xr + bj * HALF + 4);
                    a += acc[ai][bj][m][0]; b += acc[ai][bj][m][1];
                    s += (a[0] * a[0] + a[1] * a[1]) + (a[2] * a[2] + a[3] * a[3]) + (b[0] * b[0] + b[1] * b[1]) + (b[2] * b[2] + b[3] * b[3]);
                    float* o = out + (size_t)gr * DMODEL + col0 + bj * HALF; *(f32x4*)o = a; *(f32x4*)(o + 4) = b;
                    *(u32x4*)(xb + (size_t)gr * DMODEL + col0 + bj * HALF) = pack8(a, b); }
                s += __shfl_xor(s, 16); s += __shfl_xor(s, 32);
                if (fq == 0) unsafeAtomicAdd(ssq + gr, s);
                asm volatile("" ::: "memory"); }
    }
};
struct EpiDown {
    static constexpr bool PERM = true, AFTER_DRAIN = false;
    float* out;
    __device__ __forceinline__ void operator()(f32x4 (&acc)[2][2][4][2], const Unit& u, int wr, int wc, int fr, int fq, int wid, int lane) const {
        const int col0 = u.pn * BM + wc * 32 + 8 * fq;
#pragma unroll
        for (int ai = 0; ai < 2; ++ai)
#pragma unroll
            for (int m = 0; m < 4; ++m) { const int gr = u.pm * BM + ai * HALF + wr * 64 + m * 16 + fr;
                float* o = out + (size_t)gr * DMODEL + col0;
#pragma unroll
                for (int bj = 0; bj < 2; ++bj) { f32x4 a = *(const f32x4*)(o + bj * HALF), b = *(const f32x4*)(o + bj * HALF + 4);
                    a += acc[ai][bj][m][0]; b += acc[ai][bj][m][1]; *(f32x4*)(o + bj * HALF) = a; *(f32x4*)(o + bj * HALF + 4) = b; }
                asm volatile("" ::: "memory"); }
    }
};
__device__ __forceinline__ bool seq_first(int gr) { return gr == 0 || (gr >= MPROMPT && (gr & 2047) == 0); }
__device__ __forceinline__ bool seq_last(int gr) { return gr >= MPROMPT - 1 && (gr & 2047) == 2047; }
struct EpiUp {
    static constexpr bool PERM = true, AFTER_DRAIN = false;
    bf16_t* H; const float* ssq; const float* cw; const float* cb; PG8_LAS float* xch;
    __device__ __forceinline__ void operator()(f32x4 (&acc)[2][2][4][2], const Unit& u, int wr, int wc, int fr, int fq, int wid, int lane) const {
        const int lr0 = wr * 64 + fr, gr0 = 254 * u.pm - 1 + lr0;
#pragma unroll
        for (int ai = 0; ai < 2; ++ai)
#pragma unroll
            for (int m = 0; m < 4; ++m) { int gr = gr0 + ai * HALF + m * 16; gr = gr < 0 ? 0 : (gr > MTOK - 1 ? MTOK - 1 : gr);
                const float rs = __builtin_amdgcn_rsqf(ssq[gr] * (1.0f / DMODEL) + 1e-6f);
#pragma unroll
                for (int bj = 0; bj < 2; ++bj)
#pragma unroll
                    for (int n = 0; n < 2; ++n) acc[ai][bj][m][n] *= rs; }
#pragma unroll
        for (int ai = 0; ai < 2; ++ai) {
            if (fr == 0) { PG8_LAS float* p = xch + ((wid * 2 + ai) * 2 + 0) * 64 + 8 * fq;
#pragma unroll
                for (int bj = 0; bj < 2; ++bj)
#pragma unroll
                    for (int n = 0; n < 2; ++n) *(PG8_LAS f32x4*)(p + bj * 32 + 4 * n) = acc[ai][bj][0][n]; }
            if (fr == 15) { PG8_LAS float* p = xch + ((wid * 2 + ai) * 2 + 1) * 64 + 8 * fq;
#pragma unroll
                for (int bj = 0; bj < 2; ++bj)
#pragma unroll
                    for (int n = 0; n < 2; ++n) *(PG8_LAS f32x4*)(p + bj * 32 + 4 * n) = acc[ai][bj][3][n]; }
        }
        asm volatile("s_waitcnt lgkmcnt(0)" ::: "memory"); __builtin_amdgcn_s_barrier(); asm volatile("" ::: "memory");
        const int ow = (1 - wr) * 4 + wc;
        const int srcP = ((lane & 48) | ((fr + 15) & 15)) * 4, srcN = ((lane & 48) | ((fr + 1) & 15)) * 4;
        const int ch0 = 128 * u.pn + 32 * wc + 8 * fq;
#pragma unroll
        for (int n = 0; n < 2; ++n) {
            f32x4 w0[2], w1[2], w2[2], bb[2];
#pragma unroll
            for (int bj = 0; bj < 2; ++bj) { const int ch = ch0 + 4 * n + bj * DFF_;
                w0[bj] = *(const f32x4*)(cw + ch); w1[bj] = *(const f32x4*)(cw + 2 * DFF_ + ch); w2[bj] = *(const f32x4*)(cw + 4 * DFF_ + ch); bb[bj] = *(const f32x4*)(cb + ch); }
#pragma unroll
            for (int ai = 0; ai < 2; ++ai) {
                const int aiT = wr == 1 ? ai : ai - 1, aiB = wr == 0 ? ai : ai + 1;
#pragma unroll
                for (int m = 0; m < 4; ++m) {
                    const int lr = lr0 + ai * HALF + m * 16, gr = gr0 + ai * HALF + m * 16;
                    const bool first = seq_first(gr), last = seq_last(gr);
                    f32x4 c[2];
#pragma unroll
                    for (int bj = 0; bj < 2; ++bj) {
                        const f32x4 cur = acc[ai][bj][m][n];
                        f32x4 pv, nx;
#pragma unroll
                        for (int e = 0; e < 4; ++e) {
                            const float sP = (m > 0 && fr == 15) ? acc[ai][bj][m > 0 ? m - 1 : 0][n][e] : cur[e];
                            const float sN = (m < 3 && fr == 0) ? acc[ai][bj][m < 3 ? m + 1 : 3][n][e] : cur[e];
                            pv[e] = __builtin_bit_cast(float, __builtin_amdgcn_ds_bpermute(srcP, __builtin_bit_cast(int, sP)));
                            nx[e] = __builtin_bit_cast(float, __builtin_amdgcn_ds_bpermute(srcN, __builtin_bit_cast(int, sN))); }
                        if (m == 0) { const f32x4 top = (aiT >= 0) ? *(const PG8_LAS f32x4*)(xch + ((ow * 2 + (aiT < 0 ? 0 : aiT)) * 2 + 1) * 64 + 8 * fq + bj * 32 + 4 * n) : (f32x4){0.f, 0.f, 0.f, 0.f}; if (fr == 0) pv = top; }
                        if (m == 3) { const f32x4 bot = (aiB <= 1) ? *(const PG8_LAS f32x4*)(xch + ((ow * 2 + (aiB > 1 ? 1 : aiB)) * 2 + 0) * 64 + 8 * fq + bj * 32 + 4 * n) : (f32x4){0.f, 0.f, 0.f, 0.f}; if (fr == 15) nx = bot; }
                        if (first) pv = (f32x4){0.f, 0.f, 0.f, 0.f};
                        if (last) nx = (f32x4){0.f, 0.f, 0.f, 0.f};
                        c[bj] = bb[bj] + w0[bj] * pv + w1[bj] * cur + w2[bj] * nx;
                    }
                    f32x4 hv;
#pragma unroll
                    for (int e = 0; e < 4; ++e) { const float g = c[0][e]; hv[e] = g * __builtin_amdgcn_rcpf(1.0f + __builtin_amdgcn_exp2f(-1.4426950408889634f * g)) * c[1][e]; }
                    f32x2 pk; pk.x = __builtin_bit_cast(float, cvtpk(hv[0], hv[1])); pk.y = __builtin_bit_cast(float, cvtpk(hv[2], hv[3]));
                    if (lr >= 1 && lr <= 254 && gr < MTOK) *(f32x2*)(H + (size_t)gr * DFF_ + ch0 + 4 * n) = pk;
                    asm volatile("" ::: "memory");
                }
            }
        }
    }
};
template <class Epi, class Sched, bool ALIGN_EPI = false, bool SP2 = false>
__device__ __forceinline__ void gemm_phase(PG8_LAS unsigned char* lds, const Gemm g, const Sched& S, const Epi& E) {
    const int tid = threadIdx.x, wid = __builtin_amdgcn_readfirstlane(tid >> 6), lane = tid & 63, wr = wid >> 2, wc = wid & 3, fr = lane & 15, fq = lane >> 4;
    const int K = g.K, nt = K / BK;
    unsigned voffA[2], voffB[2];
#pragma unroll
    for (int i = 0; i < 2; ++i) { int R, C; stage_rc(tid * 16 + i * 8192, R, C); const int Rb = Epi::PERM ? ((R & ~31) + perm32(R & 31)) : R;
        voffA[i] = (unsigned)(R * K + C) * 2u; voffB[i] = (unsigned)(Rb * K + C) * 2u; }
    const size_t kstep = (size_t)(BK * 2);
    const size_t hstep = (size_t)HALF * K * 2;
    const size_t tstep = 2 * hstep; const size_t tstepA = (size_t)g.a_tile_rows * K * 2;
    const unsigned ldsw = (unsigned)wid * 1024u;
    const int aoff = lds_byte(wr * 64 + fr, fq * 8), boff = lds_byte(wc * 32 + fr, fq * 8);
#define PG8_SA(b, h) (((b) * 2 + (h)) * HTB)
#define PG8_SB(b, h) ((4 + (b) * 2 + (h)) * HTB)
#define PG8_STAGE(bufoff, gbase, voff) do { _Pragma("unroll") for (int _i = 0; _i < 2; ++_i) \
        __builtin_amdgcn_global_load_lds((const unsigned*)((const char*)(gbase) + (voff)[_i]), (PG8_LAS unsigned*)(lds + (bufoff) + ldsw + _i * 8192), 16, 0, 0); } while (0)
#define PG8_LDA(dst, b, h) do { _Pragma("unroll") for (int m = 0; m < 4; ++m) _Pragma("unroll") for (int k = 0; k < 2; ++k) dst[m][k] = *(const PG8_LAS bf16x8*)(lds + PG8_SA(b, h) + aoff + m * 2048 + k * 1024); } while (0)
#define PG8_LDB(dst, b, h) do { _Pragma("unroll") for (int n = 0; n < 2; ++n) _Pragma("unroll") for (int k = 0; k < 2; ++k) dst[n][k] = *(const PG8_LAS bf16x8*)(lds + PG8_SB(b, h) + boff + n * 2048 + k * 1024); } while (0)
#define PG8_MMA(ai, bj, At, Bt) do { __builtin_amdgcn_s_setprio(1); _Pragma("unroll") for (int m = 0; m < 4; ++m) _Pragma("unroll") for (int n = 0; n < 2; ++n) _Pragma("unroll") for (int k = 0; k < 2; ++k) \
        acc[ai][bj][m][n] = __builtin_amdgcn_mfma_f32_16x16x32_bf16(Bt[n][k], At[m][k], acc[ai][bj][m][n], 0, 0, 0); __builtin_amdgcn_s_setprio(0); } while (0)
#define PG8_WAIT_V(n) asm volatile("s_waitcnt vmcnt(" #n ")" ::: "memory")
#define PG8_WAIT_L(n) asm volatile("s_waitcnt lgkmcnt(" #n ")" ::: "memory")
#define PG8_BAR __builtin_amdgcn_s_barrier()
#define PG8_SCHED __builtin_amdgcn_sched_barrier(0)
    Unit cur, nxt; int ui = 0;
    if (!S.next(0, cur)) return;
    f32x4 acc[2][2][4][2];
#pragma unroll
    for (int a = 0; a < 2; ++a)
#pragma unroll
        for (int b = 0; b < 2; ++b)
#pragma unroll
            for (int m = 0; m < 4; ++m)
#pragma unroll
                for (int n = 0; n < 2; ++n) acc[a][b][m][n] = (f32x4){0.f, 0.f, 0.f, 0.f};
    bf16x8 At[4][2], B0[2][2], B1[2][2];
    const char* cA = (const char*)g.A + (size_t)cur.pm * tstepA; const char* cB = (const char*)g.Bt + (size_t)cur.pn * tstep;
    S.a_ready(cur);
    if constexpr (SP2) {
        PG8_STAGE(PG8_SB(0, 0), cB, voffB); PG8_STAGE(PG8_SB(0, 1), cB + hstep, voffB); PG8_STAGE(PG8_SA(0, 0), cA, voffA); PG8_STAGE(PG8_SA(0, 1), cA + hstep, voffA);
        if (wr == 1) PG8_BAR;
        PG8_WAIT_V(2); PG8_BAR;
        PG8_STAGE(PG8_SB(1, 0), cB + kstep, voffB); PG8_STAGE(PG8_SA(1, 0), cA + kstep, voffA); PG8_STAGE(PG8_SB(1, 1), cB + hstep + kstep, voffB);
        PG8_WAIT_V(6); PG8_BAR;
    } else {
        PG8_STAGE(PG8_SB(0, 0), cB, voffB); PG8_STAGE(PG8_SA(0, 0), cA, voffA); PG8_STAGE(PG8_SB(0, 1), cB + hstep, voffB); PG8_STAGE(PG8_SA(0, 1), cA + hstep, voffA);
        if (wr == 1) PG8_BAR;
        PG8_WAIT_V(4); PG8_BAR;
        PG8_STAGE(PG8_SB(1, 0), cB + kstep, voffB); PG8_STAGE(PG8_SA(1, 0), cA + kstep, voffA); PG8_STAGE(PG8_SB(1, 1), cB + hstep + kstep, voffB);
        PG8_WAIT_V(6); PG8_BAR;
    }
    for (;;) {
        const bool has_next = S.next(ui + 1, nxt);
        const char* nA = has_next ? (const char*)g.A + (size_t)nxt.pm * tstepA : cA; const char* nB = has_next ? (const char*)g.Bt + (size_t)nxt.pn * tstep : cB;
        for (int t = 0; t < nt; t += 2) {
            const bool last = (t == nt - 2);
            const char* a1 = cA + (size_t)(t + 1) * kstep;
            const char* a2 = last ? nA : cA + (size_t)(t + 2) * kstep; const char* b2 = last ? nB : cB + (size_t)(t + 2) * kstep;
            const char* a3 = a2 + kstep; const char* b3 = b2 + kstep;
            if (last && has_next) S.a_ready(nxt);
            if constexpr (SP2) {
            PG8_LDB(B0, 0, 0); PG8_LDB(B1, 0, 1); PG8_SCHED; PG8_LDA(At, 0, 0); PG8_STAGE(PG8_SA(1, 1), a1 + hstep, voffA);
            PG8_WAIT_V(8); PG8_WAIT_L(0); PG8_BAR; PG8_MMA(0, 0, At, B0); PG8_MMA(0, 1, At, B1); PG8_BAR; PG8_SCHED;
            PG8_LDA(At, 0, 1); PG8_STAGE(PG8_SB(0, 0), b2, voffB); PG8_STAGE(PG8_SB(0, 1), b2 + hstep, voffB); PG8_STAGE(PG8_SA(0, 0), a2, voffA);
            PG8_WAIT_V(8); PG8_WAIT_L(0); PG8_BAR; PG8_MMA(1, 0, At, B0); PG8_MMA(1, 1, At, B1); PG8_BAR; PG8_SCHED;
            PG8_LDB(B0, 1, 0); PG8_LDB(B1, 1, 1); PG8_SCHED; PG8_LDA(At, 1, 0); PG8_STAGE(PG8_SA(0, 1), a2 + hstep, voffA);
            PG8_WAIT_V(8); PG8_WAIT_L(0); PG8_BAR; PG8_MMA(0, 0, At, B0); PG8_MMA(0, 1, At, B1); PG8_BAR; PG8_SCHED;
            PG8_LDA(At, 1, 1); PG8_STAGE(PG8_SB(1, 0), b3, voffB); PG8_STAGE(PG8_SB(1, 1), b3 + hstep, voffB); PG8_STAGE(PG8_SA(1, 0), a3, voffA);
            PG8_WAIT_V(8); PG8_WAIT_L(0); PG8_BAR; PG8_MMA(1, 0, At, B0); PG8_MMA(1, 1, At, B1); PG8_BAR; PG8_SCHED;
            } else {
            PG8_LDB(B0, 0, 0); PG8_SCHED; PG8_LDA(At, 0, 0); PG8_STAGE(PG8_SA(1, 1), a1 + hstep, voffA);
            PG8_WAIT_L(8); PG8_BAR; PG8_WAIT_L(0); PG8_MMA(0, 0, At, B0); PG8_BAR; PG8_SCHED;
            PG8_LDB(B1, 0, 1); PG8_STAGE(PG8_SB(0, 0), b2, voffB);
            PG8_BAR; PG8_WAIT_L(0); PG8_MMA(0, 1, At, B1); PG8_BAR;
            PG8_LDA(At, 0, 1); PG8_STAGE(PG8_SA(0, 0), a2, voffA);
            PG8_BAR; PG8_WAIT_L(0); PG8_MMA(1, 0, At, B0); PG8_BAR; PG8_SCHED;
            PG8_STAGE(PG8_SB(0, 1), b2 + hstep, voffB);
            PG8_WAIT_V(6); PG8_BAR; PG8_MMA(1, 1, At, B1); PG8_BAR;
            PG8_LDB(B0, 1, 0); PG8_SCHED; PG8_LDA(At, 1, 0); PG8_STAGE(PG8_SA(0, 1), a2 + hstep, voffA);
            PG8_WAIT_L(8); PG8_BAR; PG8_WAIT_L(0); PG8_MMA(0, 0, At, B0); PG8_BAR; PG8_SCHED;
            PG8_LDB(B1, 1, 1); PG8_STAGE(PG8_SB(1, 0), b3, voffB);
            PG8_BAR; PG8_WAIT_L(0); PG8_MMA(0, 1, At, B1); PG8_BAR;
            PG8_LDA(At, 1, 1); PG8_STAGE(PG8_SA(1, 0), a3, voffA);
            PG8_BAR; PG8_WAIT_L(0); PG8_MMA(1, 0, At, B0); PG8_BAR; PG8_SCHED;
            PG8_STAGE(PG8_SB(1, 1), b3 + hstep, voffB);
            PG8_WAIT_V(6); PG8_BAR; PG8_MMA(1, 1, At, B1); PG8_BAR;
            }
        }
        if constexpr (ALIGN_EPI) { if (wr == 0) PG8_BAR; }
        if constexpr (!Epi::AFTER_DRAIN) { E(acc, cur, wr, wc, fr, fq, wid, lane); S.done(cur); }
        if (!has_next) break;
#pragma unroll
        for (int a = 0; a < 2; ++a)
#pragma unroll
            for (int b = 0; b < 2; ++b)
#pragma unroll
                for (int m = 0; m < 4; ++m)
#pragma unroll
                    for (int n = 0; n < 2; ++n) acc[a][b][m][n] = (f32x4){0.f, 0.f, 0.f, 0.f};
        cur = nxt; cA = nA; cB = nB; ++ui;
        if constexpr (ALIGN_EPI) { if (wr == 1) PG8_BAR; }
    }
    PG8_WAIT_V(0);
    if constexpr (!ALIGN_EPI) { if (wr == 0) PG8_BAR; }
    PG8_BAR;
    if constexpr (Epi::AFTER_DRAIN) { E.fused(acc, cur, wr, wc, fr, fq, lds, wid, lane); S.done(cur); }
#undef PG8_SA
#undef PG8_SB
#undef PG8_STAGE
#undef PG8_LDA
#undef PG8_LDB
#undef PG8_MMA
#undef PG8_WAIT_V
#undef PG8_WAIT_L
#undef PG8_BAR
#undef PG8_SCHED
}
}
#ifndef PG8_SP2
#define PG8_SP2 true
#endif
#ifndef PG8_ALIGN
#define PG8_ALIGN true
#endif

constexpr int NWAVES = 8;
constexpr int DM = 1024, M = 49152, MP = 16384, INW = 2304, DFF = 2816, UPW = 5632;
constexpr int QA_OFF = 0, KA_OFF = 512, VA_OFF = 1024, QB_OFF = 1536, KB_OFF = 2048, VB_OFF = 2176;
constexpr int UP_TILES_M = 194;
constexpr float EPS = 1e-6f, LOG2E = 1.4426950408889634f;

constexpr size_t MiB = 1u << 20;
constexpr size_t WS_SSQ = 0;
constexpr size_t WS_BAR = 1 * MiB;
constexpr size_t WS_WIN = 2 * MiB, WS_WOUT = 7 * MiB, WS_WUP = 9 * MiB, WS_WDN = 20 * MiB;
constexpr size_t WS_XN = 32 * MiB;
constexpr size_t WS_PROJ = 130 * MiB;
constexpr size_t WS_OA = 346 * MiB;
constexpr size_t WS_H = 226 * MiB;
constexpr size_t WS_LA = 490 * MiB;
constexpr size_t WS_END = 496 * MiB;
static_assert(WS_XN + (size_t)(M + 256) * DM * 2 <= WS_PROJ && WS_PROJ + (size_t)M * INW * 2 <= WS_OA && WS_OA + 3 * (size_t)M * 512 * 2 <= WS_LA && WS_H + (size_t)M * DFF * 2 <= WS_LA && WS_PROJ + (size_t)M * DM * 2 <= WS_H, "d_ws map");

constexpr int RING_BYTES = 131072, XCH_OFF = RING_BYTES, MISC_OFF = XCH_OFF + 8192, LDS_BYTES = 147456;

#define LAS __attribute__((address_space(3)))
typedef unsigned short bf16;
typedef unsigned v4u __attribute__((ext_vector_type(4)));
typedef float f32x4 __attribute__((ext_vector_type(4)));
typedef float f32x16 __attribute__((ext_vector_type(16)));
typedef short bf16x8 __attribute__((ext_vector_type(8)));
typedef short s16x4 __attribute__((ext_vector_type(4)));
using pg8::cvtpk;
__device__ __forceinline__ float bf_lo(unsigned w) { return __uint_as_float(w << 16); }
__device__ __forceinline__ float bf_hi(unsigned w) { return __uint_as_float(w & 0xffff0000u); }
__device__ __forceinline__ float wave_sum(float v) {
#pragma unroll
    for (int o = 1; o < 64; o <<= 1) v += __shfl_xor(v, o);
    return v;
}
__device__ __forceinline__ float wave_max(float v) {
#pragma unroll
    for (int o = 1; o < 64; o <<= 1) v = fmaxf(v, __shfl_xor(v, o));
    return v;
}

#define GAS __attribute__((address_space(1)))
#define RLX_AGENT __ATOMIC_RELAXED, __HIP_MEMORY_SCOPE_AGENT
#define XB_TMO      128
#define XB_XCNT(j)  (256  + 64 * (j))
#define XB_XSUB(j)  (1280 + 64 * (j))
#define XB_XGEN(j)  (2304 + 64 * (j))
#define XB_TOP      3328
#define XB_TOPGEN   3392
#define XCD_BAR_WORDS 3456
#define XB_SPIN_CAP (1u << 18)

__device__ __forceinline__ unsigned xb_ld(unsigned* p)              { return __hip_atomic_load(p, __ATOMIC_RELAXED, __HIP_MEMORY_SCOPE_AGENT); }
__device__ __forceinline__ unsigned xb_add(unsigned* p, unsigned v) { return __hip_atomic_fetch_add(p, v, __ATOMIC_RELAXED, __HIP_MEMORY_SCOPE_AGENT); }
__device__ __forceinline__ unsigned xb_xcc_id() { return (unsigned)__builtin_amdgcn_s_getreg((3 << 11) | 20) & 0xFu; }
#define XB_SPIN(cond, bar) do { unsigned _sp = 0; while (cond) { __builtin_amdgcn_s_sleep(1); \
    if ((++_sp & 255u) == 0u) { if (xb_ld(&(bar)[XB_TMO])) break; if (_sp > XB_SPIN_CAP) { atomicAdd(&(bar)[XB_TMO], 1u); break; } } } } while (0)

struct XcdBarrier {
    unsigned* bar; unsigned x;
    volatile LAS unsigned* st;
};

__device__ __forceinline__ XcdBarrier xcd_barrier_post(unsigned* bar, volatile LAS unsigned* st) {
    XcdBarrier b; b.bar = bar; b.x = xb_xcc_id(); b.st = st;
    if (threadIdx.x == 0) (void)xb_add(&bar[XB_XCNT(b.x)], 1u);
    return b;
}
__device__ __forceinline__ void xcd_barrier_complete(unsigned* bar, unsigned x, unsigned& nloc, unsigned& nx) {
    const unsigned G = gridDim.x * gridDim.y * gridDim.z;
    unsigned sum, cnt, mine, sp = 0u;
    for (;;) {
        sum = 0u; cnt = 0u; mine = 0u;
#pragma unroll
        for (unsigned j = 0; j < 16; ++j) { const unsigned c = xb_ld(&bar[XB_XCNT(j)]); sum += c; cnt += (c > 0u) ? 1u : 0u; mine = (j == x) ? c : mine; }
        if (sum == G) break;
        __builtin_amdgcn_s_sleep(1);
        if ((++sp & 255u) == 0u) { if (xb_ld(&bar[XB_TMO])) break; if (sp > XB_SPIN_CAP) { atomicAdd(&bar[XB_TMO], 1u); break; } }
    }
    nloc = mine > 0u ? mine : 1u; nx = cnt > 0u ? cnt : 1u;
}

__device__ __forceinline__ void xcd_barrier(const XcdBarrier& b) {
    asm volatile("s_waitcnt vmcnt(0)" ::: "memory");
    __syncthreads();
    if (threadIdx.x == 0) {
        unsigned* bar = b.bar;
        __builtin_amdgcn_s_waitcnt(0);
        unsigned nloc = b.st[0], nx = b.st[1];
        if (nloc == 0u) { xcd_barrier_complete(bar, b.x, nloc, nx); b.st[0] = nloc; b.st[1] = nx; }
        const unsigned old = xb_add(&bar[XB_XSUB(b.x)], 1u);
        const unsigned gen = old / nloc;
        if (old + 1u == (gen + 1u) * nloc) {
            __builtin_amdgcn_fence(__ATOMIC_RELEASE, "agent");
            asm volatile("s_waitcnt vmcnt(0)" ::: "memory");
            const unsigned og = xb_add(&bar[XB_TOP], 1u);
            const unsigned tg = og / nx;
            if (og + 1u == (tg + 1u) * nx) xb_add(&bar[XB_TOPGEN], 1u);
            else XB_SPIN(xb_ld(&bar[XB_TOPGEN]) == tg, bar);
            __builtin_amdgcn_fence(__ATOMIC_ACQUIRE, "agent");
            xb_add(&bar[XB_XGEN(b.x)], 1u);
            asm volatile("s_waitcnt vmcnt(0)" ::: "memory");
        } else {
            XB_SPIN(xb_ld(&bar[XB_XGEN(b.x)]) == gen, bar);
            __builtin_amdgcn_fence(__ATOMIC_ACQUIRE, "agent");
            asm volatile("s_waitcnt vmcnt(0)" ::: "memory");
        }
    }
    __syncthreads();
}

template <int MAP  >
__device__ __forceinline__ void p0_transpose_item(const float* W, int K, int N, bf16* WT, const float* kgain, LAS float* scr, int item, int lane) {
    const int nblk = N / 32, kb = item / nblk, nb = item % nblk, k0 = 64 * kb, n0 = 32 * nb;
#pragma unroll 8
    for (int i = 0; i < 32; ++i) { const int kk = 2 * i + (lane >> 5); float v = W[(size_t)(k0 + kk) * N + n0 + (lane & 31)]; if (kgain) v *= kgain[k0 + kk]; scr[kk * 33 + (lane & 31)] = v; }
    asm volatile("s_waitcnt lgkmcnt(0)" ::: "memory");
    const int c = lane & 7;
    int r0 = n0;
    if (MAP == 1) r0 = n0 < DFF ? ((n0 >> 7) * 256 + (n0 & 127)) : ((((n0 - DFF) >> 7) * 256) + 128 + ((n0 - DFF) & 127));
#pragma unroll
    for (int j = 0; j < 4; ++j) { const int n = (lane >> 3) + 8 * j; const LAS float* s = scr + (8 * c) * 33 + n;
        v4u o; o.x = cvtpk(s[0 * 33], s[1 * 33]); o.y = cvtpk(s[2 * 33], s[3 * 33]); o.z = cvtpk(s[4 * 33], s[5 * 33]); o.w = cvtpk(s[6 * 33], s[7 * 33]);
        *(v4u*)(WT + (size_t)(r0 + n) * K + k0 + 8 * c) = o; }
    asm volatile("s_waitcnt lgkmcnt(0)" ::: "memory");
}
__device__ __forceinline__ void rms_row_to_bf16(const float* xrow, const float* g, bf16* orow, int lane) {
    const f32x4* xr = (const f32x4*)xrow + lane; const f32x4* gr = (const f32x4*)g + lane;
    f32x4 v[4]; float s = 0.f;
#pragma unroll
    for (int j = 0; j < 4; ++j) { v[j] = xr[64 * j]; s += (v[j].x * v[j].x + v[j].y * v[j].y) + (v[j].z * v[j].z + v[j].w * v[j].w); }
    const float rstd = __builtin_amdgcn_rsqf(wave_sum(s) * (1.f / DM) + EPS);
    unsigned long long* o8 = (unsigned long long*)orow + lane;
#pragma unroll
    for (int j = 0; j < 4; ++j) { const f32x4 gg = gr[64 * j]; o8[64 * j] = (unsigned long long)cvtpk(v[j].x * rstd * gg.x, v[j].y * rstd * gg.y) | ((unsigned long long)cvtpk(v[j].z * rstd * gg.z, v[j].w * rstd * gg.w) << 32); }
}

__device__ __forceinline__ void rms_rows4_to_bf16(const float* xrow, const float* g, bf16* orow, int lane) {
    f32x4 v[4][4]; float s[4];
#pragma unroll
    for (int k = 0; k < 4; ++k)
#pragma unroll
        for (int j = 0; j < 4; ++j) v[k][j] = ((const f32x4*)(xrow + (size_t)k * DM) + lane)[64 * j];
    f32x4 gg[4];
#pragma unroll
    for (int j = 0; j < 4; ++j) gg[j] = ((const f32x4*)g + lane)[64 * j];
#pragma unroll
    for (int k = 0; k < 4; ++k) { s[k] = 0.f;
#pragma unroll
        for (int j = 0; j < 4; ++j) s[k] += (v[k][j].x * v[k][j].x + v[k][j].y * v[k][j].y) + (v[k][j].z * v[k][j].z + v[k][j].w * v[k][j].w); }
#pragma unroll
    for (int o = 1; o < 64; o <<= 1) {
#pragma unroll
        for (int k = 0; k < 4; ++k) s[k] += __shfl_xor(s[k], o); }
#pragma unroll
    for (int k = 0; k < 4; ++k) { const float rstd = __builtin_amdgcn_rsqf(s[k] * (1.f / DM) + EPS);
        unsigned long long* o8 = (unsigned long long*)(orow + (size_t)k * DM) + lane;
#pragma unroll
        for (int j = 0; j < 4; ++j) o8[64 * j] = (unsigned long long)cvtpk(v[k][j].x * rstd * gg[j].x, v[k][j].y * rstd * gg[j].y) | ((unsigned long long)cvtpk(v[k][j].z * rstd * gg[j].z, v[k][j].w * rstd * gg[j].w) << 32); }
}

template <int NKEYS, int NTHR>
__device__ __forceinline__ void stage_kv(LAS unsigned char* Kl, LAS unsigned char* Vl, const bf16* proj, int kcol, int vcol, int tok0, int dshift, int kidx0, int Ls, const float* gk, int t) {
    constexpr int NIT = NKEYS * 8 / NTHR;
    const int c = t & 7;
    const f32x4 g0 = *(const f32x4*)(gk + 8 * c), g1 = *(const f32x4*)(gk + 8 * c + 4);
    v4u kr[NIT], vr[NIT];
#pragma unroll
    for (int it = 0; it < NIT; ++it) { const int rho = (it * NTHR + t) >> 3, kidx = kidx0 + rho; const bool ok = (unsigned)kidx < (unsigned)Ls;
        const bf16* rowp = proj + (size_t)(tok0 + ((ok ? kidx : 0) << dshift)) * INW + 8 * c;
        kr[it] = *(const v4u*)(rowp + kcol); vr[it] = *(const v4u*)(rowp + vcol);
        if (!ok) { kr[it] = (v4u){0u, 0u, 0u, 0u}; vr[it] = (v4u){0u, 0u, 0u, 0u}; } }
#pragma unroll
    for (int it = 0; it < NIT; ++it) { const int rho = (it * NTHR + t) >> 3;
        float f[8] = {bf_lo(kr[it].x), bf_hi(kr[it].x), bf_lo(kr[it].y), bf_hi(kr[it].y), bf_lo(kr[it].z), bf_hi(kr[it].z), bf_lo(kr[it].w), bf_hi(kr[it].w)};
        float ss = (f[0] * f[0] + f[1] * f[1]) + (f[2] * f[2] + f[3] * f[3]) + (f[4] * f[4] + f[5] * f[5]) + (f[6] * f[6] + f[7] * f[7]);
        ss += __shfl_xor(ss, 1); ss += __shfl_xor(ss, 2); ss += __shfl_xor(ss, 4);
        const float rs = __builtin_amdgcn_rsqf(ss * (1.f / 64.f) + EPS);
        v4u o; o.x = cvtpk(f[0] * rs * g0.x, f[1] * rs * g0.y); o.y = cvtpk(f[2] * rs * g0.z, f[3] * rs * g0.w); o.z = cvtpk(f[4] * rs * g1.x, f[5] * rs * g1.y); o.w = cvtpk(f[6] * rs * g1.z, f[7] * rs * g1.w);
        *(LAS v4u*)(Kl + rho * 128 + 16 * (c ^ ((rho >> 1) & 7))) = o;
        *(LAS v4u*)(Vl + (c >> 2) * (NKEYS * 64) + rho * 64 + (c & 3) * 16) = vr[it]; }
}
__device__ __forceinline__ void load_q(bf16x8 (&qf)[4], const bf16* qrow  , const float* gq, int lane) {
    const int hi = lane >> 5;
    v4u raw[4]; float ss = 0.f;
#pragma unroll
    for (int d0 = 0; d0 < 4; ++d0) { raw[d0] = *(const v4u*)(qrow + 16 * d0 + 8 * hi);
        const float a0 = bf_lo(raw[d0].x), a1 = bf_hi(raw[d0].x), a2 = bf_lo(raw[d0].y), a3 = bf_hi(raw[d0].y), a4 = bf_lo(raw[d0].z), a5 = bf_hi(raw[d0].z), a6 = bf_lo(raw[d0].w), a7 = bf_hi(raw[d0].w);
        ss += (a0 * a0 + a1 * a1) + (a2 * a2 + a3 * a3) + (a4 * a4 + a5 * a5) + (a6 * a6 + a7 * a7); }
    ss += __shfl_xor(ss, 32);
    const float rs = __builtin_amdgcn_rsqf(ss * (1.f / 64.f) + EPS) * (0.125f * LOG2E);
#pragma unroll
    for (int d0 = 0; d0 < 4; ++d0) { const f32x4 g0 = *(const f32x4*)(gq + 16 * d0 + 8 * hi), g1 = *(const f32x4*)(gq + 16 * d0 + 8 * hi + 4);
        v4u o; o.x = cvtpk(bf_lo(raw[d0].x) * rs * g0.x, bf_hi(raw[d0].x) * rs * g0.y); o.y = cvtpk(bf_lo(raw[d0].y) * rs * g0.z, bf_hi(raw[d0].y) * rs * g0.w);
        o.z = cvtpk(bf_lo(raw[d0].z) * rs * g1.x, bf_hi(raw[d0].z) * rs * g1.y); o.w = cvtpk(bf_lo(raw[d0].w) * rs * g1.z, bf_hi(raw[d0].w) * rs * g1.w);
        qf[d0] = __builtin_bit_cast(bf16x8, o); }
}
typedef short v4i16_t __attribute__((ext_vector_type(4)));
__device__ __forceinline__ s16x4 vtr(const LAS unsigned char* p) { return __builtin_bit_cast(s16x4, __builtin_amdgcn_ds_read_tr16_b64_v4i16((LAS v4i16_t*)p)); }
template <int NT, int R>
__device__ __forceinline__ void attn_task(const LAS unsigned char* Kl, const LAS unsigned char* Vl, int vhs, int row0, int kidx_t0, int Ls, const bf16x8 (&qf)[4], float slope2, float negM, f32x16 (&o)[2], float& l, int lane) {
    const int q = lane & 31, hi = lane >> 5;
    const int vlane = (4 * hi + ((lane & 15) >> 2)) * 64 + (16 * ((lane >> 4) & 1) + 4 * (lane & 3)) * 2;
#pragma unroll 1
    for (int j = 0; j < NT; ++j) {
        const int rb = row0 + 32 * j, krow = rb + q, sw = (krow >> 1) & 7;
        const LAS unsigned char* kp = Kl + krow * 128;
        f32x16 s = {0.f, 0.f, 0.f, 0.f, 0.f, 0.f, 0.f, 0.f, 0.f, 0.f, 0.f, 0.f, 0.f, 0.f, 0.f, 0.f};
#pragma unroll
        for (int d0 = 0; d0 < 4; ++d0) { const bf16x8 kf = *(const LAS bf16x8*)(kp + 16 * ((2 * d0 + hi) ^ sw)); s = __builtin_amdgcn_mfma_f32_32x32x16_bf16(kf, qf[d0], s, 0, 0, 0); }
        float pr[16];
#pragma unroll
        for (int r = 0; r < 16; ++r) { const int cr = (r & 3) + 8 * (r >> 2) + 4 * hi, rel = 32 * j + cr - R - q, kidx = kidx_t0 + 32 * j + cr;
            const int arel = rel < 0 ? -rel : rel;
            const float t = s[r] - slope2 * (float)arel + negM;
            const bool ok = (arel <= R) && ((unsigned)kidx < (unsigned)Ls);
            const float p = ok ? __builtin_amdgcn_exp2f(t) : 0.f; l += p; pr[r] = p; }
        v4u w0, w1; w0.x = cvtpk(pr[0], pr[1]); w0.y = cvtpk(pr[2], pr[3]); w0.z = cvtpk(pr[4], pr[5]); w0.w = cvtpk(pr[6], pr[7]);
        w1.x = cvtpk(pr[8], pr[9]); w1.y = cvtpk(pr[10], pr[11]); w1.z = cvtpk(pr[12], pr[13]); w1.w = cvtpk(pr[14], pr[15]);
        const bf16x8 pa0 = __builtin_bit_cast(bf16x8, w0), pa1 = __builtin_bit_cast(bf16x8, w1);
        const LAS unsigned char* vp = Vl + rb * 64 + vlane;
#pragma unroll
        for (int dh = 0; dh < 2; ++dh)
#pragma unroll
            for (int s2 = 0; s2 < 2; ++s2) { const LAS unsigned char* vq = vp + dh * vhs + s2 * 16 * 64; const s16x4 lo = vtr(vq), h4 = vtr(vq + 8 * 64);
                const bf16x8 vf = (bf16x8){lo[0], lo[1], lo[2], lo[3], h4[0], h4[1], h4[2], h4[3]};
                o[dh] = __builtin_amdgcn_mfma_f32_32x32x16_bf16(s2 ? pa1 : pa0, vf, o[dh], 0, 0, 0); }
    }
}
__device__ __forceinline__ void store_partial(const f32x16 (&o)[2], float l, bf16* OB, float* LB, int tokq0, int dshift, int h, int lane) {
    const int hi = lane >> 5, d = lane & 31;
    l += __shfl_xor(l, 32);
    if (hi == 0) LB[(size_t)(tokq0 + (d << dshift)) * 8 + h] = l;
#pragma unroll
    for (int r = 0; r < 16; ++r) { const int qq = (r & 3) + 8 * (r >> 2) + 4 * hi; bf16* p = OB + (size_t)(tokq0 + (qq << dshift)) * 512 + h * 64 + d;
        p[0] = (bf16)(cvtpk(o[0][r], 0.f) & 0xffffu); p[32] = (bf16)(cvtpk(o[1][r], 0.f) & 0xffffu); }
}

struct Args { const float* in[17]; float* out; unsigned char* ws; };
__global__ void __launch_bounds__(NWAVES * 64, 2) fwd_megakernel(Args args) {
    extern __shared__ __attribute__((aligned(16))) unsigned char lds_raw[];
    cg::grid_group grid = cg::this_grid();
    LAS unsigned char* lds = (LAS unsigned char*)lds_raw;
    const int tid = threadIdx.x, lane = tid & 63, wave = __builtin_amdgcn_readfirstlane(tid >> 6);
    const int G = gridDim.x, bx = blockIdx.x;
    if (tid < 2) ((LAS unsigned*)(lds + MISC_OFF))[tid] = 0u;
    unsigned char* ws = args.ws;
    const float* xp = args.in[0]; const float* xs = args.in[1]; const float* norm1 = args.in[2]; const float* w_in = args.in[3];
    const float* qna = args.in[4]; const float* kna = args.in[5]; const float* qnb = args.in[6]; const float* knb = args.in[7]; const float* sinkb = args.in[8];
    const float* ona = args.in[9]; const float* onb = args.in[10]; const float* w_out = args.in[11]; const float* norm2 = args.in[12]; const float* w_up = args.in[13];
    const float* conv_w = args.in[14]; const float* conv_b = args.in[15]; const float* w_down = args.in[16];
    float* out = args.out;
    float* SSQ = (float*)(ws + WS_SSQ);
    bf16* WIN = (bf16*)(ws + WS_WIN); bf16* WOUT = (bf16*)(ws + WS_WOUT); bf16* WUP = (bf16*)(ws + WS_WUP); bf16* WDN = (bf16*)(ws + WS_WDN);
    bf16* XN = (bf16*)(ws + WS_XN) + DM;
    bf16* PROJ = (bf16*)(ws + WS_PROJ); bf16* Y = (bf16*)(ws + WS_PROJ);
    bf16* OA = (bf16*)(ws + WS_OA); bf16* OB = (bf16*)(ws + WS_XN) + DM; bf16* HB = (bf16*)(ws + WS_H);
    float* LA = (float*)(ws + WS_LA); float* LBp = LA + 3 * (size_t)M * 8;
    const int gw = bx * NWAVES + wave, NGW = G * NWAVES;

    {
        LAS float* scr = (LAS float*)(lds + wave * 16384);
        constexpr int I_IN = (DM / 64) * (INW / 32), I_OUT = (DM / 64) * (DM / 32), I_UP = (DM / 64) * (UPW / 32), I_DN = (DFF / 64) * (DM / 32);
        for (int it = gw; it < I_IN + I_OUT + I_UP + I_DN; it += NGW) {
            int r = it;
            if (r < I_IN) { p0_transpose_item<0>(w_in, DM, INW, WIN, nullptr, scr, r, lane); continue; } r -= I_IN;
            if (r < I_OUT) { p0_transpose_item<0>(w_out, DM, DM, WOUT, nullptr, scr, r, lane); continue; } r -= I_OUT;
            if (r < I_UP) { p0_transpose_item<1>(w_up, DM, UPW, WUP, norm2, scr, r, lane); continue; } r -= I_UP;
            p0_transpose_item<0>(w_down, DFF, DM, WDN, nullptr, scr, r, lane);
        }
        for (int m = gw * 4; m < M; m += NGW * 4) rms_rows4_to_bf16(m < MP ? xp + (size_t)m * DM : xs + (size_t)(m - MP) * DM, norm1, XN + (size_t)m * DM, lane);
        if (bx == 0) for (int i = tid; i < XCD_BAR_WORDS; i += 512) ((unsigned*)(ws + WS_BAR))[i] = 0u;
        for (int i = bx * 512 + tid; i < M; i += G * 512) SSQ[i] = 0.f;
    }
    grid.sync();
    XcdBarrier bar = xcd_barrier_post((unsigned*)(ws + WS_BAR), (volatile LAS unsigned*)(lds + MISC_OFF));

    {
        pg8::Gemm g{XN, WIN, M, INW, DM, 256}; pg8::StaticOrder S; S.init(M, INW, G, bx);
        pg8::EpiProj E{PROJ, INW};
        pg8::gemm_phase<pg8::EpiProj, pg8::StaticOrder, PG8_ALIGN, PG8_SP2>(lds, g, S, E);
    }
    xcd_barrier(bar);

    {
        const float gqa = fabsf(qna[lane]), gka = fabsf(kna[lane]);
        const float negMa = -8.0f * wave_max(gqa) * wave_max(gka) * LOG2E;
        const int half = wave >> 2, w4 = wave & 3, th = tid & 255;
        LAS unsigned char* Kl = lds + half * 65536; LAS unsigned char* Vl = Kl + 32768;
        for (int u = bx; u < 4608; u += G) {
            const int su = 2 * u + half, c = su / 3072, rem = su % 3072, h = rem / 384, gch = rem % 384;
            const int dshift = 2 * c;
            int seq0, S, lc; if (gch < 128) { seq0 = 0; S = 16384; lc = gch; } else { seq0 = MP + 2048 * ((gch - 128) >> 4); S = 2048; lc = (gch - 128) & 15; }
            const int Ls = S >> dshift, nch = Ls >> 7, res = lc / nch, cc = lc % nch;
            const int tok0 = seq0 + res;
            __syncthreads();
            stage_kv<256, 256>(Kl, Vl, PROJ, KA_OFF + h * 64, VA_OFF + h * 64, tok0, dshift, 128 * cc - 64, Ls, kna, th);
            const int iq0 = 128 * cc + 32 * w4;
            bf16x8 qf[4];
            load_q(qf, PROJ + (size_t)(tok0 + ((iq0 + (lane & 31)) << dshift)) * INW + QA_OFF + h * 64, qna, lane);
            __syncthreads();
            f32x16 o[2]; float l = 0.f;
#pragma unroll
            for (int r = 0; r < 16; ++r) { o[0][r] = 0.f; o[1][r] = 0.f; }
            const float slope2 = exp2f(-0.5f * (float)(h + 9)) * (float)(1 << dshift) * LOG2E;
            attn_task<5, 64>(Kl, Vl, 256 * 64, 32 * w4, iq0 - 64, Ls, qf, slope2, negMa, o, l, lane);
            store_partial(o, l, OA + (size_t)c * M * 512, LA + (size_t)c * M * 8, tok0 + (iq0 << dshift), dshift, h, lane);
        }
        const float gqb = fabsf(qnb[lane]), gkb = fabsf(knb[lane]);
        const float negMb = -8.0f * wave_max(gqb) * wave_max(gkb) * LOG2E;
        LAS unsigned char* Kb = lds; LAS unsigned char* Vb = lds + 40960;
        for (int u = bx; u < 1536; u += G) {
            const int g2 = u / 768, cb = u % 768;
            int seq0, S, lcb; if (cb < 256) { seq0 = 0; S = 16384; lcb = cb; } else { seq0 = MP + 2048 * ((cb - 256) >> 5); S = 2048; lcb = (cb - 256) & 31; }
            __syncthreads();
            stage_kv<320, 512>(Kb, Vb, PROJ, KB_OFF + g2 * 64, VB_OFF + g2 * 64, seq0, 0, 64 * lcb - 128, S, knb, tid);
            const int hb = 4 * g2 + (wave >> 1), iq0 = 64 * lcb + 32 * (wave & 1);
            bf16x8 qf[4];
            load_q(qf, PROJ + (size_t)(seq0 + iq0 + (lane & 31)) * INW + QB_OFF + hb * 64, qnb, lane);
            __syncthreads();
            f32x16 o[2]; float l = 0.f;
#pragma unroll
            for (int r = 0; r < 16; ++r) { o[0][r] = 0.f; o[1][r] = 0.f; }
            const float slope2 = exp2f(-0.5f * (float)(hb + 1)) * LOG2E;
            attn_task<9, 128>(Kb, Vb, 320 * 64, 32 * (wave & 1), iq0 - 128, S, qf, slope2, negMb, o, l, lane);
            store_partial(o, l, OB, LBp, seq0 + iq0, 0, hb, lane);
        }
        xcd_barrier(bar);
        {
            const int hh = lane >> 3;
            const float sinkterm = __builtin_amdgcn_exp2f(sinkb[hh] * LOG2E + negMb);
            const f32x4 ga0 = *(const f32x4*)(ona + 8 * lane), ga1 = *(const f32x4*)(ona + 8 * lane + 4), gb0 = *(const f32x4*)(onb + 8 * lane), gb1 = *(const f32x4*)(onb + 8 * lane + 4);
            for (int m0 = gw * 4; m0 < M; m0 += NGW * 4) {
                v4u wa[4][3], wb[4]; float la[4], lb[4];
#pragma unroll
                for (int k = 0; k < 4; ++k) { const int m = m0 + k; la[k] = 0.f;
#pragma unroll
                    for (int c = 0; c < 3; ++c) { wa[k][c] = *(const v4u*)(OA + ((size_t)c * M + m) * 512 + 8 * lane); la[k] += LA[((size_t)c * M + m) * 8 + hh]; }
                    wb[k] = *(const v4u*)(OB + (size_t)m * 512 + 8 * lane); lb[k] = LBp[(size_t)m * 8 + hh] + sinkterm; }
                float ya[4][8], yb[4][8], sa[4], sb[4];
#pragma unroll
                for (int k = 0; k < 4; ++k) { const float ia = 1.0f / la[k], ib = 1.0f / lb[k];
                    ya[k][0] = (bf_lo(wa[k][0].x) + bf_lo(wa[k][1].x) + bf_lo(wa[k][2].x)) * ia; ya[k][1] = (bf_hi(wa[k][0].x) + bf_hi(wa[k][1].x) + bf_hi(wa[k][2].x)) * ia;
                    ya[k][2] = (bf_lo(wa[k][0].y) + bf_lo(wa[k][1].y) + bf_lo(wa[k][2].y)) * ia; ya[k][3] = (bf_hi(wa[k][0].y) + bf_hi(wa[k][1].y) + bf_hi(wa[k][2].y)) * ia;
                    ya[k][4] = (bf_lo(wa[k][0].z) + bf_lo(wa[k][1].z) + bf_lo(wa[k][2].z)) * ia; ya[k][5] = (bf_hi(wa[k][0].z) + bf_hi(wa[k][1].z) + bf_hi(wa[k][2].z)) * ia;
                    ya[k][6] = (bf_lo(wa[k][0].w) + bf_lo(wa[k][1].w) + bf_lo(wa[k][2].w)) * ia; ya[k][7] = (bf_hi(wa[k][0].w) + bf_hi(wa[k][1].w) + bf_hi(wa[k][2].w)) * ia;
                    yb[k][0] = bf_lo(wb[k].x) * ib; yb[k][1] = bf_hi(wb[k].x) * ib; yb[k][2] = bf_lo(wb[k].y) * ib; yb[k][3] = bf_hi(wb[k].y) * ib;
                    yb[k][4] = bf_lo(wb[k].z) * ib; yb[k][5] = bf_hi(wb[k].z) * ib; yb[k][6] = bf_lo(wb[k].w) * ib; yb[k][7] = bf_hi(wb[k].w) * ib;
                    sa[k] = 0.f; sb[k] = 0.f;
#pragma unroll
                    for (int i = 0; i < 8; ++i) { sa[k] += ya[k][i] * ya[k][i]; sb[k] += yb[k][i] * yb[k][i]; } }
#pragma unroll
                for (int o = 1; o < 64; o <<= 1) {
#pragma unroll
                    for (int k = 0; k < 4; ++k) { sa[k] += __shfl_xor(sa[k], o); sb[k] += __shfl_xor(sb[k], o); } }
#pragma unroll
                for (int k = 0; k < 4; ++k) { const int m = m0 + k;
                    const float ra = __builtin_amdgcn_rsqf(sa[k] * (1.f / 512.f) + EPS), rb = __builtin_amdgcn_rsqf(sb[k] * (1.f / 512.f) + EPS);
                    v4u oa, ob;
                    oa.x = cvtpk(ya[k][0] * ra * ga0.x, ya[k][1] * ra * ga0.y); oa.y = cvtpk(ya[k][2] * ra * ga0.z, ya[k][3] * ra * ga0.w); oa.z = cvtpk(ya[k][4] * ra * ga1.x, ya[k][5] * ra * ga1.y); oa.w = cvtpk(ya[k][6] * ra * ga1.z, ya[k][7] * ra * ga1.w);
                    ob.x = cvtpk(yb[k][0] * rb * gb0.x, yb[k][1] * rb * gb0.y); ob.y = cvtpk(yb[k][2] * rb * gb0.z, yb[k][3] * rb * gb0.w); ob.z = cvtpk(yb[k][4] * rb * gb1.x, yb[k][5] * rb * gb1.y); ob.w = cvtpk(yb[k][6] * rb * gb1.z, yb[k][7] * rb * gb1.w);
                    *(v4u*)(Y + (size_t)m * DM + 8 * lane) = oa; *(v4u*)(Y + (size_t)m * DM + 512 + 8 * lane) = ob; }
            }
        }
    }
    xcd_barrier(bar);

    {
        pg8::Gemm g{Y, WOUT, M, DM, DM, 256}; pg8::StaticOrder S; S.init(M, DM, G, bx);
        pg8::EpiOut E{xp, xs, out, XN, SSQ};
        pg8::gemm_phase<pg8::EpiOut, pg8::StaticOrder, PG8_ALIGN, PG8_SP2>(lds, g, S, E);
    }
    xcd_barrier(bar);

    {
        pg8::Gemm g{XN - DM, WUP, UP_TILES_M * 256, UPW, DM, 254}; pg8::StaticOrder S; S.init(UP_TILES_M * 256, UPW, G, bx);
        pg8::EpiUp E{HB, SSQ, conv_w, conv_b, (LAS float*)(lds + XCH_OFF)};
        pg8::gemm_phase<pg8::EpiUp, pg8::StaticOrder, true, PG8_SP2>(lds, g, S, E);
    }
    xcd_barrier(bar);

    {
        pg8::Gemm g{HB, WDN, M, DM, DFF, 256}; pg8::StaticOrder S; S.init(M, DM, G, bx);
        pg8::EpiDown E{out};
        pg8::gemm_phase<pg8::EpiDown, pg8::StaticOrder, PG8_ALIGN, PG8_SP2>(lds, g, S, E);
    }
}

extern "C" void kernel_launch(void* const* d_in, const int* in_sizes, int n_in, void* d_out, int out_size, void* d_ws, size_t ws_size, hipStream_t stream) {
    static int grid = 0;
    if (grid == 0) {
        if (n_in != 17 || out_size != M * DM || ws_size < WS_END) { fprintf(stderr, "kernel_launch: unexpected shapes (n_in %d out %d ws %zu)\n", n_in, out_size, ws_size); grid = -1; return; }
        int dev = 0, cus = 0, per_cu = 0;
        hipGetDevice(&dev); hipDeviceGetAttribute(&cus, hipDeviceAttributeMultiprocessorCount, dev);
        if (hipFuncSetAttribute((const void*)fwd_megakernel, hipFuncAttributeMaxDynamicSharedMemorySize, LDS_BYTES) != hipSuccess) { fprintf(stderr, "kernel_launch: hipFuncSetAttribute failed\n"); grid = -1; return; }
        if (hipOccupancyMaxActiveBlocksPerMultiprocessor(&per_cu, (const void*)fwd_megakernel, NWAVES * 64, LDS_BYTES) != hipSuccess || per_cu < 1) { fprintf(stderr, "kernel_launch: occupancy query says %d\n", per_cu); per_cu = 1; }
        (void)hipGetLastError();
        grid = cus;
        fprintf(stderr, "kernel_launch: grid %d (per_cu %d)\n", grid, per_cu);
    }
    if (grid < 0) return;
    Args a{};
    for (int i = 0; i < 17; ++i) a.in[i] = (const float*)d_in[i];
    a.out = (float*)d_out; a.ws = (unsigned char*)d_ws;
    void* kargs[] = {&a};
    hipError_t e = hipLaunchCooperativeKernel((const void*)fwd_megakernel, dim3(grid), dim3(NWAVES * 64), kargs, LDS_BYTES, stream);
    if (e != hipSuccess) fprintf(stderr, "kernel_launch: cooperative launch failed: %s\n", hipGetErrorString(e));
}
```

```cpp
#include <hip/hip_runtime.h>
#include <hip/hip_cooperative_groups.h>
#include <cstdio>
#include <cstdint>
namespace cg = cooperative_groups;
namespace pg8 {
#define PG8_LAS __attribute__((address_space(3)))
typedef unsigned short bf16_t;
typedef short bf16x8 __attribute__((ext_vector_type(8)));
typedef float f32x4 __attribute__((ext_vector_type(4)));
typedef unsigned u32x4 __attribute__((ext_vector_type(4)));
constexpr int BM = 256, BK = 64, HALF = 128, HTB = HALF * BK * 2  , STAGE_BYTES = 8 * HTB, NXCD = 8, WGM = 8;

__host__ __device__ __forceinline__ int lds_byte(int r, int c) { const int st = (r >> 4) * 2 + (c >> 5), rr = r & 15, cc = c & 31, ob = rr * 64 + cc * 2; return st * 1024 + (ob ^ (((ob >> 9) & 1) << 5)); }
__host__ __device__ __forceinline__ void stage_rc(int b, int& R, int& C) { const int st = b / 1024, sb = b % 1024, swz = sb ^ (((sb >> 9) & 1) << 5); R = (st >> 1) * 16 + swz / 64; C = (st & 1) * 32 + (swz % 64) / 2; }
__host__ __device__ __forceinline__ int perm32(int rho) { const int n = rho >> 4, i = rho & 15; return 8 * (i >> 2) + 4 * n + (i & 3); }

struct Unit { int pm, pn; };
struct Gemm { const bf16_t* A; const bf16_t* Bt; int M, N, K; int a_tile_rows; };

struct StaticOrder {
    int nM, nN, nwg, G, c;
    __host__ __device__ void init(int M, int N, int G_, int c_) { nM = M / BM; nN = N / BM; nwg = nM * nN; G = G_; c = c_; }
    __host__ __device__ bool next(int i, Unit& u) const {
        const long L = (long)i * G + c; if (L >= nwg) return false;
        int wgid = (int)L; { const int q = nwg / NXCD, r = nwg % NXCD, xcd = wgid % NXCD, off = wgid / NXCD; wgid = (xcd < r ? xcd * (q + 1) : r * (q + 1) + (xcd - r) * q) + off; }
        const int nig = WGM * nN, gid = wgid / nig, fm = gid * WGM, gsz = (nM - fm) < WGM ? (nM - fm) : WGM;
        u.pm = fm + ((wgid % nig) % gsz); u.pn = (wgid % nig) / gsz; return true;
    }
    __device__ __forceinline__ void a_ready(const Unit&) const {}
    __device__ __forceinline__ void done(const Unit&) const {}
};

__device__ __forceinline__ unsigned cvt_pk_bf16(float lo, float hi) { unsigned r; asm volatile("v_cvt_pk_bf16_f32 %0, %1, %2" : "=v"(r) : "v"(lo), "v"(hi)); return r; }
typedef float f32x2 __attribute__((ext_vector_type(2))); typedef __bf16 bf16x2_t __attribute__((ext_vector_type(2)));
__device__ __forceinline__ unsigned cvtpk(float lo, float hi) { f32x2 v = {lo, hi}; bf16x2_t b = __builtin_convertvector(v, bf16x2_t); return __builtin_bit_cast(unsigned, b); }
constexpr int MTOK = 49152, MPROMPT = 16384, DMODEL = 1024, DFF_ = 2816;
__device__ __forceinline__ u32x4 pack8(const f32x4 a, const f32x4 b) { u32x4 w; w.x = cvtpk(a[0], a[1]); w.y = cvtpk(a[2], a[3]); w.z = cvtpk(b[0], b[1]); w.w = cvtpk(b[2], b[3]); return w; }

struct EpiProj {
    static constexpr bool PERM = true, AFTER_DRAIN = false;
    bf16_t* O; int ldc;
    __device__ __forceinline__ void operator()(f32x4 (&acc)[2][2][4][2], const Unit& u, int wr, int wc, int fr, int fq, int wid, int lane) const {
        const int row0 = u.pm * BM + wr * 64 + fr, col0 = u.pn * BM + wc * 32 + 8 * fq;
#pragma unroll
        for (int ai = 0; ai < 2; ++ai)
#pragma unroll
            for (int m = 0; m < 4; ++m) { bf16_t* rowp = O + (size_t)(row0 + ai * HALF + m * 16) * ldc + col0;
#pragma unroll
                for (int bj = 0; bj < 2; ++bj) *(u32x4*)(rowp + bj * HALF) = pack8(acc[ai][bj][m][0], acc[ai][bj][m][1]); }
    }
};
struct EpiOut {
    static constexpr bool PERM = true, AFTER_DRAIN = false;
    const float* xp; const float* xs; bf16_t* xb; float* ssq;
    __device__ __forceinline__ void operator()(f32x4 (&acc)[2][2][4][2], const Unit& u, int wr, int wc, int fr, int fq, int wid, int lane) const {
        const int col0 = u.pn * BM + wc * 32 + 8 * fq;
#pragma unroll
        for (int ai = 0; ai < 2; ++ai)
#pragma unroll
            for (int m = 0; m < 4; ++m) { const int gr = u.pm * BM + ai * HALF + wr * 64 + m * 16 + fr;
                const float* xr = (gr < MPROMPT ? xp + (size_t)gr * DMODEL : xs + (size_t)(gr - MPROMPT) * DMODEL) + col0;
                float s = 0.f;
#pragma unroll
                for (int bj = 0; bj < 2; ++bj) { f32x4 a = *(const f32x4*)(xr + bj * HALF), b = *(const f32x4*)(xr + bj * HALF + 4);
                    a += acc[ai][bj][m][0]; b += acc[ai][bj][m][1];
                    s += (a[0] * a[0] + a[1] * a[1]) + (a[2] * a[2] + a[3] * a[3]) + (b[0] * b[0] + b[1] * b[1]) + (b[2] * b[2] + b[3] * b[3]);
                    *(u32x4*)(xb + (size_t)gr * DMODEL + col0 + bj * HALF) = pack8(a, b); }
                s += __shfl_xor(s, 16); s += __shfl_xor(s, 32);
                if (fq == 0) unsafeAtomicAdd(ssq + gr, s);
                asm volatile("" ::: "memory"); }
    }
};
struct EpiDown {
    static constexpr bool PERM = true, AFTER_DRAIN = false;
    const bf16_t* xb; float* out;
    __device__ __forceinline__ void operator()(f32x4 (&acc)[2][2][4][2], const Unit& u, int wr, int wc, int fr, int fq, int wid, int lane) const {
        const int col0 = u.pn * BM + wc * 32 + 8 * fq;
#pragma unroll
        for (int ai = 0; ai < 2; ++ai)
#pragma unroll
            for (int m = 0; m < 4; ++m) { const int gr = u.pm * BM + ai * HALF + wr * 64 + m * 16 + fr;
                float* o = out + (size_t)gr * DMODEL + col0; const bf16_t* xr = xb + (size_t)gr * DMODEL + col0;
#pragma unroll
                for (int bj = 0; bj < 2; ++bj) { const u32x4 w = *(const u32x4*)(xr + bj * HALF);
                    f32x4 a = {__uint_as_float(w.x << 16), __uint_as_float(w.x & 0xffff0000u), __uint_as_float(w.y << 16), __uint_as_float(w.y & 0xffff0000u)};
                    f32x4 b = {__uint_as_float(w.z << 16), __uint_as_float(w.z & 0xffff0000u), __uint_as_float(w.w << 16), __uint_as_float(w.w & 0xffff0000u)};
                    a += acc[ai][bj][m][0]; b += acc[ai][bj][m][1]; *(f32x4*)(o + bj * HALF) = a; *(f32x4*)(o + bj * HALF + 4) = b; }
                asm volatile("" ::: "memory"); }
    }
};
__device__ __forceinline__ bool seq_first(int gr) { return gr == 0 || (gr >= MPROMPT && (gr & 2047) == 0); }
__device__ __forceinline__ bool seq_last(int gr) { return gr >= MPROMPT - 1 && (gr & 2047) == 2047; }
struct EpiUp {
    static constexpr bool PERM = true, AFTER_DRAIN = false;
    bf16_t* H; const float* ssq; const float* cw; const float* cb; PG8_LAS float* xch;
    __device__ __forceinline__ void operator()(f32x4 (&acc)[2][2][4][2], const Unit& u, int wr, int wc, int fr, int fq, int wid, int lane) const {
        const int lr0 = wr * 64 + fr, gr0 = 254 * u.pm - 1 + lr0;
#pragma unroll
        for (int ai = 0; ai < 2; ++ai)
#pragma unroll
            for (int m = 0; m < 4; ++m) { int gr = gr0 + ai * HALF + m * 16; gr = gr < 0 ? 0 : (gr > MTOK - 1 ? MTOK - 1 : gr);
                const float rs = __builtin_amdgcn_rsqf(ssq[gr] * (1.0f / DMODEL) + 1e-6f);
#pragma unroll
                for (int bj = 0; bj < 2; ++bj)
#pragma unroll
                    for (int n = 0; n < 2; ++n) acc[ai][bj][m][n] *= rs; }
#pragma unroll
        for (int ai = 0; ai < 2; ++ai) {
            if (fr == 0) { PG8_LAS float* p = xch + ((wid * 2 + ai) * 2 + 0) * 64 + 8 * fq;
#pragma unroll
                for (int bj = 0; bj < 2; ++bj)
#pragma unroll
                    for (int n = 0; n < 2; ++n) *(PG8_LAS f32x4*)(p + bj * 32 + 4 * n) = acc[ai][bj][0][n]; }
            if (fr == 15) { PG8_LAS float* p = xch + ((wid * 2 + ai) * 2 + 1) * 64 + 8 * fq;
#pragma unroll
                for (int bj = 0; bj < 2; ++bj)
#pragma unroll
                    for (int n = 0; n < 2; ++n) *(PG8_LAS f32x4*)(p + bj * 32 + 4 * n) = acc[ai][bj][3][n]; }
        }
        asm volatile("s_waitcnt lgkmcnt(0)" ::: "memory"); __builtin_amdgcn_s_barrier(); asm volatile("" ::: "memory");
        const int ow = (1 - wr) * 4 + wc;
        const int srcP = ((lane & 48) | ((fr + 15) & 15)) * 4, srcN = ((lane & 48) | ((fr + 1) & 15)) * 4;
        const int ch0 = 128 * u.pn + 32 * wc + 8 * fq;
#pragma unroll
        for (int n = 0; n < 2; ++n) {
            f32x4 w0[2], w1[2], w2[2], bb[2];
#pragma unroll
            for (int bj = 0; bj < 2; ++bj) { const int ch = ch0 + 4 * n + bj * DFF_;
                w0[bj] = *(const f32x4*)(cw + ch); w1[bj] = *(const f32x4*)(cw + 2 * DFF_ + ch); w2[bj] = *(const f32x4*)(cw + 4 * DFF_ + ch); bb[bj] = *(const f32x4*)(cb + ch); }
#pragma unroll
            for (int ai = 0; ai < 2; ++ai) {
                const int aiT = wr == 1 ? ai : ai - 1, aiB = wr == 0 ? ai : ai + 1;
#pragma unroll
                for (int m = 0; m < 4; ++m) {
                    const int lr = lr0 + ai * HALF + m * 16, gr = gr0 + ai * HALF + m * 16;
                    const bool first = seq_first(gr), last = seq_last(gr);
                    f32x4 c[2];
#pragma unroll
                    for (int bj = 0; bj < 2; ++bj) {
                        const f32x4 cur = acc[ai][bj][m][n];
                        f32x4 pv, nx;
#pragma unroll
                        for (int e = 0; e < 4; ++e) {
                            const float sP = (m > 0 && fr == 15) ? acc[ai][bj][m > 0 ? m - 1 : 0][n][e] : cur[e];
                            const float sN = (m < 3 && fr == 0) ? acc[ai][bj][m < 3 ? m + 1 : 3][n][e] : cur[e];
                            pv[e] = __builtin_bit_cast(float, __builtin_amdgcn_ds_bpermute(srcP, __builtin_bit_cast(int, sP)));
                            nx[e] = __builtin_bit_cast(float, __builtin_amdgcn_ds_bpermute(srcN, __builtin_bit_cast(int, sN))); }
                        if (m == 0) { const f32x4 top = (aiT >= 0) ? *(const PG8_LAS f32x4*)(xch + ((ow * 2 + (aiT < 0 ? 0 : aiT)) * 2 + 1) * 64 + 8 * fq + bj * 32 + 4 * n) : (f32x4){0.f, 0.f, 0.f, 0.f}; if (fr == 0) pv = top; }
                        if (m == 3) { const f32x4 bot = (aiB <= 1) ? *(const PG8_LAS f32x4*)(xch + ((ow * 2 + (aiB > 1 ? 1 : aiB)) * 2 + 0) * 64 + 8 * fq + bj * 32 + 4 * n) : (f32x4){0.f, 0.f, 0.f, 0.f}; if (fr == 15) nx = bot; }
                        if (first) pv = (f32x4){0.f, 0.f, 0.f, 0.f};
                        if (last) nx = (f32x4){0.f, 0.f, 0.f, 0.f};
                        c[bj] = bb[bj] + w0[bj] * pv + w1[bj] * cur + w2[bj] * nx;
                    }
                    f32x4 hv;
#pragma unroll
                    for (int e = 0; e < 4; ++e) { const float g = c[0][e]; hv[e] = g * __builtin_amdgcn_rcpf(1.0f + __builtin_amdgcn_exp2f(-1.4426950408889634f * g)) * c[1][e]; }
                    f32x2 pk; pk.x = __builtin_bit_cast(float, cvtpk(hv[0], hv[1])); pk.y = __builtin_bit_cast(float, cvtpk(hv[2], hv[3]));
                    if (lr >= 1 && lr <= 254 && gr < MTOK) *(f32x2*)(H + (size_t)gr * DFF_ + ch0 + 4 * n) = pk;
                    asm volatile("" ::: "memory");
                }
            }
        }
    }
};
template <class Epi, class Sched, bool ALIGN_EPI = false, bool SP2 = false>
__device__ __forceinline__ void gemm_phase(PG8_LAS unsigned char* lds, const Gemm g, const Sched& S, const Epi& E) {
    int tid_ = threadIdx.x; asm volatile("" : "+v"(tid_));
    const int tid = tid_, wid = __builtin_amdgcn_readfirstlane(tid >> 6), lane = tid & 63, wr = wid >> 2, wc = wid & 3, fr = lane & 15, fq = lane >> 4;
    const int K = g.K, nt = K / BK;
    unsigned voffA[2], voffB[2];
#pragma unroll
    for (int i = 0; i < 2; ++i) { int R, C; stage_rc(tid * 16 + i * 8192, R, C); const int Rb = Epi::PERM ? ((R & ~31) + perm32(R & 31)) : R;
        voffA[i] = (unsigned)(R * K + C) * 2u; voffB[i] = (unsigned)(Rb * K + C) * 2u; }
    const size_t kstep = (size_t)(BK * 2);
    const size_t hstep = (size_t)HALF * K * 2;
    const size_t tstep = 2 * hstep; const size_t tstepA = (size_t)g.a_tile_rows * K * 2;
    const unsigned ldsw = (unsigned)wid * 1024u;
    const int aoff = lds_byte(wr * 64 + fr, fq * 8), boff = lds_byte(wc * 32 + fr, fq * 8);
#define PG8_SA(b, h) (((b) * 2 + (h)) * HTB)
#define PG8_SB(b, h) ((4 + (b) * 2 + (h)) * HTB)
#define PG8_STAGE(bufoff, gbase, voff) do { _Pragma("unroll") for (int _i = 0; _i < 2; ++_i) \
        __builtin_amdgcn_global_load_lds((const unsigned*)((const char*)(gbase) + (voff)[_i]), (PG8_LAS unsigned*)(lds + (bufoff) + ldsw + _i * 8192), 16, 0, 0); } while (0)
#define PG8_LDA(dst, b, h) do { _Pragma("unroll") for (int m = 0; m < 4; ++m) _Pragma("unroll") for (int k = 0; k < 2; ++k) dst[m][k] = *(const PG8_LAS bf16x8*)(lds + PG8_SA(b, h) + aoff + m * 2048 + k * 1024); } while (0)
#define PG8_LDB(dst, b, h) do { _Pragma("unroll") for (int n = 0; n < 2; ++n) _Pragma("unroll") for (int k = 0; k < 2; ++k) dst[n][k] = *(const PG8_LAS bf16x8*)(lds + PG8_SB(b, h) + boff + n * 2048 + k * 1024); } while (0)
#define PG8_MMA(ai, bj, At, Bt) do { __builtin_amdgcn_s_setprio(1); _Pragma("unroll") for (int m = 0; m < 4; ++m) _Pragma("unroll") for (int n = 0; n < 2; ++n) _Pragma("unroll") for (int k = 0; k < 2; ++k) \
        acc[ai][bj][m][n] = __builtin_amdgcn_mfma_f32_16x16x32_bf16(Bt[n][k], At[m][k], acc[ai][bj][m][n], 0, 0, 0); __builtin_amdgcn_s_setprio(0); } while (0)
#define PG8_WAIT_V(n) asm volatile("s_waitcnt vmcnt(" #n ")" ::: "memory")
#define PG8_WAIT_L(n) asm volatile("s_waitcnt lgkmcnt(" #n ")" ::: "memory")
#define PG8_BAR __builtin_amdgcn_s_barrier()
#define PG8_SCHED __builtin_amdgcn_sched_barrier(0)
    Unit cur, nxt; int ui = 0;
    if (!S.next(0, cur)) return;
    f32x4 acc[2][2][4][2];
#pragma unroll
    for (int a = 0; a < 2; ++a)
#pragma unroll
        for (int b = 0; b < 2; ++b)
#pragma unroll
            for (int m = 0; m < 4; ++m)
#pragma unroll
                for (int n = 0; n < 2; ++n) acc[a][b][m][n] = (f32x4){0.f, 0.f, 0.f, 0.f};
    bf16x8 At[4][2], B0[2][2], B1[2][2];
    const char* cA = (const char*)g.A + (size_t)cur.pm * tstepA; const char* cB = (const char*)g.Bt + (size_t)cur.pn * tstep;
    S.a_ready(cur);
    if constexpr (SP2) {
        PG8_STAGE(PG8_SB(0, 0), cB, voffB); PG8_STAGE(PG8_SB(0, 1), cB + hstep, voffB); PG8_STAGE(PG8_SA(0, 0), cA, voffA); PG8_STAGE(PG8_SA(0, 1), cA + hstep, voffA);
        if (wr == 1) PG8_BAR;
        PG8_WAIT_V(2); PG8_BAR;
        PG8_STAGE(PG8_SB(1, 0), cB + kstep, voffB); PG8_STAGE(PG8_SA(1, 0), cA + kstep, voffA); PG8_STAGE(PG8_SB(1, 1), cB + hstep + kstep, voffB);
        PG8_WAIT_V(6); PG8_BAR;
    } else {
        PG8_STAGE(PG8_SB(0, 0), cB, voffB); PG8_STAGE(PG8_SA(0, 0), cA, voffA); PG8_STAGE(PG8_SB(0, 1), cB + hstep, voffB); PG8_STAGE(PG8_SA(0, 1), cA + hstep, voffA);
        if (wr == 1) PG8_BAR;
        PG8_WAIT_V(4); PG8_BAR;
        PG8_STAGE(PG8_SB(1, 0), cB + kstep, voffB); PG8_STAGE(PG8_SA(1, 0), cA + kstep, voffA); PG8_STAGE(PG8_SB(1, 1), cB + hstep + kstep, voffB);
        PG8_WAIT_V(6); PG8_BAR;
    }
    for (;;) {
        const bool has_next = S.next(ui + 1, nxt);
        const char* nA = has_next ? (const char*)g.A + (size_t)nxt.pm * tstepA : cA; const char* nB = has_next ? (const char*)g.Bt + (size_t)nxt.pn * tstep : cB;
        for (int t = 0; t < nt; t += 2) {
            const bool last = (t == nt - 2);
            const char* a1 = cA + (size_t)(t + 1) * kstep;
            const char* a2 = last ? nA : cA + (size_t)(t + 2) * kstep; const char* b2 = last ? nB : cB + (size_t)(t + 2) * kstep;
            const char* a3 = a2 + kstep; const char* b3 = b2 + kstep;
            if (last && has_next) S.a_ready(nxt);
            if constexpr (SP2) {
            PG8_LDB(B0, 0, 0); PG8_LDB(B1, 0, 1); PG8_SCHED; PG8_LDA(At, 0, 0); PG8_STAGE(PG8_SA(1, 1), a1 + hstep, voffA);
            PG8_WAIT_V(8); PG8_WAIT_L(0); PG8_BAR; PG8_MMA(0, 0, At, B0); PG8_MMA(0, 1, At, B1); PG8_BAR; PG8_SCHED;
            PG8_LDA(At, 0, 1); PG8_STAGE(PG8_SB(0, 0), b2, voffB); PG8_STAGE(PG8_SB(0, 1), b2 + hstep, voffB); PG8_STAGE(PG8_SA(0, 0), a2, voffA);
            PG8_WAIT_V(8); PG8_WAIT_L(0); PG8_BAR; PG8_MMA(1, 0, At, B0); PG8_MMA(1, 1, At, B1); PG8_BAR; PG8_SCHED;
            PG8_LDB(B0, 1, 0); PG8_LDB(B1, 1, 1); PG8_SCHED; PG8_LDA(At, 1, 0); PG8_STAGE(PG8_SA(0, 1), a2 + hstep, voffA);
            PG8_WAIT_V(8); PG8_WAIT_L(0); PG8_BAR; PG8_MMA(0, 0, At, B0); PG8_MMA(0, 1, At, B1); PG8_BAR; PG8_SCHED;
            PG8_LDA(At, 1, 1); PG8_STAGE(PG8_SB(1, 0), b3, voffB); PG8_STAGE(PG8_SB(1, 1), b3 + hstep, voffB); PG8_STAGE(PG8_SA(1, 0), a3, voffA);
            PG8_WAIT_V(8); PG8_WAIT_L(0); PG8_BAR; PG8_MMA(1, 0, At, B0); PG8_MMA(1, 1, At, B1); PG8_BAR; PG8_SCHED;
            } else {
            PG8_LDB(B0, 0, 0); PG8_SCHED; PG8_LDA(At, 0, 0); PG8_STAGE(PG8_SA(1, 1), a1 + hstep, voffA);
            PG8_WAIT_L(8); PG8_BAR; PG8_WAIT_L(0); PG8_MMA(0, 0, At, B0); PG8_BAR; PG8_SCHED;
            PG8_LDB(B1, 0, 1); PG8_STAGE(PG8_SB(0, 0), b2, voffB);
            PG8_BAR; PG8_WAIT_L(0); PG8_MMA(0, 1, At, B1); PG8_BAR;
            PG8_LDA(At, 0, 1); PG8_STAGE(PG8_SA(0, 0), a2, voffA);
            PG8_BAR; PG8_WAIT_L(0); PG8_MMA(1, 0, At, B0); PG8_BAR; PG8_SCHED;
            PG8_STAGE(PG8_SB(0, 1), b2 + hstep, voffB);
            PG8_WAIT_V(6); PG8_BAR; PG8_MMA(1, 1, At, B1); PG8_BAR;
            PG8_LDB(B0, 1, 0); PG8_SCHED; PG8_LDA(At, 1, 0); PG8_STAGE(PG8_SA(0, 1), a2 + hstep, voffA);
            PG8_WAIT_L(8); PG8_BAR; PG8_WAIT_L(0); PG8_MMA(0, 0, At, B0); PG8_BAR; PG8_SCHED;
            PG8_LDB(B1, 1, 1); PG8_STAGE(PG8_SB(1, 0), b3, voffB);
            PG8_BAR; PG8_WAIT_L(0); PG8_MMA(0, 1, At, B1); PG8_BAR;
            PG8_LDA(At, 1, 1); PG8_STAGE(PG8_SA(1, 0), a3, voffA);
            PG8_BAR; PG8_WAIT_L(0); PG8_MMA(1, 0, At, B0); PG8_BAR; PG8_SCHED;
            PG8_STAGE(PG8_SB(1, 1), b3 + hstep, voffB);
            PG8_WAIT_V(6); PG8_BAR; PG8_MMA(1, 1, At, B1); PG8_BAR;
            }
        }
        if constexpr (ALIGN_EPI) { if (wr == 0) PG8_BAR; }
        if constexpr (!Epi::AFTER_DRAIN) { E(acc, cur, wr, wc, fr, fq, wid, lane); S.done(cur); }
        if (!has_next) break;
#pragma unroll
        for (int a = 0; a < 2; ++a)
#pragma unroll
            for (int b = 0; b < 2; ++b)
#pragma unroll
                for (int m = 0; m < 4; ++m)
#pragma unroll
                    for (int n = 0; n < 2; ++n) acc[a][b][m][n] = (f32x4){0.f, 0.f, 0.f, 0.f};
        cur = nxt; cA = nA; cB = nB; ++ui;
        if constexpr (ALIGN_EPI) { if (wr == 1) PG8_BAR; }
    }
    PG8_WAIT_V(0);
    if constexpr (!ALIGN_EPI) { if (wr == 0) PG8_BAR; }
    PG8_BAR;
    if constexpr (Epi::AFTER_DRAIN) { E.fused(acc, cur, wr, wc, fr, fq, lds, wid, lane); S.done(cur); }
#undef PG8_SA
#undef PG8_SB
#undef PG8_STAGE
#undef PG8_LDA
#undef PG8_LDB
#undef PG8_MMA
#undef PG8_WAIT_V
#undef PG8_WAIT_L
#undef PG8_BAR
#undef PG8_SCHED
}
}
#ifndef PG8_SP2
#define PG8_SP2 true
#endif
#ifndef PG8_ALIGN
#define PG8_ALIGN true
#endif

constexpr int NWAVES = 8;
constexpr int DM = 1024, M = 49152, MP = 16384, INW = 2304, DFF = 2816, UPW = 5632;
constexpr int QA_OFF = 0, KA_OFF = 512, VA_OFF = 1024, QB_OFF = 1536, KB_OFF = 2048, VB_OFF = 2176;
constexpr int UP_TILES_M = 194;
constexpr float EPS = 1e-6f, LOG2E = 1.4426950408889634f;

constexpr size_t MiB = 1u << 20;
constexpr size_t WS_SSQ = 0;
constexpr size_t WS_BAR = 1 * MiB;
constexpr size_t WS_WIN = 2 * MiB, WS_WOUT = 7 * MiB, WS_WUP = 9 * MiB, WS_WDN = 20 * MiB;
constexpr size_t WS_XN = 32 * MiB;
constexpr size_t WS_PROJ = 130 * MiB;
constexpr size_t WS_OA = 346 * MiB;
constexpr size_t WS_H = 226 * MiB;
constexpr size_t WS_LA = 490 * MiB;
constexpr size_t WS_END = 496 * MiB;
static_assert(WS_XN + (size_t)(M + 256) * DM * 2 <= WS_PROJ && WS_PROJ + (size_t)M * INW * 2 <= WS_OA && WS_OA + 3 * (size_t)M * 512 * 2 <= WS_LA && WS_H + (size_t)M * DFF * 2 <= WS_LA && WS_PROJ + (size_t)M * DM * 2 <= WS_H, "d_ws map");

constexpr int RING_BYTES = 131072, XCH_OFF = RING_BYTES, MISC_OFF = XCH_OFF + 8192, LDS_BYTES = 147456;

#define LAS __attribute__((address_space(3)))
typedef unsigned short bf16;
typedef unsigned v4u __attribute__((ext_vector_type(4)));
typedef float f32x4 __attribute__((ext_vector_type(4)));
typedef float f32x16 __attribute__((ext_vector_type(16)));
typedef short bf16x8 __attribute__((ext_vector_type(8)));
typedef short s16x4 __attribute__((ext_vector_type(4)));
using pg8::cvtpk;
__device__ __forceinline__ float bf_lo(unsigned w) { return __uint_as_float(w << 16); }
__device__ __forceinline__ float bf_hi(unsigned w) { return __uint_as_float(w & 0xffff0000u); }
__device__ __forceinline__ float wave_sum(float v) {
#pragma unroll
    for (int o = 1; o < 64; o <<= 1) v += __shfl_xor(v, o);
    return v;
}
__device__ __forceinline__ float wave_max(float v) {
#pragma unroll
    for (int o = 1; o < 64; o <<= 1) v = fmaxf(v, __shfl_xor(v, o));
    return v;
}

#define GAS __attribute__((address_space(1)))
#define RLX_AGENT __ATOMIC_RELAXED, __HIP_MEMORY_SCOPE_AGENT
#define XB_TMO      128
#define XB_XCNT(j)  (256  + 64 * (j))
#define XB_XSUB(j)  (1280 + 64 * (j))
#define XB_XGEN(j)  (2304 + 64 * (j))
#define XB_TOP      3328
#define XB_TOPGEN   3392
#define XCD_BAR_WORDS 3456
#define XB_SPIN_CAP (1u << 18)

__device__ __forceinline__ unsigned xb_ld(unsigned* p)              { return __hip_atomic_load(p, __ATOMIC_RELAXED, __HIP_MEMORY_SCOPE_AGENT); }
__device__ __forceinline__ unsigned xb_add(unsigned* p, unsigned v) { return __hip_atomic_fetch_add(p, v, __ATOMIC_RELAXED, __HIP_MEMORY_SCOPE_AGENT); }
__device__ __forceinline__ unsigned xb_xcc_id() { return (unsigned)__builtin_amdgcn_s_getreg((3 << 11) | 20) & 0xFu; }
#define XB_SPIN(cond, bar) do { unsigned _sp = 0; while (cond) { __builtin_amdgcn_s_sleep(1); \
    if ((++_sp & 255u) == 0u) { if (xb_ld(&(bar)[XB_TMO])) break; if (_sp > XB_SPIN_CAP) { atomicAdd(&(bar)[XB_TMO], 1u); break; } } } } while (0)

struct XcdBarrier {
    unsigned* bar; unsigned x;
    volatile LAS unsigned* st;
};

__device__ __forceinline__ XcdBarrier xcd_barrier_post(unsigned* bar, volatile LAS unsigned* st) {
    XcdBarrier b; b.bar = bar; b.x = xb_xcc_id(); b.st = st;
    if (threadIdx.x == 0) (void)xb_add(&bar[XB_XCNT(b.x)], 1u);
    return b;
}
__device__ __forceinline__ void xcd_barrier_complete(unsigned* bar, unsigned x, unsigned& nloc, unsigned& nx) {
    const unsigned G = gridDim.x * gridDim.y * gridDim.z;
    unsigned sum, cnt, mine, sp = 0u;
    for (;;) {
        sum = 0u; cnt = 0u; mine = 0u;
#pragma unroll
        for (unsigned j = 0; j < 16; ++j) { const unsigned c = xb_ld(&bar[XB_XCNT(j)]); sum += c; cnt += (c > 0u) ? 1u : 0u; mine = (j == x) ? c : mine; }
        if (sum == G) break;
        __builtin_amdgcn_s_sleep(1);
        if ((++sp & 255u) == 0u) { if (xb_ld(&bar[XB_TMO])) break; if (sp > XB_SPIN_CAP) { atomicAdd(&bar[XB_TMO], 1u); break; } }
    }
    nloc = mine > 0u ? mine : 1u; nx = cnt > 0u ? cnt : 1u;
}

__device__ __forceinline__ void xcd_barrier(const XcdBarrier& b) {
    asm volatile("s_waitcnt vmcnt(0)" ::: "memory");
    __syncthreads();
    if (threadIdx.x == 0) {
        unsigned* bar = b.bar;
        __builtin_amdgcn_s_waitcnt(0);
        unsigned nloc = b.st[0], nx = b.st[1];
        if (nloc == 0u) { xcd_barrier_complete(bar, b.x, nloc, nx); b.st[0] = nloc; b.st[1] = nx; }
        const unsigned old = xb_add(&bar[XB_XSUB(b.x)], 1u);
        const unsigned gen = old / nloc;
        if (old + 1u == (gen + 1u) * nloc) {
            __builtin_amdgcn_fence(__ATOMIC_RELEASE, "agent");
            asm volatile("s_waitcnt vmcnt(0)" ::: "memory");
            const unsigned og = xb_add(&bar[XB_TOP], 1u);
            const unsigned tg = og / nx;
            if (og + 1u == (tg + 1u) * nx) xb_add(&bar[XB_TOPGEN], 1u);
            else XB_SPIN(xb_ld(&bar[XB_TOPGEN]) == tg, bar);
            __builtin_amdgcn_fence(__ATOMIC_ACQUIRE, "agent");
            xb_add(&bar[XB_XGEN(b.x)], 1u);
            asm volatile("s_waitcnt vmcnt(0)" ::: "memory");
        } else {
            XB_SPIN(xb_ld(&bar[XB_XGEN(b.x)]) == gen, bar);
            __builtin_amdgcn_fence(__ATOMIC_ACQUIRE, "agent");
            asm volatile("s_waitcnt vmcnt(0)" ::: "memory");
        }
    }
    __syncthreads();
}

template <int MAP  >
__device__ __forceinline__ void p0_transpose_item(const float* W, int K, int N, bf16* WT, const float* kgain, LAS float* scr, int item, int lane) {
    const int nblk = N / 32, kb = item / nblk, nb = item % nblk, k0 = 64 * kb, n0 = 32 * nb;
#pragma unroll 8
    for (int i = 0; i < 32; ++i) { const int kk = 2 * i + (lane >> 5); float v = W[(size_t)(k0 + kk) * N + n0 + (lane & 31)]; if (kgain) v *= kgain[k0 + kk]; scr[kk * 33 + (lane & 31)] = v; }
    asm volatile("s_waitcnt lgkmcnt(0)" ::: "memory");
    const int c = lane & 7;
    int r0 = n0;
    if (MAP == 1) r0 = n0 < DFF ? ((n0 >> 7) * 256 + (n0 & 127)) : ((((n0 - DFF) >> 7) * 256) + 128 + ((n0 - DFF) & 127));
#pragma unroll
    for (int j = 0; j < 4; ++j) { const int n = (lane >> 3) + 8 * j; const LAS float* s = scr + (8 * c) * 33 + n;
        v4u o; o.x = cvtpk(s[0 * 33], s[1 * 33]); o.y = cvtpk(s[2 * 33], s[3 * 33]); o.z = cvtpk(s[4 * 33], s[5 * 33]); o.w = cvtpk(s[6 * 33], s[7 * 33]);
        *(v4u*)(WT + (size_t)(r0 + n) * K + k0 + 8 * c) = o; }
    asm volatile("s_waitcnt lgkmcnt(0)" ::: "memory");
}
__device__ __forceinline__ void rms_row_to_bf16(const float* xrow, const float* g, bf16* orow, int lane) {
    const f32x4* xr = (const f32x4*)xrow + lane; const f32x4* gr = (const f32x4*)g + lane;
    f32x4 v[4]; float s = 0.f;
#pragma unroll
    for (int j = 0; j < 4; ++j) { v[j] = xr[64 * j]; s += (v[j].x * v[j].x + v[j].y * v[j].y) + (v[j].z * v[j].z + v[j].w * v[j].w); }
    const float rstd = __builtin_amdgcn_rsqf(wave_sum(s) * (1.f / DM) + EPS);
    unsigned long long* o8 = (unsigned long long*)orow + lane;
#pragma unroll
    for (int j = 0; j < 4; ++j) { const f32x4 gg = gr[64 * j]; o8[64 * j] = (unsigned long long)cvtpk(v[j].x * rstd * gg.x, v[j].y * rstd * gg.y) | ((unsigned long long)cvtpk(v[j].z * rstd * gg.z, v[j].w * rstd * gg.w) << 32); }
}

__device__ __forceinline__ void rms_rows4_to_bf16(const float* xrow, const float* g, bf16* orow, int lane) {
    f32x4 v[4][4]; float s[4];
#pragma unroll
    for (int k = 0; k < 4; ++k)
#pragma unroll
        for (int j = 0; j < 4; ++j) v[k][j] = ((const f32x4*)(xrow + (size_t)k * DM) + lane)[64 * j];
    f32x4 gg[4];
#pragma unroll
    for (int j = 0; j < 4; ++j) gg[j] = ((const f32x4*)g + lane)[64 * j];
#pragma unroll
    for (int k = 0; k < 4; ++k) { s[k] = 0.f;
#pragma unroll
        for (int j = 0; j < 4; ++j) s[k] += (v[k][j].x * v[k][j].x + v[k][j].y * v[k][j].y) + (v[k][j].z * v[k][j].z + v[k][j].w * v[k][j].w); }
#pragma unroll
    for (int o = 1; o < 64; o <<= 1) {
#pragma unroll
        for (int k = 0; k < 4; ++k) s[k] += __shfl_xor(s[k], o); }
#pragma unroll
    for (int k = 0; k < 4; ++k) { const float rstd = __builtin_amdgcn_rsqf(s[k] * (1.f / DM) + EPS);
        unsigned long long* o8 = (unsigned long long*)(orow + (size_t)k * DM) + lane;
#pragma unroll
        for (int j = 0; j < 4; ++j) o8[64 * j] = (unsigned long long)cvtpk(v[k][j].x * rstd * gg[j].x, v[k][j].y * rstd * gg[j].y) | ((unsigned long long)cvtpk(v[k][j].z * rstd * gg[j].z, v[k][j].w * rstd * gg[j].w) << 32); }
}

template <int NKEYS, int NTHR>
__device__ __forceinline__ void stage_load(v4u (&kr)[NKEYS * 8 / NTHR], v4u (&vr)[NKEYS * 8 / NTHR], const bf16* proj, int kcol, int vcol, int tok0, int dshift, int kidx0, int Ls, int t) {
    constexpr int NIT = NKEYS * 8 / NTHR;
    const int c = t & 7;
#pragma unroll
    for (int it = 0; it < NIT; ++it) { const int rho = (it * NTHR + t) >> 3, kidx = kidx0 + rho; const bool ok = (unsigned)kidx < (unsigned)Ls;
        const bf16* rowp = proj + (size_t)(tok0 + ((ok ? kidx : 0) << dshift)) * INW + 8 * c;
        kr[it] = *(const v4u*)(rowp + kcol); vr[it] = *(const v4u*)(rowp + vcol); }
}
template <int NKEYS, int NTHR>
__device__ __forceinline__ void stage_write(const v4u (&kr)[NKEYS * 8 / NTHR], const v4u (&vr)[NKEYS * 8 / NTHR], LAS unsigned char* Kl, LAS unsigned char* Vl, int kidx0, int Ls, const f32x4 g0, const f32x4 g1, int t) {
    constexpr int NIT = NKEYS * 8 / NTHR;
    const int c = t & 7;
#pragma unroll
    for (int it = 0; it < NIT; ++it) { const int rho = (it * NTHR + t) >> 3; const bool ok = (unsigned)(kidx0 + rho) < (unsigned)Ls;
        float f[8] = {bf_lo(kr[it].x), bf_hi(kr[it].x), bf_lo(kr[it].y), bf_hi(kr[it].y), bf_lo(kr[it].z), bf_hi(kr[it].z), bf_lo(kr[it].w), bf_hi(kr[it].w)};
        float ss = (f[0] * f[0] + f[1] * f[1]) + (f[2] * f[2] + f[3] * f[3]) + (f[4] * f[4] + f[5] * f[5]) + (f[6] * f[6] + f[7] * f[7]);
        ss += __shfl_xor(ss, 1); ss += __shfl_xor(ss, 2); ss += __shfl_xor(ss, 4);
        const float rs = ok ? __builtin_amdgcn_rsqf(ss * (1.f / 64.f) + EPS) : 0.f;
        v4u o; o.x = cvtpk(f[0] * rs * g0.x, f[1] * rs * g0.y); o.y = cvtpk(f[2] * rs * g0.z, f[3] * rs * g0.w); o.z = cvtpk(f[4] * rs * g1.x, f[5] * rs * g1.y); o.w = cvtpk(f[6] * rs * g1.z, f[7] * rs * g1.w);
        *(LAS v4u*)(Kl + rho * 128 + 16 * (c ^ ((rho >> 1) & 7))) = o;
        *(LAS v4u*)(Vl + (c >> 2) * (NKEYS * 64) + rho * 64 + (c & 3) * 16) = ok ? vr[it] : (v4u){0u, 0u, 0u, 0u}; }
}
__device__ __forceinline__ void load_q_raw(v4u (&raw)[4], const bf16* qrow, int lane) {
#pragma unroll
    for (int d0 = 0; d0 < 4; ++d0) raw[d0] = *(const v4u*)(qrow + 16 * d0 + 8 * (lane >> 5));
}
__device__ __forceinline__ void norm_q(bf16x8 (&qf)[4], const v4u (&raw)[4], const float* gq, int lane) {
    const int hi = lane >> 5; float ss = 0.f;
#pragma unroll
    for (int d0 = 0; d0 < 4; ++d0) {
        const float a0 = bf_lo(raw[d0].x), a1 = bf_hi(raw[d0].x), a2 = bf_lo(raw[d0].y), a3 = bf_hi(raw[d0].y), a4 = bf_lo(raw[d0].z), a5 = bf_hi(raw[d0].z), a6 = bf_lo(raw[d0].w), a7 = bf_hi(raw[d0].w);
        ss += (a0 * a0 + a1 * a1) + (a2 * a2 + a3 * a3) + (a4 * a4 + a5 * a5) + (a6 * a6 + a7 * a7); }
    ss += __shfl_xor(ss, 32);
    const float rs = __builtin_amdgcn_rsqf(ss * (1.f / 64.f) + EPS) * (0.125f * LOG2E);
#pragma unroll
    for (int d0 = 0; d0 < 4; ++d0) { const f32x4 g0 = *(const f32x4*)(gq + 16 * d0 + 8 * hi), g1 = *(const f32x4*)(gq + 16 * d0 + 8 * hi + 4);
        v4u o; o.x = cvtpk(bf_lo(raw[d0].x) * rs * g0.x, bf_hi(raw[d0].x) * rs * g0.y); o.y = cvtpk(bf_lo(raw[d0].y) * rs * g0.z, bf_hi(raw[d0].y) * rs * g0.w);
        o.z = cvtpk(bf_lo(raw[d0].z) * rs * g1.x, bf_hi(raw[d0].z) * rs * g1.y); o.w = cvtpk(bf_lo(raw[d0].w) * rs * g1.z, bf_hi(raw[d0].w) * rs * g1.w);
        qf[d0] = __builtin_bit_cast(bf16x8, o); }
}
typedef short v4i16_t __attribute__((ext_vector_type(4)));
__device__ __forceinline__ s16x4 vtr(const LAS unsigned char* p) { return __builtin_bit_cast(s16x4, __builtin_amdgcn_ds_read_tr16_b64_v4i16((LAS v4i16_t*)p)); }
template <int R, bool BAND, bool EDGE>
__device__ __forceinline__ void attn_tile(const bf16x8 (&kf)[4], const LAS unsigned char* vq0, int vhs, int j, int kidx_t0, int Ls, const bf16x8 (&qf)[4], float base, float nslope, float negM, f32x16 (&o)[2], float& l, int hi) {
    f32x16 s = {0.f, 0.f, 0.f, 0.f, 0.f, 0.f, 0.f, 0.f, 0.f, 0.f, 0.f, 0.f, 0.f, 0.f, 0.f, 0.f};
#pragma unroll
    for (int d0 = 0; d0 < 4; ++d0) s = __builtin_amdgcn_mfma_f32_32x32x16_bf16(kf[d0], qf[d0], s, 0, 0, 0);
    if (negM != 0.f) {
#pragma unroll
        for (int r = 0; r < 16; ++r) s[r] += negM; }
    const float basej = base + (float)(32 * j);
    float pr[16];
#pragma unroll
    for (int r = 0; r < 16; ++r) { const float relf = basej + (float)((r & 3) + 8 * (r >> 2));
        float p = __builtin_amdgcn_exp2f(__builtin_fmaf(__builtin_fabsf(relf), nslope, s[r]));
        if (BAND) p = (__builtin_fabsf(relf) <= (float)R) ? p : 0.f;
        if (EDGE) { const int kidx = kidx_t0 + 32 * j + (r & 3) + 8 * (r >> 2) + 4 * hi; p = ((unsigned)kidx < (unsigned)Ls) ? p : 0.f; }
        l += p; pr[r] = p; }
    v4u w0, w1; w0.x = cvtpk(pr[0], pr[1]); w0.y = cvtpk(pr[2], pr[3]); w0.z = cvtpk(pr[4], pr[5]); w0.w = cvtpk(pr[6], pr[7]);
    w1.x = cvtpk(pr[8], pr[9]); w1.y = cvtpk(pr[10], pr[11]); w1.z = cvtpk(pr[12], pr[13]); w1.w = cvtpk(pr[14], pr[15]);
    const bf16x8 pa0 = __builtin_bit_cast(bf16x8, w0), pa1 = __builtin_bit_cast(bf16x8, w1);
    const LAS unsigned char* vq = vq0 + j * 2048;
#pragma unroll
    for (int dh = 0; dh < 2; ++dh)
#pragma unroll
        for (int s2 = 0; s2 < 2; ++s2) { const s16x4 lo = vtr(vq + dh * vhs + s2 * 1024), h4 = vtr(vq + dh * vhs + s2 * 1024 + 512);
            const bf16x8 vf = (bf16x8){lo[0], lo[1], lo[2], lo[3], h4[0], h4[1], h4[2], h4[3]};
            o[dh] = __builtin_amdgcn_mfma_f32_32x32x16_bf16(s2 ? pa1 : pa0, vf, o[dh], 0, 0, 0); }
}
template <int NT, int R, bool EDGE>
__device__ __forceinline__ void attn_task(const LAS unsigned char* Kl, const LAS unsigned char* Vl, int vhs, int row0, int kidx_t0, int Ls, const bf16x8 (&qf)[4], float slope2, float negM, f32x16 (&o)[2], float& l, int lane) {
    const int q = lane & 31, hi = lane >> 5;
    const LAS unsigned char* vp = Vl + row0 * 64 + (4 * hi + ((lane & 15) >> 2)) * 64 + (16 * ((lane >> 4) & 1) + 4 * (lane & 3)) * 2;
    const int sw = (q >> 1) & 7;
    const LAS unsigned char* kp0 = Kl + (row0 + q) * 128 + 16 * ((0 + hi) ^ sw); const LAS unsigned char* kp1 = Kl + (row0 + q) * 128 + 16 * ((2 + hi) ^ sw);
    const LAS unsigned char* kp2 = Kl + (row0 + q) * 128 + 16 * ((4 + hi) ^ sw); const LAS unsigned char* kp3 = Kl + (row0 + q) * 128 + 16 * ((6 + hi) ^ sw);
    float base = (float)(4 * hi - R - q); asm volatile("" : "+v"(base));
    const float nslope = -slope2;
#define LOADK(dst, jj) do { dst[0] = *(const LAS bf16x8*)(kp0 + (jj) * 4096); dst[1] = *(const LAS bf16x8*)(kp1 + (jj) * 4096); dst[2] = *(const LAS bf16x8*)(kp2 + (jj) * 4096); dst[3] = *(const LAS bf16x8*)(kp3 + (jj) * 4096); } while (0)
    bf16x8 kf[4];
    LOADK(kf, 0);
    attn_tile<R, true, EDGE>(kf, vp, vhs, 0, kidx_t0, Ls, qf, base, nslope, negM, o, l, hi);
#pragma unroll 1
    for (int j = 1; j < NT - 1; ++j) {
        LOADK(kf, j);
        attn_tile<R, false, EDGE>(kf, vp, vhs, j, kidx_t0, Ls, qf, base, nslope, negM, o, l, hi);
    }
    LOADK(kf, NT - 1);
    attn_tile<R, true, EDGE>(kf, vp, vhs, NT - 1, kidx_t0, Ls, qf, base, nslope, negM, o, l, hi);
#undef LOADK
}
__device__ __forceinline__ void store_partial(const f32x16 (&o)[2], float l, bf16* OB, float* LB, int tokq0, int dshift, int h, int lane) {
    const int hi = lane >> 5, d = lane & 31;
    l += __shfl_xor(l, 32);
    if (hi == 0) LB[(size_t)(tokq0 + (d << dshift)) * 8 + h] = l;
#pragma unroll
    for (int r = 0; r < 16; ++r) { const int qq = (r & 3) + 8 * (r >> 2) + 4 * hi; bf16* p = OB + (size_t)(tokq0 + (qq << dshift)) * 512 + h * 64 + d;
        p[0] = (bf16)(cvtpk(o[0][r], 0.f) & 0xffffu); p[32] = (bf16)(cvtpk(o[1][r], 0.f) & 0xffffu); }
}
struct AUnit { int tok0, dshift, Ls, cc, h, c; };
__device__ __forceinline__ AUnit decode_a(int su) {
    AUnit a; const int sidx = su / 48, k = su % 48, blk = sidx >> 3; a.h = sidx & 7; a.c = 2 - (k >> 4); a.dshift = 2 * a.c; const int kk = k & 15;
    int seq0, S, bis; if (blk < 8) { seq0 = 0; S = 16384; bis = blk; } else { seq0 = MP + 2048 * (blk - 8); S = 2048; bis = 0; }
    a.Ls = S >> a.dshift; const int cpb = 16 >> a.dshift  , res = kk / cpb; a.cc = bis * cpb + kk % cpb; a.tok0 = seq0 + res; return a;
}
struct BUnit { int seq0, S, lcb, g2; };
__device__ __forceinline__ BUnit decode_b(int u) {
    BUnit b; b.g2 = u / 768; const int cb = u % 768;
    if (cb < 256) { b.seq0 = 0; b.S = 16384; b.lcb = cb; } else { b.seq0 = MP + 2048 * ((cb - 256) >> 5); b.S = 2048; b.lcb = (cb - 256) & 31; } return b;
}

#define LDS_BAR() asm volatile("s_waitcnt lgkmcnt(0)\n\ts_barrier" ::: "memory")
#define xp (args.in[0])
#define xs (args.in[1])
#define norm1 (args.in[2])
#define w_in (args.in[3])
#define qna (args.in[4])
#define kna (args.in[5])
#define qnb (args.in[6])
#define knb (args.in[7])
#define sinkb (args.in[8])
#define ona (args.in[9])
#define onb (args.in[10])
#define w_out (args.in[11])
#define norm2 (args.in[12])
#define w_up (args.in[13])
#define conv_w (args.in[14])
#define conv_b (args.in[15])
#define w_down (args.in[16])
#define out (args.dout)
#define SSQ ((float*)(args.ws + WS_SSQ))
#define WIN ((bf16*)(args.ws + WS_WIN))
#define WOUT ((bf16*)(args.ws + WS_WOUT))
#define WUP ((bf16*)(args.ws + WS_WUP))
#define WDN ((bf16*)(args.ws + WS_WDN))
#define XN ((bf16*)(args.ws + WS_XN) + DM)
#define PROJ ((bf16*)(args.ws + WS_PROJ))
#define Y ((bf16*)(args.ws + WS_PROJ))
#define OA ((bf16*)(args.ws + WS_OA))
#define OB ((bf16*)(args.ws + WS_XN) + DM)
#define HB ((bf16*)(args.ws + WS_H))
#define LA ((float*)(args.ws + WS_LA))
#define LBp ((float*)(args.ws + WS_LA) + 3 * (size_t)M * 8)
struct Args { const float* in[17]; float* dout; unsigned char* ws; };
__global__ void __launch_bounds__(NWAVES * 64, 2) fwd_megakernel(Args args) {
    extern __shared__ __attribute__((aligned(16))) unsigned char lds_raw[];
    cg::grid_group grid = cg::this_grid();
    LAS unsigned char* lds = (LAS unsigned char*)lds_raw;
    const int tid = threadIdx.x, lane = tid & 63, wave = __builtin_amdgcn_readfirstlane(tid >> 6);
    const int G = gridDim.x, bx = blockIdx.x;
    if (tid < 2) ((LAS unsigned*)(lds + MISC_OFF))[tid] = 0u;
    const int gw = bx * NWAVES + wave, NGW = G * NWAVES;

    {
        LAS float* scr = (LAS float*)(lds + wave * 16384);
        constexpr int I_IN = (DM / 64) * (INW / 32), I_OUT = (DM / 64) * (DM / 32), I_UP = (DM / 64) * (UPW / 32), I_DN = (DFF / 64) * (DM / 32);
        for (int it = gw; it < I_IN + I_OUT + I_UP + I_DN; it += NGW) {
            int r = it;
            if (r < I_IN) { p0_transpose_item<0>(w_in, DM, INW, WIN, nullptr, scr, r, lane); continue; } r -= I_IN;
            if (r < I_OUT) { p0_transpose_item<0>(w_out, DM, DM, WOUT, nullptr, scr, r, lane); continue; } r -= I_OUT;
            if (r < I_UP) { p0_transpose_item<1>(w_up, DM, UPW, WUP, norm2, scr, r, lane); continue; } r -= I_UP;
            p0_transpose_item<0>(w_down, DFF, DM, WDN, nullptr, scr, r, lane);
        }
        for (int m = gw * 4; m < M; m += NGW * 4) rms_rows4_to_bf16(m < MP ? xp + (size_t)m * DM : xs + (size_t)(m - MP) * DM, norm1, XN + (size_t)m * DM, lane);
        if (bx == 0) for (int i = tid; i < XCD_BAR_WORDS; i += 512) ((unsigned*)(args.ws + WS_BAR))[i] = 0u;
        for (int i = bx * 512 + tid; i < M; i += G * 512) SSQ[i] = 0.f;
    }
    grid.sync();
    XcdBarrier bar = xcd_barrier_post((unsigned*)(args.ws + WS_BAR), (volatile LAS unsigned*)(lds + MISC_OFF));

    {
        pg8::Gemm g{XN, WIN, M, INW, DM, 256}; pg8::StaticOrder S; S.init(M, INW, G, bx);
        pg8::EpiProj E{PROJ, INW};
        pg8::gemm_phase<pg8::EpiProj, pg8::StaticOrder, PG8_ALIGN, PG8_SP2>(lds, g, S, E);
    }
    xcd_barrier(bar);

    {
        const float gqa = fabsf(qna[lane]), gka = fabsf(kna[lane]);
        const float boundA = __builtin_bit_cast(float, __builtin_amdgcn_readfirstlane(__builtin_bit_cast(int, 8.0f * wave_max(gqa) * wave_max(gka) * LOG2E)));
        const float negMa = boundA > 40.f ? -boundA : 0.f;
        {
            const int half = wave >> 2, w4 = wave & 3, th = tid & 255;
            LAS unsigned char* Kl = lds + half * 65536; LAS unsigned char* Vl = Kl + 32768;
            const f32x4 gk0 = *(const f32x4*)(kna + 8 * (th & 7)), gk1 = *(const f32x4*)(kna + 8 * (th & 7) + 4);
            const int ubase = (G == 256) ? (bx & 7) * 576 + (bx >> 3) : bx, ustep = (G == 256) ? 32 : G, uend = (G == 256) ? (bx & 7) * 576 + 576 : 4608;
            v4u kr[8], vr[8], qraw[4]; AUnit nx = decode_a(2 * ubase + half);
            if (ubase < uend) { stage_load<256, 256>(kr, vr, PROJ, KA_OFF + nx.h * 64, VA_OFF + nx.h * 64, nx.tok0, nx.dshift, 128 * nx.cc - 64, nx.Ls, th);
                load_q_raw(qraw, PROJ + (size_t)(nx.tok0 + ((128 * nx.cc + 32 * w4 + (lane & 31)) << nx.dshift)) * INW + QA_OFF + nx.h * 64, lane); }
            for (int u = ubase; u < uend; u += ustep) {
                const AUnit a = nx;
                LDS_BAR();
                stage_write<256, 256>(kr, vr, Kl, Vl, 128 * a.cc - 64, a.Ls, gk0, gk1, th);
                bf16x8 qf[4]; norm_q(qf, qraw, qna, lane);
                LDS_BAR();
                if (u + ustep < uend) { nx = decode_a(2 * (u + ustep) + half);
                    stage_load<256, 256>(kr, vr, PROJ, KA_OFF + nx.h * 64, VA_OFF + nx.h * 64, nx.tok0, nx.dshift, 128 * nx.cc - 64, nx.Ls, th);
                    load_q_raw(qraw, PROJ + (size_t)(nx.tok0 + ((128 * nx.cc + 32 * w4 + (lane & 31)) << nx.dshift)) * INW + QA_OFF + nx.h * 64, lane); }
                const int iq0 = 128 * a.cc + 32 * w4;
                f32x16 o[2]; float l = 0.f;
#pragma unroll
                for (int r = 0; r < 16; ++r) { o[0][r] = 0.f; o[1][r] = 0.f; }
                const float slope2 = exp2f(-0.5f * (float)(a.h + 9)) * (float)(1 << a.dshift) * LOG2E;
                if (iq0 - 64 < 0 || iq0 + 96 > a.Ls) attn_task<5, 64, true>(Kl, Vl, 256 * 64, 32 * w4, iq0 - 64, a.Ls, qf, slope2, negMa, o, l, lane);
                else attn_task<5, 64, false>(Kl, Vl, 256 * 64, 32 * w4, iq0 - 64, a.Ls, qf, slope2, negMa, o, l, lane);
                store_partial(o, l, OA + (size_t)a.c * M * 512, LA + (size_t)a.c * M * 8, a.tok0 + (iq0 << a.dshift), a.dshift, a.h, lane);
            }
        }
        const float gqb = fabsf(qnb[lane]), gkb = fabsf(knb[lane]);
        const float boundB = __builtin_bit_cast(float, __builtin_amdgcn_readfirstlane(__builtin_bit_cast(int, 8.0f * wave_max(gqb) * wave_max(gkb) * LOG2E)));
        const float negMb = boundB > 40.f ? -boundB : 0.f;
        {
            LAS unsigned char* Kb = lds; LAS unsigned char* Vb = lds + 40960;
            const f32x4 gk0 = *(const f32x4*)(knb + 8 * (tid & 7)), gk1 = *(const f32x4*)(knb + 8 * (tid & 7) + 4);
            const int ubase = (G == 256) ? (bx & 7) * 192 + (bx >> 3) : bx, ustep = (G == 256) ? 32 : G, uend = (G == 256) ? (bx & 7) * 192 + 192 : 1536;
            v4u kr[5], vr[5], qraw[4]; BUnit nx = decode_b(ubase);
            if (ubase < uend) { stage_load<320, 512>(kr, vr, PROJ, KB_OFF + nx.g2 * 64, VB_OFF + nx.g2 * 64, nx.seq0, 0, 64 * nx.lcb - 128, nx.S, tid);
                load_q_raw(qraw, PROJ + (size_t)(nx.seq0 + 64 * nx.lcb + 32 * (wave & 1) + (lane & 31)) * INW + QB_OFF + (4 * nx.g2 + (wave >> 1)) * 64, lane); }
            for (int u = ubase; u < uend; u += ustep) {
                const BUnit b = nx;
                LDS_BAR();
                stage_write<320, 512>(kr, vr, Kb, Vb, 64 * b.lcb - 128, b.S, gk0, gk1, tid);
                bf16x8 qf[4]; norm_q(qf, qraw, qnb, lane);
                LDS_BAR();
                if (u + ustep < uend) { nx = decode_b(u + ustep);
                    stage_load<320, 512>(kr, vr, PROJ, KB_OFF + nx.g2 * 64, VB_OFF + nx.g2 * 64, nx.seq0, 0, 64 * nx.lcb - 128, nx.S, tid);
                    load_q_raw(qraw, PROJ + (size_t)(nx.seq0 + 64 * nx.lcb + 32 * (wave & 1) + (lane & 31)) * INW + QB_OFF + (4 * nx.g2 + (wave >> 1)) * 64, lane); }
                const int hb = 4 * b.g2 + (wave >> 1), iq0 = 64 * b.lcb + 32 * (wave & 1);
                f32x16 o[2]; float l = 0.f;
#pragma unroll
                for (int r = 0; r < 16; ++r) { o[0][r] = 0.f; o[1][r] = 0.f; }
                const float slope2 = exp2f(-0.5f * (float)(hb + 1)) * LOG2E;
                if (iq0 - 128 < 0 || iq0 + 160 > b.S) attn_task<9, 128, true>(Kb, Vb, 320 * 64, 32 * (wave & 1), iq0 - 128, b.S, qf, slope2, negMb, o, l, lane);
                else attn_task<9, 128, false>(Kb, Vb, 320 * 64, 32 * (wave & 1), iq0 - 128, b.S, qf, slope2, negMb, o, l, lane);
                store_partial(o, l, OB, LBp, b.seq0 + iq0, 0, hb, lane);
            }
        }
        xcd_barrier(bar);
        {
            const int hh = lane >> 3;
            const float sinkterm = __builtin_amdgcn_exp2f(sinkb[hh] * LOG2E + negMb);
            const f32x4 ga0 = *(const f32x4*)(ona + 8 * lane), ga1 = *(const f32x4*)(ona + 8 * lane + 4), gb0 = *(const f32x4*)(onb + 8 * lane), gb1 = *(const f32x4*)(onb + 8 * lane + 4);
            for (int m0 = gw * 4; m0 < M; m0 += NGW * 4) {
                v4u wa[4][3], wb[4]; float la[4], lb[4];
#pragma unroll
                for (int k = 0; k < 4; ++k) { const int m = m0 + k; la[k] = 0.f;
#pragma unroll
                    for (int c = 0; c < 3; ++c) { wa[k][c] = *(const v4u*)(OA + ((size_t)c * M + m) * 512 + 8 * lane); la[k] += LA[((size_t)c * M + m) * 8 + hh]; }
                    wb[k] = *(const v4u*)(OB + (size_t)m * 512 + 8 * lane); lb[k] = LBp[(size_t)m * 8 + hh] + sinkterm; }
                float ya[4][8], yb[4][8], sa[4], sb[4];
#pragma unroll
                for (int k = 0; k < 4; ++k) { const float ia = 1.0f / la[k], ib = 1.0f / lb[k];
                    ya[k][0] = (bf_lo(wa[k][0].x) + bf_lo(wa[k][1].x) + bf_lo(wa[k][2].x)) * ia; ya[k][1] = (bf_hi(wa[k][0].x) + bf_hi(wa[k][1].x) + bf_hi(wa[k][2].x)) * ia;
                    ya[k][2] = (bf_lo(wa[k][0].y) + bf_lo(wa[k][1].y) + bf_lo(wa[k][2].y)) * ia; ya[k][3] = (bf_hi(wa[k][0].y) + bf_hi(wa[k][1].y) + bf_hi(wa[k][2].y)) * ia;
                    ya[k][4] = (bf_lo(wa[k][0].z) + bf_lo(wa[k][1].z) + bf_lo(wa[k][2].z)) * ia; ya[k][5] = (bf_hi(wa[k][0].z) + bf_hi(wa[k][1].z) + bf_hi(wa[k][2].z)) * ia;
                    ya[k][6] = (bf_lo(wa[k][0].w) + bf_lo(wa[k][1].w) + bf_lo(wa[k][2].w)) * ia; ya[k][7] = (bf_hi(wa[k][0].w) + bf_hi(wa[k][1].w) + bf_hi(wa[k][2].w)) * ia;
                    yb[k][0] = bf_lo(wb[k].x) * ib; yb[k][1] = bf_hi(wb[k].x) * ib; yb[k][2] = bf_lo(wb[k].y) * ib; yb[k][3] = bf_hi(wb[k].y) * ib;
                    yb[k][4] = bf_lo(wb[k].z) * ib; yb[k][5] = bf_hi(wb[k].z) * ib; yb[k][6] = bf_lo(wb[k].w) * ib; yb[k][7] = bf_hi(wb[k].w) * ib;
                    sa[k] = 0.f; sb[k] = 0.f;
#pragma unroll
                    for (int i = 0; i < 8; ++i) { sa[k] += ya[k][i] * ya[k][i]; sb[k] += yb[k][i] * yb[k][i]; } }
#pragma unroll
                for (int o = 1; o < 64; o <<= 1) {
#pragma unroll
                    for (int k = 0; k < 4; ++k) { sa[k] += __shfl_xor(sa[k], o); sb[k] += __shfl_xor(sb[k], o); } }
#pragma unroll
                for (int k = 0; k < 4; ++k) { const int m = m0 + k;
                    const float ra = __builtin_amdgcn_rsqf(sa[k] * (1.f / 512.f) + EPS), rb = __builtin_amdgcn_rsqf(sb[k] * (1.f / 512.f) + EPS);
                    v4u oa, ob;
                    oa.x = cvtpk(ya[k][0] * ra * ga0.x, ya[k][1] * ra * ga0.y); oa.y = cvtpk(ya[k][2] * ra * ga0.z, ya[k][3] * ra * ga0.w); oa.z = cvtpk(ya[k][4] * ra * ga1.x, ya[k][5] * ra * ga1.y); oa.w = cvtpk(ya[k][6] * ra * ga1.z, ya[k][7] * ra * ga1.w);
                    ob.x = cvtpk(yb[k][0] * rb * gb0.x, yb[k][1] * rb * gb0.y); ob.y = cvtpk(yb[k][2] * rb * gb0.z, yb[k][3] * rb * gb0.w); ob.z = cvtpk(yb[k][4] * rb * gb1.x, yb[k][5] * rb * gb1.y); ob.w = cvtpk(yb[k][6] * rb * gb1.z, yb[k][7] * rb * gb1.w);
                    *(v4u*)(Y + (size_t)m * DM + 8 * lane) = oa; *(v4u*)(Y + (size_t)m * DM + 512 + 8 * lane) = ob; }
            }
        }
    }
    xcd_barrier(bar);

    {
        pg8::Gemm g{Y, WOUT, M, DM, DM, 256}; pg8::StaticOrder S; S.init(M, DM, G, bx);
        pg8::EpiOut E{xp, xs, XN, SSQ};
        pg8::gemm_phase<pg8::EpiOut, pg8::StaticOrder, PG8_ALIGN, PG8_SP2>(lds, g, S, E);
    }
    xcd_barrier(bar);

    {
        pg8::Gemm g{XN - DM, WUP, UP_TILES_M * 256, UPW, DM, 254}; pg8::StaticOrder S; S.init(UP_TILES_M * 256, UPW, G, bx);
        pg8::EpiUp E{HB, SSQ, conv_w, conv_b, (LAS float*)(lds + XCH_OFF)};
        pg8::gemm_phase<pg8::EpiUp, pg8::StaticOrder, true, PG8_SP2>(lds, g, S, E);
    }
    xcd_barrier(bar);

    {
        pg8::Gemm g{HB, WDN, M, DM, DFF, 256}; pg8::StaticOrder S; S.init(M, DM, G, bx);
        pg8::EpiDown E{XN, out};
        pg8::gemm_phase<pg8::EpiDown, pg8::StaticOrder, PG8_ALIGN, PG8_SP2>(lds, g, S, E);
    }
}

#undef out
#undef xp
#undef xs
extern "C" void kernel_launch(void* const* d_in, const int* in_sizes, int n_in, void* d_out, int out_size, void* d_ws, size_t ws_size, hipStream_t stream) {
    static int grid = 0;
    if (grid == 0) {
        if (n_in != 17 || out_size != M * DM || ws_size < WS_END) { fprintf(stderr, "kernel_launch: unexpected shapes (n_in %d out %d ws %zu)\n", n_in, out_size, ws_size); grid = -1; return; }
        int dev = 0, cus = 0, per_cu = 0;
        hipGetDevice(&dev); hipDeviceGetAttribute(&cus, hipDeviceAttributeMultiprocessorCount, dev);
        if (hipFuncSetAttribute((const void*)fwd_megakernel, hipFuncAttributeMaxDynamicSharedMemorySize, LDS_BYTES) != hipSuccess) { fprintf(stderr, "kernel_launch: hipFuncSetAttribute failed\n"); grid = -1; return; }
        if (hipOccupancyMaxActiveBlocksPerMultiprocessor(&per_cu, (const void*)fwd_megakernel, NWAVES * 64, LDS_BYTES) != hipSuccess || per_cu < 1) { fprintf(stderr, "kernel_launch: occupancy query says %d\n", per_cu); per_cu = 1; }
        (void)hipGetLastError();
        grid = cus;
        fprintf(stderr, "kernel_launch: grid %d (per_cu %d)\n", grid, per_cu);
    }
    if (grid < 0) return;
    Args a{};
    for (int i = 0; i < 17; ++i) a.in[i] = (const float*)d_in[i];
    a.dout = (float*)d_out; a.ws = (unsigned char*)d_ws;
    void* kargs[] = {&a};
    hipError_t e = hipLaunchCooperativeKernel((const void*)fwd_megakernel, dim3(grid), dim3(NWAVES * 64), kargs, LDS_BYTES, stream);
    if (e != hipSuccess) fprintf(stderr, "kernel_launch: cooperative launch failed: %s\n", hipGetErrorString(e));
}
```

```cpp
#include <hip/hip_runtime.h>
#include <hip/hip_cooperative_groups.h>
#include <cstdio>
#include <cstdint>
namespace cg = cooperative_groups;
namespace pg8 {
#define PG8_LAS __attribute__((address_space(3)))
typedef unsigned short bf16_t;
typedef short bf16x8 __attribute__((ext_vector_type(8)));
typedef float f32x4 __attribute__((ext_vector_type(4)));
typedef unsigned u32x4 __attribute__((ext_vector_type(4)));
constexpr int BM = 256, BK = 64, HALF = 128, HTB = HALF * BK * 2  , STAGE_BYTES = 8 * HTB, NXCD = 8, WGM = 8;

__host__ __device__ __forceinline__ int lds_byte(int r, int c) { const int st = (r >> 4) * 2 + (c >> 5), rr = r & 15, cc = c & 31, ob = rr * 64 + cc * 2; return st * 1024 + (ob ^ (((ob >> 9) & 1) << 5)); }
__host__ __device__ __forceinline__ void stage_rc(int b, int& R, int& C) { const int st = b / 1024, sb = b % 1024, swz = sb ^ (((sb >> 9) & 1) << 5); R = (st >> 1) * 16 + swz / 64; C = (st & 1) * 32 + (swz % 64) / 2; }
__host__ __device__ __forceinline__ int perm32(int rho) { const int n = rho >> 4, i = rho & 15; return 8 * (i >> 2) + 4 * n + (i & 3); }

struct Unit { int pm, pn; };
struct Gemm { const bf16_t* A; const bf16_t* Bt; int M, N, K; int a_tile_rows; };

struct StaticOrder {
    int nM, nN, nwg, G, c;
    __host__ __device__ void init(int M, int N, int G_, int c_) { nM = M / BM; nN = N / BM; nwg = nM * nN; G = G_; c = c_; }
    __host__ __device__ bool next(int i, Unit& u) const {
        const long L = (long)i * G + c; if (L >= nwg) return false;
        int wgid = (int)L; { const int q = nwg / NXCD, r = nwg % NXCD, xcd = wgid % NXCD, off = wgid / NXCD; wgid = (xcd < r ? xcd * (q + 1) : r * (q + 1) + (xcd - r) * q) + off; }
        const int nig = WGM * nN, gid = wgid / nig, fm = gid * WGM, gsz = (nM - fm) < WGM ? (nM - fm) : WGM;
        u.pm = fm + ((wgid % nig) % gsz); u.pn = (wgid % nig) / gsz; return true;
    }
    __device__ __forceinline__ void a_ready(const Unit&) const {}
    __device__ __forceinline__ void done(const Unit&) const {}
};

__device__ __forceinline__ unsigned cvt_pk_bf16(float lo, float hi) { unsigned r; asm volatile("v_cvt_pk_bf16_f32 %0, %1, %2" : "=v"(r) : "v"(lo), "v"(hi)); return r; }
typedef float f32x2 __attribute__((ext_vector_type(2))); typedef __bf16 bf16x2_t __attribute__((ext_vector_type(2)));
__device__ __forceinline__ unsigned cvtpk(float lo, float hi) { f32x2 v = {lo, hi}; bf16x2_t b = __builtin_convertvector(v, bf16x2_t); return __builtin_bit_cast(unsigned, b); }
constexpr int MTOK = 49152, MPROMPT = 16384, DMODEL = 1024, DFF_ = 2816;
__device__ __forceinline__ u32x4 pack8(const f32x4 a, const f32x4 b) { u32x4 w; w.x = cvtpk(a[0], a[1]); w.y = cvtpk(a[2], a[3]); w.z = cvtpk(b[0], b[1]); w.w = cvtpk(b[2], b[3]); return w; }

struct EpiProj {
    static constexpr bool PERM = true, AFTER_DRAIN = false;
    bf16_t* O; const float* gqa; const float* gka; const float* gqb; const float* gkb;
    __device__ __forceinline__ void operator()(f32x4 (&acc)[2][2][4][2], const Unit& u, int wr, int wc, int fr, int fq, int wid, int lane) const {
        const int hs = 4 * u.pn + wc;
        const float* g = nullptr; float sc = 1.f;
        if (hs < 8) { g = gqa; sc = 0.125f * 1.4426950408889634f; } else if (hs < 16) g = gka; else if (hs >= 24 && hs < 32) { g = gqb; sc = 0.125f * 1.4426950408889634f; } else if (hs >= 32 && hs < 34) g = gkb;
        const int row0 = u.pm * BM + wr * 64 + fr;
        bf16_t* obase = O + (size_t)row0 * 2304 + 64 * hs + 8 * fq;
        if (g) {
            f32x4 gg[2][2];
#pragma unroll
            for (int bj = 0; bj < 2; ++bj)
#pragma unroll
                for (int n = 0; n < 2; ++n) gg[bj][n] = *(const f32x4*)(g + 32 * bj + 8 * fq + 4 * n) * sc;
#pragma unroll
            for (int ai = 0; ai < 2; ++ai)
#pragma unroll
                for (int m = 0; m < 4; ++m) { float ss = 0.f;
#pragma unroll
                    for (int bj = 0; bj < 2; ++bj)
#pragma unroll
                        for (int n = 0; n < 2; ++n) { const f32x4 a = acc[ai][bj][m][n]; ss += (a[0] * a[0] + a[1] * a[1]) + (a[2] * a[2] + a[3] * a[3]); }
                    ss += __shfl_xor(ss, 16); ss += __shfl_xor(ss, 32);
                    const float rs = __builtin_amdgcn_rsqf(ss * (1.0f / 64.0f) + 1e-6f);
                    bf16_t* rowp = obase + (size_t)(ai * HALF + m * 16) * 2304;
#pragma unroll
                    for (int bj = 0; bj < 2; ++bj) *(u32x4*)(rowp + 32 * bj) = pack8(acc[ai][bj][m][0] * rs * gg[bj][0], acc[ai][bj][m][1] * rs * gg[bj][1]); }
        } else {
#pragma unroll
            for (int ai = 0; ai < 2; ++ai)
#pragma unroll
                for (int m = 0; m < 4; ++m) { bf16_t* rowp = obase + (size_t)(ai * HALF + m * 16) * 2304;
#pragma unroll
                    for (int bj = 0; bj < 2; ++bj) *(u32x4*)(rowp + 32 * bj) = pack8(acc[ai][bj][m][0], acc[ai][bj][m][1]); }
        }
    }
};
struct EpiOut {
    static constexpr bool PERM = true, AFTER_DRAIN = false;
    const float* xp; const float* xs; bf16_t* xb; float* ssq;
    __device__ __forceinline__ void operator()(f32x4 (&acc)[2][2][4][2], const Unit& u, int wr, int wc, int fr, int fq, int wid, int lane) const {
        const int col0 = u.pn * BM + wc * 32 + 8 * fq;
#pragma unroll
        for (int ai = 0; ai < 2; ++ai)
#pragma unroll
            for (int m = 0; m < 4; ++m) { const int gr = u.pm * BM + ai * HALF + wr * 64 + m * 16 + fr;
                const float* xr = (gr < MPROMPT ? xp + (size_t)gr * DMODEL : xs + (size_t)(gr - MPROMPT) * DMODEL) + col0;
                float s = 0.f;
#pragma unroll
                for (int bj = 0; bj < 2; ++bj) { f32x4 a = *(const f32x4*)(xr + bj * HALF), b = *(const f32x4*)(xr + bj * HALF + 4);
                    a += acc[ai][bj][m][0]; b += acc[ai][bj][m][1];
                    s += (a[0] * a[0] + a[1] * a[1]) + (a[2] * a[2] + a[3] * a[3]) + (b[0] * b[0] + b[1] * b[1]) + (b[2] * b[2] + b[3] * b[3]);
                    *(u32x4*)(xb + (size_t)gr * DMODEL + col0 + bj * HALF) = pack8(a, b); }
                s += __shfl_xor(s, 16); s += __shfl_xor(s, 32);
                if (fq == 0) unsafeAtomicAdd(ssq + gr, s);
                asm volatile("" ::: "memory"); }
    }
};
struct EpiDown {
    static constexpr bool PERM = true, AFTER_DRAIN = false;
    const bf16_t* xb; float* out;
    __device__ __forceinline__ void operator()(f32x4 (&acc)[2][2][4][2], const Unit& u, int wr, int wc, int fr, int fq, int wid, int lane) const {
        const int col0 = u.pn * BM + wc * 32 + 8 * fq;
#pragma unroll
        for (int ai = 0; ai < 2; ++ai)
#pragma unroll
            for (int m = 0; m < 4; ++m) { const int gr = u.pm * BM + ai * HALF + wr * 64 + m * 16 + fr;
                float* o = out + (size_t)gr * DMODEL + col0; const bf16_t* xr = xb + (size_t)gr * DMODEL + col0;
#pragma unroll
                for (int bj = 0; bj < 2; ++bj) { const u32x4 w = *(const u32x4*)(xr + bj * HALF);
                    f32x4 a = {__uint_as_float(w.x << 16), __uint_as_float(w.x & 0xffff0000u), __uint_as_float(w.y << 16), __uint_as_float(w.y & 0xffff0000u)};
                    f32x4 b = {__uint_as_float(w.z << 16), __uint_as_float(w.z & 0xffff0000u), __uint_as_float(w.w << 16), __uint_as_float(w.w & 0xffff0000u)};
                    a += acc[ai][bj][m][0]; b += acc[ai][bj][m][1]; *(f32x4*)(o + bj * HALF) = a; *(f32x4*)(o + bj * HALF + 4) = b; }
                asm volatile("" ::: "memory"); }
    }
};
__device__ __forceinline__ bool seq_first(int gr) { return gr == 0 || (gr >= MPROMPT && (gr & 2047) == 0); }
__device__ __forceinline__ bool seq_last(int gr) { return gr >= MPROMPT - 1 && (gr & 2047) == 2047; }
struct EpiUp {
    static constexpr bool PERM = true, AFTER_DRAIN = false;
    bf16_t* H; const float* ssq; const float* cw; const float* cb; PG8_LAS float* xch;
    __device__ __forceinline__ void operator()(f32x4 (&acc)[2][2][4][2], const Unit& u, int wr, int wc, int fr, int fq, int wid, int lane) const {
        const int lr0 = wr * 64 + fr, gr0 = 254 * u.pm - 1 + lr0;
#pragma unroll
        for (int ai = 0; ai < 2; ++ai)
#pragma unroll
            for (int m = 0; m < 4; ++m) { int gr = gr0 + ai * HALF + m * 16; gr = gr < 0 ? 0 : (gr > MTOK - 1 ? MTOK - 1 : gr);
                const float rs = __builtin_amdgcn_rsqf(ssq[gr] * (1.0f / DMODEL) + 1e-6f);
#pragma unroll
                for (int bj = 0; bj < 2; ++bj)
#pragma unroll
                    for (int n = 0; n < 2; ++n) acc[ai][bj][m][n] *= rs; }
#pragma unroll
        for (int ai = 0; ai < 2; ++ai) {
            if (fr == 0) { PG8_LAS float* p = xch + ((wid * 2 + ai) * 2 + 0) * 64 + 8 * fq;
#pragma unroll
                for (int bj = 0; bj < 2; ++bj)
#pragma unroll
                    for (int n = 0; n < 2; ++n) *(PG8_LAS f32x4*)(p + bj * 32 + 4 * n) = acc[ai][bj][0][n]; }
            if (fr == 15) { PG8_LAS float* p = xch + ((wid * 2 + ai) * 2 + 1) * 64 + 8 * fq;
#pragma unroll
                for (int bj = 0; bj < 2; ++bj)
#pragma unroll
                    for (int n = 0; n < 2; ++n) *(PG8_LAS f32x4*)(p + bj * 32 + 4 * n) = acc[ai][bj][3][n]; }
        }
        asm volatile("s_waitcnt lgkmcnt(0)" ::: "memory"); __builtin_amdgcn_s_barrier(); asm volatile("" ::: "memory");
        const int ow = (1 - wr) * 4 + wc;
        const int srcP = ((lane & 48) | ((fr + 15) & 15)) * 4, srcN = ((lane & 48) | ((fr + 1) & 15)) * 4;
        const int ch0 = 128 * u.pn + 32 * wc + 8 * fq;
#pragma unroll
        for (int n = 0; n < 2; ++n) {
            f32x4 w0[2], w1[2], w2[2], bb[2];
#pragma unroll
            for (int bj = 0; bj < 2; ++bj) { const int ch = ch0 + 4 * n + bj * DFF_;
                w0[bj] = *(const f32x4*)(cw + ch); w1[bj] = *(const f32x4*)(cw + 2 * DFF_ + ch); w2[bj] = *(const f32x4*)(cw + 4 * DFF_ + ch); bb[bj] = *(const f32x4*)(cb + ch); }
#pragma unroll
            for (int ai = 0; ai < 2; ++ai) {
                const int aiT = wr == 1 ? ai : ai - 1, aiB = wr == 0 ? ai : ai + 1;
#pragma unroll
                for (int m = 0; m < 4; ++m) {
                    const int lr = lr0 + ai * HALF + m * 16, gr = gr0 + ai * HALF + m * 16;
                    const bool first = seq_first(gr), last = seq_last(gr);
                    f32x4 c[2];
#pragma unroll
                    for (int bj = 0; bj < 2; ++bj) {
                        const f32x4 cur = acc[ai][bj][m][n];
                        f32x4 pv, nx;
#pragma unroll
                        for (int e = 0; e < 4; ++e) {
                            const float sP = (m > 0 && fr == 15) ? acc[ai][bj][m > 0 ? m - 1 : 0][n][e] : cur[e];
                            const float sN = (m < 3 && fr == 0) ? acc[ai][bj][m < 3 ? m + 1 : 3][n][e] : cur[e];
                            pv[e] = __builtin_bit_cast(float, __builtin_amdgcn_ds_bpermute(srcP, __builtin_bit_cast(int, sP)));
                            nx[e] = __builtin_bit_cast(float, __builtin_amdgcn_ds_bpermute(srcN, __builtin_bit_cast(int, sN))); }
                        if (m == 0) { const f32x4 top = (aiT >= 0) ? *(const PG8_LAS f32x4*)(xch + ((ow * 2 + (aiT < 0 ? 0 : aiT)) * 2 + 1) * 64 + 8 * fq + bj * 32 + 4 * n) : (f32x4){0.f, 0.f, 0.f, 0.f}; if (fr == 0) pv = top; }
                        if (m == 3) { const f32x4 bot = (aiB <= 1) ? *(const PG8_LAS f32x4*)(xch + ((ow * 2 + (aiB > 1 ? 1 : aiB)) * 2 + 0) * 64 + 8 * fq + bj * 32 + 4 * n) : (f32x4){0.f, 0.f, 0.f, 0.f}; if (fr == 15) nx = bot; }
                        if (first) pv = (f32x4){0.f, 0.f, 0.f, 0.f};
                        if (last) nx = (f32x4){0.f, 0.f, 0.f, 0.f};
                        c[bj] = bb[bj] + w0[bj] * pv + w1[bj] * cur + w2[bj] * nx;
                    }
                    f32x4 hv;
#pragma unroll
                    for (int e = 0; e < 4; ++e) { const float g = c[0][e]; hv[e] = g * __builtin_amdgcn_rcpf(1.0f + __builtin_amdgcn_exp2f(-1.4426950408889634f * g)) * c[1][e]; }
                    f32x2 pk; pk.x = __builtin_bit_cast(float, cvtpk(hv[0], hv[1])); pk.y = __builtin_bit_cast(float, cvtpk(hv[2], hv[3]));
                    if (lr >= 1 && lr <= 254 && gr < MTOK) *(f32x2*)(H + (size_t)gr * DFF_ + ch0 + 4 * n) = pk;
                    asm volatile("" ::: "memory");
                }
            }
        }
    }
};
template <class Epi, class Sched, bool ALIGN_EPI = false, bool SP2 = false>
__device__ __forceinline__ void gemm_phase(PG8_LAS unsigned char* lds, const Gemm g, const Sched& S, const Epi& E) {
    int tid_ = threadIdx.x; asm volatile("" : "+v"(tid_));
    const int tid = tid_, wid = __builtin_amdgcn_readfirstlane(tid >> 6), lane = tid & 63, wr = wid >> 2, wc = wid & 3, fr = lane & 15, fq = lane >> 4;
    const int K = g.K, nt = K / BK;
    unsigned voffA[2], voffB[2];
#pragma unroll
    for (int i = 0; i < 2; ++i) { int R, C; stage_rc(tid * 16 + i * 8192, R, C); const int Rb = Epi::PERM ? ((R & ~31) + perm32(R & 31)) : R;
        voffA[i] = (unsigned)(R * K + C) * 2u; voffB[i] = (unsigned)(Rb * K + C) * 2u; }
    const size_t kstep = (size_t)(BK * 2);
    const size_t hstep = (size_t)HALF * K * 2;
    const size_t tstep = 2 * hstep; const size_t tstepA = (size_t)g.a_tile_rows * K * 2;
    const unsigned ldsw = (unsigned)wid * 1024u;
    const int aoff = lds_byte(wr * 64 + fr, fq * 8), boff = lds_byte(wc * 32 + fr, fq * 8);
#define PG8_SA(b, h) (((b) * 2 + (h)) * HTB)
#define PG8_SB(b, h) ((4 + (b) * 2 + (h)) * HTB)
#define PG8_STAGE(bufoff, gbase, voff) do { _Pragma("unroll") for (int _i = 0; _i < 2; ++_i) \
        __builtin_amdgcn_global_load_lds((const unsigned*)((const char*)(gbase) + (voff)[_i]), (PG8_LAS unsigned*)(lds + (bufoff) + ldsw + _i * 8192), 16, 0, 0); } while (0)
#define PG8_LDA(dst, b, h) do { _Pragma("unroll") for (int m = 0; m < 4; ++m) _Pragma("unroll") for (int k = 0; k < 2; ++k) dst[m][k] = *(const PG8_LAS bf16x8*)(lds + PG8_SA(b, h) + aoff + m * 2048 + k * 1024); } while (0)
#define PG8_LDB(dst, b, h) do { _Pragma("unroll") for (int n = 0; n < 2; ++n) _Pragma("unroll") for (int k = 0; k < 2; ++k) dst[n][k] = *(const PG8_LAS bf16x8*)(lds + PG8_SB(b, h) + boff + n * 2048 + k * 1024); } while (0)
#define PG8_MMA(ai, bj, At, Bt) do { __builtin_amdgcn_s_setprio(1); _Pragma("unroll") for (int m = 0; m < 4; ++m) _Pragma("unroll") for (int n = 0; n < 2; ++n) _Pragma("unroll") for (int k = 0; k < 2; ++k) \
        acc[ai][bj][m][n] = __builtin_amdgcn_mfma_f32_16x16x32_bf16(Bt[n][k], At[m][k], acc[ai][bj][m][n], 0, 0, 0); __builtin_amdgcn_s_setprio(0); } while (0)
#define PG8_WAIT_V(n) asm volatile("s_waitcnt vmcnt(" #n ")" ::: "memory")
#define PG8_WAIT_L(n) asm volatile("s_waitcnt lgkmcnt(" #n ")" ::: "memory")
#define PG8_BAR __builtin_amdgcn_s_barrier()
#define PG8_SCHED __builtin_amdgcn_sched_barrier(0)
    Unit cur, nxt; int ui = 0;
    if (!S.next(0, cur)) return;
    f32x4 acc[2][2][4][2];
#pragma unroll
    for (int a = 0; a < 2; ++a)
#pragma unroll
        for (int b = 0; b < 2; ++b)
#pragma unroll
            for (int m = 0; m < 4; ++m)
#pragma unroll
                for (int n = 0; n < 2; ++n) acc[a][b][m][n] = (f32x4){0.f, 0.f, 0.f, 0.f};
    bf16x8 At[4][2], B0[2][2], B1[2][2];
    const char* cA = (const char*)g.A + (size_t)cur.pm * tstepA; const char* cB = (const char*)g.Bt + (size_t)cur.pn * tstep;
    S.a_ready(cur);
    if constexpr (SP2) {
        PG8_STAGE(PG8_SB(0, 0), cB, voffB); PG8_STAGE(PG8_SB(0, 1), cB + hstep, voffB); PG8_STAGE(PG8_SA(0, 0), cA, voffA); PG8_STAGE(PG8_SA(0, 1), cA + hstep, voffA);
        if (wr == 1) PG8_BAR;
        PG8_WAIT_V(2); PG8_BAR;
        PG8_STAGE(PG8_SB(1, 0), cB + kstep, voffB); PG8_STAGE(PG8_SA(1, 0), cA + kstep, voffA); PG8_STAGE(PG8_SB(1, 1), cB + hstep + kstep, voffB);
        PG8_WAIT_V(6); PG8_BAR;
    } else {
        PG8_STAGE(PG8_SB(0, 0), cB, voffB); PG8_STAGE(PG8_SA(0, 0), cA, voffA); PG8_STAGE(PG8_SB(0, 1), cB + hstep, voffB); PG8_STAGE(PG8_SA(0, 1), cA + hstep, voffA);
        if (wr == 1) PG8_BAR;
        PG8_WAIT_V(4); PG8_BAR;
        PG8_STAGE(PG8_SB(1, 0), cB + kstep, voffB); PG8_STAGE(PG8_SA(1, 0), cA + kstep, voffA); PG8_STAGE(PG8_SB(1, 1), cB + hstep + kstep, voffB);
        PG8_WAIT_V(6); PG8_BAR;
    }
    for (;;) {
        const bool has_next = S.next(ui + 1, nxt);
        const char* nA = has_next ? (const char*)g.A + (size_t)nxt.pm * tstepA : cA; const char* nB = has_next ? (const char*)g.Bt + (size_t)nxt.pn * tstep : cB;
        for (int t = 0; t < nt; t += 2) {
            const bool last = (t == nt - 2);
            const char* a1 = cA + (size_t)(t + 1) * kstep;
            const char* a2 = last ? nA : cA + (size_t)(t + 2) * kstep; const char* b2 = last ? nB : cB + (size_t)(t + 2) * kstep;
            const char* a3 = a2 + kstep; const char* b3 = b2 + kstep;
            if (last && has_next) S.a_ready(nxt);
            if constexpr (SP2) {
            PG8_LDB(B0, 0, 0); PG8_LDB(B1, 0, 1); PG8_SCHED; PG8_LDA(At, 0, 0); PG8_STAGE(PG8_SA(1, 1), a1 + hstep, voffA);
            PG8_WAIT_V(8); PG8_WAIT_L(0); PG8_BAR; PG8_MMA(0, 0, At, B0); PG8_MMA(0, 1, At, B1); PG8_BAR; PG8_SCHED;
            PG8_LDA(At, 0, 1); PG8_STAGE(PG8_SB(0, 0), b2, voffB); PG8_STAGE(PG8_SB(0, 1), b2 + hstep, voffB); PG8_STAGE(PG8_SA(0, 0), a2, voffA);
            PG8_WAIT_V(8); PG8_WAIT_L(0); PG8_BAR; PG8_MMA(1, 0, At, B0); PG8_MMA(1, 1, At, B1); PG8_BAR; PG8_SCHED;
            PG8_LDB(B0, 1, 0); PG8_LDB(B1, 1, 1); PG8_SCHED; PG8_LDA(At, 1, 0); PG8_STAGE(PG8_SA(0, 1), a2 + hstep, voffA);
            PG8_WAIT_V(8); PG8_WAIT_L(0); PG8_BAR; PG8_MMA(0, 0, At, B0); PG8_MMA(0, 1, At, B1); PG8_BAR; PG8_SCHED;
            PG8_LDA(At, 1, 1); PG8_STAGE(PG8_SB(1, 0), b3, voffB); PG8_STAGE(PG8_SB(1, 1), b3 + hstep, voffB); PG8_STAGE(PG8_SA(1, 0), a3, voffA);
            PG8_WAIT_V(8); PG8_WAIT_L(0); PG8_BAR; PG8_MMA(1, 0, At, B0); PG8_MMA(1, 1, At, B1); PG8_BAR; PG8_SCHED;
            } else {
            PG8_LDB(B0, 0, 0); PG8_SCHED; PG8_LDA(At, 0, 0); PG8_STAGE(PG8_SA(1, 1), a1 + hstep, voffA);
            PG8_WAIT_L(8); PG8_BAR; PG8_WAIT_L(0); PG8_MMA(0, 0, At, B0); PG8_BAR; PG8_SCHED;
            PG8_LDB(B1, 0, 1); PG8_STAGE(PG8_SB(0, 0), b2, voffB);
            PG8_BAR; PG8_WAIT_L(0); PG8_MMA(0, 1, At, B1); PG8_BAR;
            PG8_LDA(At, 0, 1); PG8_STAGE(PG8_SA(0, 0), a2, voffA);
            PG8_BAR; PG8_WAIT_L(0); PG8_MMA(1, 0, At, B0); PG8_BAR; PG8_SCHED;
            PG8_STAGE(PG8_SB(0, 1), b2 + hstep, voffB);
            PG8_WAIT_V(6); PG8_BAR; PG8_MMA(1, 1, At, B1); PG8_BAR;
            PG8_LDB(B0, 1, 0); PG8_SCHED; PG8_LDA(At, 1, 0); PG8_STAGE(PG8_SA(0, 1), a2 + hstep, voffA);
            PG8_WAIT_L(8); PG8_BAR; PG8_WAIT_L(0); PG8_MMA(0, 0, At, B0); PG8_BAR; PG8_SCHED;
            PG8_LDB(B1, 1, 1); PG8_STAGE(PG8_SB(1, 0), b3, voffB);
            PG8_BAR; PG8_WAIT_L(0); PG8_MMA(0, 1, At, B1); PG8_BAR;
            PG8_LDA(At, 1, 1); PG8_STAGE(PG8_SA(1, 0), a3, voffA);
            PG8_BAR; PG8_WAIT_L(0); PG8_MMA(1, 0, At, B0); PG8_BAR; PG8_SCHED;
            PG8_STAGE(PG8_SB(1, 1), b3 + hstep, voffB);
            PG8_WAIT_V(6); PG8_BAR; PG8_MMA(1, 1, At, B1); PG8_BAR;
            }
        }
        if constexpr (ALIGN_EPI) { if (wr == 0) PG8_BAR; }
        if constexpr (!Epi::AFTER_DRAIN) { E(acc, cur, wr, wc, fr, fq, wid, lane); S.done(cur); }
        if (!has_next) break;
#pragma unroll
        for (int a = 0; a < 2; ++a)
#pragma unroll
            for (int b = 0; b < 2; ++b)
#pragma unroll
                for (int m = 0; m < 4; ++m)
#pragma unroll
                    for (int n = 0; n < 2; ++n) acc[a][b][m][n] = (f32x4){0.f, 0.f, 0.f, 0.f};
        cur = nxt; cA = nA; cB = nB; ++ui;
        if constexpr (ALIGN_EPI) { if (wr == 1) PG8_BAR; }
    }
    PG8_WAIT_V(0);
    if constexpr (!ALIGN_EPI) { if (wr == 0) PG8_BAR; }
    PG8_BAR;
    if constexpr (Epi::AFTER_DRAIN) { E.fused(acc, cur, wr, wc, fr, fq, lds, wid, lane); S.done(cur); }
#undef PG8_SA
#undef PG8_SB
#undef PG8_STAGE
#undef PG8_LDA
#undef PG8_LDB
#undef PG8_MMA
#undef PG8_WAIT_V
#undef PG8_WAIT_L
#undef PG8_BAR
#undef PG8_SCHED
}
}
#ifndef PG8_SP2
#define PG8_SP2 true
#endif
#ifndef PG8_ALIGN
#define PG8_ALIGN true
#endif

constexpr int NWAVES = 8;
constexpr int DM = 1024, M = 49152, MP = 16384, INW = 2304, DFF = 2816, UPW = 5632;
constexpr int QA_OFF = 0, KA_OFF = 512, VA_OFF = 1024, QB_OFF = 1536, KB_OFF = 2048, VB_OFF = 2176;
constexpr int UP_TILES_M = 194;
constexpr float EPS = 1e-6f, LOG2E = 1.4426950408889634f;

constexpr size_t MiB = 1u << 20;
constexpr size_t WS_SSQ = 0;
constexpr size_t WS_BAR = 1 * MiB;
constexpr size_t WS_WIN = 2 * MiB, WS_WOUT = 7 * MiB, WS_WUP = 9 * MiB, WS_WDN = 20 * MiB;
constexpr size_t WS_XN = 32 * MiB;
constexpr size_t WS_PROJ = 130 * MiB;
constexpr size_t WS_OA = 346 * MiB;
constexpr size_t WS_H = 226 * MiB;
constexpr size_t WS_LA = 490 * MiB;
constexpr size_t WS_END = 496 * MiB;
static_assert(WS_XN + (size_t)(M + 256) * DM * 2 <= WS_PROJ && WS_PROJ + (size_t)M * INW * 2 <= WS_OA && WS_OA + 3 * (size_t)M * 512 * 2 <= WS_LA && WS_H + (size_t)M * DFF * 2 <= WS_LA && WS_PROJ + (size_t)M * DM * 2 <= WS_H, "d_ws map");

constexpr int RING_BYTES = 131072, XCH_OFF = RING_BYTES, MISC_OFF = XCH_OFF + 8192, LDS_BYTES = 147456;

#define LAS __attribute__((address_space(3)))
typedef unsigned short bf16;
typedef unsigned v4u __attribute__((ext_vector_type(4)));
typedef float f32x4 __attribute__((ext_vector_type(4)));
typedef float f32x16 __attribute__((ext_vector_type(16)));
typedef short bf16x8 __attribute__((ext_vector_type(8)));
typedef short s16x4 __attribute__((ext_vector_type(4)));
using pg8::cvtpk;
__device__ __forceinline__ float bf_lo(unsigned w) { return __uint_as_float(w << 16); }
__device__ __forceinline__ float bf_hi(unsigned w) { return __uint_as_float(w & 0xffff0000u); }
__device__ __forceinline__ float wave_sum(float v) {
#pragma unroll
    for (int o = 1; o < 64; o <<= 1) v += __shfl_xor(v, o);
    return v;
}
__device__ __forceinline__ float wave_max(float v) {
#pragma unroll
    for (int o = 1; o < 64; o <<= 1) v = fmaxf(v, __shfl_xor(v, o));
    return v;
}

#define GAS __attribute__((address_space(1)))
#define RLX_AGENT __ATOMIC_RELAXED, __HIP_MEMORY_SCOPE_AGENT
#define XB_TMO      128
#define XB_XCNT(j)  (256  + 64 * (j))
#define XB_XSUB(j)  (1280 + 64 * (j))
#define XB_XGEN(j)  (2304 + 64 * (j))
#define XB_TOP      3328
#define XB_TOPGEN   3392
#define XCD_BAR_WORDS 3456
#define XB_SPIN_CAP (1u << 18)

__device__ __forceinline__ unsigned xb_ld(unsigned* p)              { return __hip_atomic_load(p, __ATOMIC_RELAXED, __HIP_MEMORY_SCOPE_AGENT); }
__device__ __forceinline__ unsigned xb_add(unsigned* p, unsigned v) { return __hip_atomic_fetch_add(p, v, __ATOMIC_RELAXED, __HIP_MEMORY_SCOPE_AGENT); }
__device__ __forceinline__ unsigned xb_xcc_id() { return (unsigned)__builtin_amdgcn_s_getreg((3 << 11) | 20) & 0xFu; }
#define XB_SPIN(cond, bar) do { unsigned _sp = 0; while (cond) { __builtin_amdgcn_s_sleep(1); \
    if ((++_sp & 255u) == 0u) { if (xb_ld(&(bar)[XB_TMO])) break; if (_sp > XB_SPIN_CAP) { atomicAdd(&(bar)[XB_TMO], 1u); break; } } } } while (0)

struct XcdBarrier {
    unsigned* bar; unsigned x;
    volatile LAS unsigned* st;
};

__device__ __forceinline__ XcdBarrier xcd_barrier_post(unsigned* bar, volatile LAS unsigned* st) {
    XcdBarrier b; b.bar = bar; b.x = xb_xcc_id(); b.st = st;
    if (threadIdx.x == 0) (void)xb_add(&bar[XB_XCNT(b.x)], 1u);
    return b;
}
__device__ __forceinline__ void xcd_barrier_complete(unsigned* bar, unsigned x, unsigned& nloc, unsigned& nx) {
    const unsigned G = gridDim.x * gridDim.y * gridDim.z;
    unsigned sum, cnt, mine, sp = 0u;
    for (;;) {
        sum = 0u; cnt = 0u; mine = 0u;
#pragma unroll
        for (unsigned j = 0; j < 16; ++j) { const unsigned c = xb_ld(&bar[XB_XCNT(j)]); sum += c; cnt += (c > 0u) ? 1u : 0u; mine = (j == x) ? c : mine; }
        if (sum == G) break;
        __builtin_amdgcn_s_sleep(1);
        if ((++sp & 255u) == 0u) { if (xb_ld(&bar[XB_TMO])) break; if (sp > XB_SPIN_CAP) { atomicAdd(&bar[XB_TMO], 1u); break; } }
    }
    nloc = mine > 0u ? mine : 1u; nx = cnt > 0u ? cnt : 1u;
}

__device__ __forceinline__ void xcd_barrier(const XcdBarrier& b) {
    asm volatile("s_waitcnt vmcnt(0)" ::: "memory");
    __syncthreads();
    if (threadIdx.x == 0) {
        unsigned* bar = b.bar;
        __builtin_amdgcn_s_waitcnt(0);
        unsigned nloc = b.st[0], nx = b.st[1];
        if (nloc == 0u) { xcd_barrier_complete(bar, b.x, nloc, nx); b.st[0] = nloc; b.st[1] = nx; }
        const unsigned old = xb_add(&bar[XB_XSUB(b.x)], 1u);
        const unsigned gen = old / nloc;
        if (old + 1u == (gen + 1u) * nloc) {
            __builtin_amdgcn_fence(__ATOMIC_RELEASE, "agent");
            asm volatile("s_waitcnt vmcnt(0)" ::: "memory");
            const unsigned og = xb_add(&bar[XB_TOP], 1u);
            const unsigned tg = og / nx;
            if (og + 1u == (tg + 1u) * nx) xb_add(&bar[XB_TOPGEN], 1u);
            else XB_SPIN(xb_ld(&bar[XB_TOPGEN]) == tg, bar);
            __builtin_amdgcn_fence(__ATOMIC_ACQUIRE, "agent");
            xb_add(&bar[XB_XGEN(b.x)], 1u);
            asm volatile("s_waitcnt vmcnt(0)" ::: "memory");
        } else {
            XB_SPIN(xb_ld(&bar[XB_XGEN(b.x)]) == gen, bar);
            __builtin_amdgcn_fence(__ATOMIC_ACQUIRE, "agent");
            asm volatile("s_waitcnt vmcnt(0)" ::: "memory");
        }
    }
    __syncthreads();
}

template <int MAP  >
__device__ __forceinline__ void p0_transpose_item(const float* W, int K, int N, bf16* WT, const float* kgain, LAS float* scr, int item, int lane) {
    const int nblk = N / 32, kb = item / nblk, nb = item % nblk, k0 = 64 * kb, n0 = 32 * nb;
#pragma unroll 8
    for (int i = 0; i < 32; ++i) { const int kk = 2 * i + (lane >> 5); float v = W[(size_t)(k0 + kk) * N + n0 + (lane & 31)]; if (kgain) v *= kgain[k0 + kk]; scr[kk * 33 + (lane & 31)] = v; }
    asm volatile("s_waitcnt lgkmcnt(0)" ::: "memory");
    const int c = lane & 7;
    int r0 = n0;
    if (MAP == 2) { const int hs = n0 >> 6; r0 = 256 * (hs >> 2) + 128 * ((n0 >> 5) & 1) + 32 * (hs & 3); }
    if (MAP == 1) r0 = n0 < DFF ? ((n0 >> 7) * 256 + (n0 & 127)) : ((((n0 - DFF) >> 7) * 256) + 128 + ((n0 - DFF) & 127));
#pragma unroll
    for (int j = 0; j < 4; ++j) { const int n = (lane >> 3) + 8 * j; const LAS float* s = scr + (8 * c) * 33 + n;
        v4u o; o.x = cvtpk(s[0 * 33], s[1 * 33]); o.y = cvtpk(s[2 * 33], s[3 * 33]); o.z = cvtpk(s[4 * 33], s[5 * 33]); o.w = cvtpk(s[6 * 33], s[7 * 33]);
        *(v4u*)(WT + (size_t)(r0 + n) * K + k0 + 8 * c) = o; }
    asm volatile("s_waitcnt lgkmcnt(0)" ::: "memory");
}
__device__ __forceinline__ void rms_row_to_bf16(const float* xrow, const float* g, bf16* orow, int lane) {
    const f32x4* xr = (const f32x4*)xrow + lane; const f32x4* gr = (const f32x4*)g + lane;
    f32x4 v[4]; float s = 0.f;
#pragma unroll
    for (int j = 0; j < 4; ++j) { v[j] = xr[64 * j]; s += (v[j].x * v[j].x + v[j].y * v[j].y) + (v[j].z * v[j].z + v[j].w * v[j].w); }
    const float rstd = __builtin_amdgcn_rsqf(wave_sum(s) * (1.f / DM) + EPS);
    unsigned long long* o8 = (unsigned long long*)orow + lane;
#pragma unroll
    for (int j = 0; j < 4; ++j) { const f32x4 gg = gr[64 * j]; o8[64 * j] = (unsigned long long)cvtpk(v[j].x * rstd * gg.x, v[j].y * rstd * gg.y) | ((unsigned long long)cvtpk(v[j].z * rstd * gg.z, v[j].w * rstd * gg.w) << 32); }
}

__device__ __forceinline__ void rms_rows4_to_bf16(const float* xrow, const float* g, bf16* orow, int lane) {
    f32x4 v[4][4]; float s[4];
#pragma unroll
    for (int k = 0; k < 4; ++k)
#pragma unroll
        for (int j = 0; j < 4; ++j) v[k][j] = ((const f32x4*)(xrow + (size_t)k * DM) + lane)[64 * j];
    f32x4 gg[4];
#pragma unroll
    for (int j = 0; j < 4; ++j) gg[j] = ((const f32x4*)g + lane)[64 * j];
#pragma unroll
    for (int k = 0; k < 4; ++k) { s[k] = 0.f;
#pragma unroll
        for (int j = 0; j < 4; ++j) s[k] += (v[k][j].x * v[k][j].x + v[k][j].y * v[k][j].y) + (v[k][j].z * v[k][j].z + v[k][j].w * v[k][j].w); }
#pragma unroll
    for (int o = 1; o < 64; o <<= 1) {
#pragma unroll
        for (int k = 0; k < 4; ++k) s[k] += __shfl_xor(s[k], o); }
#pragma unroll
    for (int k = 0; k < 4; ++k) { const float rstd = __builtin_amdgcn_rsqf(s[k] * (1.f / DM) + EPS);
        unsigned long long* o8 = (unsigned long long*)(orow + (size_t)k * DM) + lane;
#pragma unroll
        for (int j = 0; j < 4; ++j) o8[64 * j] = (unsigned long long)cvtpk(v[k][j].x * rstd * gg[j].x, v[k][j].y * rstd * gg[j].y) | ((unsigned long long)cvtpk(v[k][j].z * rstd * gg[j].z, v[k][j].w * rstd * gg[j].w) << 32); }
}

template <int NKEYS, int NTHR>
__device__ __forceinline__ void stage_load(v4u (&kr)[NKEYS * 8 / NTHR], v4u (&vr)[NKEYS * 8 / NTHR], const bf16* proj, int kcol, int vcol, int tok0, int dshift, int kidx0, int Ls, int t) {
    constexpr int NIT = NKEYS * 8 / NTHR;
    const int c = t & 7;
#pragma unroll
    for (int it = 0; it < NIT; ++it) { const int rho = (it * NTHR + t) >> 3, kidx = kidx0 + rho; const bool ok = (unsigned)kidx < (unsigned)Ls;
        const bf16* rowp = proj + (size_t)(tok0 + ((ok ? kidx : 0) << dshift)) * INW + 8 * c;
        kr[it] = *(const v4u*)(rowp + kcol); vr[it] = *(const v4u*)(rowp + vcol); }
}
template <int NKEYS, int NTHR>
__device__ __forceinline__ void stage_write(const v4u (&kr)[NKEYS * 8 / NTHR], const v4u (&vr)[NKEYS * 8 / NTHR], LAS unsigned char* Kl, LAS unsigned char* Vl, int t) {
    constexpr int NIT = NKEYS * 8 / NTHR;
    const int c = t & 7;
#pragma unroll
    for (int it = 0; it < NIT; ++it) { const int rho = (it * NTHR + t) >> 3;
        *(LAS v4u*)(Kl + rho * 128 + 16 * (c ^ ((rho >> 1) & 7))) = kr[it];
        *(LAS v4u*)(Vl + (c >> 2) * (NKEYS * 64) + rho * 64 + (c & 3) * 16) = vr[it]; }
}
__device__ __forceinline__ void load_q_raw(v4u (&raw)[4], const bf16* qrow, int lane) {
#pragma unroll
    for (int d0 = 0; d0 < 4; ++d0) raw[d0] = *(const v4u*)(qrow + 16 * d0 + 8 * (lane >> 5));
}
typedef short v4i16_t __attribute__((ext_vector_type(4)));
__device__ __forceinline__ s16x4 vtr(const LAS unsigned char* p) { return __builtin_bit_cast(s16x4, __builtin_amdgcn_ds_read_tr16_b64_v4i16((LAS v4i16_t*)p)); }
template <int R, bool BAND, bool EDGE, bool SAFE>
__device__ __forceinline__ void attn_tile(const bf16x8 (&kf)[4], const LAS unsigned char* vq0, int vhs, int j, int kidx_t0, int Ls, const bf16x8 (&qf)[4], float base, float nslope, float negM, f32x16 (&o)[2], float& l, int hi) {
    f32x16 s = {0.f, 0.f, 0.f, 0.f, 0.f, 0.f, 0.f, 0.f, 0.f, 0.f, 0.f, 0.f, 0.f, 0.f, 0.f, 0.f};
#pragma unroll
    for (int d0 = 0; d0 < 4; ++d0) s = __builtin_amdgcn_mfma_f32_32x32x16_bf16(kf[d0], qf[d0], s, 0, 0, 0);
    if (SAFE) {
#pragma unroll
        for (int r = 0; r < 16; ++r) s[r] += negM; }
    const float basej = base + (float)(32 * j);
    float pr[16];
#pragma unroll
    for (int r = 0; r < 16; ++r) { const float relf = basej + (float)((r & 3) + 8 * (r >> 2));
        float p = __builtin_amdgcn_exp2f(__builtin_fmaf(__builtin_fabsf(relf), nslope, s[r]));
        if (BAND) p = (__builtin_fabsf(relf) <= (float)R) ? p : 0.f;
        if (EDGE) { const int kidx = kidx_t0 + 32 * j + (r & 3) + 8 * (r >> 2) + 4 * hi; p = ((unsigned)kidx < (unsigned)Ls) ? p : 0.f; }
        l += p; pr[r] = p; }
    v4u w0, w1; w0.x = cvtpk(pr[0], pr[1]); w0.y = cvtpk(pr[2], pr[3]); w0.z = cvtpk(pr[4], pr[5]); w0.w = cvtpk(pr[6], pr[7]);
    w1.x = cvtpk(pr[8], pr[9]); w1.y = cvtpk(pr[10], pr[11]); w1.z = cvtpk(pr[12], pr[13]); w1.w = cvtpk(pr[14], pr[15]);
    const bf16x8 pa0 = __builtin_bit_cast(bf16x8, w0), pa1 = __builtin_bit_cast(bf16x8, w1);
    const LAS unsigned char* vq = vq0 + j * 2048;
#pragma unroll
    for (int dh = 0; dh < 2; ++dh)
#pragma unroll
        for (int s2 = 0; s2 < 2; ++s2) { const s16x4 lo = vtr(vq + dh * vhs + s2 * 1024), h4 = vtr(vq + dh * vhs + s2 * 1024 + 512);
            const bf16x8 vf = (bf16x8){lo[0], lo[1], lo[2], lo[3], h4[0], h4[1], h4[2], h4[3]};
            o[dh] = __builtin_amdgcn_mfma_f32_32x32x16_bf16(s2 ? pa1 : pa0, vf, o[dh], 0, 0, 0); }
}
template <int NT, int R, bool EDGE, bool SAFE>
__device__ __forceinline__ void attn_task(const LAS unsigned char* Kl, const LAS unsigned char* Vl, int vhs, int row0, int kidx_t0, int Ls, const bf16x8 (&qf)[4], float slope2, float negM, f32x16 (&o)[2], float& l, int lane) {
    const int q = lane & 31, hi = lane >> 5;
    const LAS unsigned char* vp = Vl + row0 * 64 + (4 * hi + ((lane & 15) >> 2)) * 64 + (16 * ((lane >> 4) & 1) + 4 * (lane & 3)) * 2;
    const int sw = (q >> 1) & 7;
    const LAS unsigned char* kp0 = Kl + (row0 + q) * 128 + 16 * ((0 + hi) ^ sw); const LAS unsigned char* kp1 = Kl + (row0 + q) * 128 + 16 * ((2 + hi) ^ sw);
    const LAS unsigned char* kp2 = Kl + (row0 + q) * 128 + 16 * ((4 + hi) ^ sw); const LAS unsigned char* kp3 = Kl + (row0 + q) * 128 + 16 * ((6 + hi) ^ sw);
    float base = (float)(4 * hi - R - q); asm volatile("" : "+v"(base));
    const float nslope = -slope2;
#define LOADK(dst, jj) do { dst[0] = *(const LAS bf16x8*)(kp0 + (jj) * 4096); dst[1] = *(const LAS bf16x8*)(kp1 + (jj) * 4096); dst[2] = *(const LAS bf16x8*)(kp2 + (jj) * 4096); dst[3] = *(const LAS bf16x8*)(kp3 + (jj) * 4096); } while (0)
    bf16x8 kf[4];
    LOADK(kf, 0);
    attn_tile<R, true, EDGE, SAFE>(kf, vp, vhs, 0, kidx_t0, Ls, qf, base, nslope, negM, o, l, hi);
#pragma unroll 1
    for (int j = 1; j < NT - 1; ++j) {
        LOADK(kf, j);
        attn_tile<R, false, EDGE, SAFE>(kf, vp, vhs, j, kidx_t0, Ls, qf, base, nslope, negM, o, l, hi);
    }
    LOADK(kf, NT - 1);
    attn_tile<R, true, EDGE, SAFE>(kf, vp, vhs, NT - 1, kidx_t0, Ls, qf, base, nslope, negM, o, l, hi);
#undef LOADK
}
__device__ __forceinline__ void store_partial(const f32x16 (&o)[2], float l, bf16* OB, float* LB, int tokq0, int dshift, int h, int lane) {
    const int hi = lane >> 5, d = lane & 31;
    l += __shfl_xor(l, 32);
    if (hi == 0) LB[(size_t)(tokq0 + (d << dshift)) * 8 + h] = l;
#pragma unroll
    for (int r = 0; r < 16; ++r) { const int qq = (r & 3) + 8 * (r >> 2) + 4 * hi; bf16* p = OB + (size_t)(tokq0 + (qq << dshift)) * 512 + h * 64 + d;
        p[0] = (bf16)(cvtpk(o[0][r], 0.f) & 0xffffu); p[32] = (bf16)(cvtpk(o[1][r], 0.f) & 0xffffu); }
}
struct AUnit { int tok0, dshift, Ls, cc, h, c; };
__device__ __forceinline__ AUnit decode_a(int su) {
    AUnit a; const int sidx = su / 48, k = su % 48, blk = sidx >> 3; a.h = sidx & 7; a.c = 2 - (k >> 4); a.dshift = 2 * a.c; const int kk = k & 15;
    int seq0, S, bis; if (blk < 8) { seq0 = 0; S = 16384; bis = blk; } else { seq0 = MP + 2048 * (blk - 8); S = 2048; bis = 0; }
    a.Ls = S >> a.dshift; const int cpb = 16 >> a.dshift  , res = kk / cpb; a.cc = bis * cpb + kk % cpb; a.tok0 = seq0 + res; return a;
}
struct BUnit { int seq0, S, lcb, g2; };
__device__ __forceinline__ BUnit decode_b(int u) {
    BUnit b; b.g2 = u / 768; const int cb = u % 768;
    if (cb < 256) { b.seq0 = 0; b.S = 16384; b.lcb = cb; } else { b.seq0 = MP + 2048 * ((cb - 256) >> 5); b.S = 2048; b.lcb = (cb - 256) & 31; } return b;
}

#define LDS_BAR() asm volatile("s_waitcnt lgkmcnt(0)\n\ts_barrier" ::: "memory")
#define xp (args.in[0])
#define xs (args.in[1])
#define norm1 (args.in[2])
#define w_in (args.in[3])
#define qna (args.in[4])
#define kna (args.in[5])
#define qnb (args.in[6])
#define knb (args.in[7])
#define sinkb (args.in[8])
#define ona (args.in[9])
#define onb (args.in[10])
#define w_out (args.in[11])
#define norm2 (args.in[12])
#define w_up (args.in[13])
#define conv_w (args.in[14])
#define conv_b (args.in[15])
#define w_down (args.in[16])
#define out (args.dout)
#define SSQ ((float*)(args.ws + WS_SSQ))
#define WIN ((bf16*)(args.ws + WS_WIN))
#define WOUT ((bf16*)(args.ws + WS_WOUT))
#define WUP ((bf16*)(args.ws + WS_WUP))
#define WDN ((bf16*)(args.ws + WS_WDN))
#define XN ((bf16*)(args.ws + WS_XN) + DM)
#define PROJ ((bf16*)(args.ws + WS_PROJ))
#define Y ((bf16*)(args.ws + WS_PROJ))
#define OA ((bf16*)(args.ws + WS_OA))
#define OB ((bf16*)(args.ws + WS_XN) + DM)
#define HB ((bf16*)(args.ws + WS_H))
#define LA ((float*)(args.ws + WS_LA))
#define LBp ((float*)(args.ws + WS_LA) + 3 * (size_t)M * 8)
struct Args { const float* in[17]; float* dout; unsigned char* ws; };
__global__ void __launch_bounds__(NWAVES * 64, 2) fwd_megakernel(Args args) {
    extern __shared__ __attribute__((aligned(16))) unsigned char lds_raw[];
    cg::grid_group grid = cg::this_grid();
    LAS unsigned char* lds = (LAS unsigned char*)lds_raw;
    const int tid = threadIdx.x, lane = tid & 63, wave = __builtin_amdgcn_readfirstlane(tid >> 6);
    const int G = gridDim.x, bx = blockIdx.x;
    if (tid < 2) ((LAS unsigned*)(lds + MISC_OFF))[tid] = 0u;
    const int gw = bx * NWAVES + wave, NGW = G * NWAVES;

    {
        LAS float* scr = (LAS float*)(lds + wave * 16384);
        constexpr int I_IN = (DM / 64) * (INW / 32), I_OUT = (DM / 64) * (DM / 32), I_UP = (DM / 64) * (UPW / 32), I_DN = (DFF / 64) * (DM / 32);
        for (int it = gw; it < I_IN + I_OUT + I_UP + I_DN; it += NGW) {
            int r = it;
            if (r < I_IN) { p0_transpose_item<2>(w_in, DM, INW, WIN, nullptr, scr, r, lane); continue; } r -= I_IN;
            if (r < I_OUT) { p0_transpose_item<0>(w_out, DM, DM, WOUT, nullptr, scr, r, lane); continue; } r -= I_OUT;
            if (r < I_UP) { p0_transpose_item<1>(w_up, DM, UPW, WUP, norm2, scr, r, lane); continue; } r -= I_UP;
            p0_transpose_item<0>(w_down, DFF, DM, WDN, nullptr, scr, r, lane);
        }
        for (int m = gw * 4; m < M; m += NGW * 4) rms_rows4_to_bf16(m < MP ? xp + (size_t)m * DM : xs + (size_t)(m - MP) * DM, norm1, XN + (size_t)m * DM, lane);
        if (bx == 0) for (int i = tid; i < XCD_BAR_WORDS; i += 512) ((unsigned*)(args.ws + WS_BAR))[i] = 0u;
        for (int i = bx * 512 + tid; i < M; i += G * 512) SSQ[i] = 0.f;
    }
    grid.sync();
    XcdBarrier bar = xcd_barrier_post((unsigned*)(args.ws + WS_BAR), (volatile LAS unsigned*)(lds + MISC_OFF));

    {
        pg8::Gemm g{XN, WIN, M, INW, DM, 256}; pg8::StaticOrder S; S.init(M, INW, G, bx);
        pg8::EpiProj E{PROJ, qna, kna, qnb, knb};
        pg8::gemm_phase<pg8::EpiProj, pg8::StaticOrder, PG8_ALIGN, PG8_SP2>(lds, g, S, E);
    }
    xcd_barrier(bar);

    {
        const float gqa = fabsf(qna[lane]), gka = fabsf(kna[lane]);
        const float boundA = __builtin_bit_cast(float, __builtin_amdgcn_readfirstlane(__builtin_bit_cast(int, 8.0f * wave_max(gqa) * wave_max(gka) * LOG2E)));
        const float negMa = boundA > 40.f ? -boundA : 0.f;
        {
            const int half = wave >> 2, w4 = wave & 3, th = tid & 255;
            LAS unsigned char* Kl = lds + half * 65536; LAS unsigned char* Vl = Kl + 32768;
            const int ubase = (G == 256) ? (bx & 7) * 576 + (bx >> 3) : bx, ustep = (G == 256) ? 32 : G, uend = (G == 256) ? (bx & 7) * 576 + 576 : 4608;
            v4u kr[8], vr[8], qraw[4]; AUnit nx = decode_a(2 * ubase + half);
            if (ubase < uend) { stage_load<256, 256>(kr, vr, PROJ, KA_OFF + nx.h * 64, VA_OFF + nx.h * 64, nx.tok0, nx.dshift, 128 * nx.cc - 64, nx.Ls, th);
                load_q_raw(qraw, PROJ + (size_t)(nx.tok0 + ((128 * nx.cc + 32 * w4 + (lane & 31)) << nx.dshift)) * INW + QA_OFF + nx.h * 64, lane); }
            for (int u = ubase; u < uend; u += ustep) {
                const AUnit a = nx;
                LDS_BAR();
                stage_write<256, 256>(kr, vr, Kl, Vl, th);
                bf16x8 qf[4];
#pragma unroll
                for (int d0 = 0; d0 < 4; ++d0) qf[d0] = __builtin_bit_cast(bf16x8, qraw[d0]);
                LDS_BAR();
                if (u + ustep < uend) { nx = decode_a(2 * (u + ustep) + half);
                    stage_load<256, 256>(kr, vr, PROJ, KA_OFF + nx.h * 64, VA_OFF + nx.h * 64, nx.tok0, nx.dshift, 128 * nx.cc - 64, nx.Ls, th);
                    load_q_raw(qraw, PROJ + (size_t)(nx.tok0 + ((128 * nx.cc + 32 * w4 + (lane & 31)) << nx.dshift)) * INW + QA_OFF + nx.h * 64, lane); }
                const int iq0 = 128 * a.cc + 32 * w4;
                f32x16 o[2]; float l = 0.f;
#pragma unroll
                for (int r = 0; r < 16; ++r) { o[0][r] = 0.f; o[1][r] = 0.f; }
                const float slope2 = exp2f(-0.5f * (float)(a.h + 9)) * (float)(1 << a.dshift) * LOG2E;
                const bool edge = iq0 - 64 < 0 || iq0 + 96 > a.Ls;
                if (__builtin_expect(negMa != 0.f, 0)) { if (edge) attn_task<5, 64, true, true>(Kl, Vl, 256 * 64, 32 * w4, iq0 - 64, a.Ls, qf, slope2, negMa, o, l, lane); else attn_task<5, 64, false, true>(Kl, Vl, 256 * 64, 32 * w4, iq0 - 64, a.Ls, qf, slope2, negMa, o, l, lane); }
                else if (edge) attn_task<5, 64, true, false>(Kl, Vl, 256 * 64, 32 * w4, iq0 - 64, a.Ls, qf, slope2, 0.f, o, l, lane);
                else attn_task<5, 64, false, false>(Kl, Vl, 256 * 64, 32 * w4, iq0 - 64, a.Ls, qf, slope2, 0.f, o, l, lane);
                asm volatile("s_nop 15\n\ts_nop 7" ::: "memory");
                store_partial(o, l, OA + (size_t)a.c * M * 512, LA + (size_t)a.c * M * 8, a.tok0 + (iq0 << a.dshift), a.dshift, a.h, lane);
            }
        }
        const float gqb = fabsf(qnb[lane]), gkb = fabsf(knb[lane]);
        const float boundB = __builtin_bit_cast(float, __builtin_amdgcn_readfirstlane(__builtin_bit_cast(int, 8.0f * wave_max(gqb) * wave_max(gkb) * LOG2E)));
        const float negMb = boundB > 40.f ? -boundB : 0.f;
        {
            LAS unsigned char* Kb = lds; LAS unsigned char* Vb = lds + 40960;
            const int ubase = (G == 256) ? (bx & 7) * 192 + (bx >> 3) : bx, ustep = (G == 256) ? 32 : G, uend = (G == 256) ? (bx & 7) * 192 + 192 : 1536;
            v4u kr[5], vr[5], qraw[4]; BUnit nx = decode_b(ubase);
            if (ubase < uend) { stage_load<320, 512>(kr, vr, PROJ, KB_OFF + nx.g2 * 64, VB_OFF + nx.g2 * 64, nx.seq0, 0, 64 * nx.lcb - 128, nx.S, tid);
                load_q_raw(qraw, PROJ + (size_t)(nx.seq0 + 64 * nx.lcb + 32 * (wave & 1) + (lane & 31)) * INW + QB_OFF + (4 * nx.g2 + (wave >> 1)) * 64, lane); }
            for (int u = ubase; u < uend; u += ustep) {
                const BUnit b = nx;
                LDS_BAR();
                stage_write<320, 512>(kr, vr, Kb, Vb, tid);
                bf16x8 qf[4];
#pragma unroll
                for (int d0 = 0; d0 < 4; ++d0) qf[d0] = __builtin_bit_cast(bf16x8, qraw[d0]);
                LDS_BAR();
                if (u + ustep < uend) { nx = decode_b(u + ustep);
                    stage_load<320, 512>(kr, vr, PROJ, KB_OFF + nx.g2 * 64, VB_OFF + nx.g2 * 64, nx.seq0, 0, 64 * nx.lcb - 128, nx.S, tid);
                    load_q_raw(qraw, PROJ + (size_t)(nx.seq0 + 64 * nx.lcb + 32 * (wave & 1) + (lane & 31)) * INW + QB_OFF + (4 * nx.g2 + (wave >> 1)) * 64, lane); }
                const int hb = 4 * b.g2 + (wave >> 1), iq0 = 64 * b.lcb + 32 * (wave & 1);
                f32x16 o[2]; float l = 0.f;
#pragma unroll
                for (int r = 0; r < 16; ++r) { o[0][r] = 0.f; o[1][r] = 0.f; }
                const float slope2 = exp2f(-0.5f * (float)(hb + 1)) * LOG2E;
                const bool edge = iq0 - 128 < 0 || iq0 + 160 > b.S;
                if (__builtin_expect(negMb != 0.f, 0)) { if (edge) attn_task<9, 128, true, true>(Kb, Vb, 320 * 64, 32 * (wave & 1), iq0 - 128, b.S, qf, slope2, negMb, o, l, lane); else attn_task<9, 128, false, true>(Kb, Vb, 320 * 64, 32 * (wave & 1), iq0 - 128, b.S, qf, slope2, negMb, o, l, lane); }
                else if (edge) attn_task<9, 128, true, false>(Kb, Vb, 320 * 64, 32 * (wave & 1), iq0 - 128, b.S, qf, slope2, 0.f, o, l, lane);
                else attn_task<9, 128, false, false>(Kb, Vb, 320 * 64, 32 * (wave & 1), iq0 - 128, b.S, qf, slope2, 0.f, o, l, lane);
                asm volatile("s_nop 15\n\ts_nop 7" ::: "memory");
                store_partial(o, l, OB, LBp, b.seq0 + iq0, 0, hb, lane);
            }
        }
        xcd_barrier(bar);
        {
            const int hh = lane >> 3;
            const float sinkterm = __builtin_amdgcn_exp2f(sinkb[hh] * LOG2E + negMb);
            const f32x4 ga0 = *(const f32x4*)(ona + 8 * lane), ga1 = *(const f32x4*)(ona + 8 * lane + 4), gb0 = *(const f32x4*)(onb + 8 * lane), gb1 = *(const f32x4*)(onb + 8 * lane + 4);
            for (int m0 = gw * 4; m0 < M; m0 += NGW * 4) {
                v4u wa[4][3], wb[4]; float la[4], lb[4];
#pragma unroll
                for (int k = 0; k < 4; ++k) { const int m = m0 + k; la[k] = 0.f;
#pragma unroll
                    for (int c = 0; c < 3; ++c) { wa[k][c] = *(const v4u*)(OA + ((size_t)c * M + m) * 512 + 8 * lane); la[k] += LA[((size_t)c * M + m) * 8 + hh]; }
                    wb[k] = *(const v4u*)(OB + (size_t)m * 512 + 8 * lane); lb[k] = LBp[(size_t)m * 8 + hh] + sinkterm; }
                float ya[4][8], yb[4][8], sa[4], sb[4];
#pragma unroll
                for (int k = 0; k < 4; ++k) { const float ia = 1.0f / la[k], ib = 1.0f / lb[k];
                    ya[k][0] = (bf_lo(wa[k][0].x) + bf_lo(wa[k][1].x) + bf_lo(wa[k][2].x)) * ia; ya[k][1] = (bf_hi(wa[k][0].x) + bf_hi(wa[k][1].x) + bf_hi(wa[k][2].x)) * ia;
                    ya[k][2] = (bf_lo(wa[k][0].y) + bf_lo(wa[k][1].y) + bf_lo(wa[k][2].y)) * ia; ya[k][3] = (bf_hi(wa[k][0].y) + bf_hi(wa[k][1].y) + bf_hi(wa[k][2].y)) * ia;
                    ya[k][4] = (bf_lo(wa[k][0].z) + bf_lo(wa[k][1].z) + bf_lo(wa[k][2].z)) * ia; ya[k][5] = (bf_hi(wa[k][0].z) + bf_hi(wa[k][1].z) + bf_hi(wa[k][2].z)) * ia;
                    ya[k][6] = (bf_lo(wa[k][0].w) + bf_lo(wa[k][1].w) + bf_lo(wa[k][2].w)) * ia; ya[k][7] = (bf_hi(wa[k][0].w) + bf_hi(wa[k][1].w) + bf_hi(wa[k][2].w)) * ia;
                    yb[k][0] = bf_lo(wb[k].x) * ib; yb[k][1] = bf_hi(wb[k].x) * ib; yb[k][2] = bf_lo(wb[k].y) * ib; yb[k][3] = bf_hi(wb[k].y) * ib;
                    yb[k][4] = bf_lo(wb[k].z) * ib; yb[k][5] = bf_hi(wb[k].z) * ib; yb[k][6] = bf_lo(wb[k].w) * ib; yb[k][7] = bf_hi(wb[k].w) * ib;
                    sa[k] = 0.f; sb[k] = 0.f;
#pragma unroll
                    for (int i = 0; i < 8; ++i) { sa[k] += ya[k][i] * ya[k][i]; sb[k] += yb[k][i] * yb[k][i]; } }
#pragma unroll
                for (int o = 1; o < 64; o <<= 1) {
#pragma unroll
                    for (int k = 0; k < 4; ++k) { sa[k] += __shfl_xor(sa[k], o); sb[k] += __shfl_xor(sb[k], o); } }
#pragma unroll
                for (int k = 0; k < 4; ++k) { const int m = m0 + k;
                    const float ra = __builtin_amdgcn_rsqf(sa[k] * (1.f / 512.f) + EPS), rb = __builtin_amdgcn_rsqf(sb[k] * (1.f / 512.f) + EPS);
                    v4u oa, ob;
                    oa.x = cvtpk(ya[k][0] * ra * ga0.x, ya[k][1] * ra * ga0.y); oa.y = cvtpk(ya[k][2] * ra * ga0.z, ya[k][3] * ra * ga0.w); oa.z = cvtpk(ya[k][4] * ra * ga1.x, ya[k][5] * ra * ga1.y); oa.w = cvtpk(ya[k][6] * ra * ga1.z, ya[k][7] * ra * ga1.w);
                    ob.x = cvtpk(yb[k][0] * rb * gb0.x, yb[k][1] * rb * gb0.y); ob.y = cvtpk(yb[k][2] * rb * gb0.z, yb[k][3] * rb * gb0.w); ob.z = cvtpk(yb[k][4] * rb * gb1.x, yb[k][5] * rb * gb1.y); ob.w = cvtpk(yb[k][6] * rb * gb1.z, yb[k][7] * rb * gb1.w);
                    *(v4u*)(Y + (size_t)m * DM + 8 * lane) = oa; *(v4u*)(Y + (size_t)m * DM + 512 + 8 * lane) = ob; }
            }
        }
    }
    xcd_barrier(bar);

    {
        pg8::Gemm g{Y, WOUT, M, DM, DM, 256}; pg8::StaticOrder S; S.init(M, DM, G, bx);
        pg8::EpiOut E{xp, xs, XN, SSQ};
        pg8::gemm_phase<pg8::EpiOut, pg8::StaticOrder, PG8_ALIGN, PG8_SP2>(lds, g, S, E);
    }
    xcd_barrier(bar);

    {
        pg8::Gemm g{XN - DM, WUP, UP_TILES_M * 256, UPW, DM, 254}; pg8::StaticOrder S; S.init(UP_TILES_M * 256, UPW, G, bx);
        pg8::EpiUp E{HB, SSQ, conv_w, conv_b, (LAS float*)(lds + XCH_OFF)};
        pg8::gemm_phase<pg8::EpiUp, pg8::StaticOrder, true, PG8_SP2>(lds, g, S, E);
    }
    xcd_barrier(bar);

    {
        pg8::Gemm g{HB, WDN, M, DM, DFF, 256}; pg8::StaticOrder S; S.init(M, DM, G, bx);
        pg8::EpiDown E{XN, out};
        pg8::gemm_phase<pg8::EpiDown, pg8::StaticOrder, PG8_ALIGN, PG8_SP2>(lds, g, S, E);
    }
}

#undef out
#undef xp
#undef xs
extern "C" void kernel_launch(void* const* d_in, const int* in_sizes, int n_in, void* d_out, int out_size, void* d_ws, size_t ws_size, hipStream_t stream) {
    static int grid = 0;
    if (grid == 0) {
        if (n_in != 17 || out_size != M * DM || ws_size < WS_END) { fprintf(stderr, "kernel_launch: unexpected shapes (n_in %d out %d ws %zu)\n", n_in, out_size, ws_size); grid = -1; return; }
        int dev = 0, cus = 0, per_cu = 0;
        hipGetDevice(&dev); hipDeviceGetAttribute(&cus, hipDeviceAttributeMultiprocessorCount, dev);
        if (hipFuncSetAttribute((const void*)fwd_megakernel, hipFuncAttributeMaxDynamicSharedMemorySize, LDS_BYTES) != hipSuccess) { fprintf(stderr, "kernel_launch: hipFuncSetAttribute failed\n"); grid = -1; return; }
        if (hipOccupancyMaxActiveBlocksPerMultiprocessor(&per_cu, (const void*)fwd_megakernel, NWAVES * 64, LDS_BYTES) != hipSuccess || per_cu < 1) { fprintf(stderr, "kernel_launch: occupancy query says %d\n", per_cu); per_cu = 1; }
        (void)hipGetLastError();
        grid = cus;
        fprintf(stderr, "kernel_launch: grid %d (per_cu %d)\n", grid, per_cu);
    }
    if (grid < 0) return;
    Args a{};
    for (int i = 0; i < 17; ++i) a.in[i] = (const float*)d_in[i];
    a.dout = (float*)d_out; a.ws = (unsigned char*)d_ws;
    void* kargs[] = {&a};
    hipError_t e = hipLaunchCooperativeKernel((const void*)fwd_megakernel, dim3(grid), dim3(NWAVES * 64), kargs, LDS_BYTES, stream);
    if (e != hipSuccess) fprintf(stderr, "kernel_launch: cooperative launch failed: %s\n", hipGetErrorString(e));
}
```

```cpp
#include <hip/hip_runtime.h>
#include <hip/hip_cooperative_groups.h>
#include <cstdio>
#include <cstdint>
namespace cg = cooperative_groups;
namespace pg8 {
#define PG8_LAS __attribute__((address_space(3)))
typedef unsigned short bf16_t;
typedef short bf16x8 __attribute__((ext_vector_type(8)));
typedef float f32x4 __attribute__((ext_vector_type(4)));
typedef unsigned u32x4 __attribute__((ext_vector_type(4)));
constexpr int BM = 256, BK = 64, HALF = 128, HTB = HALF * BK * 2  , STAGE_BYTES = 8 * HTB, NXCD = 8, WGM = 8;

__host__ __device__ __forceinline__ int lds_byte(int r, int c) { const int st = (r >> 4) * 2 + (c >> 5), rr = r & 15, cc = c & 31, ob = rr * 64 + cc * 2; return st * 1024 + (ob ^ (((ob >> 9) & 1) << 5)); }
__host__ __device__ __forceinline__ void stage_rc(int b, int& R, int& C) { const int st = b / 1024, sb = b % 1024, swz = sb ^ (((sb >> 9) & 1) << 5); R = (st >> 1) * 16 + swz / 64; C = (st & 1) * 32 + (swz % 64) / 2; }
__host__ __device__ __forceinline__ int perm32(int rho) { const int n = rho >> 4, i = rho & 15; return 8 * (i >> 2) + 4 * n + (i & 3); }

struct Unit { int pm, pn; };
struct Gemm { const bf16_t* A; const bf16_t* Bt; int M, N, K; int a_tile_rows; };

struct StaticOrder {
    int nM, nN, nwg, G, c;
    __host__ __device__ void init(int M, int N, int G_, int c_) { nM = M / BM; nN = N / BM; nwg = nM * nN; G = G_; c = c_; }
    __host__ __device__ bool next(int i, Unit& u) const {
        const long L = (long)i * G + c; if (L >= nwg) return false;
        int wgid = (int)L; { const int q = nwg / NXCD, r = nwg % NXCD, xcd = wgid % NXCD, off = wgid / NXCD; wgid = (xcd < r ? xcd * (q + 1) : r * (q + 1) + (xcd - r) * q) + off; }
        const int nig = WGM * nN, gid = wgid / nig, fm = gid * WGM, gsz = (nM - fm) < WGM ? (nM - fm) : WGM;
        u.pm = fm + ((wgid % nig) % gsz); u.pn = (wgid % nig) / gsz; return true;
    }
    __device__ __forceinline__ void a_ready(const Unit&) const {}
    __device__ __forceinline__ void done(const Unit&) const {}
};

__device__ __forceinline__ unsigned cvt_pk_bf16(float lo, float hi) { unsigned r; asm volatile("v_cvt_pk_bf16_f32 %0, %1, %2" : "=v"(r) : "v"(lo), "v"(hi)); return r; }
typedef float f32x2 __attribute__((ext_vector_type(2))); typedef __bf16 bf16x2_t __attribute__((ext_vector_type(2)));
__device__ __forceinline__ unsigned cvtpk(float lo, float hi) { f32x2 v = {lo, hi}; bf16x2_t b = __builtin_convertvector(v, bf16x2_t); return __builtin_bit_cast(unsigned, b); }
constexpr int MTOK = 49152, MPROMPT = 16384, DMODEL = 1024, DFF_ = 2816;
__device__ __forceinline__ u32x4 pack8(const f32x4 a, const f32x4 b) { u32x4 w; w.x = cvtpk(a[0], a[1]); w.y = cvtpk(a[2], a[3]); w.z = cvtpk(b[0], b[1]); w.w = cvtpk(b[2], b[3]); return w; }

struct EpiProj {
    static constexpr bool PERM = true, AFTER_DRAIN = false;
    bf16_t* O; const float* gqa; const float* gka; const float* gqb; const float* gkb;
    __device__ __forceinline__ void operator()(f32x4 (&acc)[2][2][4][2], const Unit& u, int wr, int wc, int fr, int fq, int wid, int lane) const {
        const int hs = 4 * u.pn + wc;
        const float* g = nullptr; float sc = 1.f;
        if (hs < 8) { g = gqa; sc = 0.125f * 1.4426950408889634f; } else if (hs < 16) g = gka; else if (hs >= 24 && hs < 32) { g = gqb; sc = 0.125f * 1.4426950408889634f; } else if (hs >= 32 && hs < 34) g = gkb;
        const int row0 = u.pm * BM + wr * 64 + fr;
        bf16_t* obase = O + (size_t)row0 * 2304 + 64 * hs + 8 * fq;
        if (g) {
            f32x4 gg[2][2];
#pragma unroll
            for (int bj = 0; bj < 2; ++bj)
#pragma unroll
                for (int n = 0; n < 2; ++n) gg[bj][n] = *(const f32x4*)(g + 32 * bj + 8 * fq + 4 * n) * sc;
#pragma unroll
            for (int ai = 0; ai < 2; ++ai)
#pragma unroll
                for (int m = 0; m < 4; ++m) { float ss = 0.f;
#pragma unroll
                    for (int bj = 0; bj < 2; ++bj)
#pragma unroll
                        for (int n = 0; n < 2; ++n) { const f32x4 a = acc[ai][bj][m][n]; ss += (a[0] * a[0] + a[1] * a[1]) + (a[2] * a[2] + a[3] * a[3]); }
                    ss += __shfl_xor(ss, 16); ss += __shfl_xor(ss, 32);
                    const float rs = __builtin_amdgcn_rsqf(ss * (1.0f / 64.0f) + 1e-6f);
                    bf16_t* rowp = obase + (size_t)(ai * HALF + m * 16) * 2304;
#pragma unroll
                    for (int bj = 0; bj < 2; ++bj) *(u32x4*)(rowp + 32 * bj) = pack8(acc[ai][bj][m][0] * rs * gg[bj][0], acc[ai][bj][m][1] * rs * gg[bj][1]); }
        } else {
#pragma unroll
            for (int ai = 0; ai < 2; ++ai)
#pragma unroll
                for (int m = 0; m < 4; ++m) { bf16_t* rowp = obase + (size_t)(ai * HALF + m * 16) * 2304;
#pragma unroll
                    for (int bj = 0; bj < 2; ++bj) *(u32x4*)(rowp + 32 * bj) = pack8(acc[ai][bj][m][0], acc[ai][bj][m][1]); }
        }
    }
};
struct EpiOut {
    static constexpr bool PERM = true, AFTER_DRAIN = false;
    const float* xp; const float* xs; bf16_t* xb; float* ssq;
    __device__ __forceinline__ void operator()(f32x4 (&acc)[2][2][4][2], const Unit& u, int wr, int wc, int fr, int fq, int wid, int lane) const {
        const int col0 = u.pn * BM + wc * 32 + 8 * fq;
#pragma unroll
        for (int ai = 0; ai < 2; ++ai)
#pragma unroll
            for (int m = 0; m < 4; ++m) { const int gr = u.pm * BM + ai * HALF + wr * 64 + m * 16 + fr;
                const float* xr = (gr < MPROMPT ? xp + (size_t)gr * DMODEL : xs + (size_t)(gr - MPROMPT) * DMODEL) + col0;
                float s = 0.f;
#pragma unroll
                for (int bj = 0; bj < 2; ++bj) { f32x4 a = *(const f32x4*)(xr + bj * HALF), b = *(const f32x4*)(xr + bj * HALF + 4);
                    a += acc[ai][bj][m][0]; b += acc[ai][bj][m][1];
                    s += (a[0] * a[0] + a[1] * a[1]) + (a[2] * a[2] + a[3] * a[3]) + (b[0] * b[0] + b[1] * b[1]) + (b[2] * b[2] + b[3] * b[3]);
                    *(u32x4*)(xb + (size_t)gr * DMODEL + col0 + bj * HALF) = pack8(a, b); }
                s += __shfl_xor(s, 16); s += __shfl_xor(s, 32);
                if (fq == 0) unsafeAtomicAdd(ssq + gr, s);
                asm volatile("" ::: "memory"); }
    }
};
struct EpiDown {
    static constexpr bool PERM = true, AFTER_DRAIN = false;
    const bf16_t* xb; float* out;
    __device__ __forceinline__ void operator()(f32x4 (&acc)[2][2][4][2], const Unit& u, int wr, int wc, int fr, int fq, int wid, int lane) const {
        const int col0 = u.pn * BM + wc * 32 + 8 * fq;
#pragma unroll
        for (int ai = 0; ai < 2; ++ai)
#pragma unroll
            for (int m = 0; m < 4; ++m) { const int gr = u.pm * BM + ai * HALF + wr * 64 + m * 16 + fr;
                float* o = out + (size_t)gr * DMODEL + col0; const bf16_t* xr = xb + (size_t)gr * DMODEL + col0;
#pragma unroll
                for (int bj = 0; bj < 2; ++bj) { const u32x4 w = *(const u32x4*)(xr + bj * HALF);
                    f32x4 a = {__uint_as_float(w.x << 16), __uint_as_float(w.x & 0xffff0000u), __uint_as_float(w.y << 16), __uint_as_float(w.y & 0xffff0000u)};
                    f32x4 b = {__uint_as_float(w.z << 16), __uint_as_float(w.z & 0xffff0000u), __uint_as_float(w.w << 16), __uint_as_float(w.w & 0xffff0000u)};
                    a += acc[ai][bj][m][0]; b += acc[ai][bj][m][1]; *(f32x4*)(o + bj * HALF) = a; *(f32x4*)(o + bj * HALF + 4) = b; }
                asm volatile("" ::: "memory"); }
    }
};
__device__ __forceinline__ bool seq_first(int gr) { return gr == 0 || (gr >= MPROMPT && (gr & 2047) == 0); }
__device__ __forceinline__ bool seq_last(int gr) { return gr >= MPROMPT - 1 && (gr & 2047) == 2047; }
struct EpiUp {
    static constexpr bool PERM = true, AFTER_DRAIN = false;
    bf16_t* H; const float* ssq; const float* cw; const float* cb; PG8_LAS float* xch;
    __device__ __forceinline__ void operator()(f32x4 (&acc)[2][2][4][2], const Unit& u, int wr, int wc, int fr, int fq, int wid, int lane) const {
        const int lr0 = wr * 64 + fr, gr0 = 254 * u.pm - 1 + lr0;
#pragma unroll
        for (int ai = 0; ai < 2; ++ai)
#pragma unroll
            for (int m = 0; m < 4; ++m) { int gr = gr0 + ai * HALF + m * 16; gr = gr < 0 ? 0 : (gr > MTOK - 1 ? MTOK - 1 : gr);
                const float rs = __builtin_amdgcn_rsqf(ssq[gr] * (1.0f / DMODEL) + 1e-6f);
#pragma unroll
                for (int bj = 0; bj < 2; ++bj)
#pragma unroll
                    for (int n = 0; n < 2; ++n) acc[ai][bj][m][n] *= rs; }
#pragma unroll
        for (int ai = 0; ai < 2; ++ai) {
            if (fr == 0) { PG8_LAS float* p = xch + ((wid * 2 + ai) * 2 + 0) * 64 + 8 * fq;
#pragma unroll
                for (int bj = 0; bj < 2; ++bj)
#pragma unroll
                    for (int n = 0; n < 2; ++n) *(PG8_LAS f32x4*)(p + bj * 32 + 4 * n) = acc[ai][bj][0][n]; }
            if (fr == 15) { PG8_LAS float* p = xch + ((wid * 2 + ai) * 2 + 1) * 64 + 8 * fq;
#pragma unroll
                for (int bj = 0; bj < 2; ++bj)
#pragma unroll
                    for (int n = 0; n < 2; ++n) *(PG8_LAS f32x4*)(p + bj * 32 + 4 * n) = acc[ai][bj][3][n]; }
        }
        asm volatile("s_waitcnt lgkmcnt(0)" ::: "memory"); __builtin_amdgcn_s_barrier(); asm volatile("" ::: "memory");
        const int ow = (1 - wr) * 4 + wc;
        const int ch0 = 128 * u.pn + 32 * wc + 8 * fq;
#pragma unroll
        for (int n = 0; n < 2; ++n) {
            f32x4 w0[2], w1[2], w2[2], bb[2];
#pragma unroll
            for (int bj = 0; bj < 2; ++bj) { const int ch = ch0 + 4 * n + bj * DFF_;
                w0[bj] = *(const f32x4*)(cw + ch); w1[bj] = *(const f32x4*)(cw + 2 * DFF_ + ch); w2[bj] = *(const f32x4*)(cw + 4 * DFF_ + ch); bb[bj] = *(const f32x4*)(cb + ch); }
#pragma unroll
            for (int ai = 0; ai < 2; ++ai) {
                const int aiT = wr == 1 ? ai : ai - 1, aiB = wr == 0 ? ai : ai + 1;
#pragma unroll
                for (int m = 0; m < 4; ++m) {
                    const int lr = lr0 + ai * HALF + m * 16, gr = gr0 + ai * HALF + m * 16;
                    const bool first = seq_first(gr), last = seq_last(gr);
                    f32x4 c[2];
#pragma unroll
                    for (int bj = 0; bj < 2; ++bj) {
                        const f32x4 cur = acc[ai][bj][m][n];
                        f32x4 pv, nx;
#pragma unroll
                        for (int e = 0; e < 4; ++e) {
                            const float sP = (m > 0 && fr == 15) ? acc[ai][bj][m > 0 ? m - 1 : 0][n][e] : cur[e];
                            const float sN = (m < 3 && fr == 0) ? acc[ai][bj][m < 3 ? m + 1 : 3][n][e] : cur[e];
                            pv[e] = __builtin_bit_cast(float, __builtin_amdgcn_update_dpp(0, __builtin_bit_cast(int, sP), 0x121  , 0xf, 0xf, false));
                            nx[e] = __builtin_bit_cast(float, __builtin_amdgcn_update_dpp(0, __builtin_bit_cast(int, sN), 0x12f  , 0xf, 0xf, false)); }
                        if (m == 0) { const f32x4 top = (aiT >= 0) ? *(const PG8_LAS f32x4*)(xch + ((ow * 2 + (aiT < 0 ? 0 : aiT)) * 2 + 1) * 64 + 8 * fq + bj * 32 + 4 * n) : (f32x4){0.f, 0.f, 0.f, 0.f}; if (fr == 0) pv = top; }
                        if (m == 3) { const f32x4 bot = (aiB <= 1) ? *(const PG8_LAS f32x4*)(xch + ((ow * 2 + (aiB > 1 ? 1 : aiB)) * 2 + 0) * 64 + 8 * fq + bj * 32 + 4 * n) : (f32x4){0.f, 0.f, 0.f, 0.f}; if (fr == 15) nx = bot; }
                        if (first) pv = (f32x4){0.f, 0.f, 0.f, 0.f};
                        if (last) nx = (f32x4){0.f, 0.f, 0.f, 0.f};
                        c[bj] = bb[bj] + w0[bj] * pv + w1[bj] * cur + w2[bj] * nx;
                    }
                    f32x4 hv;
#pragma unroll
                    for (int e = 0; e < 4; ++e) { const float g = c[0][e]; hv[e] = g * __builtin_amdgcn_rcpf(1.0f + __builtin_amdgcn_exp2f(-1.4426950408889634f * g)) * c[1][e]; }
                    f32x2 pk; pk.x = __builtin_bit_cast(float, cvtpk(hv[0], hv[1])); pk.y = __builtin_bit_cast(float, cvtpk(hv[2], hv[3]));
                    if (lr >= 1 && lr <= 254 && gr < MTOK) *(f32x2*)(H + (size_t)gr * DFF_ + ch0 + 4 * n) = pk;
                    asm volatile("" ::: "memory");
                }
            }
        }
    }
};
template <class Epi, class Sched, bool ALIGN_EPI = false, bool SP2 = false>
__device__ __forceinline__ void gemm_phase(PG8_LAS unsigned char* lds, const Gemm g, const Sched& S, const Epi& E) {
    int tid_ = threadIdx.x; asm volatile("" : "+v"(tid_));
    const int tid = tid_, wid = __builtin_amdgcn_readfirstlane(tid >> 6), lane = tid & 63, wr = wid >> 2, wc = wid & 3, fr = lane & 15, fq = lane >> 4;
    const int K = g.K, nt = K / BK;
    unsigned voffA[2], voffB[2];
#pragma unroll
    for (int i = 0; i < 2; ++i) { int R, C; stage_rc(tid * 16 + i * 8192, R, C); const int Rb = Epi::PERM ? ((R & ~31) + perm32(R & 31)) : R;
        voffA[i] = (unsigned)(R * K + C) * 2u; voffB[i] = (unsigned)(Rb * K + C) * 2u; }
    const size_t kstep = (size_t)(BK * 2);
    const size_t hstep = (size_t)HALF * K * 2;
    const size_t tstep = 2 * hstep; const size_t tstepA = (size_t)g.a_tile_rows * K * 2;
    const unsigned ldsw = (unsigned)wid * 1024u;
    const int aoff = lds_byte(wr * 64 + fr, fq * 8), boff = lds_byte(wc * 32 + fr, fq * 8);
#define PG8_SA(b, h) (((b) * 2 + (h)) * HTB)
#define PG8_SB(b, h) ((4 + (b) * 2 + (h)) * HTB)
#define PG8_STAGE(bufoff, gbase, voff) do { _Pragma("unroll") for (int _i = 0; _i < 2; ++_i) \
        __builtin_amdgcn_global_load_lds((const unsigned*)((const char*)(gbase) + (voff)[_i]), (PG8_LAS unsigned*)(lds + (bufoff) + ldsw + _i * 8192), 16, 0, 0); } while (0)
#define PG8_LDA(dst, b, h) do { _Pragma("unroll") for (int m = 0; m < 4; ++m) _Pragma("unroll") for (int k = 0; k < 2; ++k) dst[m][k] = *(const PG8_LAS bf16x8*)(lds + PG8_SA(b, h) + aoff + m * 2048 + k * 1024); } while (0)
#define PG8_LDB(dst, b, h) do { _Pragma("unroll") for (int n = 0; n < 2; ++n) _Pragma("unroll") for (int k = 0; k < 2; ++k) dst[n][k] = *(const PG8_LAS bf16x8*)(lds + PG8_SB(b, h) + boff + n * 2048 + k * 1024); } while (0)
#define PG8_MMA(ai, bj, At, Bt) do { __builtin_amdgcn_s_setprio(1); _Pragma("unroll") for (int m = 0; m < 4; ++m) _Pragma("unroll") for (int n = 0; n < 2; ++n) _Pragma("unroll") for (int k = 0; k < 2; ++k) \
        acc[ai][bj][m][n] = __builtin_amdgcn_mfma_f32_16x16x32_bf16(Bt[n][k], At[m][k], acc[ai][bj][m][n], 0, 0, 0); __builtin_amdgcn_s_setprio(0); } while (0)
#define PG8_WAIT_V(n) asm volatile("s_waitcnt vmcnt(" #n ")" ::: "memory")
#define PG8_WAIT_L(n) asm volatile("s_waitcnt lgkmcnt(" #n ")" ::: "memory")
#define PG8_BAR __builtin_amdgcn_s_barrier()
#define PG8_SCHED __builtin_amdgcn_sched_barrier(0)
    Unit cur, nxt; int ui = 0;
    if (!S.next(0, cur)) return;
    f32x4 acc[2][2][4][2];
#pragma unroll
    for (int a = 0; a < 2; ++a)
#pragma unroll
        for (int b = 0; b < 2; ++b)
#pragma unroll
            for (int m = 0; m < 4; ++m)
#pragma unroll
                for (int n = 0; n < 2; ++n) acc[a][b][m][n] = (f32x4){0.f, 0.f, 0.f, 0.f};
    bf16x8 At[4][2], B0[2][2], B1[2][2];
    const char* cA = (const char*)g.A + (size_t)cur.pm * tstepA; const char* cB = (const char*)g.Bt + (size_t)cur.pn * tstep;
    S.a_ready(cur);
    if constexpr (SP2) {
        PG8_STAGE(PG8_SB(0, 0), cB, voffB); PG8_STAGE(PG8_SB(0, 1), cB + hstep, voffB); PG8_STAGE(PG8_SA(0, 0), cA, voffA); PG8_STAGE(PG8_SA(0, 1), cA + hstep, voffA);
        if (wr == 1) PG8_BAR;
        PG8_WAIT_V(2); PG8_BAR;
        PG8_STAGE(PG8_SB(1, 0), cB + kstep, voffB); PG8_STAGE(PG8_SA(1, 0), cA + kstep, voffA); PG8_STAGE(PG8_SB(1, 1), cB + hstep + kstep, voffB);
        PG8_WAIT_V(6); PG8_BAR;
    } else {
        PG8_STAGE(PG8_SB(0, 0), cB, voffB); PG8_STAGE(PG8_SA(0, 0), cA, voffA); PG8_STAGE(PG8_SB(0, 1), cB + hstep, voffB); PG8_STAGE(PG8_SA(0, 1), cA + hstep, voffA);
        if (wr == 1) PG8_BAR;
        PG8_WAIT_V(4); PG8_BAR;
        PG8_STAGE(PG8_SB(1, 0), cB + kstep, voffB); PG8_STAGE(PG8_SA(1, 0), cA + kstep, voffA); PG8_STAGE(PG8_SB(1, 1), cB + hstep + kstep, voffB);
        PG8_WAIT_V(6); PG8_BAR;
    }
    for (;;) {
        const bool has_next = S.next(ui + 1, nxt);
        const char* nA = has_next ? (const char*)g.A + (size_t)nxt.pm * tstepA : cA; const char* nB = has_next ? (const char*)g.Bt + (size_t)nxt.pn * tstep : cB;
        for (int t = 0; t < nt; t += 2) {
            const bool last = (t == nt - 2);
            const char* a1 = cA + (size_t)(t + 1) * kstep;
            const char* a2 = last ? nA : cA + (size_t)(t + 2) * kstep; const char* b2 = last ? nB : cB + (size_t)(t + 2) * kstep;
            const char* a3 = a2 + kstep; const char* b3 = b2 + kstep;
            if (last && has_next) S.a_ready(nxt);
            if constexpr (SP2) {
            PG8_LDB(B0, 0, 0); PG8_LDB(B1, 0, 1); PG8_SCHED; PG8_LDA(At, 0, 0); PG8_STAGE(PG8_SA(1, 1), a1 + hstep, voffA);
            PG8_WAIT_V(8); PG8_WAIT_L(0); PG8_BAR; PG8_MMA(0, 0, At, B0); PG8_MMA(0, 1, At, B1); PG8_BAR; PG8_SCHED;
            PG8_LDA(At, 0, 1); PG8_STAGE(PG8_SB(0, 0), b2, voffB); PG8_STAGE(PG8_SB(0, 1), b2 + hstep, voffB); PG8_STAGE(PG8_SA(0, 0), a2, voffA);
            PG8_WAIT_V(8); PG8_WAIT_L(0); PG8_BAR; PG8_MMA(1, 0, At, B0); PG8_MMA(1, 1, At, B1); PG8_BAR; PG8_SCHED;
            PG8_LDB(B0, 1, 0); PG8_LDB(B1, 1, 1); PG8_SCHED; PG8_LDA(At, 1, 0); PG8_STAGE(PG8_SA(0, 1), a2 + hstep, voffA);
            PG8_WAIT_V(8); PG8_WAIT_L(0); PG8_BAR; PG8_MMA(0, 0, At, B0); PG8_MMA(0, 1, At, B1); PG8_BAR; PG8_SCHED;
            PG8_LDA(At, 1, 1); PG8_STAGE(PG8_SB(1, 0), b3, voffB); PG8_STAGE(PG8_SB(1, 1), b3 + hstep, voffB); PG8_STAGE(PG8_SA(1, 0), a3, voffA);
            PG8_WAIT_V(8); PG8_WAIT_L(0); PG8_BAR; PG8_MMA(1, 0, At, B0); PG8_MMA(1, 1, At, B1); PG8_BAR; PG8_SCHED;
            } else {
            PG8_LDB(B0, 0, 0); PG8_SCHED; PG8_LDA(At, 0, 0); PG8_STAGE(PG8_SA(1, 1), a1 + hstep, voffA);
            PG8_WAIT_L(8); PG8_BAR; PG8_WAIT_L(0); PG8_MMA(0, 0, At, B0); PG8_BAR; PG8_SCHED;
            PG8_LDB(B1, 0, 1); PG8_STAGE(PG8_SB(0, 0), b2, voffB);
            PG8_BAR; PG8_WAIT_L(0); PG8_MMA(0, 1, At, B1); PG8_BAR;
            PG8_LDA(At, 0, 1); PG8_STAGE(PG8_SA(0, 0), a2, voffA);
            PG8_BAR; PG8_WAIT_L(0); PG8_MMA(1, 0, At, B0); PG8_BAR; PG8_SCHED;
            PG8_STAGE(PG8_SB(0, 1), b2 + hstep, voffB);
            PG8_WAIT_V(6); PG8_BAR; PG8_MMA(1, 1, At, B1); PG8_BAR;
            PG8_LDB(B0, 1, 0); PG8_SCHED; PG8_LDA(At, 1, 0); PG8_STAGE(PG8_SA(0, 1), a2 + hstep, voffA);
            PG8_WAIT_L(8); PG8_BAR; PG8_WAIT_L(0); PG8_MMA(0, 0, At, B0); PG8_BAR; PG8_SCHED;
            PG8_LDB(B1, 1, 1); PG8_STAGE(PG8_SB(1, 0), b3, voffB);
            PG8_BAR; PG8_WAIT_L(0); PG8_MMA(0, 1, At, B1); PG8_BAR;
            PG8_LDA(At, 1, 1); PG8_STAGE(PG8_SA(1, 0), a3, voffA);
            PG8_BAR; PG8_WAIT_L(0); PG8_MMA(1, 0, At, B0); PG8_BAR; PG8_SCHED;
            PG8_STAGE(PG8_SB(1, 1), b3 + hstep, voffB);
            PG8_WAIT_V(6); PG8_BAR; PG8_MMA(1, 1, At, B1); PG8_BAR;
            }
        }
        if constexpr (ALIGN_EPI) { if (wr == 0) PG8_BAR; }
        if constexpr (!Epi::AFTER_DRAIN) { E(acc, cur, wr, wc, fr, fq, wid, lane); S.done(cur); }
        if (!has_next) break;
#pragma unroll
        for (int a = 0; a < 2; ++a)
#pragma unroll
            for (int b = 0; b < 2; ++b)
#pragma unroll
                for (int m = 0; m < 4; ++m)
#pragma unroll
                    for (int n = 0; n < 2; ++n) acc[a][b][m][n] = (f32x4){0.f, 0.f, 0.f, 0.f};
        cur = nxt; cA = nA; cB = nB; ++ui;
        if constexpr (ALIGN_EPI) { if (wr == 1) PG8_BAR; }
    }
    PG8_WAIT_V(0);
    if constexpr (!ALIGN_EPI) { if (wr == 0) PG8_BAR; }
    PG8_BAR;
    if constexpr (Epi::AFTER_DRAIN) { E.fused(acc, cur, wr, wc, fr, fq, lds, wid, lane); S.done(cur); }
#undef PG8_SA
#undef PG8_SB
#undef PG8_STAGE
#undef PG8_LDA
#undef PG8_LDB
#undef PG8_MMA
#undef PG8_WAIT_V
#undef PG8_WAIT_L
#undef PG8_BAR
#undef PG8_SCHED
}
}
#ifndef PG8_SP2
#define PG8_SP2 true
#endif
#ifndef PG8_ALIGN
#define PG8_ALIGN true
#endif

constexpr int NWAVES = 8;
constexpr int DM = 1024, M = 49152, MP = 16384, INW = 2304, DFF = 2816, UPW = 5632;
constexpr int QA_OFF = 0, KA_OFF = 512, VA_OFF = 1024, QB_OFF = 1536, KB_OFF = 2048, VB_OFF = 2176;
constexpr int UP_TILES_M = 194;
constexpr float EPS = 1e-6f, LOG2E = 1.4426950408889634f;

constexpr size_t MiB = 1u << 20;
constexpr size_t WS_SSQ = 0;
constexpr size_t WS_BAR = 1 * MiB;
constexpr size_t WS_WIN = 2 * MiB, WS_WOUT = 7 * MiB, WS_WUP = 9 * MiB, WS_WDN = 20 * MiB;
constexpr size_t WS_XN = 32 * MiB;
constexpr size_t WS_PROJ = 130 * MiB;
constexpr size_t WS_OA = 346 * MiB;
constexpr size_t WS_H = 226 * MiB;
constexpr size_t WS_LA = 490 * MiB;
constexpr size_t WS_END = 496 * MiB;
static_assert(WS_XN + (size_t)(M + 256) * DM * 2 <= WS_PROJ && WS_PROJ + (size_t)M * INW * 2 <= WS_OA && WS_OA + 3 * (size_t)M * 512 * 2 <= WS_LA && WS_H + (size_t)M * DFF * 2 <= WS_LA && WS_PROJ + (size_t)M * DM * 2 <= WS_H, "d_ws map");

constexpr int RING_BYTES = 131072, XCH_OFF = RING_BYTES, MISC_OFF = XCH_OFF + 8192, LDS_BYTES = 147456;

#define LAS __attribute__((address_space(3)))
typedef unsigned short bf16;
typedef unsigned v4u __attribute__((ext_vector_type(4)));
typedef float f32x4 __attribute__((ext_vector_type(4)));
typedef float f32x16 __attribute__((ext_vector_type(16)));
typedef short bf16x8 __attribute__((ext_vector_type(8)));
typedef short s16x4 __attribute__((ext_vector_type(4)));
using pg8::cvtpk;
__device__ __forceinline__ float bf_lo(unsigned w) { return __uint_as_float(w << 16); }
__device__ __forceinline__ float bf_hi(unsigned w) { return __uint_as_float(w & 0xffff0000u); }
__device__ __forceinline__ float wave_sum(float v) {
#pragma unroll
    for (int o = 1; o < 64; o <<= 1) v += __shfl_xor(v, o);
    return v;
}
__device__ __forceinline__ float wave_max(float v) {
#pragma unroll
    for (int o = 1; o < 64; o <<= 1) v = fmaxf(v, __shfl_xor(v, o));
    return v;
}

#define GAS __attribute__((address_space(1)))
#define RLX_AGENT __ATOMIC_RELAXED, __HIP_MEMORY_SCOPE_AGENT
#define XB_TMO      128
#define XB_XCNT(j)  (256  + 64 * (j))
#define XB_XSUB(j)  (1280 + 64 * (j))
#define XB_XGEN(j)  (2304 + 64 * (j))
#define XB_TOP      3328
#define XB_TOPGEN   3392
#define XCD_BAR_WORDS 3456
#define XB_SPIN_CAP (1u << 18)

__device__ __forceinline__ unsigned xb_ld(unsigned* p)              { return __hip_atomic_load(p, __ATOMIC_RELAXED, __HIP_MEMORY_SCOPE_AGENT); }
__device__ __forceinline__ unsigned xb_add(unsigned* p, unsigned v) { return __hip_atomic_fetch_add(p, v, __ATOMIC_RELAXED, __HIP_MEMORY_SCOPE_AGENT); }
__device__ __forceinline__ unsigned xb_xcc_id() { return (unsigned)__builtin_amdgcn_s_getreg((3 << 11) | 20) & 0xFu; }
#define XB_SPIN(cond, bar) do { unsigned _sp = 0; while (cond) { __builtin_amdgcn_s_sleep(1); \
    if ((++_sp & 255u) == 0u) { if (xb_ld(&(bar)[XB_TMO])) break; if (_sp > XB_SPIN_CAP) { atomicAdd(&(bar)[XB_TMO], 1u); break; } } } } while (0)

struct XcdBarrier {
    unsigned* bar; unsigned x;
    volatile LAS unsigned* st;
};

__device__ __forceinline__ XcdBarrier xcd_barrier_post(unsigned* bar, volatile LAS unsigned* st) {
    XcdBarrier b; b.bar = bar; b.x = xb_xcc_id(); b.st = st;
    if (threadIdx.x == 0) (void)xb_add(&bar[XB_XCNT(b.x)], 1u);
    return b;
}
__device__ __forceinline__ void xcd_barrier_complete(unsigned* bar, unsigned x, unsigned& nloc, unsigned& nx) {
    const unsigned G = gridDim.x * gridDim.y * gridDim.z;
    unsigned sum, cnt, mine, sp = 0u;
    for (;;) {
        sum = 0u; cnt = 0u; mine = 0u;
#pragma unroll
        for (unsigned j = 0; j < 16; ++j) { const unsigned c = xb_ld(&bar[XB_XCNT(j)]); sum += c; cnt += (c > 0u) ? 1u : 0u; mine = (j == x) ? c : mine; }
        if (sum == G) break;
        __builtin_amdgcn_s_sleep(1);
        if ((++sp & 255u) == 0u) { if (xb_ld(&bar[XB_TMO])) break; if (sp > XB_SPIN_CAP) { atomicAdd(&bar[XB_TMO], 1u); break; } }
    }
    nloc = mine > 0u ? mine : 1u; nx = cnt > 0u ? cnt : 1u;
}

__device__ __forceinline__ void xcd_barrier(const XcdBarrier& b) {
    asm volatile("s_waitcnt vmcnt(0)" ::: "memory");
    __syncthreads();
    if (threadIdx.x == 0) {
        unsigned* bar = b.bar;
        __builtin_amdgcn_s_waitcnt(0);
        unsigned nloc = b.st[0], nx = b.st[1];
        if (nloc == 0u) { xcd_barrier_complete(bar, b.x, nloc, nx); b.st[0] = nloc; b.st[1] = nx; }
        const unsigned old = xb_add(&bar[XB_XSUB(b.x)], 1u);
        const unsigned gen = old / nloc;
        if (old + 1u == (gen + 1u) * nloc) {
            __builtin_amdgcn_fence(__ATOMIC_RELEASE, "agent");
            asm volatile("s_waitcnt vmcnt(0)" ::: "memory");
            const unsigned og = xb_add(&bar[XB_TOP], 1u);
            const unsigned tg = og / nx;
            if (og + 1u == (tg + 1u) * nx) xb_add(&bar[XB_TOPGEN], 1u);
            else XB_SPIN(xb_ld(&bar[XB_TOPGEN]) == tg, bar);
            __builtin_amdgcn_fence(__ATOMIC_ACQUIRE, "agent");
            xb_add(&bar[XB_XGEN(b.x)], 1u);
            asm volatile("s_waitcnt vmcnt(0)" ::: "memory");
        } else {
            XB_SPIN(xb_ld(&bar[XB_XGEN(b.x)]) == gen, bar);
            __builtin_amdgcn_fence(__ATOMIC_ACQUIRE, "agent");
            asm volatile("s_waitcnt vmcnt(0)" ::: "memory");
        }
    }
    __syncthreads();
}

template <int MAP  >
__device__ __forceinline__ void p0_transpose_item(const float* W, int K, int N, bf16* WT, const float* kgain, LAS float* scr, int item, int lane) {
    const int nblk = N / 32, kb = item / nblk, nb = item % nblk, k0 = 64 * kb, n0 = 32 * nb;
#pragma unroll 8
    for (int i = 0; i < 32; ++i) { const int kk = 2 * i + (lane >> 5); float v = W[(size_t)(k0 + kk) * N + n0 + (lane & 31)]; if (kgain) v *= kgain[k0 + kk]; scr[kk * 33 + (lane & 31)] = v; }
    asm volatile("s_waitcnt lgkmcnt(0)" ::: "memory");
    const int c = lane & 7;
    int r0 = n0;
    if (MAP == 2) { const int hs = n0 >> 6; r0 = 256 * (hs >> 2) + 128 * ((n0 >> 5) & 1) + 32 * (hs & 3); }
    if (MAP == 1) r0 = n0 < DFF ? ((n0 >> 7) * 256 + (n0 & 127)) : ((((n0 - DFF) >> 7) * 256) + 128 + ((n0 - DFF) & 127));
#pragma unroll
    for (int j = 0; j < 4; ++j) { const int n = (lane >> 3) + 8 * j; const LAS float* s = scr + (8 * c) * 33 + n;
        v4u o; o.x = cvtpk(s[0 * 33], s[1 * 33]); o.y = cvtpk(s[2 * 33], s[3 * 33]); o.z = cvtpk(s[4 * 33], s[5 * 33]); o.w = cvtpk(s[6 * 33], s[7 * 33]);
        *(v4u*)(WT + (size_t)(r0 + n) * K + k0 + 8 * c) = o; }
    asm volatile("s_waitcnt lgkmcnt(0)" ::: "memory");
}
__device__ __forceinline__ void rms_row_to_bf16(const float* xrow, const float* g, bf16* orow, int lane) {
    const f32x4* xr = (const f32x4*)xrow + lane; const f32x4* gr = (const f32x4*)g + lane;
    f32x4 v[4]; float s = 0.f;
#pragma unroll
    for (int j = 0; j < 4; ++j) { v[j] = xr[64 * j]; s += (v[j].x * v[j].x + v[j].y * v[j].y) + (v[j].z * v[j].z + v[j].w * v[j].w); }
    const float rstd = __builtin_amdgcn_rsqf(wave_sum(s) * (1.f / DM) + EPS);
    unsigned long long* o8 = (unsigned long long*)orow + lane;
#pragma unroll
    for (int j = 0; j < 4; ++j) { const f32x4 gg = gr[64 * j]; o8[64 * j] = (unsigned long long)cvtpk(v[j].x * rstd * gg.x, v[j].y * rstd * gg.y) | ((unsigned long long)cvtpk(v[j].z * rstd * gg.z, v[j].w * rstd * gg.w) << 32); }
}

__device__ __forceinline__ void rms_rows4_to_bf16(const float* xrow, const float* g, bf16* orow, int lane) {
    f32x4 v[4][4]; float s[4];
#pragma unroll
    for (int k = 0; k < 4; ++k)
#pragma unroll
        for (int j = 0; j < 4; ++j) v[k][j] = ((const f32x4*)(xrow + (size_t)k * DM) + lane)[64 * j];
    f32x4 gg[4];
#pragma unroll
    for (int j = 0; j < 4; ++j) gg[j] = ((const f32x4*)g + lane)[64 * j];
#pragma unroll
    for (int k = 0; k < 4; ++k) { s[k] = 0.f;
#pragma unroll
        for (int j = 0; j < 4; ++j) s[k] += (v[k][j].x * v[k][j].x + v[k][j].y * v[k][j].y) + (v[k][j].z * v[k][j].z + v[k][j].w * v[k][j].w); }
#pragma unroll
    for (int o = 1; o < 64; o <<= 1) {
#pragma unroll
        for (int k = 0; k < 4; ++k) s[k] += __shfl_xor(s[k], o); }
#pragma unroll
    for (int k = 0; k < 4; ++k) { const float rstd = __builtin_amdgcn_rsqf(s[k] * (1.f / DM) + EPS);
        unsigned long long* o8 = (unsigned long long*)(orow + (size_t)k * DM) + lane;
#pragma unroll
        for (int j = 0; j < 4; ++j) o8[64 * j] = (unsigned long long)cvtpk(v[k][j].x * rstd * gg[j].x, v[k][j].y * rstd * gg[j].y) | ((unsigned long long)cvtpk(v[k][j].z * rstd * gg[j].z, v[k][j].w * rstd * gg[j].w) << 32); }
}

template <int NKEYS, int NTHR>
__device__ __forceinline__ void stage_load(v4u (&kr)[NKEYS * 8 / NTHR], v4u (&vr)[NKEYS * 8 / NTHR], const bf16* proj, int kcol, int vcol, int tok0, int dshift, int kidx0, int Ls, int t) {
    constexpr int NIT = NKEYS * 8 / NTHR;
    const int c = t & 7;
#pragma unroll
    for (int it = 0; it < NIT; ++it) { const int rho = (it * NTHR + t) >> 3, kidx = kidx0 + rho; const bool ok = (unsigned)kidx < (unsigned)Ls;
        const bf16* rowp = proj + (size_t)(tok0 + ((ok ? kidx : 0) << dshift)) * INW + 8 * c;
        kr[it] = *(const v4u*)(rowp + kcol); vr[it] = *(const v4u*)(rowp + vcol); }
}
template <int NKEYS, int NTHR>
__device__ __forceinline__ void stage_write(const v4u (&kr)[NKEYS * 8 / NTHR], const v4u (&vr)[NKEYS * 8 / NTHR], LAS unsigned char* Kl, LAS unsigned char* Vl, int t) {
    constexpr int NIT = NKEYS * 8 / NTHR;
    const int c = t & 7;
#pragma unroll
    for (int it = 0; it < NIT; ++it) { const int rho = (it * NTHR + t) >> 3;
        *(LAS v4u*)(Kl + rho * 128 + 16 * (c ^ ((rho >> 1) & 7))) = kr[it];
        *(LAS v4u*)(Vl + (c >> 2) * (NKEYS * 64) + rho * 64 + (c & 3) * 16) = vr[it]; }
}
__device__ __forceinline__ void load_q_raw(v4u (&raw)[4], const bf16* qrow, int lane) {
#pragma unroll
    for (int d0 = 0; d0 < 4; ++d0) raw[d0] = *(const v4u*)(qrow + 16 * d0 + 8 * (lane >> 5));
}
typedef short v4i16_t __attribute__((ext_vector_type(4)));
__device__ __forceinline__ s16x4 vtr(const LAS unsigned char* p) { return __builtin_bit_cast(s16x4, __builtin_amdgcn_ds_read_tr16_b64_v4i16((LAS v4i16_t*)p)); }
template <int R, bool BAND, bool EDGE, bool SAFE>
__device__ __forceinline__ void attn_tile(const bf16x8 (&kf)[4], unsigned vaddr, int vhs, int j, int kidx_t0, int Ls, const bf16x8 (&qf)[4], float base, float nslope, float negM, f32x16 (&o)[2], float& l, int hi) {
    s16x4 vl[4], vh[4];
    asm volatile("ds_read_b64_tr_b16 %0, %8\n\tds_read_b64_tr_b16 %1, %8 offset:512\n\tds_read_b64_tr_b16 %2, %8 offset:1024\n\tds_read_b64_tr_b16 %3, %8 offset:1536\n\t"
                 "ds_read_b64_tr_b16 %4, %9\n\tds_read_b64_tr_b16 %5, %9 offset:512\n\tds_read_b64_tr_b16 %6, %9 offset:1024\n\tds_read_b64_tr_b16 %7, %9 offset:1536"
                 : "=&v"(vl[0]), "=&v"(vh[0]), "=&v"(vl[1]), "=&v"(vh[1]), "=&v"(vl[2]), "=&v"(vh[2]), "=&v"(vl[3]), "=&v"(vh[3]) : "v"(vaddr), "v"(vaddr + (unsigned)vhs) : "memory");
    f32x16 s = {0.f, 0.f, 0.f, 0.f, 0.f, 0.f, 0.f, 0.f, 0.f, 0.f, 0.f, 0.f, 0.f, 0.f, 0.f, 0.f};
#pragma unroll
    for (int d0 = 0; d0 < 4; ++d0) s = __builtin_amdgcn_mfma_f32_32x32x16_bf16(kf[d0], qf[d0], s, 0, 0, 0);
    if (SAFE) {
#pragma unroll
        for (int r = 0; r < 16; ++r) s[r] += negM; }
    const float basej = base + (float)(32 * j);
    float pr[16];
#pragma unroll
    for (int r = 0; r < 16; ++r) { const float relf = basej + (float)((r & 3) + 8 * (r >> 2));
        float p = __builtin_amdgcn_exp2f(__builtin_fmaf(__builtin_fabsf(relf), nslope, s[r]));
        if (BAND) p = (__builtin_fabsf(relf) <= (float)R) ? p : 0.f;
        if (EDGE) { const int kidx = kidx_t0 + 32 * j + (r & 3) + 8 * (r >> 2) + 4 * hi; p = ((unsigned)kidx < (unsigned)Ls) ? p : 0.f; }
        l += p; pr[r] = p; }
    v4u w0, w1; w0.x = cvtpk(pr[0], pr[1]); w0.y = cvtpk(pr[2], pr[3]); w0.z = cvtpk(pr[4], pr[5]); w0.w = cvtpk(pr[6], pr[7]);
    w1.x = cvtpk(pr[8], pr[9]); w1.y = cvtpk(pr[10], pr[11]); w1.z = cvtpk(pr[12], pr[13]); w1.w = cvtpk(pr[14], pr[15]);
    const bf16x8 pa0 = __builtin_bit_cast(bf16x8, w0), pa1 = __builtin_bit_cast(bf16x8, w1);
    asm volatile("s_waitcnt lgkmcnt(0)" : "+v"(vl[0]), "+v"(vh[0]), "+v"(vl[1]), "+v"(vh[1]), "+v"(vl[2]), "+v"(vh[2]), "+v"(vl[3]), "+v"(vh[3]) :: "memory");
#pragma unroll
    for (int dh = 0; dh < 2; ++dh)
#pragma unroll
        for (int s2 = 0; s2 < 2; ++s2) { const s16x4 lo = vl[2 * dh + s2], h4 = vh[2 * dh + s2];
            const bf16x8 vf = (bf16x8){lo[0], lo[1], lo[2], lo[3], h4[0], h4[1], h4[2], h4[3]};
            o[dh] = __builtin_amdgcn_mfma_f32_32x32x16_bf16(vf, s2 ? pa1 : pa0, o[dh], 0, 0, 0); }
}
template <int NT, int R, bool EDGE, bool SAFE>
__device__ __forceinline__ void attn_task(const LAS unsigned char* Kl, const LAS unsigned char* Vl, int vhs, int row0, int kidx_t0, int Ls, const bf16x8 (&qf)[4], float slope2, float negM, f32x16 (&o)[2], float& l, int lane) {
    const int q = lane & 31, hi = lane >> 5;
    const unsigned va0 = (unsigned)(uintptr_t)(Vl + row0 * 64 + (4 * hi + ((lane & 15) >> 2)) * 64 + (16 * ((lane >> 4) & 1) + 4 * (lane & 3)) * 2);
    const int sw = (q >> 1) & 7;
    const LAS unsigned char* kp0 = Kl + (row0 + q) * 128 + 16 * ((0 + hi) ^ sw); const LAS unsigned char* kp1 = Kl + (row0 + q) * 128 + 16 * ((2 + hi) ^ sw);
    const LAS unsigned char* kp2 = Kl + (row0 + q) * 128 + 16 * ((4 + hi) ^ sw); const LAS unsigned char* kp3 = Kl + (row0 + q) * 128 + 16 * ((6 + hi) ^ sw);
    float base = (float)(4 * hi - R - q); asm volatile("" : "+v"(base));
    const float nslope = -slope2;
#define LOADK(dst, jj) do { dst[0] = *(const LAS bf16x8*)(kp0 + (jj) * 4096); dst[1] = *(const LAS bf16x8*)(kp1 + (jj) * 4096); dst[2] = *(const LAS bf16x8*)(kp2 + (jj) * 4096); dst[3] = *(const LAS bf16x8*)(kp3 + (jj) * 4096); } while (0)
    bf16x8 kf[4];
    LOADK(kf, 0);
    attn_tile<R, true, EDGE, SAFE>(kf, va0, vhs, 0, kidx_t0, Ls, qf, base, nslope, negM, o, l, hi);
#pragma unroll 1
    for (int j = 1; j < NT - 1; ++j) {
        LOADK(kf, j);
        attn_tile<R, false, EDGE, SAFE>(kf, va0 + j * 2048, vhs, j, kidx_t0, Ls, qf, base, nslope, negM, o, l, hi);
    }
    LOADK(kf, NT - 1);
    attn_tile<R, true, EDGE, SAFE>(kf, va0 + (NT - 1) * 2048, vhs, NT - 1, kidx_t0, Ls, qf, base, nslope, negM, o, l, hi);
#undef LOADK
}
__device__ __forceinline__ void store_partial(const f32x16 (&o)[2], float l, bf16* OBuf, float* LB, int tokq0, int dshift, int h, int lane) {
    const int hi = lane >> 5, q = lane & 31; const size_t tok = (size_t)(tokq0 + (q << dshift));
    l += __shfl_xor(l, 32);
    if (hi == 0) LB[tok * 8 + h] = l;
    bf16* p = OBuf + tok * 512 + h * 64 + 4 * hi;
#pragma unroll
    for (int dh = 0; dh < 2; ++dh)
#pragma unroll
        for (int g = 0; g < 4; ++g) { unsigned long long w = (unsigned long long)cvtpk(o[dh][4 * g], o[dh][4 * g + 1]) | ((unsigned long long)cvtpk(o[dh][4 * g + 2], o[dh][4 * g + 3]) << 32);
            *(unsigned long long*)(p + 32 * dh + 8 * g) = w; }
}
struct AUnit { int tok0, dshift, Ls, cc, h, c; };
__device__ __forceinline__ AUnit decode_a(int su) {
    AUnit a; const int sidx = su / 48, k = su % 48, blk = sidx >> 3; a.h = sidx & 7; a.c = 2 - (k >> 4); a.dshift = 2 * a.c; const int kk = k & 15;
    int seq0, S, bis; if (blk < 8) { seq0 = 0; S = 16384; bis = blk; } else { seq0 = MP + 2048 * (blk - 8); S = 2048; bis = 0; }
    a.Ls = S >> a.dshift; const int lcpb = 4 - a.dshift  , res = kk >> lcpb; a.cc = (bis << lcpb) + (kk & ((1 << lcpb) - 1)); a.tok0 = seq0 + res; return a;
}
struct BUnit { int seq0, S, lcb, g2; };
__device__ __forceinline__ BUnit decode_b(int u) {
    BUnit b; b.g2 = u / 768; const int cb = u % 768;
    if (cb < 256) { b.seq0 = 0; b.S = 16384; b.lcb = cb; } else { b.seq0 = MP + 2048 * ((cb - 256) >> 5); b.S = 2048; b.lcb = (cb - 256) & 31; } return b;
}

#define LDS_BAR() asm volatile("s_waitcnt lgkmcnt(0)\n\ts_barrier" ::: "memory")
#define xp (args.in[0])
#define xs (args.in[1])
#define norm1 (args.in[2])
#define w_in (args.in[3])
#define qna (args.in[4])
#define kna (args.in[5])
#define qnb (args.in[6])
#define knb (args.in[7])
#define sinkb (args.in[8])
#define ona (args.in[9])
#define onb (args.in[10])
#define w_out (args.in[11])
#define norm2 (args.in[12])
#define w_up (args.in[13])
#define conv_w (args.in[14])
#define conv_b (args.in[15])
#define w_down (args.in[16])
#define out (args.dout)
#define SSQ ((float*)(args.ws + WS_SSQ))
#define WIN ((bf16*)(args.ws + WS_WIN))
#define WOUT ((bf16*)(args.ws + WS_WOUT))
#define WUP ((bf16*)(args.ws + WS_WUP))
#define WDN ((bf16*)(args.ws + WS_WDN))
#define XN ((bf16*)(args.ws + WS_XN) + DM)
#define PROJ ((bf16*)(args.ws + WS_PROJ))
#define Y ((bf16*)(args.ws + WS_PROJ))
#define OA ((bf16*)(args.ws + WS_OA))
#define OB ((bf16*)(args.ws + WS_XN) + DM)
#define HB ((bf16*)(args.ws + WS_H))
#define LA ((float*)(args.ws + WS_LA))
#define LBp ((float*)(args.ws + WS_LA) + 3 * (size_t)M * 8)
struct Args { const float* in[17]; float* dout; unsigned char* ws; };
__global__ void __launch_bounds__(NWAVES * 64, 2) fwd_megakernel(Args args) {
    extern __shared__ __attribute__((aligned(16))) unsigned char lds_raw[];
    cg::grid_group grid = cg::this_grid();
    LAS unsigned char* lds = (LAS unsigned char*)lds_raw;
    const int tid = threadIdx.x, lane = tid & 63, wave = __builtin_amdgcn_readfirstlane(tid >> 6);
    const int G = gridDim.x, bx = blockIdx.x;
    if (tid < 2) ((LAS unsigned*)(lds + MISC_OFF))[tid] = 0u;
    const int gw = bx * NWAVES + wave, NGW = G * NWAVES;
    __syncthreads();
    XcdBarrier bar = xcd_barrier_post((unsigned*)(args.ws + WS_BAR), (volatile LAS unsigned*)(lds + MISC_OFF));
    if (args.ws == nullptr) grid.sync();

    {
        LAS float* scr = (LAS float*)(lds + wave * 16384);
        constexpr int I_IN = (DM / 64) * (INW / 32), I_OUT = (DM / 64) * (DM / 32), I_UP = (DM / 64) * (UPW / 32), I_DN = (DFF / 64) * (DM / 32);
        for (int it = gw; it < I_IN + I_OUT + I_UP + I_DN; it += NGW) {
            int r = it;
            if (r < I_IN) { p0_transpose_item<2>(w_in, DM, INW, WIN, nullptr, scr, r, lane); continue; } r -= I_IN;
            if (r < I_OUT) { p0_transpose_item<0>(w_out, DM, DM, WOUT, nullptr, scr, r, lane); continue; } r -= I_OUT;
            if (r < I_UP) { p0_transpose_item<1>(w_up, DM, UPW, WUP, norm2, scr, r, lane); continue; } r -= I_UP;
            p0_transpose_item<0>(w_down, DFF, DM, WDN, nullptr, scr, r, lane);
        }
        for (int m = gw * 4; m < M; m += NGW * 4) rms_rows4_to_bf16(m < MP ? xp + (size_t)m * DM : xs + (size_t)(m - MP) * DM, norm1, XN + (size_t)m * DM, lane);
        for (int i = bx * 512 + tid; i < M; i += G * 512) SSQ[i] = 0.f;
    }
    xcd_barrier(bar);

    {
        pg8::Gemm g{XN, WIN, M, INW, DM, 256}; pg8::StaticOrder S; S.init(M, INW, G, bx);
        pg8::EpiProj E{PROJ, qna, kna, qnb, knb};
        pg8::gemm_phase<pg8::EpiProj, pg8::StaticOrder, PG8_ALIGN, PG8_SP2>(lds, g, S, E);
    }
    xcd_barrier(bar);

    {
        const float gqa = fabsf(qna[lane]), gka = fabsf(kna[lane]);
        const float boundA = __builtin_bit_cast(float, __builtin_amdgcn_readfirstlane(__builtin_bit_cast(int, 8.0f * wave_max(gqa) * wave_max(gka) * LOG2E)));
        const float negMa = boundA > 40.f ? -boundA : 0.f;
        {
            const int half = wave >> 2, w4 = wave & 3, th = tid & 255;
            LAS unsigned char* Kl = lds + half * 65536; LAS unsigned char* Vl = Kl + 32768;
            const int ubase = (G == 256) ? (bx & 7) * 576 + (bx >> 3) : bx, ustep = (G == 256) ? 32 : G, uend = (G == 256) ? (bx & 7) * 576 + 576 : 4608;
            v4u kr[8], vr[8], qraw[4]; AUnit nx = decode_a(2 * ubase + half);
            if (ubase < uend) { stage_load<256, 256>(kr, vr, PROJ, KA_OFF + nx.h * 64, VA_OFF + nx.h * 64, nx.tok0, nx.dshift, 128 * nx.cc - 64, nx.Ls, th);
                load_q_raw(qraw, PROJ + (size_t)(nx.tok0 + ((128 * nx.cc + 32 * w4 + (lane & 31)) << nx.dshift)) * INW + QA_OFF + nx.h * 64, lane); }
            for (int u = ubase; u < uend; u += ustep) {
                const AUnit a = nx;
                LDS_BAR();
                stage_write<256, 256>(kr, vr, Kl, Vl, th);
                bf16x8 qf[4];
#pragma unroll
                for (int d0 = 0; d0 < 4; ++d0) qf[d0] = __builtin_bit_cast(bf16x8, qraw[d0]);
                LDS_BAR();
                if (u + ustep < uend) { nx = decode_a(2 * (u + ustep) + half);
                    stage_load<256, 256>(kr, vr, PROJ, KA_OFF + nx.h * 64, VA_OFF + nx.h * 64, nx.tok0, nx.dshift, 128 * nx.cc - 64, nx.Ls, th);
                    load_q_raw(qraw, PROJ + (size_t)(nx.tok0 + ((128 * nx.cc + 32 * w4 + (lane & 31)) << nx.dshift)) * INW + QA_OFF + nx.h * 64, lane); }
                const int iq0 = 128 * a.cc + 32 * w4;
                f32x16 o[2]; float l = 0.f;
#pragma unroll
                for (int r = 0; r < 16; ++r) { o[0][r] = 0.f; o[1][r] = 0.f; }
                const float slope2 = __builtin_amdgcn_exp2f(-0.5f * (float)(a.h + 9) + (float)a.dshift) * LOG2E;
                const bool edge = iq0 - 64 < 0 || iq0 + 96 > a.Ls;
                if (__builtin_expect(negMa != 0.f, 0)) { if (edge) attn_task<5, 64, true, true>(Kl, Vl, 256 * 64, 32 * w4, iq0 - 64, a.Ls, qf, slope2, negMa, o, l, lane); else attn_task<5, 64, false, true>(Kl, Vl, 256 * 64, 32 * w4, iq0 - 64, a.Ls, qf, slope2, negMa, o, l, lane); }
                else if (edge) attn_task<5, 64, true, false>(Kl, Vl, 256 * 64, 32 * w4, iq0 - 64, a.Ls, qf, slope2, 0.f, o, l, lane);
                else attn_task<5, 64, false, false>(Kl, Vl, 256 * 64, 32 * w4, iq0 - 64, a.Ls, qf, slope2, 0.f, o, l, lane);
                asm volatile("s_nop 15\n\ts_nop 7" ::: "memory");
                store_partial(o, l, OA + (size_t)a.c * M * 512, LA + (size_t)a.c * M * 8, a.tok0 + (iq0 << a.dshift), a.dshift, a.h, lane);
            }
        }
        const float gqb = fabsf(qnb[lane]), gkb = fabsf(knb[lane]);
        const float boundB = __builtin_bit_cast(float, __builtin_amdgcn_readfirstlane(__builtin_bit_cast(int, 8.0f * wave_max(gqb) * wave_max(gkb) * LOG2E)));
        const float negMb = boundB > 40.f ? -boundB : 0.f;
        {
            LAS unsigned char* Kb = lds; LAS unsigned char* Vb = lds + 40960;
            const int ubase = (G == 256) ? (bx & 7) * 192 + (bx >> 3) : bx, ustep = (G == 256) ? 32 : G, uend = (G == 256) ? (bx & 7) * 192 + 192 : 1536;
            v4u kr[5], vr[5], qraw[4]; BUnit nx = decode_b(ubase);
            if (ubase < uend) { stage_load<320, 512>(kr, vr, PROJ, KB_OFF + nx.g2 * 64, VB_OFF + nx.g2 * 64, nx.seq0, 0, 64 * nx.lcb - 128, nx.S, tid);
                load_q_raw(qraw, PROJ + (size_t)(nx.seq0 + 64 * nx.lcb + 32 * (wave & 1) + (lane & 31)) * INW + QB_OFF + (4 * nx.g2 + (wave >> 1)) * 64, lane); }
            for (int u = ubase; u < uend; u += ustep) {
                const BUnit b = nx;
                LDS_BAR();
                stage_write<320, 512>(kr, vr, Kb, Vb, tid);
                bf16x8 qf[4];
#pragma unroll
                for (int d0 = 0; d0 < 4; ++d0) qf[d0] = __builtin_bit_cast(bf16x8, qraw[d0]);
                LDS_BAR();
                if (u + ustep < uend) { nx = decode_b(u + ustep);
                    stage_load<320, 512>(kr, vr, PROJ, KB_OFF + nx.g2 * 64, VB_OFF + nx.g2 * 64, nx.seq0, 0, 64 * nx.lcb - 128, nx.S, tid);
                    load_q_raw(qraw, PROJ + (size_t)(nx.seq0 + 64 * nx.lcb + 32 * (wave & 1) + (lane & 31)) * INW + QB_OFF + (4 * nx.g2 + (wave >> 1)) * 64, lane); }
                const int hb = 4 * b.g2 + (wave >> 1), iq0 = 64 * b.lcb + 32 * (wave & 1);
                f32x16 o[2]; float l = 0.f;
#pragma unroll
                for (int r = 0; r < 16; ++r) { o[0][r] = 0.f; o[1][r] = 0.f; }
                const float slope2 = __builtin_amdgcn_exp2f(-0.5f * (float)(hb + 1)) * LOG2E;
                const bool edge = iq0 - 128 < 0 || iq0 + 160 > b.S;
                if (__builtin_expect(negMb != 0.f, 0)) { if (edge) attn_task<9, 128, true, true>(Kb, Vb, 320 * 64, 32 * (wave & 1), iq0 - 128, b.S, qf, slope2, negMb, o, l, lane); else attn_task<9, 128, false, true>(Kb, Vb, 320 * 64, 32 * (wave & 1), iq0 - 128, b.S, qf, slope2, negMb, o, l, lane); }
                else if (edge) attn_task<9, 128, true, false>(Kb, Vb, 320 * 64, 32 * (wave & 1), iq0 - 128, b.S, qf, slope2, 0.f, o, l, lane);
                else attn_task<9, 128, false, false>(Kb, Vb, 320 * 64, 32 * (wave & 1), iq0 - 128, b.S, qf, slope2, 0.f, o, l, lane);
                asm volatile("s_nop 15\n\ts_nop 7" ::: "memory");
                store_partial(o, l, OB, LBp, b.seq0 + iq0, 0, hb, lane);
            }
        }
        xcd_barrier(bar);
        {
            const int hh = lane >> 3;
            const float sinkterm = __builtin_amdgcn_exp2f(sinkb[hh] * LOG2E + negMb);
            const f32x4 ga0 = *(const f32x4*)(ona + 8 * lane), ga1 = *(const f32x4*)(ona + 8 * lane + 4), gb0 = *(const f32x4*)(onb + 8 * lane), gb1 = *(const f32x4*)(onb + 8 * lane + 4);
            for (int m0 = gw * 4; m0 < M; m0 += NGW * 4) {
                v4u wa[4][3], wb[4]; float la[4], lb[4];
#pragma unroll
                for (int k = 0; k < 4; ++k) { const int m = m0 + k; la[k] = 0.f;
#pragma unroll
                    for (int c = 0; c < 3; ++c) { wa[k][c] = *(const v4u*)(OA + ((size_t)c * M + m) * 512 + 8 * lane); la[k] += LA[((size_t)c * M + m) * 8 + hh]; }
                    wb[k] = *(const v4u*)(OB + (size_t)m * 512 + 8 * lane); lb[k] = LBp[(size_t)m * 8 + hh] + sinkterm; }
                float ya[4][8], yb[4][8], sa[4], sb[4];
#pragma unroll
                for (int k = 0; k < 4; ++k) { const float ia = 1.0f / la[k], ib = 1.0f / lb[k];
                    ya[k][0] = (bf_lo(wa[k][0].x) + bf_lo(wa[k][1].x) + bf_lo(wa[k][2].x)) * ia; ya[k][1] = (bf_hi(wa[k][0].x) + bf_hi(wa[k][1].x) + bf_hi(wa[k][2].x)) * ia;
                    ya[k][2] = (bf_lo(wa[k][0].y) + bf_lo(wa[k][1].y) + bf_lo(wa[k][2].y)) * ia; ya[k][3] = (bf_hi(wa[k][0].y) + bf_hi(wa[k][1].y) + bf_hi(wa[k][2].y)) * ia;
                    ya[k][4] = (bf_lo(wa[k][0].z) + bf_lo(wa[k][1].z) + bf_lo(wa[k][2].z)) * ia; ya[k][5] = (bf_hi(wa[k][0].z) + bf_hi(wa[k][1].z) + bf_hi(wa[k][2].z)) * ia;
                    ya[k][6] = (bf_lo(wa[k][0].w) + bf_lo(wa[k][1].w) + bf_lo(wa[k][2].w)) * ia; ya[k][7] = (bf_hi(wa[k][0].w) + bf_hi(wa[k][1].w) + bf_hi(wa[k][2].w)) * ia;
                    yb[k][0] = bf_lo(wb[k].x) * ib; yb[k][1] = bf_hi(wb[k].x) * ib; yb[k][2] = bf_lo(wb[k].y) * ib; yb[k][3] = bf_hi(wb[k].y) * ib;
                    yb[k][4] = bf_lo(wb[k].z) * ib; yb[k][5] = bf_hi(wb[k].z) * ib; yb[k][6] = bf_lo(wb[k].w) * ib; yb[k][7] = bf_hi(wb[k].w) * ib;
                    sa[k] = 0.f; sb[k] = 0.f;
#pragma unroll
                    for (int i = 0; i < 8; ++i) { sa[k] += ya[k][i] * ya[k][i]; sb[k] += yb[k][i] * yb[k][i]; } }
#pragma unroll
                for (int o = 1; o < 64; o <<= 1) {
#pragma unroll
                    for (int k = 0; k < 4; ++k) { sa[k] += __shfl_xor(sa[k], o); sb[k] += __shfl_xor(sb[k], o); } }
#pragma unroll
                for (int k = 0; k < 4; ++k) { const int m = m0 + k;
                    const float ra = __builtin_amdgcn_rsqf(sa[k] * (1.f / 512.f) + EPS), rb = __builtin_amdgcn_rsqf(sb[k] * (1.f / 512.f) + EPS);
                    v4u oa, ob;
                    oa.x = cvtpk(ya[k][0] * ra * ga0.x, ya[k][1] * ra * ga0.y); oa.y = cvtpk(ya[k][2] * ra * ga0.z, ya[k][3] * ra * ga0.w); oa.z = cvtpk(ya[k][4] * ra * ga1.x, ya[k][5] * ra * ga1.y); oa.w = cvtpk(ya[k][6] * ra * ga1.z, ya[k][7] * ra * ga1.w);
                    ob.x = cvtpk(yb[k][0] * rb * gb0.x, yb[k][1] * rb * gb0.y); ob.y = cvtpk(yb[k][2] * rb * gb0.z, yb[k][3] * rb * gb0.w); ob.z = cvtpk(yb[k][4] * rb * gb1.x, yb[k][5] * rb * gb1.y); ob.w = cvtpk(yb[k][6] * rb * gb1.z, yb[k][7] * rb * gb1.w);
                    *(v4u*)(Y + (size_t)m * DM + 8 * lane) = oa; *(v4u*)(Y + (size_t)m * DM + 512 + 8 * lane) = ob; }
            }
        }
    }
    xcd_barrier(bar);

    {
        pg8::Gemm g{Y, WOUT, M, DM, DM, 256}; pg8::StaticOrder S; S.init(M, DM, G, bx);
        pg8::EpiOut E{xp, xs, XN, SSQ};
        pg8::gemm_phase<pg8::EpiOut, pg8::StaticOrder, PG8_ALIGN, PG8_SP2>(lds, g, S, E);
    }
    xcd_barrier(bar);

    {
        pg8::Gemm g{XN - DM, WUP, UP_TILES_M * 256, UPW, DM, 254}; pg8::StaticOrder S; S.init(UP_TILES_M * 256, UPW, G, bx);
        pg8::EpiUp E{HB, SSQ, conv_w, conv_b, (LAS float*)(lds + XCH_OFF)};
        pg8::gemm_phase<pg8::EpiUp, pg8::StaticOrder, true, PG8_SP2>(lds, g, S, E);
    }
    xcd_barrier(bar);

    {
        pg8::Gemm g{HB, WDN, M, DM, DFF, 256}; pg8::StaticOrder S; S.init(M, DM, G, bx);
        pg8::EpiDown E{XN, out};
        pg8::gemm_phase<pg8::EpiDown, pg8::StaticOrder, PG8_ALIGN, PG8_SP2>(lds, g, S, E);
    }
}

#undef out
#undef xp
#undef xs
extern "C" void kernel_launch(void* const* d_in, const int* in_sizes, int n_in, void* d_out, int out_size, void* d_ws, size_t ws_size, hipStream_t stream) {
    static int grid = 0;
    if (grid == 0) {
        if (n_in != 17 || out_size != M * DM || ws_size < WS_END) { fprintf(stderr, "kernel_launch: unexpected shapes (n_in %d out %d ws %zu)\n", n_in, out_size, ws_size); grid = -1; return; }
        int dev = 0, cus = 0, per_cu = 0;
        hipGetDevice(&dev); hipDeviceGetAttribute(&cus, hipDeviceAttributeMultiprocessorCount, dev);
        if (hipFuncSetAttribute((const void*)fwd_megakernel, hipFuncAttributeMaxDynamicSharedMemorySize, LDS_BYTES) != hipSuccess) { fprintf(stderr, "kernel_launch: hipFuncSetAttribute failed\n"); grid = -1; return; }
        if (hipOccupancyMaxActiveBlocksPerMultiprocessor(&per_cu, (const void*)fwd_megakernel, NWAVES * 64, LDS_BYTES) != hipSuccess || per_cu < 1) { fprintf(stderr, "kernel_launch: occupancy query says %d\n", per_cu); per_cu = 1; }
        (void)hipGetLastError();
        grid = cus;
        fprintf(stderr, "kernel_launch: grid %d (per_cu %d)\n", grid, per_cu);
    }
    if (grid < 0) return;
    Args a{};
    for (int i = 0; i < 17; ++i) a.in[i] = (const float*)d_in[i];
    a.dout = (float*)d_out; a.ws = (unsigned char*)d_ws;
    void* kargs[] = {&a};
    if (hipMemsetAsync((char*)d_ws + WS_BAR, 0, XCD_BAR_WORDS * 4, stream) != hipSuccess) { fprintf(stderr, "kernel_launch: hipMemsetAsync failed\n"); return; }
    hipError_t e = hipLaunchCooperativeKernel((const void*)fwd_megakernel, dim3(grid), dim3(NWAVES * 64), kargs, LDS_BYTES, stream);
    if (e != hipSuccess) fprintf(stderr, "kernel_launch: cooperative launch failed: %s\n", hipGetErrorString(e));
}
```

```cpp
#include <hip/hip_runtime.h>
#include <hip/hip_cooperative_groups.h>
#include <cstdio>
#include <cstdint>
namespace cg = cooperative_groups;
namespace pg8 {
#define PG8_LAS __attribute__((address_space(3)))
typedef unsigned short bf16_t;
typedef short bf16x8 __attribute__((ext_vector_type(8)));
typedef float f32x4 __attribute__((ext_vector_type(4)));
typedef unsigned u32x4 __attribute__((ext_vector_type(4)));
constexpr int BM = 256, BK = 64, HALF = 128, HTB = HALF * BK * 2  , STAGE_BYTES = 8 * HTB, NXCD = 8, WGM = 8;

__host__ __device__ __forceinline__ int lds_byte(int r, int c) { const int st = (r >> 4) * 2 + (c >> 5), rr = r & 15, cc = c & 31, ob = rr * 64 + cc * 2; return st * 1024 + (ob ^ (((ob >> 9) & 1) << 5)); }
__host__ __device__ __forceinline__ void stage_rc(int b, int& R, int& C) { const int st = b / 1024, sb = b % 1024, swz = sb ^ (((sb >> 9) & 1) << 5); R = (st >> 1) * 16 + swz / 64; C = (st & 1) * 32 + (swz % 64) / 2; }
__host__ __device__ __forceinline__ int perm32(int rho) { const int n = rho >> 4, i = rho & 15; return 8 * (i >> 2) + 4 * n + (i & 3); }

struct Unit { int pm, pn; };
struct Gemm { const bf16_t* A; const bf16_t* Bt; int M, N, K; int a_tile_rows; };

struct StaticOrder {
    int nM, nN, nwg, G, c;
    __host__ __device__ void init(int M, int N, int G_, int c_) { nM = M / BM; nN = N / BM; nwg = nM * nN; G = G_; c = c_; }
    __host__ __device__ bool next(int i, Unit& u) const {
        const long L = (long)i * G + c; if (L >= nwg) return false;
        int wgid = (int)L; { const int q = nwg / NXCD, r = nwg % NXCD, xcd = wgid % NXCD, off = wgid / NXCD; wgid = (xcd < r ? xcd * (q + 1) : r * (q + 1) + (xcd - r) * q) + off; }
        const int nig = WGM * nN, gid = wgid / nig, fm = gid * WGM, gsz = (nM - fm) < WGM ? (nM - fm) : WGM;
        u.pm = fm + ((wgid % nig) % gsz); u.pn = (wgid % nig) / gsz; return true;
    }
    __device__ __forceinline__ void a_ready(const Unit&) const {}
    __device__ __forceinline__ void done(const Unit&) const {}
};

__device__ __forceinline__ unsigned cvt_pk_bf16(float lo, float hi) { unsigned r; asm volatile("v_cvt_pk_bf16_f32 %0, %1, %2" : "=v"(r) : "v"(lo), "v"(hi)); return r; }
typedef float f32x2 __attribute__((ext_vector_type(2))); typedef __bf16 bf16x2_t __attribute__((ext_vector_type(2)));
__device__ __forceinline__ unsigned cvtpk(float lo, float hi) { f32x2 v = {lo, hi}; bf16x2_t b = __builtin_convertvector(v, bf16x2_t); return __builtin_bit_cast(unsigned, b); }
constexpr int MTOK = 49152, MPROMPT = 16384, DMODEL = 1024, DFF_ = 2816;
__device__ __forceinline__ u32x4 pack8(const f32x4 a, const f32x4 b) { u32x4 w; w.x = cvtpk(a[0], a[1]); w.y = cvtpk(a[2], a[3]); w.z = cvtpk(b[0], b[1]); w.w = cvtpk(b[2], b[3]); return w; }

struct EpiProj {
    static constexpr bool PERM = true, AFTER_DRAIN = false;
    bf16_t* O; const float* gqa; const float* gka; const float* gqb; const float* gkb;
    __device__ __forceinline__ void operator()(f32x4 (&acc)[2][2][4][2], const Unit& u, int wr, int wc, int fr, int fq, int wid, int lane) const {
        const int hs = 4 * u.pn + wc;
        const float* g = nullptr; float sc = 1.f;
        if (hs < 8) { g = gqa; sc = 0.125f * 1.4426950408889634f; } else if (hs < 16) g = gka; else if (hs >= 24 && hs < 32) { g = gqb; sc = 0.125f * 1.4426950408889634f; } else if (hs >= 32 && hs < 34) g = gkb;
        const int row0 = u.pm * BM + wr * 64 + fr;
        bf16_t* obase = O + (size_t)row0 * 2304 + 64 * hs + 8 * fq;
        if (g) {
            f32x4 gg[2][2];
#pragma unroll
            for (int bj = 0; bj < 2; ++bj)
#pragma unroll
                for (int n = 0; n < 2; ++n) gg[bj][n] = *(const f32x4*)(g + 32 * bj + 8 * fq + 4 * n) * sc;
#pragma unroll
            for (int ai = 0; ai < 2; ++ai)
#pragma unroll
                for (int m = 0; m < 4; ++m) { float ss = 0.f;
#pragma unroll
                    for (int bj = 0; bj < 2; ++bj)
#pragma unroll
                        for (int n = 0; n < 2; ++n) { const f32x4 a = acc[ai][bj][m][n]; ss += (a[0] * a[0] + a[1] * a[1]) + (a[2] * a[2] + a[3] * a[3]); }
                    ss += __shfl_xor(ss, 16); ss += __shfl_xor(ss, 32);
                    const float rs = __builtin_amdgcn_rsqf(ss * (1.0f / 64.0f) + 1e-6f);
                    bf16_t* rowp = obase + (size_t)(ai * HALF + m * 16) * 2304;
#pragma unroll
                    for (int bj = 0; bj < 2; ++bj) *(u32x4*)(rowp + 32 * bj) = pack8(acc[ai][bj][m][0] * rs * gg[bj][0], acc[ai][bj][m][1] * rs * gg[bj][1]); }
        } else {
#pragma unroll
            for (int ai = 0; ai < 2; ++ai)
#pragma unroll
                for (int m = 0; m < 4; ++m) { bf16_t* rowp = obase + (size_t)(ai * HALF + m * 16) * 2304;
#pragma unroll
                    for (int bj = 0; bj < 2; ++bj) *(u32x4*)(rowp + 32 * bj) = pack8(acc[ai][bj][m][0], acc[ai][bj][m][1]); }
        }
    }
};
struct EpiOut {
    static constexpr bool PERM = true, AFTER_DRAIN = false;
    const float* xp; const float* xs; bf16_t* xb; float* ssq;
    __device__ __forceinline__ void operator()(f32x4 (&acc)[2][2][4][2], const Unit& u, int wr, int wc, int fr, int fq, int wid, int lane) const {
        const int col0 = u.pn * BM + wc * 32 + 8 * fq;
#pragma unroll
        for (int ai = 0; ai < 2; ++ai)
#pragma unroll
            for (int m = 0; m < 4; ++m) { const int gr = u.pm * BM + ai * HALF + wr * 64 + m * 16 + fr;
                const float* xr = (gr < MPROMPT ? xp + (size_t)gr * DMODEL : xs + (size_t)(gr - MPROMPT) * DMODEL) + col0;
                float s = 0.f;
#pragma unroll
                for (int bj = 0; bj < 2; ++bj) { f32x4 a = *(const f32x4*)(xr + bj * HALF), b = *(const f32x4*)(xr + bj * HALF + 4);
                    a += acc[ai][bj][m][0]; b += acc[ai][bj][m][1];
                    s += (a[0] * a[0] + a[1] * a[1]) + (a[2] * a[2] + a[3] * a[3]) + (b[0] * b[0] + b[1] * b[1]) + (b[2] * b[2] + b[3] * b[3]);
                    *(u32x4*)(xb + (size_t)gr * DMODEL + col0 + bj * HALF) = pack8(a, b); }
                s += __shfl_xor(s, 16); s += __shfl_xor(s, 32);
                if (fq == 0) unsafeAtomicAdd(ssq + gr, s);
                asm volatile("" ::: "memory"); }
    }
};
struct EpiDown {
    static constexpr bool PERM = true, AFTER_DRAIN = false;
    const bf16_t* xb; float* out;
    __device__ __forceinline__ void operator()(f32x4 (&acc)[2][2][4][2], const Unit& u, int wr, int wc, int fr, int fq, int wid, int lane) const {
        const int col0 = u.pn * BM + wc * 32 + 8 * fq;
#pragma unroll
        for (int ai = 0; ai < 2; ++ai)
#pragma unroll
            for (int m = 0; m < 4; ++m) { const int gr = u.pm * BM + ai * HALF + wr * 64 + m * 16 + fr;
                float* o = out + (size_t)gr * DMODEL + col0; const bf16_t* xr = xb + (size_t)gr * DMODEL + col0;
#pragma unroll
                for (int bj = 0; bj < 2; ++bj) { const u32x4 w = *(const u32x4*)(xr + bj * HALF);
                    f32x4 a = {__uint_as_float(w.x << 16), __uint_as_float(w.x & 0xffff0000u), __uint_as_float(w.y << 16), __uint_as_float(w.y & 0xffff0000u)};
                    f32x4 b = {__uint_as_float(w.z << 16), __uint_as_float(w.z & 0xffff0000u), __uint_as_float(w.w << 16), __uint_as_float(w.w & 0xffff0000u)};
                    a += acc[ai][bj][m][0]; b += acc[ai][bj][m][1]; *(f32x4*)(o + bj * HALF) = a; *(f32x4*)(o + bj * HALF + 4) = b; }
                asm volatile("" ::: "memory"); }
    }
};
__device__ __forceinline__ bool seq_first(int gr) { return gr == 0 || (gr >= MPROMPT && (gr & 2047) == 0); }
__device__ __forceinline__ bool seq_last(int gr) { return gr >= MPROMPT - 1 && (gr & 2047) == 2047; }
struct EpiUp {
    static constexpr bool PERM = true, AFTER_DRAIN = false;
    bf16_t* H; const float* ssq; const float* cw; const float* cb; PG8_LAS float* xch;
    __device__ __forceinline__ void operator()(f32x4 (&acc)[2][2][4][2], const Unit& u, int wr, int wc, int fr, int fq, int wid, int lane) const {
        const int lr0 = wr * 64 + fr, gr0 = 254 * u.pm - 1 + lr0;
#pragma unroll
        for (int ai = 0; ai < 2; ++ai)
#pragma unroll
            for (int m = 0; m < 4; ++m) { int gr = gr0 + ai * HALF + m * 16; gr = gr < 0 ? 0 : (gr > MTOK - 1 ? MTOK - 1 : gr);
                const float rs = __builtin_amdgcn_rsqf(ssq[gr] * (1.0f / DMODEL) + 1e-6f);
#pragma unroll
                for (int bj = 0; bj < 2; ++bj)
#pragma unroll
                    for (int n = 0; n < 2; ++n) acc[ai][bj][m][n] *= rs; }
#pragma unroll
        for (int ai = 0; ai < 2; ++ai) {
            if (fr == 0) { PG8_LAS float* p = xch + ((wid * 2 + ai) * 2 + 0) * 64 + 8 * fq;
#pragma unroll
                for (int bj = 0; bj < 2; ++bj)
#pragma unroll
                    for (int n = 0; n < 2; ++n) *(PG8_LAS f32x4*)(p + bj * 32 + 4 * n) = acc[ai][bj][0][n]; }
            if (fr == 15) { PG8_LAS float* p = xch + ((wid * 2 + ai) * 2 + 1) * 64 + 8 * fq;
#pragma unroll
                for (int bj = 0; bj < 2; ++bj)
#pragma unroll
                    for (int n = 0; n < 2; ++n) *(PG8_LAS f32x4*)(p + bj * 32 + 4 * n) = acc[ai][bj][3][n]; }
        }
        asm volatile("s_waitcnt lgkmcnt(0)" ::: "memory"); __builtin_amdgcn_s_barrier(); asm volatile("" ::: "memory");
        const int tlo = 254 * u.pm - 1, thi = tlo + 255; const bool anyb = (tlo <= 0) || (((thi + 1) >> 11) != ((tlo - 1) >> 11));
        const int ow = (1 - wr) * 4 + wc;
        const int ch0 = 128 * u.pn + 32 * wc + 8 * fq;
#pragma unroll
        for (int n = 0; n < 2; ++n) {
            f32x4 w0[2], w1[2], w2[2], bb[2];
#pragma unroll
            for (int bj = 0; bj < 2; ++bj) { const int ch = ch0 + 4 * n + bj * DFF_;
                w0[bj] = *(const f32x4*)(cw + ch); w1[bj] = *(const f32x4*)(cw + 2 * DFF_ + ch); w2[bj] = *(const f32x4*)(cw + 4 * DFF_ + ch); bb[bj] = *(const f32x4*)(cb + ch); }
#pragma unroll
            for (int ai = 0; ai < 2; ++ai) {
                const int aiT = wr == 1 ? ai : ai - 1, aiB = wr == 0 ? ai : ai + 1;
#pragma unroll
                for (int m = 0; m < 4; ++m) {
                    const int lr = lr0 + ai * HALF + m * 16, gr = gr0 + ai * HALF + m * 16;
                    const bool first = seq_first(gr), last = seq_last(gr);
                    f32x4 c[2];
#pragma unroll
                    for (int bj = 0; bj < 2; ++bj) {
                        const f32x4 cur = acc[ai][bj][m][n];
                        f32x4 pv, nx;
#pragma unroll
                        for (int e = 0; e < 4; ++e) {
                            const float sP = (m > 0 && fr == 15) ? acc[ai][bj][m > 0 ? m - 1 : 0][n][e] : cur[e];
                            const float sN = (m < 3 && fr == 0) ? acc[ai][bj][m < 3 ? m + 1 : 3][n][e] : cur[e];
                            pv[e] = __builtin_bit_cast(float, __builtin_amdgcn_mov_dpp(__builtin_bit_cast(int, sP), 0x121  , 0xf, 0xf, true));
                            nx[e] = __builtin_bit_cast(float, __builtin_amdgcn_mov_dpp(__builtin_bit_cast(int, sN), 0x12f  , 0xf, 0xf, true)); }
                        if (m == 0) { const f32x4 top = (aiT >= 0) ? *(const PG8_LAS f32x4*)(xch + ((ow * 2 + (aiT < 0 ? 0 : aiT)) * 2 + 1) * 64 + 8 * fq + bj * 32 + 4 * n) : (f32x4){0.f, 0.f, 0.f, 0.f}; if (fr == 0) pv = top; }
                        if (m == 3) { const f32x4 bot = (aiB <= 1) ? *(const PG8_LAS f32x4*)(xch + ((ow * 2 + (aiB > 1 ? 1 : aiB)) * 2 + 0) * 64 + 8 * fq + bj * 32 + 4 * n) : (f32x4){0.f, 0.f, 0.f, 0.f}; if (fr == 15) nx = bot; }
                        if (anyb) { if (first) pv = (f32x4){0.f, 0.f, 0.f, 0.f}; if (last) nx = (f32x4){0.f, 0.f, 0.f, 0.f}; }
                        c[bj] = bb[bj] + w0[bj] * pv + w1[bj] * cur + w2[bj] * nx;
                    }
                    f32x4 hv;
#pragma unroll
                    for (int e = 0; e < 4; ++e) { const float g = c[0][e]; hv[e] = g * __builtin_amdgcn_rcpf(1.0f + __builtin_amdgcn_exp2f(-1.4426950408889634f * g)) * c[1][e]; }
                    f32x2 pk; pk.x = __builtin_bit_cast(float, cvtpk(hv[0], hv[1])); pk.y = __builtin_bit_cast(float, cvtpk(hv[2], hv[3]));
                    if (lr >= 1 && lr <= 254 && gr < MTOK) *(f32x2*)(H + (size_t)gr * DFF_ + ch0 + 4 * n) = pk;
                    asm volatile("" ::: "memory");
                }
            }
        }
    }
};
template <class Epi, class Sched, bool ALIGN_EPI = false, bool SP2 = false>
__device__ __forceinline__ void gemm_phase(PG8_LAS unsigned char* lds, const Gemm g, const Sched& S, const Epi& E) {
    int tid_ = threadIdx.x; asm volatile("" : "+v"(tid_));
    const int tid = tid_, wid = __builtin_amdgcn_readfirstlane(tid >> 6), lane = tid & 63, wr = wid >> 2, wc = wid & 3, fr = lane & 15, fq = lane >> 4;
    const int K = g.K, nt = K / BK;
    unsigned voffA[2], voffB[2];
#pragma unroll
    for (int i = 0; i < 2; ++i) { int R, C; stage_rc(tid * 16 + i * 8192, R, C); const int Rb = Epi::PERM ? ((R & ~31) + perm32(R & 31)) : R;
        voffA[i] = (unsigned)(R * K + C) * 2u; voffB[i] = (unsigned)(Rb * K + C) * 2u; }
    const size_t kstep = (size_t)(BK * 2);
    const size_t hstep = (size_t)HALF * K * 2;
    const size_t tstep = 2 * hstep; const size_t tstepA = (size_t)g.a_tile_rows * K * 2;
    const unsigned ldsw = (unsigned)wid * 1024u;
    const int aoff = lds_byte(wr * 64 + fr, fq * 8), boff = lds_byte(wc * 32 + fr, fq * 8);
#define PG8_SA(b, h) (((b) * 2 + (h)) * HTB)
#define PG8_SB(b, h) ((4 + (b) * 2 + (h)) * HTB)
#define PG8_STAGE(bufoff, gbase, voff) do { _Pragma("unroll") for (int _i = 0; _i < 2; ++_i) \
        __builtin_amdgcn_global_load_lds((const unsigned*)((const char*)(gbase) + (voff)[_i]), (PG8_LAS unsigned*)(lds + (bufoff) + ldsw + _i * 8192), 16, 0, 0); } while (0)
#define PG8_LDA(dst, b, h) do { _Pragma("unroll") for (int m = 0; m < 4; ++m) _Pragma("unroll") for (int k = 0; k < 2; ++k) dst[m][k] = *(const PG8_LAS bf16x8*)(lds + PG8_SA(b, h) + aoff + m * 2048 + k * 1024); } while (0)
#define PG8_LDB(dst, b, h) do { _Pragma("unroll") for (int n = 0; n < 2; ++n) _Pragma("unroll") for (int k = 0; k < 2; ++k) dst[n][k] = *(const PG8_LAS bf16x8*)(lds + PG8_SB(b, h) + boff + n * 2048 + k * 1024); } while (0)
#define PG8_MMA(ai, bj, At, Bt) do { __builtin_amdgcn_s_setprio(1); _Pragma("unroll") for (int m = 0; m < 4; ++m) _Pragma("unroll") for (int n = 0; n < 2; ++n) _Pragma("unroll") for (int k = 0; k < 2; ++k) \
        acc[ai][bj][m][n] = __builtin_amdgcn_mfma_f32_16x16x32_bf16(Bt[n][k], At[m][k], acc[ai][bj][m][n], 0, 0, 0); __builtin_amdgcn_s_setprio(0); } while (0)
#define PG8_WAIT_V(n) asm volatile("s_waitcnt vmcnt(" #n ")" ::: "memory")
#define PG8_WAIT_L(n) asm volatile("s_waitcnt lgkmcnt(" #n ")" ::: "memory")
#define PG8_BAR __builtin_amdgcn_s_barrier()
#define PG8_SCHED __builtin_amdgcn_sched_barrier(0)
    Unit cur, nxt; int ui = 0;
    if (!S.next(0, cur)) return;
    f32x4 acc[2][2][4][2];
#pragma unroll
    for (int a = 0; a < 2; ++a)
#pragma unroll
        for (int b = 0; b < 2; ++b)
#pragma unroll
            for (int m = 0; m < 4; ++m)
#pragma unroll
                for (int n = 0; n < 2; ++n) acc[a][b][m][n] = (f32x4){0.f, 0.f, 0.f, 0.f};
    bf16x8 At[4][2], B0[2][2], B1[2][2];
    const char* cA = (const char*)g.A + (size_t)cur.pm * tstepA; const char* cB = (const char*)g.Bt + (size_t)cur.pn * tstep;
    S.a_ready(cur);
    if constexpr (SP2) {
        PG8_STAGE(PG8_SB(0, 0), cB, voffB); PG8_STAGE(PG8_SB(0, 1), cB + hstep, voffB); PG8_STAGE(PG8_SA(0, 0), cA, voffA); PG8_STAGE(PG8_SA(0, 1), cA + hstep, voffA);
        if (wr == 1) PG8_BAR;
        PG8_WAIT_V(2); PG8_BAR;
        PG8_STAGE(PG8_SB(1, 0), cB + kstep, voffB); PG8_STAGE(PG8_SA(1, 0), cA + kstep, voffA); PG8_STAGE(PG8_SB(1, 1), cB + hstep + kstep, voffB);
        PG8_WAIT_V(6); PG8_BAR;
    } else {
        PG8_STAGE(PG8_SB(0, 0), cB, voffB); PG8_STAGE(PG8_SA(0, 0), cA, voffA); PG8_STAGE(PG8_SB(0, 1), cB + hstep, voffB); PG8_STAGE(PG8_SA(0, 1), cA + hstep, voffA);
        if (wr == 1) PG8_BAR;
        PG8_WAIT_V(4); PG8_BAR;
        PG8_STAGE(PG8_SB(1, 0), cB + kstep, voffB); PG8_STAGE(PG8_SA(1, 0), cA + kstep, voffA); PG8_STAGE(PG8_SB(1, 1), cB + hstep + kstep, voffB);
        PG8_WAIT_V(6); PG8_BAR;
    }
    for (;;) {
        const bool has_next = S.next(ui + 1, nxt);
        const char* nA = has_next ? (const char*)g.A + (size_t)nxt.pm * tstepA : cA; const char* nB = has_next ? (const char*)g.Bt + (size_t)nxt.pn * tstep : cB;
        for (int t = 0; t < nt; t += 2) {
            const bool last = (t == nt - 2);
            const char* a1 = cA + (size_t)(t + 1) * kstep;
            const char* a2 = last ? nA : cA + (size_t)(t + 2) * kstep; const char* b2 = last ? nB : cB + (size_t)(t + 2) * kstep;
            const char* a3 = a2 + kstep; const char* b3 = b2 + kstep;
            if (last && has_next) S.a_ready(nxt);
            if constexpr (SP2) {
            PG8_LDB(B0, 0, 0); PG8_LDB(B1, 0, 1); PG8_SCHED; PG8_LDA(At, 0, 0); PG8_STAGE(PG8_SA(1, 1), a1 + hstep, voffA);
            PG8_WAIT_V(8); PG8_WAIT_L(0); PG8_BAR; PG8_MMA(0, 0, At, B0); PG8_MMA(0, 1, At, B1); PG8_BAR; PG8_SCHED;
            PG8_LDA(At, 0, 1); PG8_STAGE(PG8_SB(0, 0), b2, voffB); PG8_STAGE(PG8_SB(0, 1), b2 + hstep, voffB); PG8_STAGE(PG8_SA(0, 0), a2, voffA);
            PG8_WAIT_V(8); PG8_WAIT_L(0); PG8_BAR; PG8_MMA(1, 0, At, B0); PG8_MMA(1, 1, At, B1); PG8_BAR; PG8_SCHED;
            PG8_LDB(B0, 1, 0); PG8_LDB(B1, 1, 1); PG8_SCHED; PG8_LDA(At, 1, 0); PG8_STAGE(PG8_SA(0, 1), a2 + hstep, voffA);
            PG8_WAIT_V(8); PG8_WAIT_L(0); PG8_BAR; PG8_MMA(0, 0, At, B0); PG8_MMA(0, 1, At, B1); PG8_BAR; PG8_SCHED;
            PG8_LDA(At, 1, 1); PG8_STAGE(PG8_SB(1, 0), b3, voffB); PG8_STAGE(PG8_SB(1, 1), b3 + hstep, voffB); PG8_STAGE(PG8_SA(1, 0), a3, voffA);
            PG8_WAIT_V(8); PG8_WAIT_L(0); PG8_BAR; PG8_MMA(1, 0, At, B0); PG8_MMA(1, 1, At, B1); PG8_BAR; PG8_SCHED;
            } else {
            PG8_LDB(B0, 0, 0); PG8_SCHED; PG8_LDA(At, 0, 0); PG8_STAGE(PG8_SA(1, 1), a1 + hstep, voffA);
            PG8_WAIT_L(8); PG8_BAR; PG8_WAIT_L(0); PG8_MMA(0, 0, At, B0); PG8_BAR; PG8_SCHED;
            PG8_LDB(B1, 0, 1); PG8_STAGE(PG8_SB(0, 0), b2, voffB);
            PG8_BAR; PG8_WAIT_L(0); PG8_MMA(0, 1, At, B1); PG8_BAR;
            PG8_LDA(At, 0, 1); PG8_STAGE(PG8_SA(0, 0), a2, voffA);
            PG8_BAR; PG8_WAIT_L(0); PG8_MMA(1, 0, At, B0); PG8_BAR; PG8_SCHED;
            PG8_STAGE(PG8_SB(0, 1), b2 + hstep, voffB);
            PG8_WAIT_V(6); PG8_BAR; PG8_MMA(1, 1, At, B1); PG8_BAR;
            PG8_LDB(B0, 1, 0); PG8_SCHED; PG8_LDA(At, 1, 0); PG8_STAGE(PG8_SA(0, 1), a2 + hstep, voffA);
            PG8_WAIT_L(8); PG8_BAR; PG8_WAIT_L(0); PG8_MMA(0, 0, At, B0); PG8_BAR; PG8_SCHED;
            PG8_LDB(B1, 1, 1); PG8_STAGE(PG8_SB(1, 0), b3, voffB);
            PG8_BAR; PG8_WAIT_L(0); PG8_MMA(0, 1, At, B1); PG8_BAR;
            PG8_LDA(At, 1, 1); PG8_STAGE(PG8_SA(1, 0), a3, voffA);
            PG8_BAR; PG8_WAIT_L(0); PG8_MMA(1, 0, At, B0); PG8_BAR; PG8_SCHED;
            PG8_STAGE(PG8_SB(1, 1), b3 + hstep, voffB);
            PG8_WAIT_V(6); PG8_BAR; PG8_MMA(1, 1, At, B1); PG8_BAR;
            }
        }
        if constexpr (ALIGN_EPI) { if (wr == 0) PG8_BAR; }
        if constexpr (!Epi::AFTER_DRAIN) { E(acc, cur, wr, wc, fr, fq, wid, lane); S.done(cur); }
        if (!has_next) break;
#pragma unroll
        for (int a = 0; a < 2; ++a)
#pragma unroll
            for (int b = 0; b < 2; ++b)
#pragma unroll
                for (int m = 0; m < 4; ++m)
#pragma unroll
                    for (int n = 0; n < 2; ++n) acc[a][b][m][n] = (f32x4){0.f, 0.f, 0.f, 0.f};
        cur = nxt; cA = nA; cB = nB; ++ui;
        if constexpr (ALIGN_EPI) { if (wr == 1) PG8_BAR; }
    }
    PG8_WAIT_V(0);
    if constexpr (!ALIGN_EPI) { if (wr == 0) PG8_BAR; }
    PG8_BAR;
    if constexpr (Epi::AFTER_DRAIN) { E.fused(acc, cur, wr, wc, fr, fq, lds, wid, lane); S.done(cur); }
#undef PG8_SA
#undef PG8_SB
#undef PG8_STAGE
#undef PG8_LDA
#undef PG8_LDB
#undef PG8_MMA
#undef PG8_WAIT_V
#undef PG8_WAIT_L
#undef PG8_BAR
#undef PG8_SCHED
}
}
#ifndef PG8_SP2
#define PG8_SP2 true
#endif
#ifndef PG8_ALIGN
#define PG8_ALIGN true
#endif

constexpr int NWAVES = 8;
constexpr int DM = 1024, M = 49152, MP = 16384, INW = 2304, DFF = 2816, UPW = 5632;
constexpr int QA_OFF = 0, KA_OFF = 512, VA_OFF = 1024, QB_OFF = 1536, KB_OFF = 2048, VB_OFF = 2176;
constexpr int UP_TILES_M = 194;
constexpr float EPS = 1e-6f, LOG2E = 1.4426950408889634f;

constexpr size_t MiB = 1u << 20;
constexpr size_t WS_SSQ = 0;
constexpr size_t WS_BAR = 1 * MiB;
constexpr size_t WS_WIN = 2 * MiB, WS_WOUT = 7 * MiB, WS_WUP = 9 * MiB, WS_WDN = 20 * MiB;
constexpr size_t WS_XN = 32 * MiB;
constexpr size_t WS_PROJ = 130 * MiB;
constexpr size_t WS_OA = 346 * MiB;
constexpr size_t WS_H = 226 * MiB;
constexpr size_t WS_LA = 490 * MiB;
constexpr size_t WS_END = 496 * MiB;
static_assert(WS_XN + (size_t)(M + 256) * DM * 2 <= WS_PROJ && WS_PROJ + (size_t)M * INW * 2 <= WS_OA && WS_OA + 3 * (size_t)M * 512 * 2 <= WS_LA && WS_H + (size_t)M * DFF * 2 <= WS_LA && WS_PROJ + (size_t)M * DM * 2 <= WS_H, "d_ws map");

constexpr int RING_BYTES = 131072, XCH_OFF = RING_BYTES, MISC_OFF = XCH_OFF + 8192, LDS_BYTES = 147456;

#define LAS __attribute__((address_space(3)))
typedef unsigned short bf16;
typedef unsigned v4u __attribute__((ext_vector_type(4)));
typedef float f32x4 __attribute__((ext_vector_type(4)));
typedef float f32x16 __attribute__((ext_vector_type(16)));
typedef short bf16x8 __attribute__((ext_vector_type(8)));
typedef short s16x4 __attribute__((ext_vector_type(4)));
using pg8::cvtpk;
__device__ __forceinline__ float bf_lo(unsigned w) { return __uint_as_float(w << 16); }
__device__ __forceinline__ float bf_hi(unsigned w) { return __uint_as_float(w & 0xffff0000u); }
__device__ __forceinline__ float wave_sum(float v) {
#pragma unroll
    for (int o = 1; o < 64; o <<= 1) v += __shfl_xor(v, o);
    return v;
}
__device__ __forceinline__ float wave_max(float v) {
#pragma unroll
    for (int o = 1; o < 64; o <<= 1) v = fmaxf(v, __shfl_xor(v, o));
    return v;
}

#define GAS __attribute__((address_space(1)))
#define RLX_AGENT __ATOMIC_RELAXED, __HIP_MEMORY_SCOPE_AGENT
#define XB_TMO      128
#define XB_XCNT(j)  (256  + 64 * (j))
#define XB_XSUB(j)  (1280 + 64 * (j))
#define XB_XGEN(j)  (2304 + 64 * (j))
#define XB_TOP      3328
#define XB_TOPGEN   3392
#define XCD_BAR_WORDS 3456
#define XB_SPIN_CAP (1u << 18)

__device__ __forceinline__ unsigned xb_ld(unsigned* p)              { return __hip_atomic_load(p, __ATOMIC_RELAXED, __HIP_MEMORY_SCOPE_AGENT); }
__device__ __forceinline__ unsigned xb_add(unsigned* p, unsigned v) { return __hip_atomic_fetch_add(p, v, __ATOMIC_RELAXED, __HIP_MEMORY_SCOPE_AGENT); }
__device__ __forceinline__ unsigned xb_xcc_id() { return (unsigned)__builtin_amdgcn_s_getreg((3 << 11) | 20) & 0xFu; }
#define XB_SPIN(cond, bar) do { unsigned _sp = 0; while (cond) { __builtin_amdgcn_s_sleep(1); \
    if ((++_sp & 255u) == 0u) { if (xb_ld(&(bar)[XB_TMO])) break; if (_sp > XB_SPIN_CAP) { atomicAdd(&(bar)[XB_TMO], 1u); break; } } } } while (0)

struct XcdBarrier {
    unsigned* bar; unsigned x;
    volatile LAS unsigned* st;
};

__device__ __forceinline__ XcdBarrier xcd_barrier_post(unsigned* bar, volatile LAS unsigned* st) {
    XcdBarrier b; b.bar = bar; b.x = xb_xcc_id(); b.st = st;
    if (threadIdx.x == 0) (void)xb_add(&bar[XB_XCNT(b.x)], 1u);
    return b;
}
__device__ __forceinline__ void xcd_barrier_complete(unsigned* bar, unsigned x, unsigned& nloc, unsigned& nx) {
    const unsigned G = gridDim.x * gridDim.y * gridDim.z;
    unsigned sum, cnt, mine, sp = 0u;
    for (;;) {
        sum = 0u; cnt = 0u; mine = 0u;
#pragma unroll
        for (unsigned j = 0; j < 16; ++j) { const unsigned c = xb_ld(&bar[XB_XCNT(j)]); sum += c; cnt += (c > 0u) ? 1u : 0u; mine = (j == x) ? c : mine; }
        if (sum == G) break;
        __builtin_amdgcn_s_sleep(1);
        if ((++sp & 255u) == 0u) { if (xb_ld(&bar[XB_TMO])) break; if (sp > XB_SPIN_CAP) { atomicAdd(&bar[XB_TMO], 1u); break; } }
    }
    nloc = mine > 0u ? mine : 1u; nx = cnt > 0u ? cnt : 1u;
}

__device__ __forceinline__ void xcd_barrier(const XcdBarrier& b) {
    asm volatile("s_waitcnt vmcnt(0)" ::: "memory");
    __syncthreads();
    if (threadIdx.x == 0) {
        unsigned* bar = b.bar;
        __builtin_amdgcn_s_waitcnt(0);
        unsigned nloc = b.st[0], nx = b.st[1];
        if (nloc == 0u) { xcd_barrier_complete(bar, b.x, nloc, nx); b.st[0] = nloc; b.st[1] = nx; }
        const unsigned old = xb_add(&bar[XB_XSUB(b.x)], 1u);
        const unsigned gen = old / nloc;
        if (old + 1u == (gen + 1u) * nloc) {
            __builtin_amdgcn_fence(__ATOMIC_RELEASE, "agent");
            asm volatile("s_waitcnt vmcnt(0)" ::: "memory");
            const unsigned og = xb_add(&bar[XB_TOP], 1u);
            const unsigned tg = og / nx;
            if (og + 1u == (tg + 1u) * nx) xb_add(&bar[XB_TOPGEN], 1u);
            else XB_SPIN(xb_ld(&bar[XB_TOPGEN]) == tg, bar);
            __builtin_amdgcn_fence(__ATOMIC_ACQUIRE, "agent");
            xb_add(&bar[XB_XGEN(b.x)], 1u);
            asm volatile("s_waitcnt vmcnt(0)" ::: "memory");
        } else {
            XB_SPIN(xb_ld(&bar[XB_XGEN(b.x)]) == gen, bar);
            __builtin_amdgcn_fence(__ATOMIC_ACQUIRE, "agent");
            asm volatile("s_waitcnt vmcnt(0)" ::: "memory");
        }
    }
    __syncthreads();
}

template <int MAP  >
__device__ __forceinline__ void p0_transpose_item(const float* W, int K, int N, bf16* WT, const float* kgain, LAS float* scr, int item, int lane) {
    const int nblk = N / 32, kb = item / nblk, nb = item % nblk, k0 = 64 * kb, n0 = 32 * nb;
#pragma unroll 8
    for (int i = 0; i < 32; ++i) { const int kk = 2 * i + (lane >> 5); float v = W[(size_t)(k0 + kk) * N + n0 + (lane & 31)]; if (kgain) v *= kgain[k0 + kk]; scr[kk * 33 + (lane & 31)] = v; }
    asm volatile("s_waitcnt lgkmcnt(0)" ::: "memory");
    const int c = lane & 7;
    int r0 = n0;
    if (MAP == 2) { const int hs = n0 >> 6; r0 = 256 * (hs >> 2) + 128 * ((n0 >> 5) & 1) + 32 * (hs & 3); }
    if (MAP == 1) r0 = n0 < DFF ? ((n0 >> 7) * 256 + (n0 & 127)) : ((((n0 - DFF) >> 7) * 256) + 128 + ((n0 - DFF) & 127));
#pragma unroll
    for (int j = 0; j < 4; ++j) { const int n = (lane >> 3) + 8 * j; const LAS float* s = scr + (8 * c) * 33 + n;
        v4u o; o.x = cvtpk(s[0 * 33], s[1 * 33]); o.y = cvtpk(s[2 * 33], s[3 * 33]); o.z = cvtpk(s[4 * 33], s[5 * 33]); o.w = cvtpk(s[6 * 33], s[7 * 33]);
        *(v4u*)(WT + (size_t)(r0 + n) * K + k0 + 8 * c) = o; }
    asm volatile("s_waitcnt lgkmcnt(0)" ::: "memory");
}
__device__ __forceinline__ void rms_row_to_bf16(const float* xrow, const float* g, bf16* orow, int lane) {
    const f32x4* xr = (const f32x4*)xrow + lane; const f32x4* gr = (const f32x4*)g + lane;
    f32x4 v[4]; float s = 0.f;
#pragma unroll
    for (int j = 0; j < 4; ++j) { v[j] = xr[64 * j]; s += (v[j].x * v[j].x + v[j].y * v[j].y) + (v[j].z * v[j].z + v[j].w * v[j].w); }
    const float rstd = __builtin_amdgcn_rsqf(wave_sum(s) * (1.f / DM) + EPS);
    unsigned long long* o8 = (unsigned long long*)orow + lane;
#pragma unroll
    for (int j = 0; j < 4; ++j) { const f32x4 gg = gr[64 * j]; o8[64 * j] = (unsigned long long)cvtpk(v[j].x * rstd * gg.x, v[j].y * rstd * gg.y) | ((unsigned long long)cvtpk(v[j].z * rstd * gg.z, v[j].w * rstd * gg.w) << 32); }
}

__device__ __forceinline__ void rms_rows4_to_bf16(const float* xrow, const float* g, bf16* orow, int lane) {
    f32x4 v[4][4]; float s[4];
#pragma unroll
    for (int k = 0; k < 4; ++k)
#pragma unroll
        for (int j = 0; j < 4; ++j) v[k][j] = ((const f32x4*)(xrow + (size_t)k * DM) + lane)[64 * j];
    f32x4 gg[4];
#pragma unroll
    for (int j = 0; j < 4; ++j) gg[j] = ((const f32x4*)g + lane)[64 * j];
#pragma unroll
    for (int k = 0; k < 4; ++k) { s[k] = 0.f;
#pragma unroll
        for (int j = 0; j < 4; ++j) s[k] += (v[k][j].x * v[k][j].x + v[k][j].y * v[k][j].y) + (v[k][j].z * v[k][j].z + v[k][j].w * v[k][j].w); }
#pragma unroll
    for (int o = 1; o < 64; o <<= 1) {
#pragma unroll
        for (int k = 0; k < 4; ++k) s[k] += __shfl_xor(s[k], o); }
#pragma unroll
    for (int k = 0; k < 4; ++k) { const float rstd = __builtin_amdgcn_rsqf(s[k] * (1.f / DM) + EPS);
        unsigned long long* o8 = (unsigned long long*)(orow + (size_t)k * DM) + lane;
#pragma unroll
        for (int j = 0; j < 4; ++j) o8[64 * j] = (unsigned long long)cvtpk(v[k][j].x * rstd * gg[j].x, v[k][j].y * rstd * gg[j].y) | ((unsigned long long)cvtpk(v[k][j].z * rstd * gg[j].z, v[k][j].w * rstd * gg[j].w) << 32); }
}

template <int NKEYS, int NTHR>
__device__ __forceinline__ void stage_load(v4u (&kr)[NKEYS * 8 / NTHR], v4u (&vr)[NKEYS * 8 / NTHR], const bf16* proj, int kcol, int vcol, int tok0, int dshift, int kidx0, int Ls, int t) {
    constexpr int NIT = NKEYS * 8 / NTHR;
    const int c = t & 7;
#pragma unroll
    for (int it = 0; it < NIT; ++it) { const int rho = (it * NTHR + t) >> 3, kidx = kidx0 + rho; const bool ok = (unsigned)kidx < (unsigned)Ls;
        const bf16* rowp = proj + (size_t)(tok0 + ((ok ? kidx : 0) << dshift)) * INW + 8 * c;
        kr[it] = *(const v4u*)(rowp + kcol); vr[it] = *(const v4u*)(rowp + vcol); }
}
template <int NKEYS, int NTHR>
__device__ __forceinline__ void stage_write(const v4u (&kr)[NKEYS * 8 / NTHR], const v4u (&vr)[NKEYS * 8 / NTHR], LAS unsigned char* Kl, LAS unsigned char* Vl, int t) {
    constexpr int NIT = NKEYS * 8 / NTHR;
    const int c = t & 7;
#pragma unroll
    for (int it = 0; it < NIT; ++it) { const int rho = (it * NTHR + t) >> 3;
        *(LAS v4u*)(Kl + rho * 128 + 16 * (c ^ ((rho >> 1) & 7))) = kr[it];
        *(LAS v4u*)(Vl + (c >> 2) * (NKEYS * 64) + rho * 64 + (c & 3) * 16) = vr[it]; }
}
__device__ __forceinline__ void load_q_raw(v4u (&raw)[4], const bf16* qrow, int lane) {
#pragma unroll
    for (int d0 = 0; d0 < 4; ++d0) raw[d0] = *(const v4u*)(qrow + 16 * d0 + 8 * (lane >> 5));
}
typedef short v4i16_t __attribute__((ext_vector_type(4)));
__device__ __forceinline__ s16x4 vtr(const LAS unsigned char* p) { return __builtin_bit_cast(s16x4, __builtin_amdgcn_ds_read_tr16_b64_v4i16((LAS v4i16_t*)p)); }
template <int R, bool BAND, bool EDGE, bool SAFE>
__device__ __forceinline__ void attn_tile(const bf16x8 (&kf)[4], unsigned vaddr, int vhs, int j, int kidx_t0, int Ls, const bf16x8 (&qf)[4], float base, float nslope, float negM, f32x16 (&o)[2], float& l, int hi) {
    s16x4 vl[4], vh[4];
    asm volatile("ds_read_b64_tr_b16 %0, %8\n\tds_read_b64_tr_b16 %1, %8 offset:512\n\tds_read_b64_tr_b16 %2, %8 offset:1024\n\tds_read_b64_tr_b16 %3, %8 offset:1536\n\t"
                 "ds_read_b64_tr_b16 %4, %9\n\tds_read_b64_tr_b16 %5, %9 offset:512\n\tds_read_b64_tr_b16 %6, %9 offset:1024\n\tds_read_b64_tr_b16 %7, %9 offset:1536"
                 : "=&v"(vl[0]), "=&v"(vh[0]), "=&v"(vl[1]), "=&v"(vh[1]), "=&v"(vl[2]), "=&v"(vh[2]), "=&v"(vl[3]), "=&v"(vh[3]) : "v"(vaddr), "v"(vaddr + (unsigned)vhs) : "memory");
    f32x16 s = {0.f, 0.f, 0.f, 0.f, 0.f, 0.f, 0.f, 0.f, 0.f, 0.f, 0.f, 0.f, 0.f, 0.f, 0.f, 0.f};
#pragma unroll
    for (int d0 = 0; d0 < 4; ++d0) s = __builtin_amdgcn_mfma_f32_32x32x16_bf16(kf[d0], qf[d0], s, 0, 0, 0);
    if (SAFE) {
#pragma unroll
        for (int r = 0; r < 16; ++r) s[r] += negM; }
    const float basej = base + (float)(32 * j);
    float pr[16];
#pragma unroll
    for (int r = 0; r < 16; ++r) { const float relf = basej + (float)((r & 3) + 8 * (r >> 2));
        float p = __builtin_amdgcn_exp2f(__builtin_fmaf(__builtin_fabsf(relf), nslope, s[r]));
        if (BAND) p = (__builtin_fabsf(relf) <= (float)R) ? p : 0.f;
        if (EDGE) { const int kidx = kidx_t0 + 32 * j + (r & 3) + 8 * (r >> 2) + 4 * hi; p = ((unsigned)kidx < (unsigned)Ls) ? p : 0.f; }
        l += p; pr[r] = p; }
    v4u w0, w1; w0.x = cvtpk(pr[0], pr[1]); w0.y = cvtpk(pr[2], pr[3]); w0.z = cvtpk(pr[4], pr[5]); w0.w = cvtpk(pr[6], pr[7]);
    w1.x = cvtpk(pr[8], pr[9]); w1.y = cvtpk(pr[10], pr[11]); w1.z = cvtpk(pr[12], pr[13]); w1.w = cvtpk(pr[14], pr[15]);
    const bf16x8 pa0 = __builtin_bit_cast(bf16x8, w0), pa1 = __builtin_bit_cast(bf16x8, w1);
    asm volatile("s_waitcnt lgkmcnt(0)" : "+v"(vl[0]), "+v"(vh[0]), "+v"(vl[1]), "+v"(vh[1]), "+v"(vl[2]), "+v"(vh[2]), "+v"(vl[3]), "+v"(vh[3]) :: "memory");
#pragma unroll
    for (int dh = 0; dh < 2; ++dh)
#pragma unroll
        for (int s2 = 0; s2 < 2; ++s2) { const s16x4 lo = vl[2 * dh + s2], h4 = vh[2 * dh + s2];
            const bf16x8 vf = (bf16x8){lo[0], lo[1], lo[2], lo[3], h4[0], h4[1], h4[2], h4[3]};
            o[dh] = __builtin_amdgcn_mfma_f32_32x32x16_bf16(vf, s2 ? pa1 : pa0, o[dh], 0, 0, 0); }
}
template <int NT, int R, bool EDGE, bool SAFE>
__device__ __forceinline__ void attn_task(const LAS unsigned char* Kl, const LAS unsigned char* Vl, int vhs, int row0, int kidx_t0, int Ls, const bf16x8 (&qf)[4], float slope2, float negM, f32x16 (&o)[2], float& l, int lane) {
    const int q = lane & 31, hi = lane >> 5;
    const unsigned va0 = (unsigned)(uintptr_t)(Vl + row0 * 64 + (4 * hi + ((lane & 15) >> 2)) * 64 + (16 * ((lane >> 4) & 1) + 4 * (lane & 3)) * 2);
    const int sw = (q >> 1) & 7;
    const LAS unsigned char* kp0 = Kl + (row0 + q) * 128 + 16 * ((0 + hi) ^ sw); const LAS unsigned char* kp1 = Kl + (row0 + q) * 128 + 16 * ((2 + hi) ^ sw);
    const LAS unsigned char* kp2 = Kl + (row0 + q) * 128 + 16 * ((4 + hi) ^ sw); const LAS unsigned char* kp3 = Kl + (row0 + q) * 128 + 16 * ((6 + hi) ^ sw);
    float base = (float)(4 * hi - R - q); asm volatile("" : "+v"(base));
    const float nslope = -slope2;
#define LOADK(dst, jj) do { dst[0] = *(const LAS bf16x8*)(kp0 + (jj) * 4096); dst[1] = *(const LAS bf16x8*)(kp1 + (jj) * 4096); dst[2] = *(const LAS bf16x8*)(kp2 + (jj) * 4096); dst[3] = *(const LAS bf16x8*)(kp3 + (jj) * 4096); } while (0)
    bf16x8 kf[4];
    LOADK(kf, 0);
    attn_tile<R, true, EDGE, SAFE>(kf, va0, vhs, 0, kidx_t0, Ls, qf, base, nslope, negM, o, l, hi);
#pragma unroll 1
    for (int j = 1; j < NT - 1; ++j) {
        LOADK(kf, j);
        attn_tile<R, false, EDGE, SAFE>(kf, va0 + j * 2048, vhs, j, kidx_t0, Ls, qf, base, nslope, negM, o, l, hi);
    }
    LOADK(kf, NT - 1);
    attn_tile<R, true, EDGE, SAFE>(kf, va0 + (NT - 1) * 2048, vhs, NT - 1, kidx_t0, Ls, qf, base, nslope, negM, o, l, hi);
#undef LOADK
}
__device__ __forceinline__ void store_partial(const f32x16 (&o)[2], float l, bf16* OBuf, float* LB, int tokq0, int dshift, int h, int lane) {
    const int hi = lane >> 5, q = lane & 31; const size_t tok = (size_t)(tokq0 + (q << dshift));
    l += __shfl_xor(l, 32);
    if (hi == 0) LB[tok * 8 + h] = l;
    bf16* p = OBuf + tok * 512 + h * 64 + 4 * hi;
#pragma unroll
    for (int dh = 0; dh < 2; ++dh)
#pragma unroll
        for (int g = 0; g < 4; ++g) { unsigned long long w = (unsigned long long)cvtpk(o[dh][4 * g], o[dh][4 * g + 1]) | ((unsigned long long)cvtpk(o[dh][4 * g + 2], o[dh][4 * g + 3]) << 32);
            *(unsigned long long*)(p + 32 * dh + 8 * g) = w; }
}
struct AUnit { int tok0, dshift, Ls, cc, h, c; };
__device__ __forceinline__ AUnit decode_a(int su) {
    AUnit a; const int sidx = su / 48, k = su % 48, blk = sidx >> 3; a.h = sidx & 7; a.c = 2 - (k >> 4); a.dshift = 2 * a.c; const int kk = k & 15;
    int seq0, S, bis; if (blk < 8) { seq0 = 0; S = 16384; bis = blk; } else { seq0 = MP + 2048 * (blk - 8); S = 2048; bis = 0; }
    a.Ls = S >> a.dshift; const int lcpb = 4 - a.dshift  , res = kk >> lcpb; a.cc = (bis << lcpb) + (kk & ((1 << lcpb) - 1)); a.tok0 = seq0 + res; return a;
}
struct BUnit { int seq0, S, lcb, g2; };
__device__ __forceinline__ BUnit decode_b(int u) {
    BUnit b; b.g2 = u / 768; const int cb = u % 768;
    if (cb < 256) { b.seq0 = 0; b.S = 16384; b.lcb = cb; } else { b.seq0 = MP + 2048 * ((cb - 256) >> 5); b.S = 2048; b.lcb = (cb - 256) & 31; } return b;
}

#define LDS_BAR() asm volatile("s_waitcnt lgkmcnt(0)\n\ts_barrier" ::: "memory")
#define xp (args.in[0])
#define xs (args.in[1])
#define norm1 (args.in[2])
#define w_in (args.in[3])
#define qna (args.in[4])
#define kna (args.in[5])
#define qnb (args.in[6])
#define knb (args.in[7])
#define sinkb (args.in[8])
#define ona (args.in[9])
#define onb (args.in[10])
#define w_out (args.in[11])
#define norm2 (args.in[12])
#define w_up (args.in[13])
#define conv_w (args.in[14])
#define conv_b (args.in[15])
#define w_down (args.in[16])
#define out (args.dout)
#define SSQ ((float*)(args.ws + WS_SSQ))
#define WIN ((bf16*)(args.ws + WS_WIN))
#define WOUT ((bf16*)(args.ws + WS_WOUT))
#define WUP ((bf16*)(args.ws + WS_WUP))
#define WDN ((bf16*)(args.ws + WS_WDN))
#define XN ((bf16*)(args.ws + WS_XN) + DM)
#define PROJ ((bf16*)(args.ws + WS_PROJ))
#define Y ((bf16*)(args.ws + WS_PROJ))
#define OA ((bf16*)(args.ws + WS_OA))
#define OB ((bf16*)(args.ws + WS_XN) + DM)
#define HB ((bf16*)(args.ws + WS_H))
#define LA ((float*)(args.ws + WS_LA))
#define LBp ((float*)(args.ws + WS_LA) + 3 * (size_t)M * 8)
struct Args { const float* in[17]; float* dout; unsigned char* ws; };
__global__ void __launch_bounds__(NWAVES * 64, 2) fwd_megakernel(Args args) {
    extern __shared__ __attribute__((aligned(16))) unsigned char lds_raw[];
    cg::grid_group grid = cg::this_grid();
    LAS unsigned char* lds = (LAS unsigned char*)lds_raw;
    const int tid = threadIdx.x, lane = tid & 63, wave = __builtin_amdgcn_readfirstlane(tid >> 6);
    const int G = gridDim.x, bx = blockIdx.x;
    if (tid < 2) ((LAS unsigned*)(lds + MISC_OFF))[tid] = 0u;
    const int gw = bx * NWAVES + wave, NGW = G * NWAVES;
    __syncthreads();
    XcdBarrier bar = xcd_barrier_post((unsigned*)(args.ws + WS_BAR), (volatile LAS unsigned*)(lds + MISC_OFF));
    if (args.ws == nullptr) grid.sync();

    {
        LAS float* scr = (LAS float*)(lds + wave * 16384);
        constexpr int I_IN = (DM / 64) * (INW / 32), I_OUT = (DM / 64) * (DM / 32), I_UP = (DM / 64) * (UPW / 32), I_DN = (DFF / 64) * (DM / 32);
        for (int it = gw; it < I_IN + I_OUT + I_UP + I_DN; it += NGW) {
            int r = it;
            if (r < I_IN) { p0_transpose_item<2>(w_in, DM, INW, WIN, nullptr, scr, r, lane); continue; } r -= I_IN;
            if (r < I_OUT) { p0_transpose_item<0>(w_out, DM, DM, WOUT, nullptr, scr, r, lane); continue; } r -= I_OUT;
            if (r < I_UP) { p0_transpose_item<1>(w_up, DM, UPW, WUP, norm2, scr, r, lane); continue; } r -= I_UP;
            p0_transpose_item<0>(w_down, DFF, DM, WDN, nullptr, scr, r, lane);
        }
        for (int m = gw * 4; m < M; m += NGW * 4) rms_rows4_to_bf16(m < MP ? xp + (size_t)m * DM : xs + (size_t)(m - MP) * DM, norm1, XN + (size_t)m * DM, lane);
        for (int i = bx * 512 + tid; i < M; i += G * 512) SSQ[i] = 0.f;
    }
    xcd_barrier(bar);

    {
        pg8::Gemm g{XN, WIN, M, INW, DM, 256}; pg8::StaticOrder S; S.init(M, INW, G, bx);
        pg8::EpiProj E{PROJ, qna, kna, qnb, knb};
        pg8::gemm_phase<pg8::EpiProj, pg8::StaticOrder, PG8_ALIGN, PG8_SP2>(lds, g, S, E);
    }
    xcd_barrier(bar);

    {
        const float gqa = fabsf(qna[lane]), gka = fabsf(kna[lane]);
        const float boundA = __builtin_bit_cast(float, __builtin_amdgcn_readfirstlane(__builtin_bit_cast(int, 8.0f * wave_max(gqa) * wave_max(gka) * LOG2E)));
        const float negMa = boundA > 40.f ? -boundA : 0.f;
        {
            const int half = wave >> 2, w4 = wave & 3, th = tid & 255;
            LAS unsigned char* Kl = lds + half * 65536; LAS unsigned char* Vl = Kl + 32768;
            const int ubase = (G == 256) ? (bx & 7) * 576 + (bx >> 3) : bx, ustep = (G == 256) ? 32 : G, uend = (G == 256) ? (bx & 7) * 576 + 576 : 4608;
            v4u kr[8], vr[8], qraw[4]; AUnit nx = decode_a(2 * ubase + half);
            if (ubase < uend) { stage_load<256, 256>(kr, vr, PROJ, KA_OFF + nx.h * 64, VA_OFF + nx.h * 64, nx.tok0, nx.dshift, 128 * nx.cc - 64, nx.Ls, th);
                load_q_raw(qraw, PROJ + (size_t)(nx.tok0 + ((128 * nx.cc + 32 * w4 + (lane & 31)) << nx.dshift)) * INW + QA_OFF + nx.h * 64, lane); }
            for (int u = ubase; u < uend; u += ustep) {
                const AUnit a = nx;
                LDS_BAR();
                stage_write<256, 256>(kr, vr, Kl, Vl, th);
                bf16x8 qf[4];
#pragma unroll
                for (int d0 = 0; d0 < 4; ++d0) qf[d0] = __builtin_bit_cast(bf16x8, qraw[d0]);
                LDS_BAR();
                if (u + ustep < uend) { nx = decode_a(2 * (u + ustep) + half);
                    stage_load<256, 256>(kr, vr, PROJ, KA_OFF + nx.h * 64, VA_OFF + nx.h * 64, nx.tok0, nx.dshift, 128 * nx.cc - 64, nx.Ls, th);
                    load_q_raw(qraw, PROJ + (size_t)(nx.tok0 + ((128 * nx.cc + 32 * w4 + (lane & 31)) << nx.dshift)) * INW + QA_OFF + nx.h * 64, lane); }
                const int iq0 = 128 * a.cc + 32 * w4;
                f32x16 o[2]; float l = 0.f;
#pragma unroll
                for (int r = 0; r < 16; ++r) { o[0][r] = 0.f; o[1][r] = 0.f; }
                const float slope2 = __builtin_amdgcn_exp2f(-0.5f * (float)(a.h + 9) + (float)a.dshift) * LOG2E;
                const bool edge = iq0 - 64 < 0 || iq0 + 96 > a.Ls;
                if (__builtin_expect(negMa != 0.f, 0)) { if (edge) attn_task<5, 64, true, true>(Kl, Vl, 256 * 64, 32 * w4, iq0 - 64, a.Ls, qf, slope2, negMa, o, l, lane); else attn_task<5, 64, false, true>(Kl, Vl, 256 * 64, 32 * w4, iq0 - 64, a.Ls, qf, slope2, negMa, o, l, lane); }
                else if (edge) attn_task<5, 64, true, false>(Kl, Vl, 256 * 64, 32 * w4, iq0 - 64, a.Ls, qf, slope2, 0.f, o, l, lane);
                else attn_task<5, 64, false, false>(Kl, Vl, 256 * 64, 32 * w4, iq0 - 64, a.Ls, qf, slope2, 0.f, o, l, lane);
                asm volatile("s_nop 15\n\ts_nop 7" ::: "memory");
                store_partial(o, l, OA + (size_t)a.c * M * 512, LA + (size_t)a.c * M * 8, a.tok0 + (iq0 << a.dshift), a.dshift, a.h, lane);
            }
        }
        const float gqb = fabsf(qnb[lane]), gkb = fabsf(knb[lane]);
        const float boundB = __builtin_bit_cast(float, __builtin_amdgcn_readfirstlane(__builtin_bit_cast(int, 8.0f * wave_max(gqb) * wave_max(gkb) * LOG2E)));
        const float negMb = boundB > 40.f ? -boundB : 0.f;
        {
            LAS unsigned char* Kb = lds; LAS unsigned char* Vb = lds + 40960;
            const int ubase = (G == 256) ? (bx & 7) * 192 + (bx >> 3) : bx, ustep = (G == 256) ? 32 : G, uend = (G == 256) ? (bx & 7) * 192 + 192 : 1536;
            v4u kr[5], vr[5], qraw[4]; BUnit nx = decode_b(ubase);
            if (ubase < uend) { stage_load<320, 512>(kr, vr, PROJ, KB_OFF + nx.g2 * 64, VB_OFF + nx.g2 * 64, nx.seq0, 0, 64 * nx.lcb - 128, nx.S, tid);
                load_q_raw(qraw, PROJ + (size_t)(nx.seq0 + 64 * nx.lcb + 32 * (wave & 1) + (lane & 31)) * INW + QB_OFF + (4 * nx.g2 + (wave >> 1)) * 64, lane); }
            for (int u = ubase; u < uend; u += ustep) {
                const BUnit b = nx;
                LDS_BAR();
                stage_write<320, 512>(kr, vr, Kb, Vb, tid);
                bf16x8 qf[4];
#pragma unroll
                for (int d0 = 0; d0 < 4; ++d0) qf[d0] = __builtin_bit_cast(bf16x8, qraw[d0]);
                LDS_BAR();
                if (u + ustep < uend) { nx = decode_b(u + ustep);
                    stage_load<320, 512>(kr, vr, PROJ, KB_OFF + nx.g2 * 64, VB_OFF + nx.g2 * 64, nx.seq0, 0, 64 * nx.lcb - 128, nx.S, tid);
                    load_q_raw(qraw, PROJ + (size_t)(nx.seq0 + 64 * nx.lcb + 32 * (wave & 1) + (lane & 31)) * INW + QB_OFF + (4 * nx.g2 + (wave >> 1)) * 64, lane); }
                const int hb = 4 * b.g2 + (wave >> 1), iq0 = 64 * b.lcb + 32 * (wave & 1);
                f32x16 o[2]; float l = 0.f;
#pragma unroll
                for (int r = 0; r < 16; ++r) { o[0][r] = 0.f; o[1][r] = 0.f; }
                const float slope2 = __builtin_amdgcn_exp2f(-0.5f * (float)(hb + 1)) * LOG2E;
                const bool edge = iq0 - 128 < 0 || iq0 + 160 > b.S;
                if (__builtin_expect(negMb != 0.f, 0)) { if (edge) attn_task<9, 128, true, true>(Kb, Vb, 320 * 64, 32 * (wave & 1), iq0 - 128, b.S, qf, slope2, negMb, o, l, lane); else attn_task<9, 128, false, true>(Kb, Vb, 320 * 64, 32 * (wave & 1), iq0 - 128, b.S, qf, slope2, negMb, o, l, lane); }
                else if (edge) attn_task<9, 128, true, false>(Kb, Vb, 320 * 64, 32 * (wave & 1), iq0 - 128, b.S, qf, slope2, 0.f, o, l, lane);
                else attn_task<9, 128, false, false>(Kb, Vb, 320 * 64, 32 * (wave & 1), iq0 - 128, b.S, qf, slope2, 0.f, o, l, lane);
                asm volatile("s_nop 15\n\ts_nop 7" ::: "memory");
                store_partial(o, l, OB, LBp, b.seq0 + iq0, 0, hb, lane);
            }
        }
        xcd_barrier(bar);
        {
            const int hh = lane >> 3;
            const float sinkterm = __builtin_amdgcn_exp2f(sinkb[hh] * LOG2E + negMb);
            const f32x4 ga0 = *(const f32x4*)(ona + 8 * lane), ga1 = *(const f32x4*)(ona + 8 * lane + 4), gb0 = *(const f32x4*)(onb + 8 * lane), gb1 = *(const f32x4*)(onb + 8 * lane + 4);
            for (int m0 = gw * 4; m0 < M; m0 += NGW * 4) {
                v4u wa[4][3], wb[4]; float la[4], lb[4];
#pragma unroll
                for (int k = 0; k < 4; ++k) { const int m = m0 + k; la[k] = 0.f;
#pragma unroll
                    for (int c = 0; c < 3; ++c) { wa[k][c] = *(const v4u*)(OA + ((size_t)c * M + m) * 512 + 8 * lane); la[k] += LA[((size_t)c * M + m) * 8 + hh]; }
                    wb[k] = *(const v4u*)(OB + (size_t)m * 512 + 8 * lane); lb[k] = LBp[(size_t)m * 8 + hh] + sinkterm; }
                float ya[4][8], yb[4][8], sa[4], sb[4];
#pragma unroll
                for (int k = 0; k < 4; ++k) { const float ia = 1.0f / la[k], ib = 1.0f / lb[k];
                    ya[k][0] = (bf_lo(wa[k][0].x) + bf_lo(wa[k][1].x) + bf_lo(wa[k][2].x)) * ia; ya[k][1] = (bf_hi(wa[k][0].x) + bf_hi(wa[k][1].x) + bf_hi(wa[k][2].x)) * ia;
                    ya[k][2] = (bf_lo(wa[k][0].y) + bf_lo(wa[k][1].y) + bf_lo(wa[k][2].y)) * ia; ya[k][3] = (bf_hi(wa[k][0].y) + bf_hi(wa[k][1].y) + bf_hi(wa[k][2].y)) * ia;
                    ya[k][4] = (bf_lo(wa[k][0].z) + bf_lo(wa[k][1].z) + bf_lo(wa[k][2].z)) * ia; ya[k][5] = (bf_hi(wa[k][0].z) + bf_hi(wa[k][1].z) + bf_hi(wa[k][2].z)) * ia;
                    ya[k][6] = (bf_lo(wa[k][0].w) + bf_lo(wa[k][1].w) + bf_lo(wa[k][2].w)) * ia; ya[k][7] = (bf_hi(wa[k][0].w) + bf_hi(wa[k][1].w) + bf_hi(wa[k][2].w)) * ia;
                    yb[k][0] = bf_lo(wb[k].x) * ib; yb[k][1] = bf_hi(wb[k].x) * ib; yb[k][2] = bf_lo(wb[k].y) * ib; yb[k][3] = bf_hi(wb[k].y) * ib;
                    yb[k][4] = bf_lo(wb[k].z) * ib; yb[k][5] = bf_hi(wb[k].z) * ib; yb[k][6] = bf_lo(wb[k].w) * ib; yb[k][7] = bf_hi(wb[k].w) * ib;
                    sa[k] = 0.f; sb[k] = 0.f;
#pragma unroll
                    for (int i = 0; i < 8; ++i) { sa[k] += ya[k][i] * ya[k][i]; sb[k] += yb[k][i] * yb[k][i]; } }
#pragma unroll
                for (int o = 1; o < 64; o <<= 1) {
#pragma unroll
                    for (int k = 0; k < 4; ++k) { sa[k] += __shfl_xor(sa[k], o); sb[k] += __shfl_xor(sb[k], o); } }
#pragma unroll
                for (int k = 0; k < 4; ++k) { const int m = m0 + k;
                    const float ra = __builtin_amdgcn_rsqf(sa[k] * (1.f / 512.f) + EPS), rb = __builtin_amdgcn_rsqf(sb[k] * (1.f / 512.f) + EPS);
                    v4u oa, ob;
                    oa.x = cvtpk(ya[k][0] * ra * ga0.x, ya[k][1] * ra * ga0.y); oa.y = cvtpk(ya[k][2] * ra * ga0.z, ya[k][3] * ra * ga0.w); oa.z = cvtpk(ya[k][4] * ra * ga1.x, ya[k][5] * ra * ga1.y); oa.w = cvtpk(ya[k][6] * ra * ga1.z, ya[k][7] * ra * ga1.w);
                    ob.x = cvtpk(yb[k][0] * rb * gb0.x, yb[k][1] * rb * gb0.y); ob.y = cvtpk(yb[k][2] * rb * gb0.z, yb[k][3] * rb * gb0.w); ob.z = cvtpk(yb[k][4] * rb * gb1.x, yb[k][5] * rb * gb1.y); ob.w = cvtpk(yb[k][6] * rb * gb1.z, yb[k][7] * rb * gb1.w);
                    *(v4u*)(Y + (size_t)m * DM + 8 * lane) = oa; *(v4u*)(Y + (size_t)m * DM + 512 + 8 * lane) = ob; }
            }
        }
    }
    xcd_barrier(bar);

    {
        pg8::Gemm g{Y, WOUT, M, DM, DM, 256}; pg8::StaticOrder S; S.init(M, DM, G, bx);
        pg8::EpiOut E{xp, xs, XN, SSQ};
        pg8::gemm_phase<pg8::EpiOut, pg8::StaticOrder, PG8_ALIGN, PG8_SP2>(lds, g, S, E);
    }
    xcd_barrier(bar);

    {
        pg8::Gemm g{XN - DM, WUP, UP_TILES_M * 256, UPW, DM, 254}; pg8::StaticOrder S; S.init(UP_TILES_M * 256, UPW, G, bx);
        pg8::EpiUp E{HB, SSQ, conv_w, conv_b, (LAS float*)(lds + XCH_OFF)};
        pg8::gemm_phase<pg8::EpiUp, pg8::StaticOrder, true, PG8_SP2>(lds, g, S, E);
    }
    xcd_barrier(bar);

    {
        pg8::Gemm g{HB, WDN, M, DM, DFF, 256}; pg8::StaticOrder S; S.init(M, DM, G, bx);
        pg8::EpiDown E{XN, out};
        pg8::gemm_phase<pg8::EpiDown, pg8::StaticOrder, PG8_ALIGN, PG8_SP2>(lds, g, S, E);
    }
}

#undef out
#undef xp
#undef xs
extern "C" void kernel_launch(void* const* d_in, const int* in_sizes, int n_in, void* d_out, int out_size, void* d_ws, size_t ws_size, hipStream_t stream) {
    static int grid = 0;
    if (grid == 0) {
        if (n_in != 17 || out_size != M * DM || ws_size < WS_END) { fprintf(stderr, "kernel_launch: unexpected shapes (n_in %d out %d ws %zu)\n", n_in, out_size, ws_size); grid = -1; return; }
        int dev = 0, cus = 0, per_cu = 0;
        hipGetDevice(&dev); hipDeviceGetAttribute(&cus, hipDeviceAttributeMultiprocessorCount, dev);
        if (hipFuncSetAttribute((const void*)fwd_megakernel, hipFuncAttributeMaxDynamicSharedMemorySize, LDS_BYTES) != hipSuccess) { fprintf(stderr, "kernel_launch: hipFuncSetAttribute failed\n"); grid = -1; return; }
        if (hipOccupancyMaxActiveBlocksPerMultiprocessor(&per_cu, (const void*)fwd_megakernel, NWAVES * 64, LDS_BYTES) != hipSuccess || per_cu < 1) { fprintf(stderr, "kernel_launch: occupancy query says %d\n", per_cu); per_cu = 1; }
        (void)hipGetLastError();
        grid = cus;
        fprintf(stderr, "kernel_launch: grid %d (per_cu %d)\n", grid, per_cu);
    }
    if (grid < 0) return;
    Args a{};
    for (int i = 0; i < 17; ++i) a.in[i] = (const float*)d_in[i];
    a.dout = (float*)d_out; a.ws = (unsigned char*)d_ws;
    void* kargs[] = {&a};
    if (hipMemsetAsync((char*)d_ws + WS_BAR, 0, XCD_BAR_WORDS * 4, stream) != hipSuccess) { fprintf(stderr, "kernel_launch: hipMemsetAsync failed\n"); return; }
    hipError_t e = hipLaunchCooperativeKernel((const void*)fwd_megakernel, dim3(grid), dim3(NWAVES * 64), kargs, LDS_BYTES, stream);
    if (e != hipSuccess) fprintf(stderr, "kernel_launch: cooperative launch failed: %s\n", hipGetErrorString(e));
}
```

```cpp
#include <hip/hip_runtime.h>
#include <hip/hip_cooperative_groups.h>
#include <cstdio>
#include <cstdint>
namespace cg = cooperative_groups;
namespace pg8 {
#define PG8_LAS __attribute__((address_space(3)))
typedef unsigned short bf16_t;
typedef short bf16x8 __attribute__((ext_vector_type(8)));
typedef float f32x4 __attribute__((ext_vector_type(4)));
typedef unsigned u32x4 __attribute__((ext_vector_type(4)));
constexpr int BM = 256, BK = 64, HALF = 128, HTB = HALF * BK * 2  , STAGE_BYTES = 8 * HTB, NXCD = 8, WGM = 8;

__host__ __device__ __forceinline__ int lds_byte(int r, int c) { const int st = (r >> 4) * 2 + (c >> 5), rr = r & 15, cc = c & 31, ob = rr * 64 + cc * 2; return st * 1024 + (ob ^ (((ob >> 9) & 1) << 5)); }
__host__ __device__ __forceinline__ void stage_rc(int b, int& R, int& C) { const int st = b / 1024, sb = b % 1024, swz = sb ^ (((sb >> 9) & 1) << 5); R = (st >> 1) * 16 + swz / 64; C = (st & 1) * 32 + (swz % 64) / 2; }
__host__ __device__ __forceinline__ int perm32(int rho) { const int n = rho >> 4, i = rho & 15; return 8 * (i >> 2) + 4 * n + (i & 3); }

struct Unit { int pm, pn; };
struct Gemm { const bf16_t* A; const bf16_t* Bt; int M, N, K; int a_tile_rows; };

struct StaticOrder {
    int nM, nN, nwg, G, c;
    __host__ __device__ void init(int M, int N, int G_, int c_) { nM = M / BM; nN = N / BM; nwg = nM * nN; G = G_; c = c_; }
    __host__ __device__ bool next(int i, Unit& u) const {
        const long L = (long)i * G + c; if (L >= nwg) return false;
        int wgid = (int)L; { const int q = nwg / NXCD, r = nwg % NXCD, xcd = wgid % NXCD, off = wgid / NXCD; wgid = (xcd < r ? xcd * (q + 1) : r * (q + 1) + (xcd - r) * q) + off; }
        const int nig = WGM * nN, gid = wgid / nig, fm = gid * WGM, gsz = (nM - fm) < WGM ? (nM - fm) : WGM;
        u.pm = fm + ((wgid % nig) % gsz); u.pn = (wgid % nig) / gsz; return true;
    }
    __device__ __forceinline__ void a_ready(const Unit&) const {}
    __device__ __forceinline__ void done(const Unit&) const {}
};

__device__ __forceinline__ unsigned cvt_pk_bf16(float lo, float hi) { unsigned r; asm volatile("v_cvt_pk_bf16_f32 %0, %1, %2" : "=v"(r) : "v"(lo), "v"(hi)); return r; }
typedef float f32x2 __attribute__((ext_vector_type(2))); typedef __bf16 bf16x2_t __attribute__((ext_vector_type(2)));
__device__ __forceinline__ unsigned cvtpk(float lo, float hi) { f32x2 v = {lo, hi}; bf16x2_t b = __builtin_convertvector(v, bf16x2_t); return __builtin_bit_cast(unsigned, b); }
constexpr int MTOK = 49152, MPROMPT = 16384, DMODEL = 1024, DFF_ = 2816;
__device__ __forceinline__ u32x4 pack8(const f32x4 a, const f32x4 b) { u32x4 w; w.x = cvtpk(a[0], a[1]); w.y = cvtpk(a[2], a[3]); w.z = cvtpk(b[0], b[1]); w.w = cvtpk(b[2], b[3]); return w; }

struct EpiProj {
    static constexpr bool PERM = true, AFTER_DRAIN = false;
    bf16_t* O; const float* gqa; const float* gka; const float* gqb; const float* gkb;
    __device__ __forceinline__ void operator()(f32x4 (&acc)[2][2][4][2], const Unit& u, int wr, int wc, int fr, int fq, int wid, int lane) const {
        const int hs = 4 * u.pn + wc;
        const float* g = nullptr; float sc = 1.f;
        if (hs < 8) { g = gqa; sc = 0.125f * 1.4426950408889634f; } else if (hs < 16) g = gka; else if (hs >= 24 && hs < 32) { g = gqb; sc = 0.125f * 1.4426950408889634f; } else if (hs >= 32 && hs < 34) g = gkb;
        const int row0 = u.pm * BM + wr * 64 + fr;
        bf16_t* obase = O + (size_t)row0 * 2304 + 64 * hs + 8 * fq;
        if (g) {
            f32x4 gg[2][2];
#pragma unroll
            for (int bj = 0; bj < 2; ++bj)
#pragma unroll
                for (int n = 0; n < 2; ++n) gg[bj][n] = *(const f32x4*)(g + 32 * bj + 8 * fq + 4 * n) * sc;
#pragma unroll
            for (int ai = 0; ai < 2; ++ai)
#pragma unroll
                for (int m = 0; m < 4; ++m) { float ss = 0.f;
#pragma unroll
                    for (int bj = 0; bj < 2; ++bj)
#pragma unroll
                        for (int n = 0; n < 2; ++n) { const f32x4 a = acc[ai][bj][m][n]; ss += (a[0] * a[0] + a[1] * a[1]) + (a[2] * a[2] + a[3] * a[3]); }
                    ss += __shfl_xor(ss, 16); ss += __shfl_xor(ss, 32);
                    const float rs = __builtin_amdgcn_rsqf(ss * (1.0f / 64.0f) + 1e-6f);
                    bf16_t* rowp = obase + (size_t)(ai * HALF + m * 16) * 2304;
#pragma unroll
                    for (int bj = 0; bj < 2; ++bj) *(u32x4*)(rowp + 32 * bj) = pack8(acc[ai][bj][m][0] * rs * gg[bj][0], acc[ai][bj][m][1] * rs * gg[bj][1]); }
        } else {
#pragma unroll
            for (int ai = 0; ai < 2; ++ai)
#pragma unroll
                for (int m = 0; m < 4; ++m) { bf16_t* rowp = obase + (size_t)(ai * HALF + m * 16) * 2304;
#pragma unroll
                    for (int bj = 0; bj < 2; ++bj) *(u32x4*)(rowp + 32 * bj) = pack8(acc[ai][bj][m][0], acc[ai][bj][m][1]); }
        }
    }
};
struct EpiOut {
    static constexpr bool PERM = true, AFTER_DRAIN = false;
    const float* xp; const float* xs; bf16_t* xb; float* ssq;
    __device__ __forceinline__ void operator()(f32x4 (&acc)[2][2][4][2], const Unit& u, int wr, int wc, int fr, int fq, int wid, int lane) const {
        const int col0 = u.pn * BM + wc * 32 + 8 * fq;
#pragma unroll
        for (int ai = 0; ai < 2; ++ai) {
            f32x4 xv[4][2][2];
#pragma unroll
            for (int m = 0; m < 4; ++m) { const int gr = u.pm * BM + ai * HALF + wr * 64 + m * 16 + fr;
                const float* xr = (gr < MPROMPT ? xp + (size_t)gr * DMODEL : xs + (size_t)(gr - MPROMPT) * DMODEL) + col0;
#pragma unroll
                for (int bj = 0; bj < 2; ++bj) { xv[m][bj][0] = *(const f32x4*)(xr + bj * HALF); xv[m][bj][1] = *(const f32x4*)(xr + bj * HALF + 4); } }
#pragma unroll
            for (int m = 0; m < 4; ++m) { const int gr = u.pm * BM + ai * HALF + wr * 64 + m * 16 + fr;
                float s = 0.f;
#pragma unroll
                for (int bj = 0; bj < 2; ++bj) { const f32x4 a = xv[m][bj][0] + acc[ai][bj][m][0], b = xv[m][bj][1] + acc[ai][bj][m][1];
                    s += (a[0] * a[0] + a[1] * a[1]) + (a[2] * a[2] + a[3] * a[3]) + (b[0] * b[0] + b[1] * b[1]) + (b[2] * b[2] + b[3] * b[3]);
                    *(u32x4*)(xb + (size_t)gr * DMODEL + col0 + bj * HALF) = pack8(a, b); }
                s += __shfl_xor(s, 16); s += __shfl_xor(s, 32);
                if (fq == 0) unsafeAtomicAdd(ssq + gr, s); }
            asm volatile("" ::: "memory");
        }
    }
};
struct EpiDown {
    static constexpr bool PERM = true, AFTER_DRAIN = false;
    const bf16_t* xb; float* out;
    __device__ __forceinline__ void operator()(f32x4 (&acc)[2][2][4][2], const Unit& u, int wr, int wc, int fr, int fq, int wid, int lane) const {
        const int col0 = u.pn * BM + wc * 32 + 8 * fq; const int gr0 = u.pm * BM + wr * 64 + fr;
        u32x4 w[2][4][2];
#pragma unroll
        for (int ai = 0; ai < 2; ++ai)
#pragma unroll
            for (int m = 0; m < 4; ++m)
#pragma unroll
                for (int bj = 0; bj < 2; ++bj) w[ai][m][bj] = *(const u32x4*)(xb + (size_t)(gr0 + ai * HALF + m * 16) * DMODEL + col0 + bj * HALF);
#pragma unroll
        for (int ai = 0; ai < 2; ++ai)
#pragma unroll
            for (int m = 0; m < 4; ++m) { float* o = out + (size_t)(gr0 + ai * HALF + m * 16) * DMODEL + col0;
#pragma unroll
                for (int bj = 0; bj < 2; ++bj) { const u32x4 v = w[ai][m][bj];
                    f32x4 a = {__uint_as_float(v.x << 16), __uint_as_float(v.x & 0xffff0000u), __uint_as_float(v.y << 16), __uint_as_float(v.y & 0xffff0000u)};
                    f32x4 b = {__uint_as_float(v.z << 16), __uint_as_float(v.z & 0xffff0000u), __uint_as_float(v.w << 16), __uint_as_float(v.w & 0xffff0000u)};
                    a += acc[ai][bj][m][0]; b += acc[ai][bj][m][1]; *(f32x4*)(o + bj * HALF) = a; *(f32x4*)(o + bj * HALF + 4) = b; } }
    }
};
__device__ __forceinline__ bool seq_first(int gr) { return gr == 0 || (gr >= MPROMPT && (gr & 2047) == 0); }
__device__ __forceinline__ bool seq_last(int gr) { return gr >= MPROMPT - 1 && (gr & 2047) == 2047; }
struct EpiUp {
    static constexpr bool PERM = true, AFTER_DRAIN = false;
    bf16_t* H; const float* ssq; const float* cw; const float* cb; PG8_LAS float* xch;
    __device__ __forceinline__ void operator()(f32x4 (&acc)[2][2][4][2], const Unit& u, int wr, int wc, int fr, int fq, int wid, int lane) const {
        const int lr0 = wr * 64 + fr, gr0 = 254 * u.pm - 1 + lr0;
#pragma unroll
        for (int ai = 0; ai < 2; ++ai)
#pragma unroll
            for (int m = 0; m < 4; ++m) { int gr = gr0 + ai * HALF + m * 16; gr = gr < 0 ? 0 : (gr > MTOK - 1 ? MTOK - 1 : gr);
                const float rs = __builtin_amdgcn_rsqf(ssq[gr] * (1.0f / DMODEL) + 1e-6f);
#pragma unroll
                for (int bj = 0; bj < 2; ++bj)
#pragma unroll
                    for (int n = 0; n < 2; ++n) acc[ai][bj][m][n] *= rs; }
#pragma unroll
        for (int ai = 0; ai < 2; ++ai) {
            if (fr == 0) { PG8_LAS float* p = xch + ((wid * 2 + ai) * 2 + 0) * 64 + 8 * fq;
#pragma unroll
                for (int bj = 0; bj < 2; ++bj)
#pragma unroll
                    for (int n = 0; n < 2; ++n) *(PG8_LAS f32x4*)(p + bj * 32 + 4 * n) = acc[ai][bj][0][n]; }
            if (fr == 15) { PG8_LAS float* p = xch + ((wid * 2 + ai) * 2 + 1) * 64 + 8 * fq;
#pragma unroll
                for (int bj = 0; bj < 2; ++bj)
#pragma unroll
                    for (int n = 0; n < 2; ++n) *(PG8_LAS f32x4*)(p + bj * 32 + 4 * n) = acc[ai][bj][3][n]; }
        }
        asm volatile("s_waitcnt lgkmcnt(0)" ::: "memory"); __builtin_amdgcn_s_barrier(); asm volatile("" ::: "memory");
        const int tlo = 254 * u.pm - 1, thi = tlo + 255; const bool anyb = (tlo <= 0) || (((thi + 1) >> 11) != ((tlo - 1) >> 11));
        const int ow = (1 - wr) * 4 + wc;
        const int ch0 = 128 * u.pn + 32 * wc + 8 * fq;
#pragma unroll
        for (int n = 0; n < 2; ++n) {
            f32x4 w0[2], w1[2], w2[2], bb[2];
#pragma unroll
            for (int bj = 0; bj < 2; ++bj) { const int ch = ch0 + 4 * n + bj * DFF_;
                w0[bj] = *(const f32x4*)(cw + ch); w1[bj] = *(const f32x4*)(cw + 2 * DFF_ + ch); w2[bj] = *(const f32x4*)(cw + 4 * DFF_ + ch); bb[bj] = *(const f32x4*)(cb + ch); }
#pragma unroll
            for (int ai = 0; ai < 2; ++ai) {
                const int aiT = wr == 1 ? ai : ai - 1, aiB = wr == 0 ? ai : ai + 1;
#pragma unroll
                for (int m = 0; m < 4; ++m) {
                    const int lr = lr0 + ai * HALF + m * 16, gr = gr0 + ai * HALF + m * 16;
                    const bool first = seq_first(gr), last = seq_last(gr);
                    f32x4 c[2];
#pragma unroll
                    for (int bj = 0; bj < 2; ++bj) {
                        const f32x4 cur = acc[ai][bj][m][n];
                        f32x4 pv, nx;
#pragma unroll
                        for (int e = 0; e < 4; ++e) {
                            const float sP = (m > 0 && fr == 15) ? acc[ai][bj][m > 0 ? m - 1 : 0][n][e] : cur[e];
                            const float sN = (m < 3 && fr == 0) ? acc[ai][bj][m < 3 ? m + 1 : 3][n][e] : cur[e];
                            pv[e] = __builtin_bit_cast(float, __builtin_amdgcn_mov_dpp(__builtin_bit_cast(int, sP), 0x121  , 0xf, 0xf, true));
                            nx[e] = __builtin_bit_cast(float, __builtin_amdgcn_mov_dpp(__builtin_bit_cast(int, sN), 0x12f  , 0xf, 0xf, true)); }
                        if (m == 0) { const f32x4 top = (aiT >= 0) ? *(const PG8_LAS f32x4*)(xch + ((ow * 2 + (aiT < 0 ? 0 : aiT)) * 2 + 1) * 64 + 8 * fq + bj * 32 + 4 * n) : (f32x4){0.f, 0.f, 0.f, 0.f}; if (fr == 0) pv = top; }
                        if (m == 3) { const f32x4 bot = (aiB <= 1) ? *(const PG8_LAS f32x4*)(xch + ((ow * 2 + (aiB > 1 ? 1 : aiB)) * 2 + 0) * 64 + 8 * fq + bj * 32 + 4 * n) : (f32x4){0.f, 0.f, 0.f, 0.f}; if (fr == 15) nx = bot; }
                        if (anyb) { if (first) pv = (f32x4){0.f, 0.f, 0.f, 0.f}; if (last) nx = (f32x4){0.f, 0.f, 0.f, 0.f}; }
                        c[bj] = bb[bj] + w0[bj] * pv + w1[bj] * cur + w2[bj] * nx;
                    }
                    f32x4 hv;
#pragma unroll
                    for (int e = 0; e < 4; ++e) { const float g = c[0][e]; hv[e] = g * __builtin_amdgcn_rcpf(1.0f + __builtin_amdgcn_exp2f(-1.4426950408889634f * g)) * c[1][e]; }
                    f32x2 pk; pk.x = __builtin_bit_cast(float, cvtpk(hv[0], hv[1])); pk.y = __builtin_bit_cast(float, cvtpk(hv[2], hv[3]));
                    if (lr >= 1 && lr <= 254 && gr < MTOK) *(f32x2*)(H + (size_t)gr * DFF_ + ch0 + 4 * n) = pk;
                    asm volatile("" ::: "memory");
                }
            }
        }
    }
};
template <class Epi, class Sched, bool ALIGN_EPI = false, bool SP2 = false>
__device__ __forceinline__ void gemm_phase(PG8_LAS unsigned char* lds, const Gemm g, const Sched& S, const Epi& E) {
    int tid_ = threadIdx.x; asm volatile("" : "+v"(tid_));
    const int tid = tid_, wid = __builtin_amdgcn_readfirstlane(tid >> 6), lane = tid & 63, wr = wid >> 2, wc = wid & 3, fr = lane & 15, fq = lane >> 4;
    const int K = g.K, nt = K / BK;
    unsigned voffA[2], voffB[2];
#pragma unroll
    for (int i = 0; i < 2; ++i) { int R, C; stage_rc(tid * 16 + i * 8192, R, C); const int Rb = Epi::PERM ? ((R & ~31) + perm32(R & 31)) : R;
        voffA[i] = (unsigned)(R * K + C) * 2u; voffB[i] = (unsigned)(Rb * K + C) * 2u; }
    const size_t kstep = (size_t)(BK * 2);
    const size_t hstep = (size_t)HALF * K * 2;
    const size_t tstep = 2 * hstep; const size_t tstepA = (size_t)g.a_tile_rows * K * 2;
    const unsigned ldsw = (unsigned)wid * 1024u;
    const int aoff = lds_byte(wr * 64 + fr, fq * 8), boff = lds_byte(wc * 32 + fr, fq * 8);
#define PG8_SA(b, h) (((b) * 2 + (h)) * HTB)
#define PG8_SB(b, h) ((4 + (b) * 2 + (h)) * HTB)
#define PG8_STAGE(bufoff, gbase, voff) do { _Pragma("unroll") for (int _i = 0; _i < 2; ++_i) \
        __builtin_amdgcn_global_load_lds((const unsigned*)((const char*)(gbase) + (voff)[_i]), (PG8_LAS unsigned*)(lds + (bufoff) + ldsw + _i * 8192), 16, 0, 0); } while (0)
#define PG8_LDA(dst, b, h) do { _Pragma("unroll") for (int m = 0; m < 4; ++m) _Pragma("unroll") for (int k = 0; k < 2; ++k) dst[m][k] = *(const PG8_LAS bf16x8*)(lds + PG8_SA(b, h) + aoff + m * 2048 + k * 1024); } while (0)
#define PG8_LDB(dst, b, h) do { _Pragma("unroll") for (int n = 0; n < 2; ++n) _Pragma("unroll") for (int k = 0; k < 2; ++k) dst[n][k] = *(const PG8_LAS bf16x8*)(lds + PG8_SB(b, h) + boff + n * 2048 + k * 1024); } while (0)
#define PG8_MMA(ai, bj, At, Bt) do { __builtin_amdgcn_s_setprio(1); _Pragma("unroll") for (int m = 0; m < 4; ++m) _Pragma("unroll") for (int n = 0; n < 2; ++n) _Pragma("unroll") for (int k = 0; k < 2; ++k) \
        acc[ai][bj][m][n] = __builtin_amdgcn_mfma_f32_16x16x32_bf16(Bt[n][k], At[m][k], acc[ai][bj][m][n], 0, 0, 0); __builtin_amdgcn_s_setprio(0); } while (0)
#define PG8_WAIT_V(n) asm volatile("s_waitcnt vmcnt(" #n ")" ::: "memory")
#define PG8_WAIT_L(n) asm volatile("s_waitcnt lgkmcnt(" #n ")" ::: "memory")
#define PG8_BAR __builtin_amdgcn_s_barrier()
#define PG8_SCHED __builtin_amdgcn_sched_barrier(0)
    Unit cur, nxt; int ui = 0;
    if (!S.next(0, cur)) return;
    f32x4 acc[2][2][4][2];
#pragma unroll
    for (int a = 0; a < 2; ++a)
#pragma unroll
        for (int b = 0; b < 2; ++b)
#pragma unroll
            for (int m = 0; m < 4; ++m)
#pragma unroll
                for (int n = 0; n < 2; ++n) acc[a][b][m][n] = (f32x4){0.f, 0.f, 0.f, 0.f};
    bf16x8 At[4][2], B0[2][2], B1[2][2];
    const char* cA = (const char*)g.A + (size_t)cur.pm * tstepA; const char* cB = (const char*)g.Bt + (size_t)cur.pn * tstep;
    S.a_ready(cur);
    if constexpr (SP2) {
        PG8_STAGE(PG8_SB(0, 0), cB, voffB); PG8_STAGE(PG8_SB(0, 1), cB + hstep, voffB); PG8_STAGE(PG8_SA(0, 0), cA, voffA); PG8_STAGE(PG8_SA(0, 1), cA + hstep, voffA);
        if (wr == 1) PG8_BAR;
        PG8_WAIT_V(2); PG8_BAR;
        PG8_STAGE(PG8_SB(1, 0), cB + kstep, voffB); PG8_STAGE(PG8_SA(1, 0), cA + kstep, voffA); PG8_STAGE(PG8_SB(1, 1), cB + hstep + kstep, voffB);
        PG8_WAIT_V(6); PG8_BAR;
    } else {
        PG8_STAGE(PG8_SB(0, 0), cB, voffB); PG8_STAGE(PG8_SA(0, 0), cA, voffA); PG8_STAGE(PG8_SB(0, 1), cB + hstep, voffB); PG8_STAGE(PG8_SA(0, 1), cA + hstep, voffA);
        if (wr == 1) PG8_BAR;
        PG8_WAIT_V(4); PG8_BAR;
        PG8_STAGE(PG8_SB(1, 0), cB + kstep, voffB); PG8_STAGE(PG8_SA(1, 0), cA + kstep, voffA); PG8_STAGE(PG8_SB(1, 1), cB + hstep + kstep, voffB);
        PG8_WAIT_V(6); PG8_BAR;
    }
    for (;;) {
        const bool has_next = S.next(ui + 1, nxt);
        const char* nA = has_next ? (const char*)g.A + (size_t)nxt.pm * tstepA : cA; const char* nB = has_next ? (const char*)g.Bt + (size_t)nxt.pn * tstep : cB;
        for (int t = 0; t < nt; t += 2) {
            const bool last = (t == nt - 2);
            const char* a1 = cA + (size_t)(t + 1) * kstep;
            const char* a2 = last ? nA : cA + (size_t)(t + 2) * kstep; const char* b2 = last ? nB : cB + (size_t)(t + 2) * kstep;
            const char* a3 = a2 + kstep; const char* b3 = b2 + kstep;
            if (last && has_next) S.a_ready(nxt);
            if constexpr (SP2) {
            PG8_LDB(B0, 0, 0); PG8_LDB(B1, 0, 1); PG8_SCHED; PG8_LDA(At, 0, 0); PG8_STAGE(PG8_SA(1, 1), a1 + hstep, voffA);
            PG8_WAIT_V(8); PG8_WAIT_L(0); PG8_BAR; PG8_MMA(0, 0, At, B0); PG8_MMA(0, 1, At, B1); PG8_BAR; PG8_SCHED;
            PG8_LDA(At, 0, 1); PG8_STAGE(PG8_SB(0, 0), b2, voffB); PG8_STAGE(PG8_SB(0, 1), b2 + hstep, voffB); PG8_STAGE(PG8_SA(0, 0), a2, voffA);
            PG8_WAIT_V(8); PG8_WAIT_L(0); PG8_BAR; PG8_MMA(1, 0, At, B0); PG8_MMA(1, 1, At, B1); PG8_BAR; PG8_SCHED;
            PG8_LDB(B0, 1, 0); PG8_LDB(B1, 1, 1); PG8_SCHED; PG8_LDA(At, 1, 0); PG8_STAGE(PG8_SA(0, 1), a2 + hstep, voffA);
            PG8_WAIT_V(8); PG8_WAIT_L(0); PG8_BAR; PG8_MMA(0, 0, At, B0); PG8_MMA(0, 1, At, B1); PG8_BAR; PG8_SCHED;
            PG8_LDA(At, 1, 1); PG8_STAGE(PG8_SB(1, 0), b3, voffB); PG8_STAGE(PG8_SB(1, 1), b3 + hstep, voffB); PG8_STAGE(PG8_SA(1, 0), a3, voffA);
            PG8_WAIT_V(8); PG8_WAIT_L(0); PG8_BAR; PG8_MMA(1, 0, At, B0); PG8_MMA(1, 1, At, B1); PG8_BAR; PG8_SCHED;
            } else {
            PG8_LDB(B0, 0, 0); PG8_SCHED; PG8_LDA(At, 0, 0); PG8_STAGE(PG8_SA(1, 1), a1 + hstep, voffA);
            PG8_WAIT_L(8); PG8_BAR; PG8_WAIT_L(0); PG8_MMA(0, 0, At, B0); PG8_BAR; PG8_SCHED;
            PG8_LDB(B1, 0, 1); PG8_STAGE(PG8_SB(0, 0), b2, voffB);
            PG8_BAR; PG8_WAIT_L(0); PG8_MMA(0, 1, At, B1); PG8_BAR;
            PG8_LDA(At, 0, 1); PG8_STAGE(PG8_SA(0, 0), a2, voffA);
            PG8_BAR; PG8_WAIT_L(0); PG8_MMA(1, 0, At, B0); PG8_BAR; PG8_SCHED;
            PG8_STAGE(PG8_SB(0, 1), b2 + hstep, voffB);
            PG8_WAIT_V(6); PG8_BAR; PG8_MMA(1, 1, At, B1); PG8_BAR;
            PG8_LDB(B0, 1, 0); PG8_SCHED; PG8_LDA(At, 1, 0); PG8_STAGE(PG8_SA(0, 1), a2 + hstep, voffA);
            PG8_WAIT_L(8); PG8_BAR; PG8_WAIT_L(0); PG8_MMA(0, 0, At, B0); PG8_BAR; PG8_SCHED;
            PG8_LDB(B1, 1, 1); PG8_STAGE(PG8_SB(1, 0), b3, voffB);
            PG8_BAR; PG8_WAIT_L(0); PG8_MMA(0, 1, At, B1); PG8_BAR;
            PG8_LDA(At, 1, 1); PG8_STAGE(PG8_SA(1, 0), a3, voffA);
            PG8_BAR; PG8_WAIT_L(0); PG8_MMA(1, 0, At, B0); PG8_BAR; PG8_SCHED;
            PG8_STAGE(PG8_SB(1, 1), b3 + hstep, voffB);
            PG8_WAIT_V(6); PG8_BAR; PG8_MMA(1, 1, At, B1); PG8_BAR;
            }
        }
        if constexpr (ALIGN_EPI) { if (wr == 0) PG8_BAR; }
        if constexpr (!Epi::AFTER_DRAIN) { E(acc, cur, wr, wc, fr, fq, wid, lane); S.done(cur); }
        if (!has_next) break;
#pragma unroll
        for (int a = 0; a < 2; ++a)
#pragma unroll
            for (int b = 0; b < 2; ++b)
#pragma unroll
                for (int m = 0; m < 4; ++m)
#pragma unroll
                    for (int n = 0; n < 2; ++n) acc[a][b][m][n] = (f32x4){0.f, 0.f, 0.f, 0.f};
        cur = nxt; cA = nA; cB = nB; ++ui;
        if constexpr (ALIGN_EPI) { if (wr == 1) PG8_BAR; }
    }
    PG8_WAIT_V(0);
    if constexpr (!ALIGN_EPI) { if (wr == 0) PG8_BAR; }
    PG8_BAR;
    if constexpr (Epi::AFTER_DRAIN) { E.fused(acc, cur, wr, wc, fr, fq, lds, wid, lane); S.done(cur); }
#undef PG8_SA
#undef PG8_SB
#undef PG8_STAGE
#undef PG8_LDA
#undef PG8_LDB
#undef PG8_MMA
#undef PG8_WAIT_V
#undef PG8_WAIT_L
#undef PG8_BAR
#undef PG8_SCHED
}
}
#ifndef PG8_SP2
#define PG8_SP2 true
#endif
#ifndef PG8_ALIGN
#define PG8_ALIGN true
#endif

constexpr int NWAVES = 8;
constexpr int DM = 1024, M = 49152, MP = 16384, INW = 2304, DFF = 2816, UPW = 5632;
constexpr int QA_OFF = 0, KA_OFF = 512, VA_OFF = 1024, QB_OFF = 1536, KB_OFF = 2048, VB_OFF = 2176;
constexpr int UP_TILES_M = 194;
constexpr float EPS = 1e-6f, LOG2E = 1.4426950408889634f;

constexpr size_t MiB = 1u << 20;
constexpr size_t WS_SSQ = 0;
constexpr size_t WS_BAR = 1 * MiB;
constexpr size_t WS_WIN = 2 * MiB, WS_WOUT = 7 * MiB, WS_WUP = 9 * MiB, WS_WDN = 20 * MiB;
constexpr size_t WS_XN = 32 * MiB;
constexpr size_t WS_PROJ = 130 * MiB;
constexpr size_t WS_OA = 346 * MiB;
constexpr size_t WS_H = 226 * MiB;
constexpr size_t WS_LA = 490 * MiB;
constexpr size_t WS_END = 496 * MiB;
static_assert(WS_XN + (size_t)(M + 256) * DM * 2 <= WS_PROJ && WS_PROJ + (size_t)M * INW * 2 <= WS_OA && WS_OA + 3 * (size_t)M * 512 * 2 <= WS_LA && WS_H + (size_t)M * DFF * 2 <= WS_LA && WS_PROJ + (size_t)M * DM * 2 <= WS_H, "d_ws map");

constexpr int RING_BYTES = 131072, XCH_OFF = RING_BYTES, MISC_OFF = XCH_OFF + 8192, LDS_BYTES = 147456;

#define LAS __attribute__((address_space(3)))
typedef unsigned short bf16;
typedef unsigned v4u __attribute__((ext_vector_type(4)));
typedef float f32x4 __attribute__((ext_vector_type(4)));
typedef float f32x16 __attribute__((ext_vector_type(16)));
typedef short bf16x8 __attribute__((ext_vector_type(8)));
typedef short s16x4 __attribute__((ext_vector_type(4)));
using pg8::cvtpk;
__device__ __forceinline__ float bf_lo(unsigned w) { return __uint_as_float(w << 16); }
__device__ __forceinline__ float bf_hi(unsigned w) { return __uint_as_float(w & 0xffff0000u); }
__device__ __forceinline__ float wave_sum(float v) {
#pragma unroll
    for (int o = 1; o < 64; o <<= 1) v += __shfl_xor(v, o);
    return v;
}
__device__ __forceinline__ float wave_max(float v) {
#pragma unroll
    for (int o = 1; o < 64; o <<= 1) v = fmaxf(v, __shfl_xor(v, o));
    return v;
}

#define GAS __attribute__((address_space(1)))
#define RLX_AGENT __ATOMIC_RELAXED, __HIP_MEMORY_SCOPE_AGENT
#define XB_TMO      128
#define XB_XCNT(j)  (256  + 64 * (j))
#define XB_XSUB(j)  (1280 + 64 * (j))
#define XB_XGEN(j)  (2304 + 64 * (j))
#define XB_TOP      3328
#define XB_TOPGEN   3392
#define XCD_BAR_WORDS 3456
#define XB_SPIN_CAP (1u << 18)

__device__ __forceinline__ unsigned xb_ld(unsigned* p)              { return __hip_atomic_load(p, __ATOMIC_RELAXED, __HIP_MEMORY_SCOPE_AGENT); }
__device__ __forceinline__ unsigned xb_add(unsigned* p, unsigned v) { return __hip_atomic_fetch_add(p, v, __ATOMIC_RELAXED, __HIP_MEMORY_SCOPE_AGENT); }
__device__ __forceinline__ unsigned xb_xcc_id() { return (unsigned)__builtin_amdgcn_s_getreg((3 << 11) | 20) & 0xFu; }
#define XB_SPIN(cond, bar) do { unsigned _sp = 0; while (cond) { __builtin_amdgcn_s_sleep(1); \
    if ((++_sp & 255u) == 0u) { if (xb_ld(&(bar)[XB_TMO])) break; if (_sp > XB_SPIN_CAP) { atomicAdd(&(bar)[XB_TMO], 1u); break; } } } } while (0)

struct XcdBarrier {
    unsigned* bar; unsigned x;
    volatile LAS unsigned* st;
};

__device__ __forceinline__ XcdBarrier xcd_barrier_post(unsigned* bar, volatile LAS unsigned* st) {
    XcdBarrier b; b.bar = bar; b.x = xb_xcc_id(); b.st = st;
    if (threadIdx.x == 0) (void)xb_add(&bar[XB_XCNT(b.x)], 1u);
    return b;
}
__device__ __forceinline__ void xcd_barrier_complete(unsigned* bar, unsigned x, unsigned& nloc, unsigned& nx) {
    const unsigned G = gridDim.x * gridDim.y * gridDim.z;
    unsigned sum, cnt, mine, sp = 0u;
    for (;;) {
        sum = 0u; cnt = 0u; mine = 0u;
#pragma unroll
        for (unsigned j = 0; j < 16; ++j) { const unsigned c = xb_ld(&bar[XB_XCNT(j)]); sum += c; cnt += (c > 0u) ? 1u : 0u; mine = (j == x) ? c : mine; }
        if (sum == G) break;
        __builtin_amdgcn_s_sleep(1);
        if ((++sp & 255u) == 0u) { if (xb_ld(&bar[XB_TMO])) break; if (sp > XB_SPIN_CAP) { atomicAdd(&bar[XB_TMO], 1u); break; } }
    }
    nloc = mine > 0u ? mine : 1u; nx = cnt > 0u ? cnt : 1u;
}

__device__ __forceinline__ void xcd_barrier(const XcdBarrier& b) {
    asm volatile("s_waitcnt vmcnt(0)" ::: "memory");
    __syncthreads();
    if (threadIdx.x == 0) {
        unsigned* bar = b.bar;
        __builtin_amdgcn_s_waitcnt(0);
        unsigned nloc = b.st[0], nx = b.st[1];
        if (nloc == 0u) { xcd_barrier_complete(bar, b.x, nloc, nx); b.st[0] = nloc; b.st[1] = nx; }
        const unsigned old = xb_add(&bar[XB_XSUB(b.x)], 1u);
        const unsigned gen = old / nloc;
        if (old + 1u == (gen + 1u) * nloc) {
            __builtin_amdgcn_fence(__ATOMIC_RELEASE, "agent");
            asm volatile("s_waitcnt vmcnt(0)" ::: "memory");
            const unsigned og = xb_add(&bar[XB_TOP], 1u);
            const unsigned tg = og / nx;
            if (og + 1u == (tg + 1u) * nx) xb_add(&bar[XB_TOPGEN], 1u);
            else XB_SPIN(xb_ld(&bar[XB_TOPGEN]) == tg, bar);
            __builtin_amdgcn_fence(__ATOMIC_ACQUIRE, "agent");
            xb_add(&bar[XB_XGEN(b.x)], 1u);
            asm volatile("s_waitcnt vmcnt(0)" ::: "memory");
        } else {
            XB_SPIN(xb_ld(&bar[XB_XGEN(b.x)]) == gen, bar);
            __builtin_amdgcn_fence(__ATOMIC_ACQUIRE, "agent");
            asm volatile("s_waitcnt vmcnt(0)" ::: "memory");
        }
    }
    __syncthreads();
}

template <int MAP  >
__device__ __forceinline__ void p0_transpose_item(const float* W, int K, int N, bf16* WT, const float* kgain, LAS float* scr, int item, int lane) {
    const int nblk = N / 32, kb = item / nblk, nb = item % nblk, k0 = 64 * kb, n0 = 32 * nb;
#pragma unroll 8
    for (int i = 0; i < 32; ++i) { const int kk = 2 * i + (lane >> 5); float v = W[(size_t)(k0 + kk) * N + n0 + (lane & 31)]; if (kgain) v *= kgain[k0 + kk]; scr[kk * 33 + (lane & 31)] = v; }
    asm volatile("s_waitcnt lgkmcnt(0)" ::: "memory");
    const int c = lane & 7;
    int r0 = n0;
    if (MAP == 2) { const int hs = n0 >> 6; r0 = 256 * (hs >> 2) + 128 * ((n0 >> 5) & 1) + 32 * (hs & 3); }
    if (MAP == 1) r0 = n0 < DFF ? ((n0 >> 7) * 256 + (n0 & 127)) : ((((n0 - DFF) >> 7) * 256) + 128 + ((n0 - DFF) & 127));
#pragma unroll
    for (int j = 0; j < 4; ++j) { const int n = (lane >> 3) + 8 * j; const LAS float* s = scr + (8 * c) * 33 + n;
        v4u o; o.x = cvtpk(s[0 * 33], s[1 * 33]); o.y = cvtpk(s[2 * 33], s[3 * 33]); o.z = cvtpk(s[4 * 33], s[5 * 33]); o.w = cvtpk(s[6 * 33], s[7 * 33]);
        *(v4u*)(WT + (size_t)(r0 + n) * K + k0 + 8 * c) = o; }
    asm volatile("s_waitcnt lgkmcnt(0)" ::: "memory");
}
__device__ __forceinline__ void rms_rows4_to_bf16(const float* xrow, const float* g, bf16* orow, int lane) {
    f32x4 v[4][4]; float s[4];
#pragma unroll
    for (int k = 0; k < 4; ++k)
#pragma unroll
        for (int j = 0; j < 4; ++j) v[k][j] = ((const f32x4*)(xrow + (size_t)k * DM) + lane)[64 * j];
    f32x4 gg[4];
#pragma unroll
    for (int j = 0; j < 4; ++j) gg[j] = ((const f32x4*)g + lane)[64 * j];
#pragma unroll
    for (int k = 0; k < 4; ++k) { s[k] = 0.f;
#pragma unroll
        for (int j = 0; j < 4; ++j) s[k] += (v[k][j].x * v[k][j].x + v[k][j].y * v[k][j].y) + (v[k][j].z * v[k][j].z + v[k][j].w * v[k][j].w); }
#pragma unroll
    for (int o = 1; o < 64; o <<= 1) {
#pragma unroll
        for (int k = 0; k < 4; ++k) s[k] += __shfl_xor(s[k], o); }
#pragma unroll
    for (int k = 0; k < 4; ++k) { const float rstd = __builtin_amdgcn_rsqf(s[k] * (1.f / DM) + EPS);
        unsigned long long* o8 = (unsigned long long*)(orow + (size_t)k * DM) + lane;
#pragma unroll
        for (int j = 0; j < 4; ++j) o8[64 * j] = (unsigned long long)cvtpk(v[k][j].x * rstd * gg[j].x, v[k][j].y * rstd * gg[j].y) | ((unsigned long long)cvtpk(v[k][j].z * rstd * gg[j].z, v[k][j].w * rstd * gg[j].w) << 32); }
}

template <int NKEYS, int NTHR>
__device__ __forceinline__ void stage_load(v4u (&kr)[NKEYS * 8 / NTHR], v4u (&vr)[NKEYS * 8 / NTHR], const bf16* proj, int kcol, int vcol, int tok0, int dshift, int kidx0, int Ls, int t) {
    constexpr int NIT = NKEYS * 8 / NTHR;
    const int c = t & 7;
#pragma unroll
    for (int it = 0; it < NIT; ++it) { const int rho = (it * NTHR + t) >> 3, kidx = kidx0 + rho; const bool ok = (unsigned)kidx < (unsigned)Ls;
        const bf16* rowp = proj + (size_t)(tok0 + ((ok ? kidx : 0) << dshift)) * INW + 8 * c;
        kr[it] = *(const v4u*)(rowp + kcol); vr[it] = *(const v4u*)(rowp + vcol); }
}
template <int NKEYS, int NTHR>
__device__ __forceinline__ void stage_write(const v4u (&kr)[NKEYS * 8 / NTHR], const v4u (&vr)[NKEYS * 8 / NTHR], LAS unsigned char* Kl, LAS unsigned char* Vl, int t) {
    constexpr int NIT = NKEYS * 8 / NTHR;
    const int c = t & 7;
#pragma unroll
    for (int it = 0; it < NIT; ++it) { const int rho = (it * NTHR + t) >> 3;
        *(LAS v4u*)(Kl + rho * 128 + 16 * (c ^ ((rho >> 1) & 7))) = kr[it];
        *(LAS v4u*)(Vl + (c >> 2) * (NKEYS * 64) + rho * 64 + (c & 3) * 16) = vr[it]; }
}
__device__ __forceinline__ void load_q_raw(v4u (&raw)[4], const bf16* qrow, int lane) {
#pragma unroll
    for (int d0 = 0; d0 < 4; ++d0) raw[d0] = *(const v4u*)(qrow + 16 * d0 + 8 * (lane >> 5));
}
typedef short v4i16_t __attribute__((ext_vector_type(4)));
__device__ __forceinline__ s16x4 vtr(const LAS unsigned char* p) { return __builtin_bit_cast(s16x4, __builtin_amdgcn_ds_read_tr16_b64_v4i16((LAS v4i16_t*)p)); }
template <int R, bool BAND, bool EDGE, bool SAFE>
__device__ __forceinline__ void attn_tile(const bf16x8 (&kf)[4], unsigned vaddr, int vhs, int j, int kidx_t0, int Ls, const bf16x8 (&qf)[4], float base, float nslope, float negM, f32x16 (&o)[2], float& l, int hi) {
    s16x4 vl[4], vh[4];
    asm volatile("ds_read_b64_tr_b16 %0, %8\n\tds_read_b64_tr_b16 %1, %8 offset:512\n\tds_read_b64_tr_b16 %2, %8 offset:1024\n\tds_read_b64_tr_b16 %3, %8 offset:1536\n\t"
                 "ds_read_b64_tr_b16 %4, %9\n\tds_read_b64_tr_b16 %5, %9 offset:512\n\tds_read_b64_tr_b16 %6, %9 offset:1024\n\tds_read_b64_tr_b16 %7, %9 offset:1536"
                 : "=&v"(vl[0]), "=&v"(vh[0]), "=&v"(vl[1]), "=&v"(vh[1]), "=&v"(vl[2]), "=&v"(vh[2]), "=&v"(vl[3]), "=&v"(vh[3]) : "v"(vaddr), "v"(vaddr + (unsigned)vhs) : "memory");
    f32x16 s = {0.f, 0.f, 0.f, 0.f, 0.f, 0.f, 0.f, 0.f, 0.f, 0.f, 0.f, 0.f, 0.f, 0.f, 0.f, 0.f};
#pragma unroll
    for (int d0 = 0; d0 < 4; ++d0) s = __builtin_amdgcn_mfma_f32_32x32x16_bf16(kf[d0], qf[d0], s, 0, 0, 0);
    if (SAFE) {
#pragma unroll
        for (int r = 0; r < 16; ++r) s[r] += negM; }
    const float basej = base + (float)(32 * j);
    float pr[16];
#pragma unroll
    for (int r = 0; r < 16; ++r) { const float relf = basej + (float)((r & 3) + 8 * (r >> 2));
        float p = __builtin_amdgcn_exp2f(__builtin_fmaf(__builtin_fabsf(relf), nslope, s[r]));
        if (BAND) p = (__builtin_fabsf(relf) <= (float)R) ? p : 0.f;
        if (EDGE) { const int kidx = kidx_t0 + 32 * j + (r & 3) + 8 * (r >> 2) + 4 * hi; p = ((unsigned)kidx < (unsigned)Ls) ? p : 0.f; }
        l += p; pr[r] = p; }
    v4u w0, w1; w0.x = cvtpk(pr[0], pr[1]); w0.y = cvtpk(pr[2], pr[3]); w0.z = cvtpk(pr[4], pr[5]); w0.w = cvtpk(pr[6], pr[7]);
    w1.x = cvtpk(pr[8], pr[9]); w1.y = cvtpk(pr[10], pr[11]); w1.z = cvtpk(pr[12], pr[13]); w1.w = cvtpk(pr[14], pr[15]);
    const bf16x8 pa0 = __builtin_bit_cast(bf16x8, w0), pa1 = __builtin_bit_cast(bf16x8, w1);
    asm volatile("s_waitcnt lgkmcnt(0)" : "+v"(vl[0]), "+v"(vh[0]), "+v"(vl[1]), "+v"(vh[1]), "+v"(vl[2]), "+v"(vh[2]), "+v"(vl[3]), "+v"(vh[3]) :: "memory");
#pragma unroll
    for (int dh = 0; dh < 2; ++dh)
#pragma unroll
        for (int s2 = 0; s2 < 2; ++s2) { const s16x4 lo = vl[2 * dh + s2], h4 = vh[2 * dh + s2];
            const bf16x8 vf = (bf16x8){lo[0], lo[1], lo[2], lo[3], h4[0], h4[1], h4[2], h4[3]};
            o[dh] = __builtin_amdgcn_mfma_f32_32x32x16_bf16(vf, s2 ? pa1 : pa0, o[dh], 0, 0, 0); }
}
template <int NT, int R, bool EDGE, bool SAFE>
__device__ __forceinline__ void attn_task(const LAS unsigned char* Kl, const LAS unsigned char* Vl, int vhs, int row0, int kidx_t0, int Ls, const bf16x8 (&qf)[4], float slope2, float negM, f32x16 (&o)[2], float& l, int lane) {
    const int q = lane & 31, hi = lane >> 5;
    const unsigned va0 = (unsigned)(uintptr_t)(Vl + row0 * 64 + (4 * hi + ((lane & 15) >> 2)) * 64 + (16 * ((lane >> 4) & 1) + 4 * (lane & 3)) * 2);
    const int sw = (q >> 1) & 7;
    const LAS unsigned char* kp0 = Kl + (row0 + q) * 128 + 16 * ((0 + hi) ^ sw); const LAS unsigned char* kp1 = Kl + (row0 + q) * 128 + 16 * ((2 + hi) ^ sw);
    const LAS unsigned char* kp2 = Kl + (row0 + q) * 128 + 16 * ((4 + hi) ^ sw); const LAS unsigned char* kp3 = Kl + (row0 + q) * 128 + 16 * ((6 + hi) ^ sw);
    float base = (float)(4 * hi - R - q); asm volatile("" : "+v"(base));
    const float nslope = -slope2;
#define LOADK(dst, jj) do { dst[0] = *(const LAS bf16x8*)(kp0 + (jj) * 4096); dst[1] = *(const LAS bf16x8*)(kp1 + (jj) * 4096); dst[2] = *(const LAS bf16x8*)(kp2 + (jj) * 4096); dst[3] = *(const LAS bf16x8*)(kp3 + (jj) * 4096); } while (0)
    bf16x8 kf[4];
    LOADK(kf, 0);
    attn_tile<R, true, EDGE, SAFE>(kf, va0, vhs, 0, kidx_t0, Ls, qf, base, nslope, negM, o, l, hi);
#pragma unroll 1
    for (int j = 1; j < NT - 1; ++j) {
        LOADK(kf, j);
        attn_tile<R, false, EDGE, SAFE>(kf, va0 + j * 2048, vhs, j, kidx_t0, Ls, qf, base, nslope, negM, o, l, hi);
    }
    LOADK(kf, NT - 1);
    attn_tile<R, true, EDGE, SAFE>(kf, va0 + (NT - 1) * 2048, vhs, NT - 1, kidx_t0, Ls, qf, base, nslope, negM, o, l, hi);
#undef LOADK
}
__device__ __forceinline__ void store_partial(const f32x16 (&o)[2], float l, bf16* OBuf, float* LB, int tokq0, int dshift, int h, int lane) {
    const int hi = lane >> 5, q = lane & 31; const size_t tok = (size_t)(tokq0 + (q << dshift));
    l += __shfl_xor(l, 32);
    if (hi == 0) LB[tok * 8 + h] = l;
    bf16* p = OBuf + tok * 512 + h * 64 + 4 * hi;
#pragma unroll
    for (int dh = 0; dh < 2; ++dh)
#pragma unroll
        for (int g = 0; g < 4; ++g) { unsigned long long w = (unsigned long long)cvtpk(o[dh][4 * g], o[dh][4 * g + 1]) | ((unsigned long long)cvtpk(o[dh][4 * g + 2], o[dh][4 * g + 3]) << 32);
            *(unsigned long long*)(p + 32 * dh + 8 * g) = w; }
}
struct AUnit { int tok0, dshift, Ls, cc, h, c; };
__device__ __forceinline__ AUnit decode_a(int su) {
    AUnit a; const int sidx = su / 48, k = su % 48, blk = sidx >> 3; a.h = sidx & 7; a.c = 2 - (k >> 4); a.dshift = 2 * a.c; const int kk = k & 15;
    int seq0, S, bis; if (blk < 8) { seq0 = 0; S = 16384; bis = blk; } else { seq0 = MP + 2048 * (blk - 8); S = 2048; bis = 0; }
    a.Ls = S >> a.dshift; const int lcpb = 4 - a.dshift  , res = kk >> lcpb; a.cc = (bis << lcpb) + (kk & ((1 << lcpb) - 1)); a.tok0 = seq0 + res; return a;
}
struct BUnit { int seq0, S, lcb, g2; };
__device__ __forceinline__ BUnit decode_b(int u) {
    BUnit b; b.g2 = u / 768; const int cb = u % 768;
    if (cb < 256) { b.seq0 = 0; b.S = 16384; b.lcb = cb; } else { b.seq0 = MP + 2048 * ((cb - 256) >> 5); b.S = 2048; b.lcb = (cb - 256) & 31; } return b;
}

#define LDS_BAR() asm volatile("s_waitcnt lgkmcnt(0)\n\ts_barrier" ::: "memory")
#define xp (args.in[0])
#define xs (args.in[1])
#define norm1 (args.in[2])
#define w_in (args.in[3])
#define qna (args.in[4])
#define kna (args.in[5])
#define qnb (args.in[6])
#define knb (args.in[7])
#define sinkb (args.in[8])
#define ona (args.in[9])
#define onb (args.in[10])
#define w_out (args.in[11])
#define norm2 (args.in[12])
#define w_up (args.in[13])
#define conv_w (args.in[14])
#define conv_b (args.in[15])
#define w_down (args.in[16])
#define out (args.dout)
#define SSQ ((float*)(args.ws + WS_SSQ))
#define WIN ((bf16*)(args.ws + WS_WIN))
#define WOUT ((bf16*)(args.ws + WS_WOUT))
#define WUP ((bf16*)(args.ws + WS_WUP))
#define WDN ((bf16*)(args.ws + WS_WDN))
#define XN ((bf16*)(args.ws + WS_XN) + DM)
#define PROJ ((bf16*)(args.ws + WS_PROJ))
#define Y ((bf16*)(args.ws + WS_PROJ))
#define OA ((bf16*)(args.ws + WS_OA))
#define OB ((bf16*)(args.ws + WS_XN) + DM)
#define HB ((bf16*)(args.ws + WS_H))
#define LA ((float*)(args.ws + WS_LA))
#define LBp ((float*)(args.ws + WS_LA) + 3 * (size_t)M * 8)
struct Args { const float* in[17]; float* dout; unsigned char* ws; };
__global__ void __launch_bounds__(NWAVES * 64, 2) fwd_megakernel(Args args) {
    extern __shared__ __attribute__((aligned(16))) unsigned char lds_raw[];
    cg::grid_group grid = cg::this_grid();
    LAS unsigned char* lds = (LAS unsigned char*)lds_raw;
    const int tid = threadIdx.x, lane = tid & 63, wave = __builtin_amdgcn_readfirstlane(tid >> 6);
    const int G = gridDim.x, bx = blockIdx.x;
    if (tid < 2) ((LAS unsigned*)(lds + MISC_OFF))[tid] = 0u;
    const int gw = bx * NWAVES + wave, NGW = G * NWAVES;
    __syncthreads();
    XcdBarrier bar = xcd_barrier_post((unsigned*)(args.ws + WS_BAR), (volatile LAS unsigned*)(lds + MISC_OFF));
    if (args.ws == nullptr) grid.sync();

    {
        LAS float* scr = (LAS float*)(lds + wave * 16384);
        constexpr int I_IN = (DM / 64) * (INW / 32), I_OUT = (DM / 64) * (DM / 32), I_UP = (DM / 64) * (UPW / 32), I_DN = (DFF / 64) * (DM / 32);
        for (int it = gw; it < I_IN + I_OUT + I_UP + I_DN; it += NGW) {
            int r = it;
            if (r < I_IN) { p0_transpose_item<2>(w_in, DM, INW, WIN, nullptr, scr, r, lane); continue; } r -= I_IN;
            if (r < I_OUT) { p0_transpose_item<0>(w_out, DM, DM, WOUT, nullptr, scr, r, lane); continue; } r -= I_OUT;
            if (r < I_UP) { p0_transpose_item<1>(w_up, DM, UPW, WUP, norm2, scr, r, lane); continue; } r -= I_UP;
            p0_transpose_item<0>(w_down, DFF, DM, WDN, nullptr, scr, r, lane);
        }
        for (int m = gw * 4; m < M; m += NGW * 4) rms_rows4_to_bf16(m < MP ? xp + (size_t)m * DM : xs + (size_t)(m - MP) * DM, norm1, XN + (size_t)m * DM, lane);
        for (int i = bx * 512 + tid; i < M; i += G * 512) SSQ[i] = 0.f;
    }
    xcd_barrier(bar);

    {
        pg8::Gemm g{XN, WIN, M, INW, DM, 256}; pg8::StaticOrder S; S.init(M, INW, G, bx);
        pg8::EpiProj E{PROJ, qna, kna, qnb, knb};
        pg8::gemm_phase<pg8::EpiProj, pg8::StaticOrder, PG8_ALIGN, PG8_SP2>(lds, g, S, E);
    }
    xcd_barrier(bar);

    {
        const float gqa = fabsf(qna[lane]), gka = fabsf(kna[lane]);
        const float boundA = __builtin_bit_cast(float, __builtin_amdgcn_readfirstlane(__builtin_bit_cast(int, 8.0f * wave_max(gqa) * wave_max(gka) * LOG2E)));
        const float negMa = boundA > 40.f ? -boundA : 0.f;
        {
            const int half = wave >> 2, w4 = wave & 3, th = tid & 255;
            LAS unsigned char* Kl = lds + half * 65536; LAS unsigned char* Vl = Kl + 32768;
            const int ubase = (G == 256) ? (bx & 7) * 576 + (bx >> 3) : bx, ustep = (G == 256) ? 32 : G, uend = (G == 256) ? (bx & 7) * 576 + 576 : 4608;
            v4u kr[8], vr[8], qraw[4]; AUnit nx = decode_a(2 * ubase + half);
            if (ubase < uend) { stage_load<256, 256>(kr, vr, PROJ, KA_OFF + nx.h * 64, VA_OFF + nx.h * 64, nx.tok0, nx.dshift, 128 * nx.cc - 64, nx.Ls, th);
                load_q_raw(qraw, PROJ + (size_t)(nx.tok0 + ((128 * nx.cc + 32 * w4 + (lane & 31)) << nx.dshift)) * INW + QA_OFF + nx.h * 64, lane); }
            for (int u = ubase; u < uend; u += ustep) {
                const AUnit a = nx;
                LDS_BAR();
                stage_write<256, 256>(kr, vr, Kl, Vl, th);
                bf16x8 qf[4];
#pragma unroll
                for (int d0 = 0; d0 < 4; ++d0) qf[d0] = __builtin_bit_cast(bf16x8, qraw[d0]);
                LDS_BAR();
                if (u + ustep < uend) { nx = decode_a(2 * (u + ustep) + half);
                    stage_load<256, 256>(kr, vr, PROJ, KA_OFF + nx.h * 64, VA_OFF + nx.h * 64, nx.tok0, nx.dshift, 128 * nx.cc - 64, nx.Ls, th);
                    load_q_raw(qraw, PROJ + (size_t)(nx.tok0 + ((128 * nx.cc + 32 * w4 + (lane & 31)) << nx.dshift)) * INW + QA_OFF + nx.h * 64, lane); }
                const int iq0 = 128 * a.cc + 32 * w4;
                f32x16 o[2]; float l = 0.f;
#pragma unroll
                for (int r = 0; r < 16; ++r) { o[0][r] = 0.f; o[1][r] = 0.f; }
                const float slope2 = __builtin_amdgcn_exp2f(-0.5f * (float)(a.h + 9) + (float)a.dshift) * LOG2E;
                const bool edge = iq0 - 64 < 0 || iq0 + 96 > a.Ls;
                if (__builtin_expect(negMa != 0.f, 0)) { if (edge) attn_task<5, 64, true, true>(Kl, Vl, 256 * 64, 32 * w4, iq0 - 64, a.Ls, qf, slope2, negMa, o, l, lane); else attn_task<5, 64, false, true>(Kl, Vl, 256 * 64, 32 * w4, iq0 - 64, a.Ls, qf, slope2, negMa, o, l, lane); }
                else if (edge) attn_task<5, 64, true, false>(Kl, Vl, 256 * 64, 32 * w4, iq0 - 64, a.Ls, qf, slope2, 0.f, o, l, lane);
                else attn_task<5, 64, false, false>(Kl, Vl, 256 * 64, 32 * w4, iq0 - 64, a.Ls, qf, slope2, 0.f, o, l, lane);
                asm volatile("s_nop 15\n\ts_nop 7" ::: "memory");
                store_partial(o, l, OA + (size_t)a.c * M * 512, LA + (size_t)a.c * M * 8, a.tok0 + (iq0 << a.dshift), a.dshift, a.h, lane);
            }
        }
        const float gqb = fabsf(qnb[lane]), gkb = fabsf(knb[lane]);
        const float boundB = __builtin_bit_cast(float, __builtin_amdgcn_readfirstlane(__builtin_bit_cast(int, 8.0f * wave_max(gqb) * wave_max(gkb) * LOG2E)));
        const float negMb = boundB > 40.f ? -boundB : 0.f;
        {
            LAS unsigned char* Kb = lds; LAS unsigned char* Vb = lds + 40960;
            const int ubase = (G == 256) ? (bx & 7) * 192 + (bx >> 3) : bx, ustep = (G == 256) ? 32 : G, uend = (G == 256) ? (bx & 7) * 192 + 192 : 1536;
            v4u kr[5], vr[5], qraw[4]; BUnit nx = decode_b(ubase);
            if (ubase < uend) { stage_load<320, 512>(kr, vr, PROJ, KB_OFF + nx.g2 * 64, VB_OFF + nx.g2 * 64, nx.seq0, 0, 64 * nx.lcb - 128, nx.S, tid);
                load_q_raw(qraw, PROJ + (size_t)(nx.seq0 + 64 * nx.lcb + 32 * (wave & 1) + (lane & 31)) * INW + QB_OFF + (4 * nx.g2 + (wave >> 1)) * 64, lane); }
            for (int u = ubase; u < uend; u += ustep) {
                const BUnit b = nx;
                LDS_BAR();
                stage_write<320, 512>(kr, vr, Kb, Vb, tid);
                bf16x8 qf[4];
#pragma unroll
                for (int d0 = 0; d0 < 4; ++d0) qf[d0] = __builtin_bit_cast(bf16x8, qraw[d0]);
                LDS_BAR();
                if (u + ustep < uend) { nx = decode_b(u + ustep);
                    stage_load<320, 512>(kr, vr, PROJ, KB_OFF + nx.g2 * 64, VB_OFF + nx.g2 * 64, nx.seq0, 0, 64 * nx.lcb - 128, nx.S, tid);
                    load_q_raw(qraw, PROJ + (size_t)(nx.seq0 + 64 * nx.lcb + 32 * (wave & 1) + (lane & 31)) * INW + QB_OFF + (4 * nx.g2 + (wave >> 1)) * 64, lane); }
                const int hb = 4 * b.g2 + (wave >> 1), iq0 = 64 * b.lcb + 32 * (wave & 1);
                f32x16 o[2]; float l = 0.f;
#pragma unroll
                for (int r = 0; r < 16; ++r) { o[0][r] = 0.f; o[1][r] = 0.f; }
                const float slope2 = __builtin_amdgcn_exp2f(-0.5f * (float)(hb + 1)) * LOG2E;
                const bool edge = iq0 - 128 < 0 || iq0 + 160 > b.S;
                if (__builtin_expect(negMb != 0.f, 0)) { if (edge) attn_task<9, 128, true, true>(Kb, Vb, 320 * 64, 32 * (wave & 1), iq0 - 128, b.S, qf, slope2, negMb, o, l, lane); else attn_task<9, 128, false, true>(Kb, Vb, 320 * 64, 32 * (wave & 1), iq0 - 128, b.S, qf, slope2, negMb, o, l, lane); }
                else if (edge) attn_task<9, 128, true, false>(Kb, Vb, 320 * 64, 32 * (wave & 1), iq0 - 128, b.S, qf, slope2, 0.f, o, l, lane);
                else attn_task<9, 128, false, false>(Kb, Vb, 320 * 64, 32 * (wave & 1), iq0 - 128, b.S, qf, slope2, 0.f, o, l, lane);
                asm volatile("s_nop 15\n\ts_nop 7" ::: "memory");
                store_partial(o, l, OB, LBp, b.seq0 + iq0, 0, hb, lane);
            }
        }
        xcd_barrier(bar);
        {
            const int hh = lane >> 3;
            const float sinkterm = __builtin_amdgcn_exp2f(sinkb[hh] * LOG2E + negMb);
            const f32x4 ga0 = *(const f32x4*)(ona + 8 * lane), ga1 = *(const f32x4*)(ona + 8 * lane + 4), gb0 = *(const f32x4*)(onb + 8 * lane), gb1 = *(const f32x4*)(onb + 8 * lane + 4);
            for (int m0 = gw * 4; m0 < M; m0 += NGW * 4) {
                v4u wa[4][3], wb[4]; float la[4], lb[4];
#pragma unroll
                for (int k = 0; k < 4; ++k) { const int m = m0 + k; la[k] = 0.f;
#pragma unroll
                    for (int c = 0; c < 3; ++c) { wa[k][c] = *(const v4u*)(OA + ((size_t)c * M + m) * 512 + 8 * lane); la[k] += LA[((size_t)c * M + m) * 8 + hh]; }
                    wb[k] = *(const v4u*)(OB + (size_t)m * 512 + 8 * lane); lb[k] = LBp[(size_t)m * 8 + hh] + sinkterm; }
                float ya[4][8], yb[4][8], sa[4], sb[4];
#pragma unroll
                for (int k = 0; k < 4; ++k) { const float ia = 1.0f / la[k], ib = 1.0f / lb[k];
                    ya[k][0] = (bf_lo(wa[k][0].x) + bf_lo(wa[k][1].x) + bf_lo(wa[k][2].x)) * ia; ya[k][1] = (bf_hi(wa[k][0].x) + bf_hi(wa[k][1].x) + bf_hi(wa[k][2].x)) * ia;
                    ya[k][2] = (bf_lo(wa[k][0].y) + bf_lo(wa[k][1].y) + bf_lo(wa[k][2].y)) * ia; ya[k][3] = (bf_hi(wa[k][0].y) + bf_hi(wa[k][1].y) + bf_hi(wa[k][2].y)) * ia;
                    ya[k][4] = (bf_lo(wa[k][0].z) + bf_lo(wa[k][1].z) + bf_lo(wa[k][2].z)) * ia; ya[k][5] = (bf_hi(wa[k][0].z) + bf_hi(wa[k][1].z) + bf_hi(wa[k][2].z)) * ia;
                    ya[k][6] = (bf_lo(wa[k][0].w) + bf_lo(wa[k][1].w) + bf_lo(wa[k][2].w)) * ia; ya[k][7] = (bf_hi(wa[k][0].w) + bf_hi(wa[k][1].w) + bf_hi(wa[k][2].w)) * ia;
                    yb[k][0] = bf_lo(wb[k].x) * ib; yb[k][1] = bf_hi(wb[k].x) * ib; yb[k][2] = bf_lo(wb[k].y) * ib; yb[k][3] = bf_hi(wb[k].y) * ib;
                    yb[k][4] = bf_lo(wb[k].z) * ib; yb[k][5] = bf_hi(wb[k].z) * ib; yb[k][6] = bf_lo(wb[k].w) * ib; yb[k][7] = bf_hi(wb[k].w) * ib;
                    sa[k] = 0.f; sb[k] = 0.f;
#pragma unroll
                    for (int i = 0; i < 8; ++i) { sa[k] += ya[k][i] * ya[k][i]; sb[k] += yb[k][i] * yb[k][i]; } }
#pragma unroll
                for (int o = 1; o < 64; o <<= 1) {
#pragma unroll
                    for (int k = 0; k < 4; ++k) { sa[k] += __shfl_xor(sa[k], o); sb[k] += __shfl_xor(sb[k], o); } }
#pragma unroll
                for (int k = 0; k < 4; ++k) { const int m = m0 + k;
                    const float ra = __builtin_amdgcn_rsqf(sa[k] * (1.f / 512.f) + EPS), rb = __builtin_amdgcn_rsqf(sb[k] * (1.f / 512.f) + EPS);
                    v4u oa, ob;
                    oa.x = cvtpk(ya[k][0] * ra * ga0.x, ya[k][1] * ra * ga0.y); oa.y = cvtpk(ya[k][2] * ra * ga0.z, ya[k][3] * ra * ga0.w); oa.z = cvtpk(ya[k][4] * ra * ga1.x, ya[k][5] * ra * ga1.y); oa.w = cvtpk(ya[k][6] * ra * ga1.z, ya[k][7] * ra * ga1.w);
                    ob.x = cvtpk(yb[k][0] * rb * gb0.x, yb[k][1] * rb * gb0.y); ob.y = cvtpk(yb[k][2] * rb * gb0.z, yb[k][3] * rb * gb0.w); ob.z = cvtpk(yb[k][4] * rb * gb1.x, yb[k][5] * rb * gb1.y); ob.w = cvtpk(yb[k][6] * rb * gb1.z, yb[k][7] * rb * gb1.w);
                    *(v4u*)(Y + (size_t)m * DM + 8 * lane) = oa; *(v4u*)(Y + (size_t)m * DM + 512 + 8 * lane) = ob; }
            }
        }
    }
    xcd_barrier(bar);

    {
        pg8::Gemm g{Y, WOUT, M, DM, DM, 256}; pg8::StaticOrder S; S.init(M, DM, G, bx);
        pg8::EpiOut E{xp, xs, XN, SSQ};
        pg8::gemm_phase<pg8::EpiOut, pg8::StaticOrder, PG8_ALIGN, PG8_SP2>(lds, g, S, E);
    }
    xcd_barrier(bar);

    {
        pg8::Gemm g{XN - DM, WUP, UP_TILES_M * 256, UPW, DM, 254}; pg8::StaticOrder S; S.init(UP_TILES_M * 256, UPW, G, bx);
        pg8::EpiUp E{HB, SSQ, conv_w, conv_b, (LAS float*)(lds + XCH_OFF)};
        pg8::gemm_phase<pg8::EpiUp, pg8::StaticOrder, true, PG8_SP2>(lds, g, S, E);
    }
    xcd_barrier(bar);

    {
        pg8::Gemm g{HB, WDN, M, DM, DFF, 256}; pg8::StaticOrder S; S.init(M, DM, G, bx);
        pg8::EpiDown E{XN, out};
        pg8::gemm_phase<pg8::EpiDown, pg8::StaticOrder, PG8_ALIGN, PG8_SP2>(lds, g, S, E);
    }
}

#undef out
#undef xp
#undef xs
extern "C" void kernel_launch(void* const* d_in, const int* in_sizes, int n_in, void* d_out, int out_size, void* d_ws, size_t ws_size, hipStream_t stream) {
    static int grid = 0;
    if (grid == 0) {
        if (n_in != 17 || out_size != M * DM || ws_size < WS_END) { fprintf(stderr, "kernel_launch: unexpected shapes (n_in %d out %d ws %zu)\n", n_in, out_size, ws_size); grid = -1; return; }
        int dev = 0, cus = 0, per_cu = 0;
        hipGetDevice(&dev); hipDeviceGetAttribute(&cus, hipDeviceAttributeMultiprocessorCount, dev);
        if (hipFuncSetAttribute((const void*)fwd_megakernel, hipFuncAttributeMaxDynamicSharedMemorySize, LDS_BYTES) != hipSuccess) { fprintf(stderr, "kernel_launch: hipFuncSetAttribute failed\n"); grid = -1; return; }
        if (hipOccupancyMaxActiveBlocksPerMultiprocessor(&per_cu, (const void*)fwd_megakernel, NWAVES * 64, LDS_BYTES) != hipSuccess || per_cu < 1) { fprintf(stderr, "kernel_launch: occupancy query says %d\n", per_cu); per_cu = 1; }
        (void)hipGetLastError();
        grid = cus;
        fprintf(stderr, "kernel_launch: grid %d (per_cu %d)\n", grid, per_cu);
    }
    if (grid < 0) return;
    Args a{};
    for (int i = 0; i < 17; ++i) a.in[i] = (const float*)d_in[i];
    a.dout = (float*)d_out; a.ws = (unsigned char*)d_ws;
    void* kargs[] = {&a};
    if (hipMemsetAsync((char*)d_ws + WS_BAR, 0, XCD_BAR_WORDS * 4, stream) != hipSuccess) { fprintf(stderr, "kernel_launch: hipMemsetAsync failed\n"); return; }
    hipError_t e = hipLaunchCooperativeKernel((const void*)fwd_megakernel, dim3(grid), dim3(NWAVES * 64), kargs, LDS_BYTES, stream);
    if (e != hipSuccess) fprintf(stderr, "kernel_launch: cooperative launch failed: %s\n", hipGetErrorString(e));
}
```

```cpp
#include <hip/hip_runtime.h>
#include <hip/hip_cooperative_groups.h>
#include <cstdio>
#include <cstdint>
namespace cg = cooperative_groups;
namespace pg8 {
#define PG8_LAS __attribute__((address_space(3)))
typedef unsigned short bf16_t;
typedef short bf16x8 __attribute__((ext_vector_type(8)));
typedef float f32x4 __attribute__((ext_vector_type(4)));
typedef unsigned u32x4 __attribute__((ext_vector_type(4)));
constexpr int BM = 256, BK = 64, HALF = 128, HTB = HALF * BK * 2  , STAGE_BYTES = 8 * HTB, NXCD = 8, WGM = 8;

__host__ __device__ __forceinline__ int lds_byte(int r, int c) { const int st = (r >> 4) * 2 + (c >> 5), rr = r & 15, cc = c & 31, ob = rr * 64 + cc * 2; return st * 1024 + (ob ^ (((ob >> 9) & 1) << 5)); }
__host__ __device__ __forceinline__ void stage_rc(int b, int& R, int& C) { const int st = b / 1024, sb = b % 1024, swz = sb ^ (((sb >> 9) & 1) << 5); R = (st >> 1) * 16 + swz / 64; C = (st & 1) * 32 + (swz % 64) / 2; }
__host__ __device__ __forceinline__ int perm32(int rho) { const int n = rho >> 4, i = rho & 15; return 8 * (i >> 2) + 4 * n + (i & 3); }

struct Unit { int pm, pn; };
struct Gemm { const bf16_t* A; const bf16_t* Bt; int M, N, K; int a_tile_rows; };

struct StaticOrder {
    int nM, nN, nwg, G, c;
    __host__ __device__ void init(int M, int N, int G_, int c_) { nM = M / BM; nN = N / BM; nwg = nM * nN; G = G_; c = c_; }
    __host__ __device__ bool next(int i, Unit& u) const {
        const long L = (long)i * G + c; if (L >= nwg) return false;
        int wgid = (int)L; { const int q = nwg / NXCD, r = nwg % NXCD, xcd = wgid % NXCD, off = wgid / NXCD; wgid = (xcd < r ? xcd * (q + 1) : r * (q + 1) + (xcd - r) * q) + off; }
        const int nig = WGM * nN, gid = wgid / nig, fm = gid * WGM, gsz = (nM - fm) < WGM ? (nM - fm) : WGM;
        u.pm = fm + ((wgid % nig) % gsz); u.pn = (wgid % nig) / gsz; return true;
    }
    __device__ __forceinline__ void a_ready(const Unit&) const {}
    __device__ __forceinline__ void done(const Unit&) const {}
};

__device__ __forceinline__ unsigned cvt_pk_bf16(float lo, float hi) { unsigned r; asm volatile("v_cvt_pk_bf16_f32 %0, %1, %2" : "=v"(r) : "v"(lo), "v"(hi)); return r; }
typedef float f32x2 __attribute__((ext_vector_type(2))); typedef __bf16 bf16x2_t __attribute__((ext_vector_type(2)));
__device__ __forceinline__ unsigned cvtpk(float lo, float hi) { f32x2 v = {lo, hi}; bf16x2_t b = __builtin_convertvector(v, bf16x2_t); return __builtin_bit_cast(unsigned, b); }
constexpr int MTOK = 49152, MPROMPT = 16384, DMODEL = 1024, DFF_ = 2816;
__device__ __forceinline__ u32x4 pack8(const f32x4 a, const f32x4 b) { u32x4 w; w.x = cvtpk(a[0], a[1]); w.y = cvtpk(a[2], a[3]); w.z = cvtpk(b[0], b[1]); w.w = cvtpk(b[2], b[3]); return w; }

struct EpiProj {
    static constexpr bool PERM = true, AFTER_DRAIN = false;
    bf16_t* O; const float* ssq1; const float* gqa; const float* gka; const float* gqb; const float* gkb;
    __device__ __forceinline__ void operator()(f32x4 (&acc)[2][2][4][2], const Unit& u, int wr, int wc, int fr, int fq, int wid, int lane) const {
        const int hs = 4 * u.pn + wc;
        const float* g = nullptr; float sc = 1.f;
        if (hs < 8) { g = gqa; sc = 0.125f * 1.4426950408889634f; } else if (hs < 16) g = gka; else if (hs >= 24 && hs < 32) { g = gqb; sc = 0.125f * 1.4426950408889634f; } else if (hs >= 32 && hs < 34) g = gkb;
        const int row0 = u.pm * BM + wr * 64 + fr;
        bf16_t* obase = O + ((size_t)hs * MTOK + row0) * 64 + 8 * fq;
#pragma unroll
        for (int ai = 0; ai < 2; ++ai)
#pragma unroll
            for (int m = 0; m < 4; ++m) { const float r1 = __builtin_amdgcn_rsqf(ssq1[row0 + ai * HALF + m * 16] * (1.0f / DMODEL) + 1e-6f);
#pragma unroll
                for (int bj = 0; bj < 2; ++bj)
#pragma unroll
                    for (int n = 0; n < 2; ++n) acc[ai][bj][m][n] *= r1; }
        if (g) {
            f32x4 gg[2][2];
#pragma unroll
            for (int bj = 0; bj < 2; ++bj)
#pragma unroll
                for (int n = 0; n < 2; ++n) gg[bj][n] = *(const f32x4*)(g + 32 * bj + 8 * fq + 4 * n) * sc;
#pragma unroll
            for (int ai = 0; ai < 2; ++ai)
#pragma unroll
                for (int m = 0; m < 4; ++m) { float ss = 0.f;
#pragma unroll
                    for (int bj = 0; bj < 2; ++bj)
#pragma unroll
                        for (int n = 0; n < 2; ++n) { const f32x4 a = acc[ai][bj][m][n]; ss += (a[0] * a[0] + a[1] * a[1]) + (a[2] * a[2] + a[3] * a[3]); }
                    ss += __shfl_xor(ss, 16); ss += __shfl_xor(ss, 32);
                    const float rs = __builtin_amdgcn_rsqf(ss * (1.0f / 64.0f) + 1e-6f);
                    bf16_t* rowp = obase + (size_t)(ai * HALF + m * 16) * 64;
#pragma unroll
                    for (int bj = 0; bj < 2; ++bj) *(u32x4*)(rowp + 32 * bj) = pack8(acc[ai][bj][m][0] * rs * gg[bj][0], acc[ai][bj][m][1] * rs * gg[bj][1]); }
        } else {
#pragma unroll
            for (int ai = 0; ai < 2; ++ai)
#pragma unroll
                for (int m = 0; m < 4; ++m) { bf16_t* rowp = obase + (size_t)(ai * HALF + m * 16) * 64;
#pragma unroll
                    for (int bj = 0; bj < 2; ++bj) *(u32x4*)(rowp + 32 * bj) = pack8(acc[ai][bj][m][0], acc[ai][bj][m][1]); }
        }
    }
};
struct EpiOut {
    static constexpr bool PERM = true, AFTER_DRAIN = false;
    bf16_t* xb; float* ssq;
    __device__ __forceinline__ void operator()(f32x4 (&acc)[2][2][4][2], const Unit& u, int wr, int wc, int fr, int fq, int wid, int lane) const {
        const int col0 = u.pn * BM + wc * 32 + 8 * fq; const int gr0 = u.pm * BM + wr * 64 + fr;
        u32x4 w[2][4][2];
#pragma unroll
        for (int ai = 0; ai < 2; ++ai)
#pragma unroll
            for (int m = 0; m < 4; ++m)
#pragma unroll
                for (int bj = 0; bj < 2; ++bj) w[ai][m][bj] = *(const u32x4*)(xb + (size_t)(gr0 + ai * HALF + m * 16) * DMODEL + col0 + bj * HALF);
#pragma unroll
        for (int ai = 0; ai < 2; ++ai)
#pragma unroll
            for (int m = 0; m < 4; ++m) { const int gr = gr0 + ai * HALF + m * 16;
                float s = 0.f;
#pragma unroll
                for (int bj = 0; bj < 2; ++bj) { const u32x4 v = w[ai][m][bj];
                    f32x4 a = {__uint_as_float(v.x << 16), __uint_as_float(v.x & 0xffff0000u), __uint_as_float(v.y << 16), __uint_as_float(v.y & 0xffff0000u)};
                    f32x4 b = {__uint_as_float(v.z << 16), __uint_as_float(v.z & 0xffff0000u), __uint_as_float(v.w << 16), __uint_as_float(v.w & 0xffff0000u)};
                    a += acc[ai][bj][m][0]; b += acc[ai][bj][m][1];
                    s += (a[0] * a[0] + a[1] * a[1]) + (a[2] * a[2] + a[3] * a[3]) + (b[0] * b[0] + b[1] * b[1]) + (b[2] * b[2] + b[3] * b[3]);
                    *(u32x4*)(xb + (size_t)gr * DMODEL + col0 + bj * HALF) = pack8(a, b); }
                s += __shfl_xor(s, 16); s += __shfl_xor(s, 32);
                if (fq == 0) unsafeAtomicAdd(ssq + gr, s); }
    }
};
struct EpiDown {
    static constexpr bool PERM = true, AFTER_DRAIN = false;
    const bf16_t* xb; float* out;
    __device__ __forceinline__ void operator()(f32x4 (&acc)[2][2][4][2], const Unit& u, int wr, int wc, int fr, int fq, int wid, int lane) const {
        const int col0 = u.pn * BM + wc * 32 + 8 * fq; const int gr0 = u.pm * BM + wr * 64 + fr;
        u32x4 w[2][4][2];
#pragma unroll
        for (int ai = 0; ai < 2; ++ai)
#pragma unroll
            for (int m = 0; m < 4; ++m)
#pragma unroll
                for (int bj = 0; bj < 2; ++bj) w[ai][m][bj] = *(const u32x4*)(xb + (size_t)(gr0 + ai * HALF + m * 16) * DMODEL + col0 + bj * HALF);
#pragma unroll
        for (int ai = 0; ai < 2; ++ai)
#pragma unroll
            for (int m = 0; m < 4; ++m) { float* o = out + (size_t)(gr0 + ai * HALF + m * 16) * DMODEL + col0;
#pragma unroll
                for (int bj = 0; bj < 2; ++bj) { const u32x4 v = w[ai][m][bj];
                    f32x4 a = {__uint_as_float(v.x << 16), __uint_as_float(v.x & 0xffff0000u), __uint_as_float(v.y << 16), __uint_as_float(v.y & 0xffff0000u)};
                    f32x4 b = {__uint_as_float(v.z << 16), __uint_as_float(v.z & 0xffff0000u), __uint_as_float(v.w << 16), __uint_as_float(v.w & 0xffff0000u)};
                    a += acc[ai][bj][m][0]; b += acc[ai][bj][m][1]; *(f32x4*)(o + bj * HALF) = a; *(f32x4*)(o + bj * HALF + 4) = b; } }
    }
};
__device__ __forceinline__ bool seq_first(int gr) { return gr == 0 || (gr >= MPROMPT && (gr & 2047) == 0); }
__device__ __forceinline__ bool seq_last(int gr) { return gr >= MPROMPT - 1 && (gr & 2047) == 2047; }
struct EpiUp {
    static constexpr bool PERM = true, AFTER_DRAIN = false;
    bf16_t* H; const float* ssq; const float* cw; const float* cb; PG8_LAS float* xch;
    __device__ __forceinline__ void operator()(f32x4 (&acc)[2][2][4][2], const Unit& u, int wr, int wc, int fr, int fq, int wid, int lane) const {
        const int lr0 = wr * 64 + fr, gr0 = 254 * u.pm - 1 + lr0;
#pragma unroll
        for (int ai = 0; ai < 2; ++ai)
#pragma unroll
            for (int m = 0; m < 4; ++m) { int gr = gr0 + ai * HALF + m * 16; gr = gr < 0 ? 0 : (gr > MTOK - 1 ? MTOK - 1 : gr);
                const float rs = __builtin_amdgcn_rsqf(ssq[gr] * (1.0f / DMODEL) + 1e-6f);
#pragma unroll
                for (int bj = 0; bj < 2; ++bj)
#pragma unroll
                    for (int n = 0; n < 2; ++n) acc[ai][bj][m][n] *= rs; }
#pragma unroll
        for (int ai = 0; ai < 2; ++ai) {
            if (fr == 0) { PG8_LAS float* p = xch + ((wid * 2 + ai) * 2 + 0) * 64 + 8 * fq;
#pragma unroll
                for (int bj = 0; bj < 2; ++bj)
#pragma unroll
                    for (int n = 0; n < 2; ++n) *(PG8_LAS f32x4*)(p + bj * 32 + 4 * n) = acc[ai][bj][0][n]; }
            if (fr == 15) { PG8_LAS float* p = xch + ((wid * 2 + ai) * 2 + 1) * 64 + 8 * fq;
#pragma unroll
                for (int bj = 0; bj < 2; ++bj)
#pragma unroll
                    for (int n = 0; n < 2; ++n) *(PG8_LAS f32x4*)(p + bj * 32 + 4 * n) = acc[ai][bj][3][n]; }
        }
        asm volatile("s_waitcnt lgkmcnt(0)" ::: "memory"); __builtin_amdgcn_s_barrier(); asm volatile("" ::: "memory");
        const int tlo = 254 * u.pm - 1, thi = tlo + 255; const bool anyb = (tlo <= 0) || (((thi + 1) >> 11) != ((tlo - 1) >> 11));
        const int ow = (1 - wr) * 4 + wc;
        const int ch0 = 128 * u.pn + 32 * wc + 8 * fq;
#pragma unroll
        for (int n = 0; n < 2; ++n) {
            f32x4 w0[2], w1[2], w2[2], bb[2];
#pragma unroll
            for (int bj = 0; bj < 2; ++bj) { const int ch = ch0 + 4 * n + bj * DFF_;
                w0[bj] = *(const f32x4*)(cw + ch); w1[bj] = *(const f32x4*)(cw + 2 * DFF_ + ch); w2[bj] = *(const f32x4*)(cw + 4 * DFF_ + ch); bb[bj] = *(const f32x4*)(cb + ch); }
#pragma unroll
            for (int ai = 0; ai < 2; ++ai) {
                const int aiT = wr == 1 ? ai : ai - 1, aiB = wr == 0 ? ai : ai + 1;
#pragma unroll
                for (int m = 0; m < 4; ++m) {
                    const int lr = lr0 + ai * HALF + m * 16, gr = gr0 + ai * HALF + m * 16;
                    const bool first = seq_first(gr), last = seq_last(gr);
                    f32x4 c[2];
#pragma unroll
                    for (int bj = 0; bj < 2; ++bj) {
                        const f32x4 cur = acc[ai][bj][m][n];
                        f32x4 pv, nx;
#pragma unroll
                        for (int e = 0; e < 4; ++e) {
                            const float sP = (m > 0 && fr == 15) ? acc[ai][bj][m > 0 ? m - 1 : 0][n][e] : cur[e];
                            const float sN = (m < 3 && fr == 0) ? acc[ai][bj][m < 3 ? m + 1 : 3][n][e] : cur[e];
                            pv[e] = __builtin_bit_cast(float, __builtin_amdgcn_mov_dpp(__builtin_bit_cast(int, sP), 0x121  , 0xf, 0xf, true));
                            nx[e] = __builtin_bit_cast(float, __builtin_amdgcn_mov_dpp(__builtin_bit_cast(int, sN), 0x12f  , 0xf, 0xf, true)); }
                        if (m == 0) { const f32x4 top = (aiT >= 0) ? *(const PG8_LAS f32x4*)(xch + ((ow * 2 + (aiT < 0 ? 0 : aiT)) * 2 + 1) * 64 + 8 * fq + bj * 32 + 4 * n) : (f32x4){0.f, 0.f, 0.f, 0.f}; if (fr == 0) pv = top; }
                        if (m == 3) { const f32x4 bot = (aiB <= 1) ? *(const PG8_LAS f32x4*)(xch + ((ow * 2 + (aiB > 1 ? 1 : aiB)) * 2 + 0) * 64 + 8 * fq + bj * 32 + 4 * n) : (f32x4){0.f, 0.f, 0.f, 0.f}; if (fr == 15) nx = bot; }
                        if (anyb) { if (first) pv = (f32x4){0.f, 0.f, 0.f, 0.f}; if (last) nx = (f32x4){0.f, 0.f, 0.f, 0.f}; }
                        c[bj] = bb[bj] + w0[bj] * pv + w1[bj] * cur + w2[bj] * nx;
                    }
                    f32x4 hv;
#pragma unroll
                    for (int e = 0; e < 4; ++e) { const float g = c[0][e]; hv[e] = g * __builtin_amdgcn_rcpf(1.0f + __builtin_amdgcn_exp2f(-1.4426950408889634f * g)) * c[1][e]; }
                    f32x2 pk; pk.x = __builtin_bit_cast(float, cvtpk(hv[0], hv[1])); pk.y = __builtin_bit_cast(float, cvtpk(hv[2], hv[3]));
                    if (lr >= 1 && lr <= 254 && gr < MTOK) *(f32x2*)(H + (size_t)gr * DFF_ + ch0 + 4 * n) = pk;
                    asm volatile("" ::: "memory");
                }
            }
        }
    }
};
template <class Epi, class Sched, bool ALIGN_EPI = false, bool SP2 = false>
__device__ __forceinline__ void gemm_phase(PG8_LAS unsigned char* lds, const Gemm g, const Sched& S, const Epi& E) {
    int tid_ = threadIdx.x; asm volatile("" : "+v"(tid_));
    const int tid = tid_, wid = __builtin_amdgcn_readfirstlane(tid >> 6), lane = tid & 63, wr = wid >> 2, wc = wid & 3, fr = lane & 15, fq = lane >> 4;
    const int K = g.K, nt = K / BK;
    unsigned voffA[2], voffB[2];
#pragma unroll
    for (int i = 0; i < 2; ++i) { int R, C; stage_rc(tid * 16 + i * 8192, R, C); const int Rb = Epi::PERM ? ((R & ~31) + perm32(R & 31)) : R;
        voffA[i] = (unsigned)(R * K + C) * 2u; voffB[i] = (unsigned)(Rb * K + C) * 2u; }
    const size_t kstep = (size_t)(BK * 2);
    const size_t hstep = (size_t)HALF * K * 2;
    const size_t tstep = 2 * hstep; const size_t tstepA = (size_t)g.a_tile_rows * K * 2;
    const unsigned ldsw = (unsigned)wid * 1024u;
    const int aoff = lds_byte(wr * 64 + fr, fq * 8), boff = lds_byte(wc * 32 + fr, fq * 8);
#define PG8_SA(b, h) (((b) * 2 + (h)) * HTB)
#define PG8_SB(b, h) ((4 + (b) * 2 + (h)) * HTB)
#define PG8_STAGE(bufoff, gbase, voff) do { _Pragma("unroll") for (int _i = 0; _i < 2; ++_i) \
        __builtin_amdgcn_global_load_lds((const unsigned*)((const char*)(gbase) + (voff)[_i]), (PG8_LAS unsigned*)(lds + (bufoff) + ldsw + _i * 8192), 16, 0, 0); } while (0)
#define PG8_LDA(dst, b, h) do { _Pragma("unroll") for (int m = 0; m < 4; ++m) _Pragma("unroll") for (int k = 0; k < 2; ++k) dst[m][k] = *(const PG8_LAS bf16x8*)(lds + PG8_SA(b, h) + aoff + m * 2048 + k * 1024); } while (0)
#define PG8_LDB(dst, b, h) do { _Pragma("unroll") for (int n = 0; n < 2; ++n) _Pragma("unroll") for (int k = 0; k < 2; ++k) dst[n][k] = *(const PG8_LAS bf16x8*)(lds + PG8_SB(b, h) + boff + n * 2048 + k * 1024); } while (0)
#define PG8_MMA(ai, bj, At, Bt) do { __builtin_amdgcn_s_setprio(1); _Pragma("unroll") for (int m = 0; m < 4; ++m) _Pragma("unroll") for (int n = 0; n < 2; ++n) _Pragma("unroll") for (int k = 0; k < 2; ++k) \
        acc[ai][bj][m][n] = __builtin_amdgcn_mfma_f32_16x16x32_bf16(Bt[n][k], At[m][k], acc[ai][bj][m][n], 0, 0, 0); __builtin_amdgcn_s_setprio(0); } while (0)
#define PG8_WAIT_V(n) asm volatile("s_waitcnt vmcnt(" #n ")" ::: "memory")
#define PG8_WAIT_L(n) asm volatile("s_waitcnt lgkmcnt(" #n ")" ::: "memory")
#define PG8_BAR __builtin_amdgcn_s_barrier()
#define PG8_SCHED __builtin_amdgcn_sched_barrier(0)
    Unit cur, nxt; int ui = 0;
    if (!S.next(0, cur)) return;
    f32x4 acc[2][2][4][2];
#pragma unroll
    for (int a = 0; a < 2; ++a)
#pragma unroll
        for (int b = 0; b < 2; ++b)
#pragma unroll
            for (int m = 0; m < 4; ++m)
#pragma unroll
                for (int n = 0; n < 2; ++n) acc[a][b][m][n] = (f32x4){0.f, 0.f, 0.f, 0.f};
    bf16x8 At[4][2], B0[2][2], B1[2][2];
    const char* cA = (const char*)g.A + (size_t)cur.pm * tstepA; const char* cB = (const char*)g.Bt + (size_t)cur.pn * tstep;
    S.a_ready(cur);
    if constexpr (SP2) {
        PG8_STAGE(PG8_SB(0, 0), cB, voffB); PG8_STAGE(PG8_SB(0, 1), cB + hstep, voffB); PG8_STAGE(PG8_SA(0, 0), cA, voffA); PG8_STAGE(PG8_SA(0, 1), cA + hstep, voffA);
        if (wr == 1) PG8_BAR;
        PG8_WAIT_V(2); PG8_BAR;
        PG8_STAGE(PG8_SB(1, 0), cB + kstep, voffB); PG8_STAGE(PG8_SA(1, 0), cA + kstep, voffA); PG8_STAGE(PG8_SB(1, 1), cB + hstep + kstep, voffB);
        PG8_WAIT_V(6); PG8_BAR;
    } else {
        PG8_STAGE(PG8_SB(0, 0), cB, voffB); PG8_STAGE(PG8_SA(0, 0), cA, voffA); PG8_STAGE(PG8_SB(0, 1), cB + hstep, voffB); PG8_STAGE(PG8_SA(0, 1), cA + hstep, voffA);
        if (wr == 1) PG8_BAR;
        PG8_WAIT_V(4); PG8_BAR;
        PG8_STAGE(PG8_SB(1, 0), cB + kstep, voffB); PG8_STAGE(PG8_SA(1, 0), cA + kstep, voffA); PG8_STAGE(PG8_SB(1, 1), cB + hstep + kstep, voffB);
        PG8_WAIT_V(6); PG8_BAR;
    }
    for (;;) {
        const bool has_next = S.next(ui + 1, nxt);
        const char* nA = has_next ? (const char*)g.A + (size_t)nxt.pm * tstepA : cA; const char* nB = has_next ? (const char*)g.Bt + (size_t)nxt.pn * tstep : cB;
        for (int t = 0; t < nt; t += 2) {
            const bool last = (t == nt - 2);
            const char* a1 = cA + (size_t)(t + 1) * kstep;
            const char* a2 = last ? nA : cA + (size_t)(t + 2) * kstep; const char* b2 = last ? nB : cB + (size_t)(t + 2) * kstep;
            const char* a3 = a2 + kstep; const char* b3 = b2 + kstep;
            if (last && has_next) S.a_ready(nxt);
            if constexpr (SP2) {
            PG8_LDB(B0, 0, 0); PG8_LDB(B1, 0, 1); PG8_SCHED; PG8_LDA(At, 0, 0); PG8_STAGE(PG8_SA(1, 1), a1 + hstep, voffA);
            PG8_WAIT_V(8); PG8_WAIT_L(0); PG8_BAR; PG8_MMA(0, 0, At, B0); PG8_MMA(0, 1, At, B1); PG8_BAR; PG8_SCHED;
            PG8_LDA(At, 0, 1); PG8_STAGE(PG8_SB(0, 0), b2, voffB); PG8_STAGE(PG8_SB(0, 1), b2 + hstep, voffB); PG8_STAGE(PG8_SA(0, 0), a2, voffA);
            PG8_WAIT_V(8); PG8_WAIT_L(0); PG8_BAR; PG8_MMA(1, 0, At, B0); PG8_MMA(1, 1, At, B1); PG8_BAR; PG8_SCHED;
            PG8_LDB(B0, 1, 0); PG8_LDB(B1, 1, 1); PG8_SCHED; PG8_LDA(At, 1, 0); PG8_STAGE(PG8_SA(0, 1), a2 + hstep, voffA);
            PG8_WAIT_V(8); PG8_WAIT_L(0); PG8_BAR; PG8_MMA(0, 0, At, B0); PG8_MMA(0, 1, At, B1); PG8_BAR; PG8_SCHED;
            PG8_LDA(At, 1, 1); PG8_STAGE(PG8_SB(1, 0), b3, voffB); PG8_STAGE(PG8_SB(1, 1), b3 + hstep, voffB); PG8_STAGE(PG8_SA(1, 0), a3, voffA);
            PG8_WAIT_V(8); PG8_WAIT_L(0); PG8_BAR; PG8_MMA(1, 0, At, B0); PG8_MMA(1, 1, At, B1); PG8_BAR; PG8_SCHED;
            } else {
            PG8_LDB(B0, 0, 0); PG8_SCHED; PG8_LDA(At, 0, 0); PG8_STAGE(PG8_SA(1, 1), a1 + hstep, voffA);
            PG8_WAIT_L(8); PG8_BAR; PG8_WAIT_L(0); PG8_MMA(0, 0, At, B0); PG8_BAR; PG8_SCHED;
            PG8_LDB(B1, 0, 1); PG8_STAGE(PG8_SB(0, 0), b2, voffB);
            PG8_BAR; PG8_WAIT_L(0); PG8_MMA(0, 1, At, B1); PG8_BAR;
            PG8_LDA(At, 0, 1); PG8_STAGE(PG8_SA(0, 0), a2, voffA);
            PG8_BAR; PG8_WAIT_L(0); PG8_MMA(1, 0, At, B0); PG8_BAR; PG8_SCHED;
            PG8_STAGE(PG8_SB(0, 1), b2 + hstep, voffB);
            PG8_WAIT_V(6); PG8_BAR; PG8_MMA(1, 1, At, B1); PG8_BAR;
            PG8_LDB(B0, 1, 0); PG8_SCHED; PG8_LDA(At, 1, 0); PG8_STAGE(PG8_SA(0, 1), a2 + hstep, voffA);
            PG8_WAIT_L(8); PG8_BAR; PG8_WAIT_L(0); PG8_MMA(0, 0, At, B0); PG8_BAR; PG8_SCHED;
            PG8_LDB(B1, 1, 1); PG8_STAGE(PG8_SB(1, 0), b3, voffB);
            PG8_BAR; PG8_WAIT_L(0); PG8_MMA(0, 1, At, B1); PG8_BAR;
            PG8_LDA(At, 1, 1); PG8_STAGE(PG8_SA(1, 0), a3, voffA);
            PG8_BAR; PG8_WAIT_L(0); PG8_MMA(1, 0, At, B0); PG8_BAR; PG8_SCHED;
            PG8_STAGE(PG8_SB(1, 1), b3 + hstep, voffB);
            PG8_WAIT_V(6); PG8_BAR; PG8_MMA(1, 1, At, B1); PG8_BAR;
            }
        }
        if constexpr (ALIGN_EPI) { if (wr == 0) PG8_BAR; }
        if constexpr (!Epi::AFTER_DRAIN) { E(acc, cur, wr, wc, fr, fq, wid, lane); S.done(cur); }
        if (!has_next) break;
#pragma unroll
        for (int a = 0; a < 2; ++a)
#pragma unroll
            for (int b = 0; b < 2; ++b)
#pragma unroll
                for (int m = 0; m < 4; ++m)
#pragma unroll
                    for (int n = 0; n < 2; ++n) acc[a][b][m][n] = (f32x4){0.f, 0.f, 0.f, 0.f};
        cur = nxt; cA = nA; cB = nB; ++ui;
        if constexpr (ALIGN_EPI) { if (wr == 1) PG8_BAR; }
    }
    PG8_WAIT_V(0);
    if constexpr (!ALIGN_EPI) { if (wr == 0) PG8_BAR; }
    PG8_BAR;
    if constexpr (Epi::AFTER_DRAIN) { E.fused(acc, cur, wr, wc, fr, fq, lds, wid, lane); S.done(cur); }
#undef PG8_SA
#undef PG8_SB
#undef PG8_STAGE
#undef PG8_LDA
#undef PG8_LDB
#undef PG8_MMA
#undef PG8_WAIT_V
#undef PG8_WAIT_L
#undef PG8_BAR
#undef PG8_SCHED
}
}
#ifndef PG8_SP2
#define PG8_SP2 true
#endif
#ifndef PG8_ALIGN
#define PG8_ALIGN true
#endif

constexpr int NWAVES = 8;
constexpr int DM = 1024, M = 49152, MP = 16384, INW = 2304, DFF = 2816, UPW = 5632;
constexpr int QA_OFF = 0, KA_OFF = 512, VA_OFF = 1024, QB_OFF = 1536, KB_OFF = 2048, VB_OFF = 2176;
constexpr int UP_TILES_M = 194;
constexpr float EPS = 1e-6f, LOG2E = 1.4426950408889634f;

constexpr size_t MiB = 1u << 20;
constexpr size_t WS_SSQ = 0;
constexpr size_t WS_SSQ1 = 512 * 1024;
constexpr size_t WS_BAR = 1 * MiB;
constexpr size_t WS_WIN = 2 * MiB, WS_WOUT = 7 * MiB, WS_WUP = 9 * MiB, WS_WDN = 20 * MiB;
constexpr size_t WS_XN = 32 * MiB;
constexpr size_t WS_PROJ = 130 * MiB;
constexpr size_t WS_OA = 346 * MiB;
constexpr size_t WS_H = 226 * MiB;
constexpr size_t WS_LA = 490 * MiB;
constexpr size_t WS_END = 496 * MiB;
static_assert(WS_XN + (size_t)(M + 256) * DM * 2 <= WS_PROJ && WS_PROJ + (size_t)M * INW * 2 <= WS_OA && WS_OA + 3 * (size_t)M * 512 * 2 <= WS_LA && WS_H + (size_t)M * DFF * 2 <= WS_LA && WS_PROJ + (size_t)M * DM * 2 <= WS_H, "d_ws map");

constexpr int RING_BYTES = 131072, XCH_OFF = RING_BYTES, MISC_OFF = XCH_OFF + 8192, LDS_BYTES = 147456;

#define LAS __attribute__((address_space(3)))
typedef unsigned short bf16;
typedef unsigned v4u __attribute__((ext_vector_type(4)));
typedef float f32x4 __attribute__((ext_vector_type(4)));
typedef float f32x16 __attribute__((ext_vector_type(16)));
typedef short bf16x8 __attribute__((ext_vector_type(8)));
typedef short s16x4 __attribute__((ext_vector_type(4)));
using pg8::cvtpk;
__device__ __forceinline__ float bf_lo(unsigned w) { return __uint_as_float(w << 16); }
__device__ __forceinline__ float bf_hi(unsigned w) { return __uint_as_float(w & 0xffff0000u); }
__device__ __forceinline__ float wave_sum(float v) {
#pragma unroll
    for (int o = 1; o < 64; o <<= 1) v += __shfl_xor(v, o);
    return v;
}
__device__ __forceinline__ float wave_max(float v) {
#pragma unroll
    for (int o = 1; o < 64; o <<= 1) v = fmaxf(v, __shfl_xor(v, o));
    return v;
}

#define GAS __attribute__((address_space(1)))
#define RLX_AGENT __ATOMIC_RELAXED, __HIP_MEMORY_SCOPE_AGENT
#define XB_TMO      128
#define XB_XCNT(j)  (256  + 64 * (j))
#define XB_XSUB(j)  (1280 + 64 * (j))
#define XB_XGEN(j)  (2304 + 64 * (j))
#define XB_TOP      3328
#define XB_TOPGEN   3392
#define XCD_BAR_WORDS 3456
#define XB_SPIN_CAP (1u << 18)

__device__ __forceinline__ unsigned xb_ld(unsigned* p)              { return __hip_atomic_load(p, __ATOMIC_RELAXED, __HIP_MEMORY_SCOPE_AGENT); }
__device__ __forceinline__ unsigned xb_add(unsigned* p, unsigned v) { return __hip_atomic_fetch_add(p, v, __ATOMIC_RELAXED, __HIP_MEMORY_SCOPE_AGENT); }
__device__ __forceinline__ unsigned xb_xcc_id() { return (unsigned)__builtin_amdgcn_s_getreg((3 << 11) | 20) & 0xFu; }
#define XB_SPIN(cond, bar) do { unsigned _sp = 0; while (cond) { __builtin_amdgcn_s_sleep(1); \
    if ((++_sp & 255u) == 0u) { if (xb_ld(&(bar)[XB_TMO])) break; if (_sp > XB_SPIN_CAP) { atomicAdd(&(bar)[XB_TMO], 1u); break; } } } } while (0)

struct XcdBarrier {
    unsigned* bar; unsigned x;
    volatile LAS unsigned* st;
};

__device__ __forceinline__ XcdBarrier xcd_barrier_post(unsigned* bar, volatile LAS unsigned* st) {
    XcdBarrier b; b.bar = bar; b.x = xb_xcc_id(); b.st = st;
    if (threadIdx.x == 0) (void)xb_add(&bar[XB_XCNT(b.x)], 1u);
    return b;
}
__device__ __forceinline__ void xcd_barrier_complete(unsigned* bar, unsigned x, unsigned& nloc, unsigned& nx) {
    const unsigned G = gridDim.x * gridDim.y * gridDim.z;
    unsigned sum, cnt, mine, sp = 0u;
    for (;;) {
        sum = 0u; cnt = 0u; mine = 0u;
#pragma unroll
        for (unsigned j = 0; j < 16; ++j) { const unsigned c = xb_ld(&bar[XB_XCNT(j)]); sum += c; cnt += (c > 0u) ? 1u : 0u; mine = (j == x) ? c : mine; }
        if (sum == G) break;
        __builtin_amdgcn_s_sleep(1);
        if ((++sp & 255u) == 0u) { if (xb_ld(&bar[XB_TMO])) break; if (sp > XB_SPIN_CAP) { atomicAdd(&bar[XB_TMO], 1u); break; } }
    }
    nloc = mine > 0u ? mine : 1u; nx = cnt > 0u ? cnt : 1u;
}

__device__ __forceinline__ void xcd_barrier(const XcdBarrier& b) {
    asm volatile("s_waitcnt vmcnt(0)" ::: "memory");
    __syncthreads();
    if (threadIdx.x == 0) {
        unsigned* bar = b.bar;
        __builtin_amdgcn_s_waitcnt(0);
        unsigned nloc = b.st[0], nx = b.st[1];
        if (nloc == 0u) { xcd_barrier_complete(bar, b.x, nloc, nx); b.st[0] = nloc; b.st[1] = nx; }
        const unsigned old = xb_add(&bar[XB_XSUB(b.x)], 1u);
        const unsigned gen = old / nloc;
        if (old + 1u == (gen + 1u) * nloc) {
            __builtin_amdgcn_fence(__ATOMIC_RELEASE, "agent");
            asm volatile("s_waitcnt vmcnt(0)" ::: "memory");
            const unsigned og = xb_add(&bar[XB_TOP], 1u);
            const unsigned tg = og / nx;
            if (og + 1u == (tg + 1u) * nx) xb_add(&bar[XB_TOPGEN], 1u);
            else XB_SPIN(xb_ld(&bar[XB_TOPGEN]) == tg, bar);
            __builtin_amdgcn_fence(__ATOMIC_ACQUIRE, "agent");
            xb_add(&bar[XB_XGEN(b.x)], 1u);
            asm volatile("s_waitcnt vmcnt(0)" ::: "memory");
        } else {
            XB_SPIN(xb_ld(&bar[XB_XGEN(b.x)]) == gen, bar);
            __builtin_amdgcn_fence(__ATOMIC_ACQUIRE, "agent");
            asm volatile("s_waitcnt vmcnt(0)" ::: "memory");
        }
    }
    __syncthreads();
}

template <int MAP  >
__device__ __forceinline__ void p0_transpose_item(const float* W, int K, int N, bf16* WT, const float* kgain, LAS float* scr, int item, int lane) {
    const int nblk = N / 32, kb = item / nblk, nb = item % nblk, k0 = 64 * kb, n0 = 32 * nb;
#pragma unroll 8
    for (int i = 0; i < 32; ++i) { const int kk = 2 * i + (lane >> 5); float v = W[(size_t)(k0 + kk) * N + n0 + (lane & 31)]; if (kgain) v *= kgain[k0 + kk]; scr[kk * 33 + (lane & 31)] = v; }
    asm volatile("s_waitcnt lgkmcnt(0)" ::: "memory");
    const int c = lane & 7;
    int r0 = n0;
    if (MAP == 2) { const int hs = n0 >> 6; r0 = 256 * (hs >> 2) + 128 * ((n0 >> 5) & 1) + 32 * (hs & 3); }
    if (MAP == 1) r0 = n0 < DFF ? ((n0 >> 7) * 256 + (n0 & 127)) : ((((n0 - DFF) >> 7) * 256) + 128 + ((n0 - DFF) & 127));
#pragma unroll
    for (int j = 0; j < 4; ++j) { const int n = (lane >> 3) + 8 * j; const LAS float* s = scr + (8 * c) * 33 + n;
        v4u o; o.x = cvtpk(s[0 * 33], s[1 * 33]); o.y = cvtpk(s[2 * 33], s[3 * 33]); o.z = cvtpk(s[4 * 33], s[5 * 33]); o.w = cvtpk(s[6 * 33], s[7 * 33]);
        *(v4u*)(WT + (size_t)(r0 + n) * K + k0 + 8 * c) = o; }
    asm volatile("s_waitcnt lgkmcnt(0)" ::: "memory");
}
__device__ __forceinline__ void rows4_to_bf16(const float* xrow, bf16* orow, float* ssq, int lane) {
    f32x4 v[4][4]; float s[4];
#pragma unroll
    for (int k = 0; k < 4; ++k)
#pragma unroll
        for (int j = 0; j < 4; ++j) v[k][j] = ((const f32x4*)(xrow + (size_t)k * DM) + lane)[64 * j];
#pragma unroll
    for (int k = 0; k < 4; ++k) { s[k] = 0.f;
#pragma unroll
        for (int j = 0; j < 4; ++j) s[k] += (v[k][j].x * v[k][j].x + v[k][j].y * v[k][j].y) + (v[k][j].z * v[k][j].z + v[k][j].w * v[k][j].w);
        unsigned long long* o8 = (unsigned long long*)(orow + (size_t)k * DM) + lane;
#pragma unroll
        for (int j = 0; j < 4; ++j) o8[64 * j] = (unsigned long long)cvtpk(v[k][j].x, v[k][j].y) | ((unsigned long long)cvtpk(v[k][j].z, v[k][j].w) << 32); }
#pragma unroll
    for (int o = 1; o < 64; o <<= 1) {
#pragma unroll
        for (int k = 0; k < 4; ++k) s[k] += __shfl_xor(s[k], o); }
    if (lane < 4) ssq[lane] = lane == 0 ? s[0] : lane == 1 ? s[1] : lane == 2 ? s[2] : s[3];
}

template <int NKEYS, int NTHR>
__device__ __forceinline__ void stage_load(v4u (&kr)[NKEYS * 8 / NTHR], v4u (&vr)[NKEYS * 8 / NTHR], const bf16* kbase, const bf16* vbase, int tok0, int dshift, int kidx0, int Ls, int t) {
    constexpr int NIT = NKEYS * 8 / NTHR;
    const int c = t & 7;
#pragma unroll
    for (int it = 0; it < NIT; ++it) { const int rho = (it * NTHR + t) >> 3, kidx = kidx0 + rho; const bool ok = (unsigned)kidx < (unsigned)Ls;
        const size_t off = (size_t)(tok0 + ((ok ? kidx : 0) << dshift)) * 64 + 8 * c;
        kr[it] = *(const v4u*)(kbase + off); vr[it] = *(const v4u*)(vbase + off); }
}
template <int NKEYS, int NTHR>
__device__ __forceinline__ void stage_write(const v4u (&kr)[NKEYS * 8 / NTHR], const v4u (&vr)[NKEYS * 8 / NTHR], LAS unsigned char* Kl, LAS unsigned char* Vl, int t) {
    constexpr int NIT = NKEYS * 8 / NTHR;
    const int c = t & 7;
#pragma unroll
    for (int it = 0; it < NIT; ++it) { const int rho = (it * NTHR + t) >> 3;
        *(LAS v4u*)(Kl + rho * 128 + 16 * (c ^ ((rho >> 1) & 7))) = kr[it];
        *(LAS v4u*)(Vl + (c >> 2) * (NKEYS * 64) + rho * 64 + (c & 3) * 16) = vr[it]; }
}
__device__ __forceinline__ void load_q_raw(v4u (&raw)[4], const bf16* qrow, int lane) {
#pragma unroll
    for (int d0 = 0; d0 < 4; ++d0) raw[d0] = *(const v4u*)(qrow + 16 * d0 + 8 * (lane >> 5));
}
typedef short v4i16_t __attribute__((ext_vector_type(4)));
__device__ __forceinline__ s16x4 vtr(const LAS unsigned char* p) { return __builtin_bit_cast(s16x4, __builtin_amdgcn_ds_read_tr16_b64_v4i16((LAS v4i16_t*)p)); }
template <int R, bool BAND, bool EDGE, bool SAFE>
__device__ __forceinline__ void attn_tile(const bf16x8 (&kf)[4], unsigned vaddr, int vhs, int j, int kidx_t0, int Ls, const bf16x8 (&qf)[4], float base, float nslope, float negM, f32x16 (&o)[2], float& l, int hi) {
    s16x4 vl[4], vh[4];
    asm volatile("ds_read_b64_tr_b16 %0, %8\n\tds_read_b64_tr_b16 %1, %8 offset:512\n\tds_read_b64_tr_b16 %2, %8 offset:1024\n\tds_read_b64_tr_b16 %3, %8 offset:1536\n\t"
                 "ds_read_b64_tr_b16 %4, %9\n\tds_read_b64_tr_b16 %5, %9 offset:512\n\tds_read_b64_tr_b16 %6, %9 offset:1024\n\tds_read_b64_tr_b16 %7, %9 offset:1536"
                 : "=&v"(vl[0]), "=&v"(vh[0]), "=&v"(vl[1]), "=&v"(vh[1]), "=&v"(vl[2]), "=&v"(vh[2]), "=&v"(vl[3]), "=&v"(vh[3]) : "v"(vaddr), "v"(vaddr + (unsigned)vhs) : "memory");
    f32x16 s = {0.f, 0.f, 0.f, 0.f, 0.f, 0.f, 0.f, 0.f, 0.f, 0.f, 0.f, 0.f, 0.f, 0.f, 0.f, 0.f};
#pragma unroll
    for (int d0 = 0; d0 < 4; ++d0) s = __builtin_amdgcn_mfma_f32_32x32x16_bf16(kf[d0], qf[d0], s, 0, 0, 0);
    if (SAFE) {
#pragma unroll
        for (int r = 0; r < 16; ++r) s[r] += negM; }
    const float basej = base + (float)(32 * j);
    float pr[16];
#pragma unroll
    for (int r = 0; r < 16; ++r) { const float relf = basej + (float)((r & 3) + 8 * (r >> 2));
        float p = __builtin_amdgcn_exp2f(__builtin_fmaf(__builtin_fabsf(relf), nslope, s[r]));
        if (BAND) p = (__builtin_fabsf(relf) <= (float)R) ? p : 0.f;
        if (EDGE) { const int kidx = kidx_t0 + 32 * j + (r & 3) + 8 * (r >> 2) + 4 * hi; p = ((unsigned)kidx < (unsigned)Ls) ? p : 0.f; }
        l += p; pr[r] = p; }
    v4u w0, w1; w0.x = cvtpk(pr[0], pr[1]); w0.y = cvtpk(pr[2], pr[3]); w0.z = cvtpk(pr[4], pr[5]); w0.w = cvtpk(pr[6], pr[7]);
    w1.x = cvtpk(pr[8], pr[9]); w1.y = cvtpk(pr[10], pr[11]); w1.z = cvtpk(pr[12], pr[13]); w1.w = cvtpk(pr[14], pr[15]);
    const bf16x8 pa0 = __builtin_bit_cast(bf16x8, w0), pa1 = __builtin_bit_cast(bf16x8, w1);
    asm volatile("s_waitcnt lgkmcnt(0)" : "+v"(vl[0]), "+v"(vh[0]), "+v"(vl[1]), "+v"(vh[1]), "+v"(vl[2]), "+v"(vh[2]), "+v"(vl[3]), "+v"(vh[3]) :: "memory");
#pragma unroll
    for (int dh = 0; dh < 2; ++dh)
#pragma unroll
        for (int s2 = 0; s2 < 2; ++s2) { const s16x4 lo = vl[2 * dh + s2], h4 = vh[2 * dh + s2];
            const bf16x8 vf = (bf16x8){lo[0], lo[1], lo[2], lo[3], h4[0], h4[1], h4[2], h4[3]};
            o[dh] = __builtin_amdgcn_mfma_f32_32x32x16_bf16(vf, s2 ? pa1 : pa0, o[dh], 0, 0, 0); }
}
template <int NT, int R, bool EDGE, bool SAFE>
__device__ __forceinline__ void attn_task(const LAS unsigned char* Kl, const LAS unsigned char* Vl, int vhs, int row0, int kidx_t0, int Ls, const bf16x8 (&qf)[4], float slope2, float negM, f32x16 (&o)[2], float& l, int lane) {
    const int q = lane & 31, hi = lane >> 5;
    const unsigned va0 = (unsigned)(uintptr_t)(Vl + row0 * 64 + (4 * hi + ((lane & 15) >> 2)) * 64 + (16 * ((lane >> 4) & 1) + 4 * (lane & 3)) * 2);
    const int sw = (q >> 1) & 7;
    const LAS unsigned char* kp0 = Kl + (row0 + q) * 128 + 16 * ((0 + hi) ^ sw); const LAS unsigned char* kp1 = Kl + (row0 + q) * 128 + 16 * ((2 + hi) ^ sw);
    const LAS unsigned char* kp2 = Kl + (row0 + q) * 128 + 16 * ((4 + hi) ^ sw); const LAS unsigned char* kp3 = Kl + (row0 + q) * 128 + 16 * ((6 + hi) ^ sw);
    float base = (float)(4 * hi - R - q); asm volatile("" : "+v"(base));
    const float nslope = -slope2;
#define LOADK(dst, jj) do { dst[0] = *(const LAS bf16x8*)(kp0 + (jj) * 4096); dst[1] = *(const LAS bf16x8*)(kp1 + (jj) * 4096); dst[2] = *(const LAS bf16x8*)(kp2 + (jj) * 4096); dst[3] = *(const LAS bf16x8*)(kp3 + (jj) * 4096); } while (0)
    bf16x8 kf[4];
    LOADK(kf, 0);
    attn_tile<R, true, EDGE, SAFE>(kf, va0, vhs, 0, kidx_t0, Ls, qf, base, nslope, negM, o, l, hi);
#pragma unroll 1
    for (int j = 1; j < NT - 1; ++j) {
        LOADK(kf, j);
        attn_tile<R, false, EDGE, SAFE>(kf, va0 + j * 2048, vhs, j, kidx_t0, Ls, qf, base, nslope, negM, o, l, hi);
    }
    LOADK(kf, NT - 1);
    attn_tile<R, true, EDGE, SAFE>(kf, va0 + (NT - 1) * 2048, vhs, NT - 1, kidx_t0, Ls, qf, base, nslope, negM, o, l, hi);
#undef LOADK
}
__device__ __forceinline__ void store_partial(const f32x16 (&o)[2], float l, bf16* OBuf, float* LB, int tokq0, int dshift, int h, int lane) {
    const int hi = lane >> 5, q = lane & 31; const size_t row = (size_t)h * M + (size_t)(tokq0 + (q << dshift));
    l += __shfl_xor(l, 32);
    if (hi == 0) LB[row] = l;
    bf16* p = OBuf + row * 64 + 4 * hi;
#pragma unroll
    for (int dh = 0; dh < 2; ++dh)
#pragma unroll
        for (int g = 0; g < 4; ++g) { unsigned long long w = (unsigned long long)cvtpk(o[dh][4 * g], o[dh][4 * g + 1]) | ((unsigned long long)cvtpk(o[dh][4 * g + 2], o[dh][4 * g + 3]) << 32);
            *(unsigned long long*)(p + 32 * dh + 8 * g) = w; }
}
struct AUnit { int tok0, dshift, Ls, cc, h, c; };
__device__ __forceinline__ AUnit decode_a(int su) {
    AUnit a; const int sidx = su / 48, k = su % 48, blk = sidx >> 3; a.h = sidx & 7; a.c = 2 - (k >> 4); a.dshift = 2 * a.c; const int kk = k & 15;
    int seq0, S, bis; if (blk < 8) { seq0 = 0; S = 16384; bis = blk; } else { seq0 = MP + 2048 * (blk - 8); S = 2048; bis = 0; }
    a.Ls = S >> a.dshift; const int lcpb = 4 - a.dshift  , res = kk >> lcpb; a.cc = (bis << lcpb) + (kk & ((1 << lcpb) - 1)); a.tok0 = seq0 + res; return a;
}
struct BUnit { int seq0, S, lcb, g2; };
__device__ __forceinline__ BUnit decode_b(int u) {
    BUnit b; b.g2 = u / 768; const int cb = u % 768;
    if (cb < 256) { b.seq0 = 0; b.S = 16384; b.lcb = cb; } else { b.seq0 = MP + 2048 * ((cb - 256) >> 5); b.S = 2048; b.lcb = (cb - 256) & 31; } return b;
}

#define LDS_BAR() asm volatile("s_waitcnt lgkmcnt(0)\n\ts_barrier" ::: "memory")
#define xp (args.in[0])
#define xs (args.in[1])
#define norm1 (args.in[2])
#define w_in (args.in[3])
#define qna (args.in[4])
#define kna (args.in[5])
#define qnb (args.in[6])
#define knb (args.in[7])
#define sinkb (args.in[8])
#define ona (args.in[9])
#define onb (args.in[10])
#define w_out (args.in[11])
#define norm2 (args.in[12])
#define w_up (args.in[13])
#define conv_w (args.in[14])
#define conv_b (args.in[15])
#define w_down (args.in[16])
#define out (args.dout)
#define SSQ ((float*)(args.ws + WS_SSQ))
#define SSQ1 ((float*)(args.ws + WS_SSQ1))
#define WIN ((bf16*)(args.ws + WS_WIN))
#define WOUT ((bf16*)(args.ws + WS_WOUT))
#define WUP ((bf16*)(args.ws + WS_WUP))
#define WDN ((bf16*)(args.ws + WS_WDN))
#define XN ((bf16*)(args.ws + WS_XN) + DM)
#define PROJ ((bf16*)(args.ws + WS_PROJ))
#define Y ((bf16*)(args.ws + WS_PROJ))
#define OA ((bf16*)(args.ws + WS_OA))
#define OB ((bf16*)args.dout)
#define HB ((bf16*)(args.ws + WS_H))
#define LA ((float*)(args.ws + WS_LA))
#define LBp ((float*)(args.ws + WS_LA) + 3 * (size_t)M * 8)
struct Args { const float* in[17]; float* dout; unsigned char* ws; };
__global__ void __launch_bounds__(NWAVES * 64, 2) fwd_megakernel(Args args) {
    extern __shared__ __attribute__((aligned(16))) unsigned char lds_raw[];
    cg::grid_group grid = cg::this_grid();
    LAS unsigned char* lds = (LAS unsigned char*)lds_raw;
    const int tid = threadIdx.x, lane = tid & 63, wave = __builtin_amdgcn_readfirstlane(tid >> 6);
    const int G = gridDim.x, bx = blockIdx.x;
    if (tid < 2) ((LAS unsigned*)(lds + MISC_OFF))[tid] = 0u;
    const int gw = bx * NWAVES + wave, NGW = G * NWAVES;
    __syncthreads();
    XcdBarrier bar = xcd_barrier_post((unsigned*)(args.ws + WS_BAR), (volatile LAS unsigned*)(lds + MISC_OFF));
    if (args.ws == nullptr) grid.sync();

    {
        LAS float* scr = (LAS float*)(lds + wave * 16384);
        constexpr int I_IN = (DM / 64) * (INW / 32), I_OUT = (DM / 64) * (DM / 32), I_UP = (DM / 64) * (UPW / 32), I_DN = (DFF / 64) * (DM / 32);
        for (int it = gw; it < I_IN + I_OUT + I_UP + I_DN; it += NGW) {
            int r = it;
            if (r < I_IN) { p0_transpose_item<2>(w_in, DM, INW, WIN, norm1, scr, r, lane); continue; } r -= I_IN;
            if (r < I_OUT) { p0_transpose_item<0>(w_out, DM, DM, WOUT, nullptr, scr, r, lane); continue; } r -= I_OUT;
            if (r < I_UP) { p0_transpose_item<1>(w_up, DM, UPW, WUP, norm2, scr, r, lane); continue; } r -= I_UP;
            p0_transpose_item<0>(w_down, DFF, DM, WDN, nullptr, scr, r, lane);
        }
        for (int m = gw * 4; m < M; m += NGW * 4) rows4_to_bf16(m < MP ? xp + (size_t)m * DM : xs + (size_t)(m - MP) * DM, XN + (size_t)m * DM, SSQ1 + m, lane);
        for (int i = bx * 512 + tid; i < M; i += G * 512) SSQ[i] = 0.f;
    }
    xcd_barrier(bar);

    {
        pg8::Gemm g{XN, WIN, M, INW, DM, 256}; pg8::StaticOrder S; S.init(M, INW, G, bx);
        pg8::EpiProj E{PROJ, SSQ1, qna, kna, qnb, knb};
        pg8::gemm_phase<pg8::EpiProj, pg8::StaticOrder, PG8_ALIGN, PG8_SP2>(lds, g, S, E);
    }
    xcd_barrier(bar);

    {
        const float gqa = fabsf(qna[lane]), gka = fabsf(kna[lane]);
        const float boundA = __builtin_bit_cast(float, __builtin_amdgcn_readfirstlane(__builtin_bit_cast(int, 8.0f * wave_max(gqa) * wave_max(gka) * LOG2E)));
        const float negMa = boundA > 40.f ? -boundA : 0.f;
        {
            const int half = wave >> 2, w4 = wave & 3, th = tid & 255;
            LAS unsigned char* Kl = lds + half * 65536; LAS unsigned char* Vl = Kl + 32768;
            const int ubase = (G == 256) ? (bx & 7) * 576 + (bx >> 3) : bx, ustep = (G == 256) ? 32 : G, uend = (G == 256) ? (bx & 7) * 576 + 576 : 4608;
            v4u kr[8], vr[8], qraw[4]; AUnit nx = decode_a(2 * ubase + half);
            if (ubase < uend) { stage_load<256, 256>(kr, vr, PROJ + (size_t)(8 + nx.h) * M * 64, PROJ + (size_t)(16 + nx.h) * M * 64, nx.tok0, nx.dshift, 128 * nx.cc - 64, nx.Ls, th);
                load_q_raw(qraw, PROJ + ((size_t)nx.h * M + (nx.tok0 + ((128 * nx.cc + 32 * w4 + (lane & 31)) << nx.dshift))) * 64, lane); }
            for (int u = ubase; u < uend; u += ustep) {
                const AUnit a = nx;
                LDS_BAR();
                stage_write<256, 256>(kr, vr, Kl, Vl, th);
                bf16x8 qf[4];
#pragma unroll
                for (int d0 = 0; d0 < 4; ++d0) qf[d0] = __builtin_bit_cast(bf16x8, qraw[d0]);
                LDS_BAR();
                if (u + ustep < uend) { nx = decode_a(2 * (u + ustep) + half);
                    stage_load<256, 256>(kr, vr, PROJ + (size_t)(8 + nx.h) * M * 64, PROJ + (size_t)(16 + nx.h) * M * 64, nx.tok0, nx.dshift, 128 * nx.cc - 64, nx.Ls, th);
                    load_q_raw(qraw, PROJ + ((size_t)nx.h * M + (nx.tok0 + ((128 * nx.cc + 32 * w4 + (lane & 31)) << nx.dshift))) * 64, lane); }
                const int iq0 = 128 * a.cc + 32 * w4;
                f32x16 o[2]; float l = 0.f;
#pragma unroll
                for (int r = 0; r < 16; ++r) { o[0][r] = 0.f; o[1][r] = 0.f; }
                const float slope2 = __builtin_amdgcn_exp2f(-0.5f * (float)(a.h + 9) + (float)a.dshift) * LOG2E;
                const bool edge = iq0 - 64 < 0 || iq0 + 96 > a.Ls;
                if (__builtin_expect(negMa != 0.f, 0)) { if (edge) attn_task<5, 64, true, true>(Kl, Vl, 256 * 64, 32 * w4, iq0 - 64, a.Ls, qf, slope2, negMa, o, l, lane); else attn_task<5, 64, false, true>(Kl, Vl, 256 * 64, 32 * w4, iq0 - 64, a.Ls, qf, slope2, negMa, o, l, lane); }
                else if (edge) attn_task<5, 64, true, false>(Kl, Vl, 256 * 64, 32 * w4, iq0 - 64, a.Ls, qf, slope2, 0.f, o, l, lane);
                else attn_task<5, 64, false, false>(Kl, Vl, 256 * 64, 32 * w4, iq0 - 64, a.Ls, qf, slope2, 0.f, o, l, lane);
                asm volatile("s_nop 15\n\ts_nop 7" ::: "memory");
                store_partial(o, l, OA + (size_t)a.c * M * 512, LA + (size_t)a.c * M * 8, a.tok0 + (iq0 << a.dshift), a.dshift, a.h, lane);
            }
        }
        const float gqb = fabsf(qnb[lane]), gkb = fabsf(knb[lane]);
        const float boundB = __builtin_bit_cast(float, __builtin_amdgcn_readfirstlane(__builtin_bit_cast(int, 8.0f * wave_max(gqb) * wave_max(gkb) * LOG2E)));
        const float negMb = boundB > 40.f ? -boundB : 0.f;
        {
            LAS unsigned char* Kb = lds; LAS unsigned char* Vb = lds + 40960;
            const int ubase = (G == 256) ? (bx & 7) * 192 + (bx >> 3) : bx, ustep = (G == 256) ? 32 : G, uend = (G == 256) ? (bx & 7) * 192 + 192 : 1536;
            v4u kr[5], vr[5], qraw[4]; BUnit nx = decode_b(ubase);
            if (ubase < uend) { stage_load<320, 512>(kr, vr, PROJ + (size_t)(32 + nx.g2) * M * 64, PROJ + (size_t)(34 + nx.g2) * M * 64, nx.seq0, 0, 64 * nx.lcb - 128, nx.S, tid);
                load_q_raw(qraw, PROJ + ((size_t)(24 + 4 * nx.g2 + (wave >> 1)) * M + (nx.seq0 + 64 * nx.lcb + 32 * (wave & 1) + (lane & 31))) * 64, lane); }
            for (int u = ubase; u < uend; u += ustep) {
                const BUnit b = nx;
                LDS_BAR();
                stage_write<320, 512>(kr, vr, Kb, Vb, tid);
                bf16x8 qf[4];
#pragma unroll
                for (int d0 = 0; d0 < 4; ++d0) qf[d0] = __builtin_bit_cast(bf16x8, qraw[d0]);
                LDS_BAR();
                if (u + ustep < uend) { nx = decode_b(u + ustep);
                    stage_load<320, 512>(kr, vr, PROJ + (size_t)(32 + nx.g2) * M * 64, PROJ + (size_t)(34 + nx.g2) * M * 64, nx.seq0, 0, 64 * nx.lcb - 128, nx.S, tid);
                    load_q_raw(qraw, PROJ + ((size_t)(24 + 4 * nx.g2 + (wave >> 1)) * M + (nx.seq0 + 64 * nx.lcb + 32 * (wave & 1) + (lane & 31))) * 64, lane); }
                const int hb = 4 * b.g2 + (wave >> 1), iq0 = 64 * b.lcb + 32 * (wave & 1);
                f32x16 o[2]; float l = 0.f;
#pragma unroll
                for (int r = 0; r < 16; ++r) { o[0][r] = 0.f; o[1][r] = 0.f; }
                const float slope2 = __builtin_amdgcn_exp2f(-0.5f * (float)(hb + 1)) * LOG2E;
                const bool edge = iq0 - 128 < 0 || iq0 + 160 > b.S;
                if (__builtin_expect(negMb != 0.f, 0)) { if (edge) attn_task<9, 128, true, true>(Kb, Vb, 320 * 64, 32 * (wave & 1), iq0 - 128, b.S, qf, slope2, negMb, o, l, lane); else attn_task<9, 128, false, true>(Kb, Vb, 320 * 64, 32 * (wave & 1), iq0 - 128, b.S, qf, slope2, negMb, o, l, lane); }
                else if (edge) attn_task<9, 128, true, false>(Kb, Vb, 320 * 64, 32 * (wave & 1), iq0 - 128, b.S, qf, slope2, 0.f, o, l, lane);
                else attn_task<9, 128, false, false>(Kb, Vb, 320 * 64, 32 * (wave & 1), iq0 - 128, b.S, qf, slope2, 0.f, o, l, lane);
                asm volatile("s_nop 15\n\ts_nop 7" ::: "memory");
                store_partial(o, l, OB, LBp, b.seq0 + iq0, 0, hb, lane);
            }
        }
        xcd_barrier(bar);
        {
            const int hh = lane >> 3;
            const float sinkterm = __builtin_amdgcn_exp2f(sinkb[hh] * LOG2E + negMb);
            const f32x4 ga0 = *(const f32x4*)(ona + 8 * lane), ga1 = *(const f32x4*)(ona + 8 * lane + 4), gb0 = *(const f32x4*)(onb + 8 * lane), gb1 = *(const f32x4*)(onb + 8 * lane + 4);
            for (int m0 = gw * 4; m0 < M; m0 += NGW * 4) {
                v4u wa[4][3], wb[4]; float la[4], lb[4];
#pragma unroll
                for (int k = 0; k < 4; ++k) { const int m = m0 + k; la[k] = 0.f;
#pragma unroll
                    for (int c = 0; c < 3; ++c) { wa[k][c] = *(const v4u*)(OA + (((size_t)c * 8 + hh) * M + m) * 64 + 8 * (lane & 7)); la[k] += LA[((size_t)c * 8 + hh) * M + m]; }
                    wb[k] = *(const v4u*)(OB + ((size_t)hh * M + m) * 64 + 8 * (lane & 7)); lb[k] = LBp[(size_t)hh * M + m] + sinkterm; }
                float ya[4][8], yb[4][8], sa[4], sb[4];
#pragma unroll
                for (int k = 0; k < 4; ++k) { const float ia = 1.0f / la[k], ib = 1.0f / lb[k];
                    ya[k][0] = (bf_lo(wa[k][0].x) + bf_lo(wa[k][1].x) + bf_lo(wa[k][2].x)) * ia; ya[k][1] = (bf_hi(wa[k][0].x) + bf_hi(wa[k][1].x) + bf_hi(wa[k][2].x)) * ia;
                    ya[k][2] = (bf_lo(wa[k][0].y) + bf_lo(wa[k][1].y) + bf_lo(wa[k][2].y)) * ia; ya[k][3] = (bf_hi(wa[k][0].y) + bf_hi(wa[k][1].y) + bf_hi(wa[k][2].y)) * ia;
                    ya[k][4] = (bf_lo(wa[k][0].z) + bf_lo(wa[k][1].z) + bf_lo(wa[k][2].z)) * ia; ya[k][5] = (bf_hi(wa[k][0].z) + bf_hi(wa[k][1].z) + bf_hi(wa[k][2].z)) * ia;
                    ya[k][6] = (bf_lo(wa[k][0].w) + bf_lo(wa[k][1].w) + bf_lo(wa[k][2].w)) * ia; ya[k][7] = (bf_hi(wa[k][0].w) + bf_hi(wa[k][1].w) + bf_hi(wa[k][2].w)) * ia;
                    yb[k][0] = bf_lo(wb[k].x) * ib; yb[k][1] = bf_hi(wb[k].x) * ib; yb[k][2] = bf_lo(wb[k].y) * ib; yb[k][3] = bf_hi(wb[k].y) * ib;
                    yb[k][4] = bf_lo(wb[k].z) * ib; yb[k][5] = bf_hi(wb[k].z) * ib; yb[k][6] = bf_lo(wb[k].w) * ib; yb[k][7] = bf_hi(wb[k].w) * ib;
                    sa[k] = 0.f; sb[k] = 0.f;
#pragma unroll
                    for (int i = 0; i < 8; ++i) { sa[k] += ya[k][i] * ya[k][i]; sb[k] += yb[k][i] * yb[k][i]; } }
#pragma unroll
                for (int o = 1; o < 64; o <<= 1) {
#pragma unroll
                    for (int k = 0; k < 4; ++k) { sa[k] += __shfl_xor(sa[k], o); sb[k] += __shfl_xor(sb[k], o); } }
#pragma unroll
                for (int k = 0; k < 4; ++k) { const int m = m0 + k;
                    const float ra = __builtin_amdgcn_rsqf(sa[k] * (1.f / 512.f) + EPS), rb = __builtin_amdgcn_rsqf(sb[k] * (1.f / 512.f) + EPS);
                    v4u oa, ob;
                    oa.x = cvtpk(ya[k][0] * ra * ga0.x, ya[k][1] * ra * ga0.y); oa.y = cvtpk(ya[k][2] * ra * ga0.z, ya[k][3] * ra * ga0.w); oa.z = cvtpk(ya[k][4] * ra * ga1.x, ya[k][5] * ra * ga1.y); oa.w = cvtpk(ya[k][6] * ra * ga1.z, ya[k][7] * ra * ga1.w);
                    ob.x = cvtpk(yb[k][0] * rb * gb0.x, yb[k][1] * rb * gb0.y); ob.y = cvtpk(yb[k][2] * rb * gb0.z, yb[k][3] * rb * gb0.w); ob.z = cvtpk(yb[k][4] * rb * gb1.x, yb[k][5] * rb * gb1.y); ob.w = cvtpk(yb[k][6] * rb * gb1.z, yb[k][7] * rb * gb1.w);
                    *(v4u*)(Y + (size_t)m * DM + 8 * lane) = oa; *(v4u*)(Y + (size_t)m * DM + 512 + 8 * lane) = ob; }
            }
        }
    }
    xcd_barrier(bar);

    {
        pg8::Gemm g{Y, WOUT, M, DM, DM, 256}; pg8::StaticOrder S; S.init(M, DM, G, bx);
        pg8::EpiOut E{XN, SSQ};
        pg8::gemm_phase<pg8::EpiOut, pg8::StaticOrder, PG8_ALIGN, PG8_SP2>(lds, g, S, E);
    }
    xcd_barrier(bar);

    {
        pg8::Gemm g{XN - DM, WUP, UP_TILES_M * 256, UPW, DM, 254}; pg8::StaticOrder S; S.init(UP_TILES_M * 256, UPW, G, bx);
        pg8::EpiUp E{HB, SSQ, conv_w, conv_b, (LAS float*)(lds + XCH_OFF)};
        pg8::gemm_phase<pg8::EpiUp, pg8::StaticOrder, true, PG8_SP2>(lds, g, S, E);
    }
    xcd_barrier(bar);

    {
        pg8::Gemm g{HB, WDN, M, DM, DFF, 256}; pg8::StaticOrder S; S.init(M, DM, G, bx);
        pg8::EpiDown E{XN, out};
        pg8::gemm_phase<pg8::EpiDown, pg8::StaticOrder, PG8_ALIGN, PG8_SP2>(lds, g, S, E);
    }
}

#undef out
#undef xp
#undef xs
extern "C" void kernel_launch(void* const* d_in, const int* in_sizes, int n_in, void* d_out, int out_size, void* d_ws, size_t ws_size, hipStream_t stream) {
    static int grid = 0;
    if (grid == 0) {
        if (n_in != 17 || out_size != M * DM || ws_size < WS_END) { fprintf(stderr, "kernel_launch: unexpected shapes (n_in %d out %d ws %zu)\n", n_in, out_size, ws_size); grid = -1; return; }
        int dev = 0, cus = 0, per_cu = 0;
        hipGetDevice(&dev); hipDeviceGetAttribute(&cus, hipDeviceAttributeMultiprocessorCount, dev);
        if (hipFuncSetAttribute((const void*)fwd_megakernel, hipFuncAttributeMaxDynamicSharedMemorySize, LDS_BYTES) != hipSuccess) { fprintf(stderr, "kernel_launch: hipFuncSetAttribute failed\n"); grid = -1; return; }
        if (hipOccupancyMaxActiveBlocksPerMultiprocessor(&per_cu, (const void*)fwd_megakernel, NWAVES * 64, LDS_BYTES) != hipSuccess || per_cu < 1) { fprintf(stderr, "kernel_launch: occupancy query says %d\n", per_cu); per_cu = 1; }
        (void)hipGetLastError();
        grid = cus;
        fprintf(stderr, "kernel_launch: grid %d (per_cu %d)\n", grid, per_cu);
    }
    if (grid < 0) return;
    Args a{};
    for (int i = 0; i < 17; ++i) a.in[i] = (const float*)d_in[i];
    a.dout = (float*)d_out; a.ws = (unsigned char*)d_ws;
    void* kargs[] = {&a};
    if (hipMemsetAsync((char*)d_ws + WS_BAR, 0, XCD_BAR_WORDS * 4, stream) != hipSuccess) { fprintf(stderr, "kernel_launch: hipMemsetAsync failed\n"); return; }
    hipError_t e = hipLaunchCooperativeKernel((const void*)fwd_megakernel, dim3(grid), dim3(NWAVES * 64), kargs, LDS_BYTES, stream);
    if (e != hipSuccess) fprintf(stderr, "kernel_launch: cooperative launch failed: %s\n", hipGetErrorString(e));
}
```

```cpp
#include <hip/hip_runtime.h>
#include <hip/hip_cooperative_groups.h>
#include <cstdio>
#include <cstdint>
namespace cg = cooperative_groups;
namespace pg8 {
#define PG8_LAS __attribute__((address_space(3)))
typedef unsigned short bf16_t;
typedef short bf16x8 __attribute__((ext_vector_type(8)));
typedef float f32x4 __attribute__((ext_vector_type(4)));
typedef unsigned u32x4 __attribute__((ext_vector_type(4)));
constexpr int BM = 256, BK = 64, HALF = 128, HTB = HALF * BK * 2  , STAGE_BYTES = 8 * HTB, NXCD = 8, WGM = 8;

__host__ __device__ __forceinline__ int lds_byte(int r, int c) { const int st = (r >> 4) * 2 + (c >> 5), rr = r & 15, cc = c & 31, ob = rr * 64 + cc * 2; return st * 1024 + (ob ^ (((ob >> 9) & 1) << 5)); }
__host__ __device__ __forceinline__ void stage_rc(int b, int& R, int& C) { const int st = b / 1024, sb = b % 1024, swz = sb ^ (((sb >> 9) & 1) << 5); R = (st >> 1) * 16 + swz / 64; C = (st & 1) * 32 + (swz % 64) / 2; }
__host__ __device__ __forceinline__ int perm32(int rho) { const int n = rho >> 4, i = rho & 15; return 8 * (i >> 2) + 4 * n + (i & 3); }

struct Unit { int pm, pn; };
struct Gemm { const bf16_t* A; const bf16_t* Bt; int M, N, K; int a_tile_rows; };

struct StaticOrder {
    int nM, nN, nwg, G, c;
    __host__ __device__ void init(int M, int N, int G_, int c_) { nM = M / BM; nN = N / BM; nwg = nM * nN; G = G_; c = c_; }
    __host__ __device__ bool next(int i, Unit& u) const {
        const long L = (long)i * G + c; if (L >= nwg) return false;
        int wgid = (int)L; { const int q = nwg / NXCD, r = nwg % NXCD, xcd = wgid % NXCD, off = wgid / NXCD; wgid = (xcd < r ? xcd * (q + 1) : r * (q + 1) + (xcd - r) * q) + off; }
        const int nig = WGM * nN, gid = wgid / nig, fm = gid * WGM, gsz = (nM - fm) < WGM ? (nM - fm) : WGM;
        u.pm = fm + ((wgid % nig) % gsz); u.pn = (wgid % nig) / gsz; return true;
    }
    __device__ __forceinline__ void a_ready(const Unit&) const {}
    __device__ __forceinline__ void done(const Unit&) const {}
};

__device__ __forceinline__ unsigned cvt_pk_bf16(float lo, float hi) { unsigned r; asm volatile("v_cvt_pk_bf16_f32 %0, %1, %2" : "=v"(r) : "v"(lo), "v"(hi)); return r; }
typedef float f32x2 __attribute__((ext_vector_type(2))); typedef __bf16 bf16x2_t __attribute__((ext_vector_type(2)));
__device__ __forceinline__ unsigned cvtpk(float lo, float hi) { f32x2 v = {lo, hi}; bf16x2_t b = __builtin_convertvector(v, bf16x2_t); return __builtin_bit_cast(unsigned, b); }
constexpr int MTOK = 49152, MPROMPT = 16384, DMODEL = 1024, DFF_ = 2816;
__device__ __forceinline__ u32x4 pack8(const f32x4 a, const f32x4 b) { u32x4 w; w.x = cvtpk(a[0], a[1]); w.y = cvtpk(a[2], a[3]); w.z = cvtpk(b[0], b[1]); w.w = cvtpk(b[2], b[3]); return w; }

struct EpiProj {
    static constexpr bool PERM = true, AFTER_DRAIN = false;
    bf16_t* O; const float* ssq1; const float* gqa; const float* gka; const float* gqb; const float* gkb;
    __device__ __forceinline__ void operator()(f32x4 (&acc)[2][2][4][2], const Unit& u, int wr, int wc, int fr, int fq, int wid, int lane) const {
        const int hs = 4 * u.pn + wc;
        const float* g = nullptr; float sc = 1.f;
        if (hs < 8) { g = gqa; sc = 0.125f * 1.4426950408889634f; } else if (hs < 16) g = gka; else if (hs >= 24 && hs < 32) { g = gqb; sc = 0.125f * 1.4426950408889634f; } else if (hs >= 32 && hs < 34) g = gkb;
        const int row0 = u.pm * BM + wr * 64 + fr;
        bf16_t* obase = O + ((size_t)hs * MTOK + row0) * 64 + 8 * fq;
#pragma unroll
        for (int ai = 0; ai < 2; ++ai)
#pragma unroll
            for (int m = 0; m < 4; ++m) { const float r1 = __builtin_amdgcn_rsqf(ssq1[row0 + ai * HALF + m * 16] * (1.0f / DMODEL) + 1e-6f);
#pragma unroll
                for (int bj = 0; bj < 2; ++bj)
#pragma unroll
                    for (int n = 0; n < 2; ++n) acc[ai][bj][m][n] *= r1; }
        if (g) {
            f32x4 gg[2][2];
#pragma unroll
            for (int bj = 0; bj < 2; ++bj)
#pragma unroll
                for (int n = 0; n < 2; ++n) gg[bj][n] = *(const f32x4*)(g + 32 * bj + 8 * fq + 4 * n) * sc;
#pragma unroll
            for (int ai = 0; ai < 2; ++ai)
#pragma unroll
                for (int m = 0; m < 4; ++m) { float ss = 0.f;
#pragma unroll
                    for (int bj = 0; bj < 2; ++bj)
#pragma unroll
                        for (int n = 0; n < 2; ++n) { const f32x4 a = acc[ai][bj][m][n]; ss += (a[0] * a[0] + a[1] * a[1]) + (a[2] * a[2] + a[3] * a[3]); }
                    ss += __shfl_xor(ss, 16); ss += __shfl_xor(ss, 32);
                    const float rs = __builtin_amdgcn_rsqf(ss * (1.0f / 64.0f) + 1e-6f);
                    bf16_t* rowp = obase + (size_t)(ai * HALF + m * 16) * 64;
#pragma unroll
                    for (int bj = 0; bj < 2; ++bj) *(u32x4*)(rowp + 32 * bj) = pack8(acc[ai][bj][m][0] * rs * gg[bj][0], acc[ai][bj][m][1] * rs * gg[bj][1]); }
        } else {
#pragma unroll
            for (int ai = 0; ai < 2; ++ai)
#pragma unroll
                for (int m = 0; m < 4; ++m) { bf16_t* rowp = obase + (size_t)(ai * HALF + m * 16) * 64;
#pragma unroll
                    for (int bj = 0; bj < 2; ++bj) *(u32x4*)(rowp + 32 * bj) = pack8(acc[ai][bj][m][0], acc[ai][bj][m][1]); }
        }
    }
};
struct EpiOut {
    static constexpr bool PERM = true, AFTER_DRAIN = false;
    bf16_t* xb; float* ssq;
    __device__ __forceinline__ void operator()(f32x4 (&acc)[2][2][4][2], const Unit& u, int wr, int wc, int fr, int fq, int wid, int lane) const {
        const int col0 = u.pn * BM + wc * 32 + 8 * fq; const int gr0 = u.pm * BM + wr * 64 + fr;
        u32x4 w[2][4][2];
#pragma unroll
        for (int ai = 0; ai < 2; ++ai)
#pragma unroll
            for (int m = 0; m < 4; ++m)
#pragma unroll
                for (int bj = 0; bj < 2; ++bj) w[ai][m][bj] = *(const u32x4*)(xb + (size_t)(gr0 + ai * HALF + m * 16) * DMODEL + col0 + bj * HALF);
#pragma unroll
        for (int ai = 0; ai < 2; ++ai)
#pragma unroll
            for (int m = 0; m < 4; ++m) { const int gr = gr0 + ai * HALF + m * 16;
                float s = 0.f;
#pragma unroll
                for (int bj = 0; bj < 2; ++bj) { const u32x4 v = w[ai][m][bj];
                    f32x4 a = {__uint_as_float(v.x << 16), __uint_as_float(v.x & 0xffff0000u), __uint_as_float(v.y << 16), __uint_as_float(v.y & 0xffff0000u)};
                    f32x4 b = {__uint_as_float(v.z << 16), __uint_as_float(v.z & 0xffff0000u), __uint_as_float(v.w << 16), __uint_as_float(v.w & 0xffff0000u)};
                    a += acc[ai][bj][m][0]; b += acc[ai][bj][m][1];
                    s += (a[0] * a[0] + a[1] * a[1]) + (a[2] * a[2] + a[3] * a[3]) + (b[0] * b[0] + b[1] * b[1]) + (b[2] * b[2] + b[3] * b[3]);
                    *(u32x4*)(xb + (size_t)gr * DMODEL + col0 + bj * HALF) = pack8(a, b); }
                s += __shfl_xor(s, 16); s += __shfl_xor(s, 32);
                if (fq == 0) unsafeAtomicAdd(ssq + gr, s); }
    }
};
struct EpiDown {
    static constexpr bool PERM = true, AFTER_DRAIN = false;
    const bf16_t* xb; float* out;
    __device__ __forceinline__ void operator()(f32x4 (&acc)[2][2][4][2], const Unit& u, int wr, int wc, int fr, int fq, int wid, int lane) const {
        const int col0 = u.pn * BM + wc * 32 + 8 * fq; const int gr0 = u.pm * BM + wr * 64 + fr;
        u32x4 w[2][4][2];
#pragma unroll
        for (int ai = 0; ai < 2; ++ai)
#pragma unroll
            for (int m = 0; m < 4; ++m)
#pragma unroll
                for (int bj = 0; bj < 2; ++bj) w[ai][m][bj] = *(const u32x4*)(xb + (size_t)(gr0 + ai * HALF + m * 16) * DMODEL + col0 + bj * HALF);
#pragma unroll
        for (int ai = 0; ai < 2; ++ai)
#pragma unroll
            for (int m = 0; m < 4; ++m) { float* o = out + (size_t)(gr0 + ai * HALF + m * 16) * DMODEL + col0;
#pragma unroll
                for (int bj = 0; bj < 2; ++bj) { const u32x4 v = w[ai][m][bj];
                    f32x4 a = {__uint_as_float(v.x << 16), __uint_as_float(v.x & 0xffff0000u), __uint_as_float(v.y << 16), __uint_as_float(v.y & 0xffff0000u)};
                    f32x4 b = {__uint_as_float(v.z << 16), __uint_as_float(v.z & 0xffff0000u), __uint_as_float(v.w << 16), __uint_as_float(v.w & 0xffff0000u)};
                    a += acc[ai][bj][m][0]; b += acc[ai][bj][m][1]; *(f32x4*)(o + bj * HALF) = a; *(f32x4*)(o + bj * HALF + 4) = b; } }
    }
};
__device__ __forceinline__ bool seq_first(int gr) { return gr == 0 || (gr >= MPROMPT && (gr & 2047) == 0); }
__device__ __forceinline__ bool seq_last(int gr) { return gr >= MPROMPT - 1 && (gr & 2047) == 2047; }
struct EpiUp {
    static constexpr bool PERM = true, AFTER_DRAIN = false;
    bf16_t* H; const float* ssq; const float* cw; const float* cb; PG8_LAS float* xch;
    __device__ __forceinline__ void operator()(f32x4 (&acc)[2][2][4][2], const Unit& u, int wr, int wc, int fr, int fq, int wid, int lane) const {
        const int lr0 = wr * 64 + fr, gr0 = 254 * u.pm - 1 + lr0;
#pragma unroll
        for (int ai = 0; ai < 2; ++ai)
#pragma unroll
            for (int m = 0; m < 4; ++m) { int gr = gr0 + ai * HALF + m * 16; gr = gr < 0 ? 0 : (gr > MTOK - 1 ? MTOK - 1 : gr);
                const float rs = __builtin_amdgcn_rsqf(ssq[gr] * (1.0f / DMODEL) + 1e-6f);
#pragma unroll
                for (int bj = 0; bj < 2; ++bj)
#pragma unroll
                    for (int n = 0; n < 2; ++n) acc[ai][bj][m][n] *= rs; }
#pragma unroll
        for (int ai = 0; ai < 2; ++ai) {
            if (fr == 0) { PG8_LAS float* p = xch + ((wid * 2 + ai) * 2 + 0) * 64 + 8 * fq;
#pragma unroll
                for (int bj = 0; bj < 2; ++bj)
#pragma unroll
                    for (int n = 0; n < 2; ++n) *(PG8_LAS f32x4*)(p + bj * 32 + 4 * n) = acc[ai][bj][0][n]; }
            if (fr == 15) { PG8_LAS float* p = xch + ((wid * 2 + ai) * 2 + 1) * 64 + 8 * fq;
#pragma unroll
                for (int bj = 0; bj < 2; ++bj)
#pragma unroll
                    for (int n = 0; n < 2; ++n) *(PG8_LAS f32x4*)(p + bj * 32 + 4 * n) = acc[ai][bj][3][n]; }
        }
        asm volatile("s_waitcnt lgkmcnt(0)" ::: "memory"); __builtin_amdgcn_s_barrier(); asm volatile("" ::: "memory");
        const int tlo = 254 * u.pm - 1, thi = tlo + 255; const bool anyb = (tlo <= 0) || (((thi + 1) >> 11) != ((tlo - 1) >> 11));
        const int ow = (1 - wr) * 4 + wc;
        const int ch0 = 128 * u.pn + 32 * wc + 8 * fq;
#pragma unroll
        for (int n = 0; n < 2; ++n) {
            f32x4 w0[2], w1[2], w2[2], bb[2];
#pragma unroll
            for (int bj = 0; bj < 2; ++bj) { const int ch = ch0 + 4 * n + bj * DFF_;
                w0[bj] = *(const f32x4*)(cw + ch); w1[bj] = *(const f32x4*)(cw + 2 * DFF_ + ch); w2[bj] = *(const f32x4*)(cw + 4 * DFF_ + ch); bb[bj] = *(const f32x4*)(cb + ch); }
#pragma unroll
            for (int ai = 0; ai < 2; ++ai) {
                const int aiT = wr == 1 ? ai : ai - 1, aiB = wr == 0 ? ai : ai + 1;
#pragma unroll
                for (int m = 0; m < 4; ++m) {
                    const int lr = lr0 + ai * HALF + m * 16, gr = gr0 + ai * HALF + m * 16;
                    const bool first = seq_first(gr), last = seq_last(gr);
                    f32x4 c[2];
#pragma unroll
                    for (int bj = 0; bj < 2; ++bj) {
                        const f32x4 cur = acc[ai][bj][m][n];
                        f32x4 pv, nx;
#pragma unroll
                        for (int e = 0; e < 4; ++e) {
                            const float sP = (m > 0 && fr == 15) ? acc[ai][bj][m > 0 ? m - 1 : 0][n][e] : cur[e];
                            const float sN = (m < 3 && fr == 0) ? acc[ai][bj][m < 3 ? m + 1 : 3][n][e] : cur[e];
                            pv[e] = __builtin_bit_cast(float, __builtin_amdgcn_mov_dpp(__builtin_bit_cast(int, sP), 0x121  , 0xf, 0xf, true));
                            nx[e] = __builtin_bit_cast(float, __builtin_amdgcn_mov_dpp(__builtin_bit_cast(int, sN), 0x12f  , 0xf, 0xf, true)); }
                        if (m == 0) { const f32x4 top = (aiT >= 0) ? *(const PG8_LAS f32x4*)(xch + ((ow * 2 + (aiT < 0 ? 0 : aiT)) * 2 + 1) * 64 + 8 * fq + bj * 32 + 4 * n) : (f32x4){0.f, 0.f, 0.f, 0.f}; if (fr == 0) pv = top; }
                        if (m == 3) { const f32x4 bot = (aiB <= 1) ? *(const PG8_LAS f32x4*)(xch + ((ow * 2 + (aiB > 1 ? 1 : aiB)) * 2 + 0) * 64 + 8 * fq + bj * 32 + 4 * n) : (f32x4){0.f, 0.f, 0.f, 0.f}; if (fr == 15) nx = bot; }
                        if (anyb) { if (first) pv = (f32x4){0.f, 0.f, 0.f, 0.f}; if (last) nx = (f32x4){0.f, 0.f, 0.f, 0.f}; }
                        c[bj] = bb[bj] + w0[bj] * pv + w1[bj] * cur + w2[bj] * nx;
                    }
                    f32x4 hv;
#pragma unroll
                    for (int e = 0; e < 4; ++e) { const float g = c[0][e]; hv[e] = g * __builtin_amdgcn_rcpf(1.0f + __builtin_amdgcn_exp2f(-1.4426950408889634f * g)) * c[1][e]; }
                    f32x2 pk; pk.x = __builtin_bit_cast(float, cvtpk(hv[0], hv[1])); pk.y = __builtin_bit_cast(float, cvtpk(hv[2], hv[3]));
                    if (lr >= 1 && lr <= 254 && gr < MTOK) *(f32x2*)(H + (size_t)gr * DFF_ + ch0 + 4 * n) = pk;
                    asm volatile("" ::: "memory");
                }
            }
        }
    }
};
template <class Epi, class Sched, bool ALIGN_EPI = false, bool SP2 = false>
__device__ __forceinline__ void gemm_phase(PG8_LAS unsigned char* lds, const Gemm g, const Sched& S, const Epi& E) {
    int tid_ = threadIdx.x; asm volatile("" : "+v"(tid_));
    const int tid = tid_, wid = __builtin_amdgcn_readfirstlane(tid >> 6), lane = tid & 63, wr = wid >> 2, wc = wid & 3, fr = lane & 15, fq = lane >> 4;
    const int K = g.K, nt = K / BK;
    unsigned voffA[2], voffB[2];
#pragma unroll
    for (int i = 0; i < 2; ++i) { int R, C; stage_rc(tid * 16 + i * 8192, R, C); const int Rb = Epi::PERM ? ((R & ~31) + perm32(R & 31)) : R;
        voffA[i] = (unsigned)(R * K + C) * 2u; voffB[i] = (unsigned)(Rb * K + C) * 2u; }
    const size_t kstep = (size_t)(BK * 2);
    const size_t hstep = (size_t)HALF * K * 2;
    const size_t tstep = 2 * hstep; const size_t tstepA = (size_t)g.a_tile_rows * K * 2;
    const unsigned ldsw = (unsigned)wid * 1024u;
    const int aoff = lds_byte(wr * 64 + fr, fq * 8), boff = lds_byte(wc * 32 + fr, fq * 8);
#define PG8_SA(b, h) (((b) * 2 + (h)) * HTB)
#define PG8_SB(b, h) ((4 + (b) * 2 + (h)) * HTB)
#define PG8_STAGE(bufoff, gbase, voff) do { _Pragma("unroll") for (int _i = 0; _i < 2; ++_i) \
        __builtin_amdgcn_global_load_lds((const unsigned*)((const char*)(gbase) + (voff)[_i]), (PG8_LAS unsigned*)(lds + (bufoff) + ldsw + _i * 8192), 16, 0, 0); } while (0)
#define PG8_LDA(dst, b, h) do { _Pragma("unroll") for (int m = 0; m < 4; ++m) _Pragma("unroll") for (int k = 0; k < 2; ++k) dst[m][k] = *(const PG8_LAS bf16x8*)(lds + PG8_SA(b, h) + aoff + m * 2048 + k * 1024); } while (0)
#define PG8_LDB(dst, b, h) do { _Pragma("unroll") for (int n = 0; n < 2; ++n) _Pragma("unroll") for (int k = 0; k < 2; ++k) dst[n][k] = *(const PG8_LAS bf16x8*)(lds + PG8_SB(b, h) + boff + n * 2048 + k * 1024); } while (0)
#define PG8_MMA(ai, bj, At, Bt) do { __builtin_amdgcn_s_setprio(1); _Pragma("unroll") for (int m = 0; m < 4; ++m) _Pragma("unroll") for (int n = 0; n < 2; ++n) _Pragma("unroll") for (int k = 0; k < 2; ++k) \
        acc[ai][bj][m][n] = __builtin_amdgcn_mfma_f32_16x16x32_bf16(Bt[n][k], At[m][k], acc[ai][bj][m][n], 0, 0, 0); __builtin_amdgcn_s_setprio(0); } while (0)
#define PG8_WAIT_V(n) asm volatile("s_waitcnt vmcnt(" #n ")" ::: "memory")
#define PG8_WAIT_L(n) asm volatile("s_waitcnt lgkmcnt(" #n ")" ::: "memory")
#define PG8_BAR __builtin_amdgcn_s_barrier()
#define PG8_SCHED __builtin_amdgcn_sched_barrier(0)
    Unit cur, nxt; int ui = 0;
    if (!S.next(0, cur)) return;
    f32x4 acc[2][2][4][2];
#pragma unroll
    for (int a = 0; a < 2; ++a)
#pragma unroll
        for (int b = 0; b < 2; ++b)
#pragma unroll
            for (int m = 0; m < 4; ++m)
#pragma unroll
                for (int n = 0; n < 2; ++n) acc[a][b][m][n] = (f32x4){0.f, 0.f, 0.f, 0.f};
    bf16x8 At[4][2], B0[2][2], B1[2][2];
    const char* cA = (const char*)g.A + (size_t)cur.pm * tstepA; const char* cB = (const char*)g.Bt + (size_t)cur.pn * tstep;
    S.a_ready(cur);
    if constexpr (SP2) {
        PG8_STAGE(PG8_SB(0, 0), cB, voffB); PG8_STAGE(PG8_SB(0, 1), cB + hstep, voffB); PG8_STAGE(PG8_SA(0, 0), cA, voffA); PG8_STAGE(PG8_SA(0, 1), cA + hstep, voffA);
        if (wr == 1) PG8_BAR;
        PG8_WAIT_V(2); PG8_BAR;
        PG8_STAGE(PG8_SB(1, 0), cB + kstep, voffB); PG8_STAGE(PG8_SA(1, 0), cA + kstep, voffA); PG8_STAGE(PG8_SB(1, 1), cB + hstep + kstep, voffB);
        PG8_WAIT_V(6); PG8_BAR;
    } else {
        PG8_STAGE(PG8_SB(0, 0), cB, voffB); PG8_STAGE(PG8_SA(0, 0), cA, voffA); PG8_STAGE(PG8_SB(0, 1), cB + hstep, voffB); PG8_STAGE(PG8_SA(0, 1), cA + hstep, voffA);
        if (wr == 1) PG8_BAR;
        PG8_WAIT_V(4); PG8_BAR;
        PG8_STAGE(PG8_SB(1, 0), cB + kstep, voffB); PG8_STAGE(PG8_SA(1, 0), cA + kstep, voffA); PG8_STAGE(PG8_SB(1, 1), cB + hstep + kstep, voffB);
        PG8_WAIT_V(6); PG8_BAR;
    }
    for (;;) {
        const bool has_next = S.next(ui + 1, nxt);
        const char* nA = has_next ? (const char*)g.A + (size_t)nxt.pm * tstepA : cA; const char* nB = has_next ? (const char*)g.Bt + (size_t)nxt.pn * tstep : cB;
        for (int t = 0; t < nt; t += 2) {
            const bool last = (t == nt - 2);
            const char* a1 = cA + (size_t)(t + 1) * kstep;
            const char* a2 = last ? nA : cA + (size_t)(t + 2) * kstep; const char* b2 = last ? nB : cB + (size_t)(t + 2) * kstep;
            const char* a3 = a2 + kstep; const char* b3 = b2 + kstep;
            if (last && has_next) S.a_ready(nxt);
            if constexpr (SP2) {
            PG8_LDB(B0, 0, 0); PG8_LDB(B1, 0, 1); PG8_SCHED; PG8_LDA(At, 0, 0); PG8_STAGE(PG8_SA(1, 1), a1 + hstep, voffA);
            PG8_WAIT_V(8); PG8_WAIT_L(0); PG8_BAR; PG8_MMA(0, 0, At, B0); PG8_MMA(0, 1, At, B1); PG8_BAR; PG8_SCHED;
            PG8_LDA(At, 0, 1); PG8_STAGE(PG8_SB(0, 0), b2, voffB); PG8_STAGE(PG8_SB(0, 1), b2 + hstep, voffB); PG8_STAGE(PG8_SA(0, 0), a2, voffA);
            PG8_WAIT_V(8); PG8_WAIT_L(0); PG8_BAR; PG8_MMA(1, 0, At, B0); PG8_MMA(1, 1, At, B1); PG8_BAR; PG8_SCHED;
            PG8_LDB(B0, 1, 0); PG8_LDB(B1, 1, 1); PG8_SCHED; PG8_LDA(At, 1, 0); PG8_STAGE(PG8_SA(0, 1), a2 + hstep, voffA);
            PG8_WAIT_V(8); PG8_WAIT_L(0); PG8_BAR; PG8_MMA(0, 0, At, B0); PG8_MMA(0, 1, At, B1); PG8_BAR; PG8_SCHED;
            PG8_LDA(At, 1, 1); PG8_STAGE(PG8_SB(1, 0), b3, voffB); PG8_STAGE(PG8_SB(1, 1), b3 + hstep, voffB); PG8_STAGE(PG8_SA(1, 0), a3, voffA);
            PG8_WAIT_V(8); PG8_WAIT_L(0); PG8_BAR; PG8_MMA(1, 0, At, B0); PG8_MMA(1, 1, At, B1); PG8_BAR; PG8_SCHED;
            } else {
            PG8_LDB(B0, 0, 0); PG8_SCHED; PG8_LDA(At, 0, 0); PG8_STAGE(PG8_SA(1, 1), a1 + hstep, voffA);
            PG8_WAIT_L(8); PG8_BAR; PG8_WAIT_L(0); PG8_MMA(0, 0, At, B0); PG8_BAR; PG8_SCHED;
            PG8_LDB(B1, 0, 1); PG8_STAGE(PG8_SB(0, 0), b2, voffB);
            PG8_BAR; PG8_WAIT_L(0); PG8_MMA(0, 1, At, B1); PG8_BAR;
            PG8_LDA(At, 0, 1); PG8_STAGE(PG8_SA(0, 0), a2, voffA);
            PG8_BAR; PG8_WAIT_L(0); PG8_MMA(1, 0, At, B0); PG8_BAR; PG8_SCHED;
            PG8_STAGE(PG8_SB(0, 1), b2 + hstep, voffB);
            PG8_WAIT_V(6); PG8_BAR; PG8_MMA(1, 1, At, B1); PG8_BAR;
            PG8_LDB(B0, 1, 0); PG8_SCHED; PG8_LDA(At, 1, 0); PG8_STAGE(PG8_SA(0, 1), a2 + hstep, voffA);
            PG8_WAIT_L(8); PG8_BAR; PG8_WAIT_L(0); PG8_MMA(0, 0, At, B0); PG8_BAR; PG8_SCHED;
            PG8_LDB(B1, 1, 1); PG8_STAGE(PG8_SB(1, 0), b3, voffB);
            PG8_BAR; PG8_WAIT_L(0); PG8_MMA(0, 1, At, B1); PG8_BAR;
            PG8_LDA(At, 1, 1); PG8_STAGE(PG8_SA(1, 0), a3, voffA);
            PG8_BAR; PG8_WAIT_L(0); PG8_MMA(1, 0, At, B0); PG8_BAR; PG8_SCHED;
            PG8_STAGE(PG8_SB(1, 1), b3 + hstep, voffB);
            PG8_WAIT_V(6); PG8_BAR; PG8_MMA(1, 1, At, B1); PG8_BAR;
            }
        }
        if constexpr (ALIGN_EPI) { if (wr == 0) PG8_BAR; }
        if constexpr (!Epi::AFTER_DRAIN) { E(acc, cur, wr, wc, fr, fq, wid, lane); S.done(cur); }
        if (!has_next) break;
#pragma unroll
        for (int a = 0; a < 2; ++a)
#pragma unroll
            for (int b = 0; b < 2; ++b)
#pragma unroll
                for (int m = 0; m < 4; ++m)
#pragma unroll
                    for (int n = 0; n < 2; ++n) acc[a][b][m][n] = (f32x4){0.f, 0.f, 0.f, 0.f};
        cur = nxt; cA = nA; cB = nB; ++ui;
        if constexpr (ALIGN_EPI) { if (wr == 1) PG8_BAR; }
    }
    PG8_WAIT_V(0);
    if constexpr (!ALIGN_EPI) { if (wr == 0) PG8_BAR; }
    PG8_BAR;
    if constexpr (Epi::AFTER_DRAIN) { E.fused(acc, cur, wr, wc, fr, fq, lds, wid, lane); S.done(cur); }
#undef PG8_SA
#undef PG8_SB
#undef PG8_STAGE
#undef PG8_LDA
#undef PG8_LDB
#undef PG8_MMA
#undef PG8_WAIT_V
#undef PG8_WAIT_L
#undef PG8_BAR
#undef PG8_SCHED
}
}
#ifndef PG8_SP2
#define PG8_SP2 true
#endif
#ifndef PG8_ALIGN
#define PG8_ALIGN true
#endif

constexpr int NWAVES = 8;
constexpr int DM = 1024, M = 49152, MP = 16384, INW = 2304, DFF = 2816, UPW = 5632;
constexpr int QA_OFF = 0, KA_OFF = 512, VA_OFF = 1024, QB_OFF = 1536, KB_OFF = 2048, VB_OFF = 2176;
constexpr int UP_TILES_M = 194;
constexpr float EPS = 1e-6f, LOG2E = 1.4426950408889634f;

constexpr size_t MiB = 1u << 20;
constexpr size_t WS_SSQ = 0;
constexpr size_t WS_SSQ1 = 512 * 1024;
constexpr size_t WS_BAR = 1 * MiB;
constexpr size_t WS_WIN = 2 * MiB, WS_WOUT = 7 * MiB, WS_WUP = 9 * MiB, WS_WDN = 20 * MiB;
constexpr size_t WS_XN = 32 * MiB;
constexpr size_t WS_PROJ = 130 * MiB;
constexpr size_t WS_OA = 346 * MiB;
constexpr size_t WS_H = 226 * MiB;
constexpr size_t WS_LA = 490 * MiB;
constexpr size_t WS_END = 496 * MiB;
static_assert(WS_XN + (size_t)(M + 256) * DM * 2 <= WS_PROJ && WS_PROJ + (size_t)M * INW * 2 <= WS_OA && WS_OA + 3 * (size_t)M * 512 * 2 <= WS_LA && WS_H + (size_t)M * DFF * 2 <= WS_LA && WS_PROJ + (size_t)M * DM * 2 <= WS_H, "d_ws map");

constexpr int RING_BYTES = 131072, XCH_OFF = RING_BYTES, MISC_OFF = XCH_OFF + 8192, LDS_BYTES = 147456;

#define LAS __attribute__((address_space(3)))
typedef unsigned short bf16;
typedef unsigned v4u __attribute__((ext_vector_type(4)));
typedef float f32x4 __attribute__((ext_vector_type(4)));
typedef float f32x16 __attribute__((ext_vector_type(16)));
typedef short bf16x8 __attribute__((ext_vector_type(8)));
typedef short s16x4 __attribute__((ext_vector_type(4)));
using pg8::cvtpk;
__device__ __forceinline__ float bf_lo(unsigned w) { return __uint_as_float(w << 16); }
__device__ __forceinline__ float bf_hi(unsigned w) { return __uint_as_float(w & 0xffff0000u); }
__device__ __forceinline__ float wave_sum(float v) {
#pragma unroll
    for (int o = 1; o < 64; o <<= 1) v += __shfl_xor(v, o);
    return v;
}
__device__ __forceinline__ float wave_max(float v) {
#pragma unroll
    for (int o = 1; o < 64; o <<= 1) v = fmaxf(v, __shfl_xor(v, o));
    return v;
}

#define GAS __attribute__((address_space(1)))
#define RLX_AGENT __ATOMIC_RELAXED, __HIP_MEMORY_SCOPE_AGENT
#define XB_TMO      128
#define XB_XCNT(j)  (256  + 64 * (j))
#define XB_XSUB(j)  (1280 + 64 * (j))
#define XB_XGEN(j)  (2304 + 64 * (j))
#define XB_TOP      3328
#define XB_TOPGEN   3392
#define XCD_BAR_WORDS 3456
#define XB_SPIN_CAP (1u << 18)

__device__ __forceinline__ unsigned xb_ld(unsigned* p)              { return __hip_atomic_load(p, __ATOMIC_RELAXED, __HIP_MEMORY_SCOPE_AGENT); }
__device__ __forceinline__ unsigned xb_add(unsigned* p, unsigned v) { return __hip_atomic_fetch_add(p, v, __ATOMIC_RELAXED, __HIP_MEMORY_SCOPE_AGENT); }
__device__ __forceinline__ unsigned xb_xcc_id() { return (unsigned)__builtin_amdgcn_s_getreg((3 << 11) | 20) & 0xFu; }
#define XB_SPIN(cond, bar) do { unsigned _sp = 0; while (cond) { __builtin_amdgcn_s_sleep(1); \
    if ((++_sp & 255u) == 0u) { if (xb_ld(&(bar)[XB_TMO])) break; if (_sp > XB_SPIN_CAP) { atomicAdd(&(bar)[XB_TMO], 1u); break; } } } } while (0)

struct XcdBarrier {
    unsigned* bar; unsigned x;
    volatile LAS unsigned* st;
};

__device__ __forceinline__ XcdBarrier xcd_barrier_post(unsigned* bar, volatile LAS unsigned* st) {
    XcdBarrier b; b.bar = bar; b.x = xb_xcc_id(); b.st = st;
    if (threadIdx.x == 0) (void)xb_add(&bar[XB_XCNT(b.x)], 1u);
    return b;
}
__device__ __forceinline__ void xcd_barrier_complete(unsigned* bar, unsigned x, unsigned& nloc, unsigned& nx) {
    const unsigned G = gridDim.x * gridDim.y * gridDim.z;
    unsigned sum, cnt, mine, sp = 0u;
    for (;;) {
        sum = 0u; cnt = 0u; mine = 0u;
#pragma unroll
        for (unsigned j = 0; j < 16; ++j) { const unsigned c = xb_ld(&bar[XB_XCNT(j)]); sum += c; cnt += (c > 0u) ? 1u : 0u; mine = (j == x) ? c : mine; }
        if (sum == G) break;
        __builtin_amdgcn_s_sleep(1);
        if ((++sp & 255u) == 0u) { if (xb_ld(&bar[XB_TMO])) break; if (sp > XB_SPIN_CAP) { atomicAdd(&bar[XB_TMO], 1u); break; } }
    }
    nloc = mine > 0u ? mine : 1u; nx = cnt > 0u ? cnt : 1u;
}

__device__ __forceinline__ void xcd_barrier(const XcdBarrier& b) {
    asm volatile("s_waitcnt vmcnt(0)" ::: "memory");
    __syncthreads();
    if (threadIdx.x == 0) {
        unsigned* bar = b.bar;
        __builtin_amdgcn_s_waitcnt(0);
        unsigned nloc = b.st[0], nx = b.st[1];
        if (nloc == 0u) { xcd_barrier_complete(bar, b.x, nloc, nx); b.st[0] = nloc; b.st[1] = nx; }
        const unsigned old = xb_add(&bar[XB_XSUB(b.x)], 1u);
        const unsigned gen = old / nloc;
        if (old + 1u == (gen + 1u) * nloc) {
            __builtin_amdgcn_fence(__ATOMIC_RELEASE, "agent");
            asm volatile("s_waitcnt vmcnt(0)" ::: "memory");
            const unsigned og = xb_add(&bar[XB_TOP], 1u);
            const unsigned tg = og / nx;
            if (og + 1u == (tg + 1u) * nx) xb_add(&bar[XB_TOPGEN], 1u);
            else XB_SPIN(xb_ld(&bar[XB_TOPGEN]) == tg, bar);
            __builtin_amdgcn_fence(__ATOMIC_ACQUIRE, "agent");
            xb_add(&bar[XB_XGEN(b.x)], 1u);
            asm volatile("s_waitcnt vmcnt(0)" ::: "memory");
        } else {
            XB_SPIN(xb_ld(&bar[XB_XGEN(b.x)]) == gen, bar);
            __builtin_amdgcn_fence(__ATOMIC_ACQUIRE, "agent");
            asm volatile("s_waitcnt vmcnt(0)" ::: "memory");
        }
    }
    __syncthreads();
}

template <int MAP  >
__device__ __forceinline__ void p0_transpose_item(const float* W, int K, int N, bf16* WT, const float* kgain, LAS float* scr, int item, int lane) {
    const int nblk = N / 32, kb = item / nblk, nb = item % nblk, k0 = 64 * kb, n0 = 32 * nb;
#pragma unroll 8
    for (int i = 0; i < 32; ++i) { const int kk = 2 * i + (lane >> 5); float v = W[(size_t)(k0 + kk) * N + n0 + (lane & 31)]; if (kgain) v *= kgain[k0 + kk]; scr[kk * 33 + (lane & 31)] = v; }
    asm volatile("s_waitcnt lgkmcnt(0)" ::: "memory");
    const int c = lane & 7;
    int r0 = n0;
    if (MAP == 2) { const int hs = n0 >> 6; r0 = 256 * (hs >> 2) + 128 * ((n0 >> 5) & 1) + 32 * (hs & 3); }
    if (MAP == 1) r0 = n0 < DFF ? ((n0 >> 7) * 256 + (n0 & 127)) : ((((n0 - DFF) >> 7) * 256) + 128 + ((n0 - DFF) & 127));
#pragma unroll
    for (int j = 0; j < 4; ++j) { const int n = (lane >> 3) + 8 * j; const LAS float* s = scr + (8 * c) * 33 + n;
        v4u o; o.x = cvtpk(s[0 * 33], s[1 * 33]); o.y = cvtpk(s[2 * 33], s[3 * 33]); o.z = cvtpk(s[4 * 33], s[5 * 33]); o.w = cvtpk(s[6 * 33], s[7 * 33]);
        *(v4u*)(WT + (size_t)(r0 + n) * K + k0 + 8 * c) = o; }
    asm volatile("s_waitcnt lgkmcnt(0)" ::: "memory");
}
__device__ __forceinline__ void rows4_to_bf16(const float* xrow, bf16* orow, float* ssq, int lane) {
    f32x4 v[4][4]; float s[4];
#pragma unroll
    for (int k = 0; k < 4; ++k)
#pragma unroll
        for (int j = 0; j < 4; ++j) v[k][j] = ((const f32x4*)(xrow + (size_t)k * DM) + lane)[64 * j];
#pragma unroll
    for (int k = 0; k < 4; ++k) { s[k] = 0.f;
#pragma unroll
        for (int j = 0; j < 4; ++j) s[k] += (v[k][j].x * v[k][j].x + v[k][j].y * v[k][j].y) + (v[k][j].z * v[k][j].z + v[k][j].w * v[k][j].w);
        unsigned long long* o8 = (unsigned long long*)(orow + (size_t)k * DM) + lane;
#pragma unroll
        for (int j = 0; j < 4; ++j) o8[64 * j] = (unsigned long long)cvtpk(v[k][j].x, v[k][j].y) | ((unsigned long long)cvtpk(v[k][j].z, v[k][j].w) << 32); }
#pragma unroll
    for (int o = 1; o < 64; o <<= 1) {
#pragma unroll
        for (int k = 0; k < 4; ++k) s[k] += __shfl_xor(s[k], o); }
    if (lane < 4) ssq[lane] = lane == 0 ? s[0] : lane == 1 ? s[1] : lane == 2 ? s[2] : s[3];
}

template <int NKEYS, int NTHR>
__device__ __forceinline__ void stage_load(v4u (&kr)[NKEYS * 8 / NTHR], v4u (&vr)[NKEYS * 8 / NTHR], const bf16* kbase, const bf16* vbase, int tok0, int dshift, int kidx0, int Ls, int t) {
    constexpr int NIT = NKEYS * 8 / NTHR;
    const int c = t & 7;
#pragma unroll
    for (int it = 0; it < NIT; ++it) { const int rho = (it * NTHR + t) >> 3, kidx = kidx0 + rho; const bool ok = (unsigned)kidx < (unsigned)Ls;
        const size_t off = (size_t)(tok0 + ((ok ? kidx : 0) << dshift)) * 64 + 8 * c;
        kr[it] = *(const v4u*)(kbase + off); vr[it] = *(const v4u*)(vbase + off); }
}
template <int NKEYS, int NTHR>
__device__ __forceinline__ void stage_write(const v4u (&kr)[NKEYS * 8 / NTHR], const v4u (&vr)[NKEYS * 8 / NTHR], LAS unsigned char* Kl, LAS unsigned char* Vl, int t) {
    constexpr int NIT = NKEYS * 8 / NTHR;
    const int c = t & 7;
#pragma unroll
    for (int it = 0; it < NIT; ++it) { const int rho = (it * NTHR + t) >> 3;
        *(LAS v4u*)(Kl + rho * 128 + 16 * (c ^ ((rho >> 1) & 7))) = kr[it];
        *(LAS v4u*)(Vl + (c >> 2) * (NKEYS * 64) + rho * 64 + (c & 3) * 16) = vr[it]; }
}
__device__ __forceinline__ void load_q_raw(v4u (&raw)[4], const bf16* qrow, int lane) {
#pragma unroll
    for (int d0 = 0; d0 < 4; ++d0) raw[d0] = *(const v4u*)(qrow + 16 * d0 + 8 * (lane >> 5));
}
typedef short v4i16_t __attribute__((ext_vector_type(4)));
__device__ __forceinline__ s16x4 vtr(const LAS unsigned char* p) { return __builtin_bit_cast(s16x4, __builtin_amdgcn_ds_read_tr16_b64_v4i16((LAS v4i16_t*)p)); }
template <int R, bool BAND, bool EDGE, bool SAFE>
__device__ __forceinline__ void attn_tile(const bf16x8 (&kf)[4], unsigned vaddr, int vhs, int j, int kidx_t0, int Ls, const bf16x8 (&qf)[4], float base, float nslope, float negM, f32x16 (&o)[2], float& l, int hi) {
    s16x4 vl[4], vh[4];
    asm volatile("ds_read_b64_tr_b16 %0, %8\n\tds_read_b64_tr_b16 %1, %8 offset:512\n\tds_read_b64_tr_b16 %2, %8 offset:1024\n\tds_read_b64_tr_b16 %3, %8 offset:1536\n\t"
                 "ds_read_b64_tr_b16 %4, %9\n\tds_read_b64_tr_b16 %5, %9 offset:512\n\tds_read_b64_tr_b16 %6, %9 offset:1024\n\tds_read_b64_tr_b16 %7, %9 offset:1536"
                 : "=&v"(vl[0]), "=&v"(vh[0]), "=&v"(vl[1]), "=&v"(vh[1]), "=&v"(vl[2]), "=&v"(vh[2]), "=&v"(vl[3]), "=&v"(vh[3]) : "v"(vaddr), "v"(vaddr + (unsigned)vhs) : "memory");
    f32x16 s = {0.f, 0.f, 0.f, 0.f, 0.f, 0.f, 0.f, 0.f, 0.f, 0.f, 0.f, 0.f, 0.f, 0.f, 0.f, 0.f};
#pragma unroll
    for (int d0 = 0; d0 < 4; ++d0) s = __builtin_amdgcn_mfma_f32_32x32x16_bf16(kf[d0], qf[d0], s, 0, 0, 0);
    if (SAFE) {
#pragma unroll
        for (int r = 0; r < 16; ++r) s[r] += negM; }
    const float basej = base + (float)(32 * j);
    float pr[16];
#pragma unroll
    for (int r = 0; r < 16; ++r) { const float relf = basej + (float)((r & 3) + 8 * (r >> 2));
        float p = __builtin_amdgcn_exp2f(__builtin_fmaf(__builtin_fabsf(relf), nslope, s[r]));
        if (BAND) p = (__builtin_fabsf(relf) <= (float)R) ? p : 0.f;
        if (EDGE) { const int kidx = kidx_t0 + 32 * j + (r & 3) + 8 * (r >> 2) + 4 * hi; p = ((unsigned)kidx < (unsigned)Ls) ? p : 0.f; }
        l += p; pr[r] = p; }
    v4u w0, w1; w0.x = cvtpk(pr[0], pr[1]); w0.y = cvtpk(pr[2], pr[3]); w0.z = cvtpk(pr[4], pr[5]); w0.w = cvtpk(pr[6], pr[7]);
    w1.x = cvtpk(pr[8], pr[9]); w1.y = cvtpk(pr[10], pr[11]); w1.z = cvtpk(pr[12], pr[13]); w1.w = cvtpk(pr[14], pr[15]);
    const bf16x8 pa0 = __builtin_bit_cast(bf16x8, w0), pa1 = __builtin_bit_cast(bf16x8, w1);
    asm volatile("s_waitcnt lgkmcnt(0)" : "+v"(vl[0]), "+v"(vh[0]), "+v"(vl[1]), "+v"(vh[1]), "+v"(vl[2]), "+v"(vh[2]), "+v"(vl[3]), "+v"(vh[3]) :: "memory");
#pragma unroll
    for (int dh = 0; dh < 2; ++dh)
#pragma unroll
        for (int s2 = 0; s2 < 2; ++s2) { const s16x4 lo = vl[2 * dh + s2], h4 = vh[2 * dh + s2];
            const bf16x8 vf = (bf16x8){lo[0], lo[1], lo[2], lo[3], h4[0], h4[1], h4[2], h4[3]};
            o[dh] = __builtin_amdgcn_mfma_f32_32x32x16_bf16(vf, s2 ? pa1 : pa0, o[dh], 0, 0, 0); }
}
template <int NT, int R, bool SAFE>
__device__ __forceinline__ void attn_task(const LAS unsigned char* Kl, const LAS unsigned char* Vl, int vhs, int row0, int kidx_t0, int Ls, const bf16x8 (&qf)[4], float slope2, float negM, f32x16 (&o)[2], float& l, int lane) {
    const int q = lane & 31, hi = lane >> 5;
    const unsigned va0 = (unsigned)(uintptr_t)(Vl + row0 * 64 + (4 * hi + ((lane & 15) >> 2)) * 64 + (16 * ((lane >> 4) & 1) + 4 * (lane & 3)) * 2);
    const int sw = (q >> 1) & 7;
    const LAS unsigned char* kp0 = Kl + (row0 + q) * 128 + 16 * ((0 + hi) ^ sw); const LAS unsigned char* kp1 = Kl + (row0 + q) * 128 + 16 * ((2 + hi) ^ sw);
    const LAS unsigned char* kp2 = Kl + (row0 + q) * 128 + 16 * ((4 + hi) ^ sw); const LAS unsigned char* kp3 = Kl + (row0 + q) * 128 + 16 * ((6 + hi) ^ sw);
    float base = (float)(4 * hi - R - q); asm volatile("" : "+v"(base));
    const float nslope = -slope2;
#define LOADK(dst, jj) do { dst[0] = *(const LAS bf16x8*)(kp0 + (jj) * 4096); dst[1] = *(const LAS bf16x8*)(kp1 + (jj) * 4096); dst[2] = *(const LAS bf16x8*)(kp2 + (jj) * 4096); dst[3] = *(const LAS bf16x8*)(kp3 + (jj) * 4096); } while (0)
    bf16x8 kf[4];
    if ((unsigned)kidx_t0 < (unsigned)Ls) { LOADK(kf, 0); attn_tile<R, true, false, SAFE>(kf, va0, vhs, 0, kidx_t0, Ls, qf, base, nslope, negM, o, l, hi); }
#pragma unroll 1
    for (int j = 1; j < NT - 1; ++j) {
        if ((unsigned)(kidx_t0 + 32 * j) < (unsigned)Ls) {
            LOADK(kf, j);
            attn_tile<R, false, false, SAFE>(kf, va0 + j * 2048, vhs, j, kidx_t0, Ls, qf, base, nslope, negM, o, l, hi); }
    }
    if ((unsigned)(kidx_t0 + 32 * (NT - 1)) < (unsigned)Ls) { LOADK(kf, NT - 1); attn_tile<R, true, false, SAFE>(kf, va0 + (NT - 1) * 2048, vhs, NT - 1, kidx_t0, Ls, qf, base, nslope, negM, o, l, hi); }
#undef LOADK
}
__device__ __forceinline__ void store_partial(const f32x16 (&o)[2], float l, bf16* OBuf, float* LB, int tokq0, int dshift, int h, int lane) {
    const int hi = lane >> 5, q = lane & 31; const size_t row = (size_t)h * M + (size_t)(tokq0 + (q << dshift));
    l += __shfl_xor(l, 32);
    if (hi == 0) LB[row] = l;
    bf16* p = OBuf + row * 64 + 4 * hi;
#pragma unroll
    for (int dh = 0; dh < 2; ++dh)
#pragma unroll
        for (int g = 0; g < 4; ++g) { unsigned long long w = (unsigned long long)cvtpk(o[dh][4 * g], o[dh][4 * g + 1]) | ((unsigned long long)cvtpk(o[dh][4 * g + 2], o[dh][4 * g + 3]) << 32);
            *(unsigned long long*)(p + 32 * dh + 8 * g) = w; }
}
struct AUnit { int tok0, dshift, Ls, cc, h, c; };
__device__ __forceinline__ AUnit decode_a(int su) {
    AUnit a; const int sidx = su / 48, k = su % 48, blk = sidx >> 3; a.h = sidx & 7; a.c = 2 - (k >> 4); a.dshift = 2 * a.c; const int kk = k & 15;
    int seq0, S, bis; if (blk < 8) { seq0 = 0; S = 16384; bis = blk; } else { seq0 = MP + 2048 * (blk - 8); S = 2048; bis = 0; }
    a.Ls = S >> a.dshift; const int lcpb = 4 - a.dshift  , res = kk >> lcpb; a.cc = (bis << lcpb) + (kk & ((1 << lcpb) - 1)); a.tok0 = seq0 + res; return a;
}
struct BUnit { int seq0, S, lcb, g2; };
__device__ __forceinline__ BUnit decode_b(int u) {
    BUnit b; b.g2 = u / 768; const int cb = u % 768;
    if (cb < 256) { b.seq0 = 0; b.S = 16384; b.lcb = cb; } else { b.seq0 = MP + 2048 * ((cb - 256) >> 5); b.S = 2048; b.lcb = (cb - 256) & 31; } return b;
}

#define LDS_BAR() asm volatile("s_waitcnt lgkmcnt(0)\n\ts_barrier" ::: "memory")
#define xp (args.in[0])
#define xs (args.in[1])
#define norm1 (args.in[2])
#define w_in (args.in[3])
#define qna (args.in[4])
#define kna (args.in[5])
#define qnb (args.in[6])
#define knb (args.in[7])
#define sinkb (args.in[8])
#define ona (args.in[9])
#define onb (args.in[10])
#define w_out (args.in[11])
#define norm2 (args.in[12])
#define w_up (args.in[13])
#define conv_w (args.in[14])
#define conv_b (args.in[15])
#define w_down (args.in[16])
#define out (args.dout)
#define SSQ ((float*)(args.ws + WS_SSQ))
#define SSQ1 ((float*)(args.ws + WS_SSQ1))
#define WIN ((bf16*)(args.ws + WS_WIN))
#define WOUT ((bf16*)(args.ws + WS_WOUT))
#define WUP ((bf16*)(args.ws + WS_WUP))
#define WDN ((bf16*)(args.ws + WS_WDN))
#define XN ((bf16*)(args.ws + WS_XN) + DM)
#define PROJ ((bf16*)(args.ws + WS_PROJ))
#define Y ((bf16*)(args.ws + WS_PROJ))
#define OA ((bf16*)(args.ws + WS_OA))
#define OB ((bf16*)args.dout)
#define HB ((bf16*)(args.ws + WS_H))
#define LA ((float*)(args.ws + WS_LA))
#define LBp ((float*)(args.ws + WS_LA) + 3 * (size_t)M * 8)
struct Args { const float* in[17]; float* dout; unsigned char* ws; };
__global__ void __launch_bounds__(NWAVES * 64, 2) fwd_megakernel(Args args) {
    extern __shared__ __attribute__((aligned(16))) unsigned char lds_raw[];
    cg::grid_group grid = cg::this_grid();
    LAS unsigned char* lds = (LAS unsigned char*)lds_raw;
    const int tid = threadIdx.x, lane = tid & 63, wave = __builtin_amdgcn_readfirstlane(tid >> 6);
    const int G = gridDim.x, bx = blockIdx.x;
    if (tid < 2) ((LAS unsigned*)(lds + MISC_OFF))[tid] = 0u;
    const int gw = bx * NWAVES + wave, NGW = G * NWAVES;
    __syncthreads();
    XcdBarrier bar = xcd_barrier_post((unsigned*)(args.ws + WS_BAR), (volatile LAS unsigned*)(lds + MISC_OFF));
    if (args.ws == nullptr) grid.sync();

    {
        LAS float* scr = (LAS float*)(lds + wave * 16384);
        constexpr int I_IN = (DM / 64) * (INW / 32), I_OUT = (DM / 64) * (DM / 32), I_UP = (DM / 64) * (UPW / 32), I_DN = (DFF / 64) * (DM / 32);
        for (int it = gw; it < I_IN + I_OUT + I_UP + I_DN; it += NGW) {
            int r = it;
            if (r < I_IN) { p0_transpose_item<2>(w_in, DM, INW, WIN, norm1, scr, r, lane); continue; } r -= I_IN;
            if (r < I_OUT) { p0_transpose_item<0>(w_out, DM, DM, WOUT, nullptr, scr, r, lane); continue; } r -= I_OUT;
            if (r < I_UP) { p0_transpose_item<1>(w_up, DM, UPW, WUP, norm2, scr, r, lane); continue; } r -= I_UP;
            p0_transpose_item<0>(w_down, DFF, DM, WDN, nullptr, scr, r, lane);
        }
        for (int m = gw * 4; m < M; m += NGW * 4) rows4_to_bf16(m < MP ? xp + (size_t)m * DM : xs + (size_t)(m - MP) * DM, XN + (size_t)m * DM, SSQ1 + m, lane);
        for (int i = bx * 512 + tid; i < M; i += G * 512) SSQ[i] = 0.f;
    }
    xcd_barrier(bar);

    {
        pg8::Gemm g{XN, WIN, M, INW, DM, 256}; pg8::StaticOrder S; S.init(M, INW, G, bx);
        pg8::EpiProj E{PROJ, SSQ1, qna, kna, qnb, knb};
        pg8::gemm_phase<pg8::EpiProj, pg8::StaticOrder, PG8_ALIGN, PG8_SP2>(lds, g, S, E);
    }
    xcd_barrier(bar);

    {
        const float gqa = fabsf(qna[lane]), gka = fabsf(kna[lane]);
        const float boundA = __builtin_bit_cast(float, __builtin_amdgcn_readfirstlane(__builtin_bit_cast(int, 8.0f * wave_max(gqa) * wave_max(gka) * LOG2E)));
        const float negMa = boundA > 40.f ? -boundA : 0.f;
        {
            const int half = wave >> 2, w4 = wave & 3, th = tid & 255;
            LAS unsigned char* Kl = lds + half * 65536; LAS unsigned char* Vl = Kl + 32768;
            const int ubase = (G == 256) ? (bx & 7) * 576 + (bx >> 3) : bx, ustep = (G == 256) ? 32 : G, uend = (G == 256) ? (bx & 7) * 576 + 576 : 4608;
            v4u kr[8], vr[8], qraw[4]; AUnit nx = decode_a(2 * ubase + half);
            if (ubase < uend) { stage_load<256, 256>(kr, vr, PROJ + (size_t)(8 + nx.h) * M * 64, PROJ + (size_t)(16 + nx.h) * M * 64, nx.tok0, nx.dshift, 128 * nx.cc - 64, nx.Ls, th);
                load_q_raw(qraw, PROJ + ((size_t)nx.h * M + (nx.tok0 + ((128 * nx.cc + 32 * w4 + (lane & 31)) << nx.dshift))) * 64, lane); }
            for (int u = ubase; u < uend; u += ustep) {
                const AUnit a = nx;
                LDS_BAR();
                stage_write<256, 256>(kr, vr, Kl, Vl, th);
                bf16x8 qf[4];
#pragma unroll
                for (int d0 = 0; d0 < 4; ++d0) qf[d0] = __builtin_bit_cast(bf16x8, qraw[d0]);
                LDS_BAR();
                if (u + ustep < uend) { nx = decode_a(2 * (u + ustep) + half);
                    stage_load<256, 256>(kr, vr, PROJ + (size_t)(8 + nx.h) * M * 64, PROJ + (size_t)(16 + nx.h) * M * 64, nx.tok0, nx.dshift, 128 * nx.cc - 64, nx.Ls, th);
                    load_q_raw(qraw, PROJ + ((size_t)nx.h * M + (nx.tok0 + ((128 * nx.cc + 32 * w4 + (lane & 31)) << nx.dshift))) * 64, lane); }
                const int iq0 = 128 * a.cc + 32 * w4;
                f32x16 o[2]; float l = 0.f;
#pragma unroll
                for (int r = 0; r < 16; ++r) { o[0][r] = 0.f; o[1][r] = 0.f; }
                const float slope2 = __builtin_amdgcn_exp2f(-0.5f * (float)(a.h + 9) + (float)a.dshift) * LOG2E;
                if (__builtin_expect(negMa != 0.f, 0)) attn_task<5, 64, true>(Kl, Vl, 256 * 64, 32 * w4, iq0 - 64, a.Ls, qf, slope2, negMa, o, l, lane);
                else attn_task<5, 64, false>(Kl, Vl, 256 * 64, 32 * w4, iq0 - 64, a.Ls, qf, slope2, 0.f, o, l, lane);
                asm volatile("s_nop 15\n\ts_nop 7" ::: "memory");
                store_partial(o, l, OA + (size_t)a.c * M * 512, LA + (size_t)a.c * M * 8, a.tok0 + (iq0 << a.dshift), a.dshift, a.h, lane);
            }
        }
        const float gqb = fabsf(qnb[lane]), gkb = fabsf(knb[lane]);
        const float boundB = __builtin_bit_cast(float, __builtin_amdgcn_readfirstlane(__builtin_bit_cast(int, 8.0f * wave_max(gqb) * wave_max(gkb) * LOG2E)));
        const float negMb = boundB > 40.f ? -boundB : 0.f;
        {
            LAS unsigned char* Kb = lds; LAS unsigned char* Vb = lds + 40960;
            const int ubase = (G == 256) ? (bx & 7) * 192 + (bx >> 3) : bx, ustep = (G == 256) ? 32 : G, uend = (G == 256) ? (bx & 7) * 192 + 192 : 1536;
            v4u kr[5], vr[5], qraw[4]; BUnit nx = decode_b(ubase);
            if (ubase < uend) { stage_load<320, 512>(kr, vr, PROJ + (size_t)(32 + nx.g2) * M * 64, PROJ + (size_t)(34 + nx.g2) * M * 64, nx.seq0, 0, 64 * nx.lcb - 128, nx.S, tid);
                load_q_raw(qraw, PROJ + ((size_t)(24 + 4 * nx.g2 + (wave >> 1)) * M + (nx.seq0 + 64 * nx.lcb + 32 * (wave & 1) + (lane & 31))) * 64, lane); }
            for (int u = ubase; u < uend; u += ustep) {
                const BUnit b = nx;
                LDS_BAR();
                stage_write<320, 512>(kr, vr, Kb, Vb, tid);
                bf16x8 qf[4];
#pragma unroll
                for (int d0 = 0; d0 < 4; ++d0) qf[d0] = __builtin_bit_cast(bf16x8, qraw[d0]);
                LDS_BAR();
                if (u + ustep < uend) { nx = decode_b(u + ustep);
                    stage_load<320, 512>(kr, vr, PROJ + (size_t)(32 + nx.g2) * M * 64, PROJ + (size_t)(34 + nx.g2) * M * 64, nx.seq0, 0, 64 * nx.lcb - 128, nx.S, tid);
                    load_q_raw(qraw, PROJ + ((size_t)(24 + 4 * nx.g2 + (wave >> 1)) * M + (nx.seq0 + 64 * nx.lcb + 32 * (wave & 1) + (lane & 31))) * 64, lane); }
                const int hb = 4 * b.g2 + (wave >> 1), iq0 = 64 * b.lcb + 32 * (wave & 1);
                f32x16 o[2]; float l = 0.f;
#pragma unroll
                for (int r = 0; r < 16; ++r) { o[0][r] = 0.f; o[1][r] = 0.f; }
                const float slope2 = __builtin_amdgcn_exp2f(-0.5f * (float)(hb + 1)) * LOG2E;
                if (__builtin_expect(negMb != 0.f, 0)) attn_task<9, 128, true>(Kb, Vb, 320 * 64, 32 * (wave & 1), iq0 - 128, b.S, qf, slope2, negMb, o, l, lane);
                else attn_task<9, 128, false>(Kb, Vb, 320 * 64, 32 * (wave & 1), iq0 - 128, b.S, qf, slope2, 0.f, o, l, lane);
                asm volatile("s_nop 15\n\ts_nop 7" ::: "memory");
                store_partial(o, l, OB, LBp, b.seq0 + iq0, 0, hb, lane);
            }
        }
        xcd_barrier(bar);
        {
            const int hh = lane >> 3;
            const float sinkterm = __builtin_amdgcn_exp2f(sinkb[hh] * LOG2E + negMb);
            const f32x4 ga0 = *(const f32x4*)(ona + 8 * lane), ga1 = *(const f32x4*)(ona + 8 * lane + 4), gb0 = *(const f32x4*)(onb + 8 * lane), gb1 = *(const f32x4*)(onb + 8 * lane + 4);
            for (int m0 = gw * 4; m0 < M; m0 += NGW * 4) {
                v4u wa[4][3], wb[4]; float la[4], lb[4];
#pragma unroll
                for (int k = 0; k < 4; ++k) { const int m = m0 + k; la[k] = 0.f;
#pragma unroll
                    for (int c = 0; c < 3; ++c) { wa[k][c] = *(const v4u*)(OA + (((size_t)c * 8 + hh) * M + m) * 64 + 8 * (lane & 7)); la[k] += LA[((size_t)c * 8 + hh) * M + m]; }
                    wb[k] = *(const v4u*)(OB + ((size_t)hh * M + m) * 64 + 8 * (lane & 7)); lb[k] = LBp[(size_t)hh * M + m] + sinkterm; }
                float ya[4][8], yb[4][8], sa[4], sb[4];
#pragma unroll
                for (int k = 0; k < 4; ++k) { const float ia = 1.0f / la[k], ib = 1.0f / lb[k];
                    ya[k][0] = (bf_lo(wa[k][0].x) + bf_lo(wa[k][1].x) + bf_lo(wa[k][2].x)) * ia; ya[k][1] = (bf_hi(wa[k][0].x) + bf_hi(wa[k][1].x) + bf_hi(wa[k][2].x)) * ia;
                    ya[k][2] = (bf_lo(wa[k][0].y) + bf_lo(wa[k][1].y) + bf_lo(wa[k][2].y)) * ia; ya[k][3] = (bf_hi(wa[k][0].y) + bf_hi(wa[k][1].y) + bf_hi(wa[k][2].y)) * ia;
                    ya[k][4] = (bf_lo(wa[k][0].z) + bf_lo(wa[k][1].z) + bf_lo(wa[k][2].z)) * ia; ya[k][5] = (bf_hi(wa[k][0].z) + bf_hi(wa[k][1].z) + bf_hi(wa[k][2].z)) * ia;
                    ya[k][6] = (bf_lo(wa[k][0].w) + bf_lo(wa[k][1].w) + bf_lo(wa[k][2].w)) * ia; ya[k][7] = (bf_hi(wa[k][0].w) + bf_hi(wa[k][1].w) + bf_hi(wa[k][2].w)) * ia;
                    yb[k][0] = bf_lo(wb[k].x) * ib; yb[k][1] = bf_hi(wb[k].x) * ib; yb[k][2] = bf_lo(wb[k].y) * ib; yb[k][3] = bf_hi(wb[k].y) * ib;
                    yb[k][4] = bf_lo(wb[k].z) * ib; yb[k][5] = bf_hi(wb[k].z) * ib; yb[k][6] = bf_lo(wb[k].w) * ib; yb[k][7] = bf_hi(wb[k].w) * ib;
                    sa[k] = 0.f; sb[k] = 0.f;
#pragma unroll
                    for (int i = 0; i < 8; ++i) { sa[k] += ya[k][i] * ya[k][i]; sb[k] += yb[k][i] * yb[k][i]; } }
#pragma unroll
                for (int o = 1; o < 64; o <<= 1) {
#pragma unroll
                    for (int k = 0; k < 4; ++k) { sa[k] += __shfl_xor(sa[k], o); sb[k] += __shfl_xor(sb[k], o); } }
#pragma unroll
                for (int k = 0; k < 4; ++k) { const int m = m0 + k;
                    const float ra = __builtin_amdgcn_rsqf(sa[k] * (1.f / 512.f) + EPS), rb = __builtin_amdgcn_rsqf(sb[k] * (1.f / 512.f) + EPS);
                    v4u oa, ob;
                    oa.x = cvtpk(ya[k][0] * ra * ga0.x, ya[k][1] * ra * ga0.y); oa.y = cvtpk(ya[k][2] * ra * ga0.z, ya[k][3] * ra * ga0.w); oa.z = cvtpk(ya[k][4] * ra * ga1.x, ya[k][5] * ra * ga1.y); oa.w = cvtpk(ya[k][6] * ra * ga1.z, ya[k][7] * ra * ga1.w);
                    ob.x = cvtpk(yb[k][0] * rb * gb0.x, yb[k][1] * rb * gb0.y); ob.y = cvtpk(yb[k][2] * rb * gb0.z, yb[k][3] * rb * gb0.w); ob.z = cvtpk(yb[k][4] * rb * gb1.x, yb[k][5] * rb * gb1.y); ob.w = cvtpk(yb[k][6] * rb * gb1.z, yb[k][7] * rb * gb1.w);
                    *(v4u*)(Y + (size_t)m * DM + 8 * lane) = oa; *(v4u*)(Y + (size_t)m * DM + 512 + 8 * lane) = ob; }
            }
        }
    }
    xcd_barrier(bar);

    {
        pg8::Gemm g{Y, WOUT, M, DM, DM, 256}; pg8::StaticOrder S; S.init(M, DM, G, bx);
        pg8::EpiOut E{XN, SSQ};
        pg8::gemm_phase<pg8::EpiOut, pg8::StaticOrder, PG8_ALIGN, PG8_SP2>(lds, g, S, E);
    }
    xcd_barrier(bar);

    {
        pg8::Gemm g{XN - DM, WUP, UP_TILES_M * 256, UPW, DM, 254}; pg8::StaticOrder S; S.init(UP_TILES_M * 256, UPW, G, bx);
        pg8::EpiUp E{HB, SSQ, conv_w, conv_b, (LAS float*)(lds + XCH_OFF)};
        pg8::gemm_phase<pg8::EpiUp, pg8::StaticOrder, true, PG8_SP2>(lds, g, S, E);
    }
    xcd_barrier(bar);

    {
        pg8::Gemm g{HB, WDN, M, DM, DFF, 256}; pg8::StaticOrder S; S.init(M, DM, G, bx);
        pg8::EpiDown E{XN, out};
        pg8::gemm_phase<pg8::EpiDown, pg8::StaticOrder, PG8_ALIGN, PG8_SP2>(lds, g, S, E);
    }
}

#undef out
#undef xp
#undef xs
extern "C" void kernel_launch(void* const* d_in, const int* in_sizes, int n_in, void* d_out, int out_size, void* d_ws, size_t ws_size, hipStream_t stream) {
    static int grid = 0;
    if (grid == 0) {
        if (n_in != 17 || out_size != M * DM || ws_size < WS_END) { fprintf(stderr, "kernel_launch: unexpected shapes (n_in %d out %d ws %zu)\n", n_in, out_size, ws_size); grid = -1; return; }
        int dev = 0, cus = 0, per_cu = 0;
        hipGetDevice(&dev); hipDeviceGetAttribute(&cus, hipDeviceAttributeMultiprocessorCount, dev);
        if (hipFuncSetAttribute((const void*)fwd_megakernel, hipFuncAttributeMaxDynamicSharedMemorySize, LDS_BYTES) != hipSuccess) { fprintf(stderr, "kernel_launch: hipFuncSetAttribute failed\n"); grid = -1; return; }
        if (hipOccupancyMaxActiveBlocksPerMultiprocessor(&per_cu, (const void*)fwd_megakernel, NWAVES * 64, LDS_BYTES) != hipSuccess || per_cu < 1) { fprintf(stderr, "kernel_launch: occupancy query says %d\n", per_cu); per_cu = 1; }
        (void)hipGetLastError();
        grid = cus;
        fprintf(stderr, "kernel_launch: grid %d (per_cu %d)\n", grid, per_cu);
    }
    if (grid < 0) return;
    Args a{};
    for (int i = 0; i < 17; ++i) a.in[i] = (const float*)d_in[i];
    a.dout = (float*)d_out; a.ws = (unsigned char*)d_ws;
    void* kargs[] = {&a};
    if (hipMemsetAsync((char*)d_ws + WS_BAR, 0, XCD_BAR_WORDS * 4, stream) != hipSuccess) { fprintf(stderr, "kernel_launch: hipMemsetAsync failed\n"); return; }
    hipError_t e = hipLaunchCooperativeKernel((const void*)fwd_megakernel, dim3(grid), dim3(NWAVES * 64), kargs, LDS_BYTES, stream);
    if (e != hipSuccess) fprintf(stderr, "kernel_launch: cooperative launch failed: %s\n", hipGetErrorString(e));
}
```

```cpp
#include <hip/hip_runtime.h>
#include <hip/hip_cooperative_groups.h>
#include <cstdio>
#include <cstdint>
namespace cg = cooperative_groups;
namespace pg8 {
#define PG8_LAS __attribute__((address_space(3)))
typedef unsigned short bf16_t;
typedef short bf16x8 __attribute__((ext_vector_type(8)));
typedef float f32x4 __attribute__((ext_vector_type(4)));
typedef unsigned u32x4 __attribute__((ext_vector_type(4)));
constexpr int BM = 256, BK = 64, HALF = 128, HTB = HALF * BK * 2  , STAGE_BYTES = 8 * HTB, NXCD = 8, WGM = 8;

__host__ __device__ __forceinline__ int lds_byte(int r, int c) { const int st = (r >> 4) * 2 + (c >> 5), rr = r & 15, cc = c & 31, ob = rr * 64 + cc * 2; return st * 1024 + (ob ^ (((ob >> 9) & 1) << 5)); }
__host__ __device__ __forceinline__ void stage_rc(int b, int& R, int& C) { const int st = b / 1024, sb = b % 1024, swz = sb ^ (((sb >> 9) & 1) << 5); R = (st >> 1) * 16 + swz / 64; C = (st & 1) * 32 + (swz % 64) / 2; }
__host__ __device__ __forceinline__ int perm32(int rho) { const int n = rho >> 4, i = rho & 15; return 8 * (i >> 2) + 4 * n + (i & 3); }

struct Unit { int pm, pn; };
struct Gemm { const bf16_t* A; const bf16_t* Bt; int M, N, K; int a_tile_rows; };

struct StaticOrder {
    int nM, nN, nwg, G, c;
    __host__ __device__ void init(int M, int N, int G_, int c_) { nM = M / BM; nN = N / BM; nwg = nM * nN; G = G_; c = c_; }
    __host__ __device__ bool next(int i, Unit& u) const {
        const long L = (long)i * G + c; if (L >= nwg) return false;
        int wgid = (int)L; { const int q = nwg / NXCD, r = nwg % NXCD, xcd = wgid % NXCD, off = wgid / NXCD; wgid = (xcd < r ? xcd * (q + 1) : r * (q + 1) + (xcd - r) * q) + off; }
        const int nig = WGM * nN, gid = wgid / nig, fm = gid * WGM, gsz = (nM - fm) < WGM ? (nM - fm) : WGM;
        u.pm = fm + ((wgid % nig) % gsz); u.pn = (wgid % nig) / gsz; return true;
    }
    __device__ __forceinline__ void a_ready(const Unit&) const {}
    __device__ __forceinline__ void done(const Unit&) const {}
};

__device__ __forceinline__ unsigned cvt_pk_bf16(float lo, float hi) { unsigned r; asm volatile("v_cvt_pk_bf16_f32 %0, %1, %2" : "=v"(r) : "v"(lo), "v"(hi)); return r; }
typedef float f32x2 __attribute__((ext_vector_type(2))); typedef __bf16 bf16x2_t __attribute__((ext_vector_type(2)));
__device__ __forceinline__ unsigned cvtpk(float lo, float hi) { f32x2 v = {lo, hi}; bf16x2_t b = __builtin_convertvector(v, bf16x2_t); return __builtin_bit_cast(unsigned, b); }
constexpr int MTOK = 49152, MPROMPT = 16384, DMODEL = 1024, DFF_ = 2816;
__device__ __forceinline__ u32x4 pack8(const f32x4 a, const f32x4 b) { u32x4 w; w.x = cvtpk(a[0], a[1]); w.y = cvtpk(a[2], a[3]); w.z = cvtpk(b[0], b[1]); w.w = cvtpk(b[2], b[3]); return w; }

struct EpiProj {
    static constexpr bool PERM = true, AFTER_DRAIN = false;
    bf16_t* O; const float* ssq1; const float* gqa; const float* gka; const float* gqb; const float* gkb;
    __device__ __forceinline__ void operator()(f32x4 (&acc)[2][2][4][2], const Unit& u, int wr, int wc, int fr, int fq, int wid, int lane) const {
        const int hs = 4 * u.pn + wc;
        const float* g = nullptr; float sc = 1.f;
        if (hs < 8) { g = gqa; sc = 0.125f * 1.4426950408889634f; } else if (hs < 16) g = gka; else if (hs >= 24 && hs < 32) { g = gqb; sc = 0.125f * 1.4426950408889634f; } else if (hs >= 32 && hs < 34) g = gkb;
        const int row0 = u.pm * BM + wr * 64 + fr;
        bf16_t* obase = O + ((size_t)hs * MTOK + row0) * 64 + 8 * fq;
#pragma unroll
        for (int ai = 0; ai < 2; ++ai)
#pragma unroll
            for (int m = 0; m < 4; ++m) { const float r1 = __builtin_amdgcn_rsqf(ssq1[row0 + ai * HALF + m * 16] * (1.0f / DMODEL) + 1e-6f);
#pragma unroll
                for (int bj = 0; bj < 2; ++bj)
#pragma unroll
                    for (int n = 0; n < 2; ++n) acc[ai][bj][m][n] *= r1; }
        if (g) {
            f32x4 gg[2][2];
#pragma unroll
            for (int bj = 0; bj < 2; ++bj)
#pragma unroll
                for (int n = 0; n < 2; ++n) gg[bj][n] = *(const f32x4*)(g + 32 * bj + 8 * fq + 4 * n) * sc;
#pragma unroll
            for (int ai = 0; ai < 2; ++ai)
#pragma unroll
                for (int m = 0; m < 4; ++m) { float ss = 0.f;
#pragma unroll
                    for (int bj = 0; bj < 2; ++bj)
#pragma unroll
                        for (int n = 0; n < 2; ++n) { const f32x4 a = acc[ai][bj][m][n]; ss += (a[0] * a[0] + a[1] * a[1]) + (a[2] * a[2] + a[3] * a[3]); }
                    ss += __shfl_xor(ss, 16); ss += __shfl_xor(ss, 32);
                    const float rs = __builtin_amdgcn_rsqf(ss * (1.0f / 64.0f) + 1e-6f);
                    bf16_t* rowp = obase + (size_t)(ai * HALF + m * 16) * 64;
#pragma unroll
                    for (int bj = 0; bj < 2; ++bj) *(u32x4*)(rowp + 32 * bj) = pack8(acc[ai][bj][m][0] * rs * gg[bj][0], acc[ai][bj][m][1] * rs * gg[bj][1]); }
        } else {
#pragma unroll
            for (int ai = 0; ai < 2; ++ai)
#pragma unroll
                for (int m = 0; m < 4; ++m) { bf16_t* rowp = obase + (size_t)(ai * HALF + m * 16) * 64;
#pragma unroll
                    for (int bj = 0; bj < 2; ++bj) *(u32x4*)(rowp + 32 * bj) = pack8(acc[ai][bj][m][0], acc[ai][bj][m][1]); }
        }
    }
};
struct EpiOut {
    static constexpr bool PERM = true, AFTER_DRAIN = false;
    bf16_t* xb; float* ssq;
    __device__ __forceinline__ void operator()(f32x4 (&acc)[2][2][4][2], const Unit& u, int wr, int wc, int fr, int fq, int wid, int lane) const {
        const int col0 = u.pn * BM + wc * 32 + 8 * fq; const int gr0 = u.pm * BM + wr * 64 + fr;
        u32x4 w[2][4][2];
#pragma unroll
        for (int ai = 0; ai < 2; ++ai)
#pragma unroll
            for (int m = 0; m < 4; ++m)
#pragma unroll
                for (int bj = 0; bj < 2; ++bj) w[ai][m][bj] = *(const u32x4*)(xb + (size_t)(gr0 + ai * HALF + m * 16) * DMODEL + col0 + bj * HALF);
#pragma unroll
        for (int ai = 0; ai < 2; ++ai)
#pragma unroll
            for (int m = 0; m < 4; ++m) { const int gr = gr0 + ai * HALF + m * 16;
                float s = 0.f;
#pragma unroll
                for (int bj = 0; bj < 2; ++bj) { const u32x4 v = w[ai][m][bj];
                    f32x4 a = {__uint_as_float(v.x << 16), __uint_as_float(v.x & 0xffff0000u), __uint_as_float(v.y << 16), __uint_as_float(v.y & 0xffff0000u)};
                    f32x4 b = {__uint_as_float(v.z << 16), __uint_as_float(v.z & 0xffff0000u), __uint_as_float(v.w << 16), __uint_as_float(v.w & 0xffff0000u)};
                    a += acc[ai][bj][m][0]; b += acc[ai][bj][m][1];
                    s += (a[0] * a[0] + a[1] * a[1]) + (a[2] * a[2] + a[3] * a[3]) + (b[0] * b[0] + b[1] * b[1]) + (b[2] * b[2] + b[3] * b[3]);
                    *(u32x4*)(xb + (size_t)gr * DMODEL + col0 + bj * HALF) = pack8(a, b); }
                s += __shfl_xor(s, 16); s += __shfl_xor(s, 32);
                if (fq == 0) unsafeAtomicAdd(ssq + gr, s); }
    }
};
struct EpiDown {
    static constexpr bool PERM = true, AFTER_DRAIN = false;
    const bf16_t* xb; float* out;
    __device__ __forceinline__ void operator()(f32x4 (&acc)[2][2][4][2], const Unit& u, int wr, int wc, int fr, int fq, int wid, int lane) const {
        const int col0 = u.pn * BM + wc * 32 + 8 * fq; const int gr0 = u.pm * BM + wr * 64 + fr;
        u32x4 w[2][4][2];
#pragma unroll
        for (int ai = 0; ai < 2; ++ai)
#pragma unroll
            for (int m = 0; m < 4; ++m)
#pragma unroll
                for (int bj = 0; bj < 2; ++bj) w[ai][m][bj] = *(const u32x4*)(xb + (size_t)(gr0 + ai * HALF + m * 16) * DMODEL + col0 + bj * HALF);
#pragma unroll
        for (int ai = 0; ai < 2; ++ai)
#pragma unroll
            for (int m = 0; m < 4; ++m) { float* o = out + (size_t)(gr0 + ai * HALF + m * 16) * DMODEL + col0;
#pragma unroll
                for (int bj = 0; bj < 2; ++bj) { const u32x4 v = w[ai][m][bj];
                    f32x4 a = {__uint_as_float(v.x << 16), __uint_as_float(v.x & 0xffff0000u), __uint_as_float(v.y << 16), __uint_as_float(v.y & 0xffff0000u)};
                    f32x4 b = {__uint_as_float(v.z << 16), __uint_as_float(v.z & 0xffff0000u), __uint_as_float(v.w << 16), __uint_as_float(v.w & 0xffff0000u)};
                    a += acc[ai][bj][m][0]; b += acc[ai][bj][m][1]; *(f32x4*)(o + bj * HALF) = a; *(f32x4*)(o + bj * HALF + 4) = b; } }
    }
};
__device__ __forceinline__ bool seq_first(int gr) { return gr == 0 || (gr >= MPROMPT && (gr & 2047) == 0); }
__device__ __forceinline__ bool seq_last(int gr) { return gr >= MPROMPT - 1 && (gr & 2047) == 2047; }
struct EpiUp {
    static constexpr bool PERM = true, AFTER_DRAIN = false;
    bf16_t* H; const float* ssq; const float* cw; const float* cb; PG8_LAS float* xch;
    __device__ __forceinline__ void operator()(f32x4 (&acc)[2][2][4][2], const Unit& u, int wr, int wc, int fr, int fq, int wid, int lane) const {
        const int lr0 = wr * 64 + fr, gr0 = 254 * u.pm - 1 + lr0;
#pragma unroll
        for (int ai = 0; ai < 2; ++ai)
#pragma unroll
            for (int m = 0; m < 4; ++m) { int gr = gr0 + ai * HALF + m * 16; gr = gr < 0 ? 0 : (gr > MTOK - 1 ? MTOK - 1 : gr);
                const float rs = __builtin_amdgcn_rsqf(ssq[gr] * (1.0f / DMODEL) + 1e-6f);
#pragma unroll
                for (int bj = 0; bj < 2; ++bj)
#pragma unroll
                    for (int n = 0; n < 2; ++n) acc[ai][bj][m][n] *= rs; }
#pragma unroll
        for (int ai = 0; ai < 2; ++ai) {
            if (fr == 0) { PG8_LAS float* p = xch + ((wid * 2 + ai) * 2 + 0) * 64 + 8 * fq;
#pragma unroll
                for (int bj = 0; bj < 2; ++bj)
#pragma unroll
                    for (int n = 0; n < 2; ++n) *(PG8_LAS f32x4*)(p + bj * 32 + 4 * n) = acc[ai][bj][0][n]; }
            if (fr == 15) { PG8_LAS float* p = xch + ((wid * 2 + ai) * 2 + 1) * 64 + 8 * fq;
#pragma unroll
                for (int bj = 0; bj < 2; ++bj)
#pragma unroll
                    for (int n = 0; n < 2; ++n) *(PG8_LAS f32x4*)(p + bj * 32 + 4 * n) = acc[ai][bj][3][n]; }
        }
        asm volatile("s_waitcnt lgkmcnt(0)" ::: "memory"); __builtin_amdgcn_s_barrier(); asm volatile("" ::: "memory");
        const int tlo = 254 * u.pm - 1, thi = tlo + 255; const bool anyb = (tlo <= 0) || (((thi + 1) >> 11) != ((tlo - 1) >> 11));
        const int ow = (1 - wr) * 4 + wc;
        const int ch0 = 128 * u.pn + 32 * wc + 8 * fq;
#pragma unroll
        for (int n = 0; n < 2; ++n) {
            f32x4 w0[2], w1[2], w2[2], bb[2];
#pragma unroll
            for (int bj = 0; bj < 2; ++bj) { const int ch = ch0 + 4 * n + bj * DFF_;
                w0[bj] = *(const f32x4*)(cw + ch); w1[bj] = *(const f32x4*)(cw + 2 * DFF_ + ch); w2[bj] = *(const f32x4*)(cw + 4 * DFF_ + ch); bb[bj] = *(const f32x4*)(cb + ch); }
#pragma unroll
            for (int ai = 0; ai < 2; ++ai) {
                const int aiT = wr == 1 ? ai : ai - 1, aiB = wr == 0 ? ai : ai + 1;
#pragma unroll
                for (int m = 0; m < 4; ++m) {
                    const int lr = lr0 + ai * HALF + m * 16, gr = gr0 + ai * HALF + m * 16;
                    const bool first = seq_first(gr), last = seq_last(gr);
                    f32x4 c[2];
#pragma unroll
                    for (int bj = 0; bj < 2; ++bj) {
                        const f32x4 cur = acc[ai][bj][m][n];
                        f32x4 pv, nx;
#pragma unroll
                        for (int e = 0; e < 4; ++e) {
                            const float sP = (m > 0 && fr == 15) ? acc[ai][bj][m > 0 ? m - 1 : 0][n][e] : cur[e];
                            const float sN = (m < 3 && fr == 0) ? acc[ai][bj][m < 3 ? m + 1 : 3][n][e] : cur[e];
                            pv[e] = __builtin_bit_cast(float, __builtin_amdgcn_mov_dpp(__builtin_bit_cast(int, sP), 0x121  , 0xf, 0xf, true));
                            nx[e] = __builtin_bit_cast(float, __builtin_amdgcn_mov_dpp(__builtin_bit_cast(int, sN), 0x12f  , 0xf, 0xf, true)); }
                        if (m == 0) { const f32x4 top = (aiT >= 0) ? *(const PG8_LAS f32x4*)(xch + ((ow * 2 + (aiT < 0 ? 0 : aiT)) * 2 + 1) * 64 + 8 * fq + bj * 32 + 4 * n) : (f32x4){0.f, 0.f, 0.f, 0.f}; if (fr == 0) pv = top; }
                        if (m == 3) { const f32x4 bot = (aiB <= 1) ? *(const PG8_LAS f32x4*)(xch + ((ow * 2 + (aiB > 1 ? 1 : aiB)) * 2 + 0) * 64 + 8 * fq + bj * 32 + 4 * n) : (f32x4){0.f, 0.f, 0.f, 0.f}; if (fr == 15) nx = bot; }
                        if (anyb) { if (first) pv = (f32x4){0.f, 0.f, 0.f, 0.f}; if (last) nx = (f32x4){0.f, 0.f, 0.f, 0.f}; }
                        c[bj] = bb[bj] + w0[bj] * pv + w1[bj] * cur + w2[bj] * nx;
                    }
                    f32x4 hv;
#pragma unroll
                    for (int e = 0; e < 4; ++e) { const float g = c[0][e]; hv[e] = g * __builtin_amdgcn_rcpf(1.0f + __builtin_amdgcn_exp2f(-1.4426950408889634f * g)) * c[1][e]; }
                    f32x2 pk; pk.x = __builtin_bit_cast(float, cvtpk(hv[0], hv[1])); pk.y = __builtin_bit_cast(float, cvtpk(hv[2], hv[3]));
                    if (lr >= 1 && lr <= 254 && gr < MTOK) *(f32x2*)(H + (size_t)gr * DFF_ + ch0 + 4 * n) = pk;
                    asm volatile("" ::: "memory");
                }
            }
        }
    }
};
template <class Epi, class Sched, bool ALIGN_EPI = false, bool SP2 = false>
__device__ __forceinline__ void gemm_phase(PG8_LAS unsigned char* lds, const Gemm g, const Sched& S, const Epi& E) {
    int tid_ = threadIdx.x; asm volatile("" : "+v"(tid_));
    const int tid = tid_, wid = __builtin_amdgcn_readfirstlane(tid >> 6), lane = tid & 63, wr = wid >> 2, wc = wid & 3, fr = lane & 15, fq = lane >> 4;
    const int K = g.K, nt = K / BK;
    unsigned voffA[2], voffB[2];
#pragma unroll
    for (int i = 0; i < 2; ++i) { int R, C; stage_rc(tid * 16 + i * 8192, R, C); const int Rb = Epi::PERM ? ((R & ~31) + perm32(R & 31)) : R;
        voffA[i] = (unsigned)(R * K + C) * 2u; voffB[i] = (unsigned)(Rb * K + C) * 2u; }
    const size_t kstep = (size_t)(BK * 2);
    const size_t hstep = (size_t)HALF * K * 2;
    const size_t tstep = 2 * hstep; const size_t tstepA = (size_t)g.a_tile_rows * K * 2;
    const unsigned ldsw = (unsigned)wid * 1024u;
    const int aoff = lds_byte(wr * 64 + fr, fq * 8), boff = lds_byte(wc * 32 + fr, fq * 8);
#define PG8_SA(b, h) (((b) * 2 + (h)) * HTB)
#define PG8_SB(b, h) ((4 + (b) * 2 + (h)) * HTB)
#define PG8_STAGE(bufoff, gbase, voff) do { _Pragma("unroll") for (int _i = 0; _i < 2; ++_i) \
        __builtin_amdgcn_global_load_lds((const unsigned*)((const char*)(gbase) + (voff)[_i]), (PG8_LAS unsigned*)(lds + (bufoff) + ldsw + _i * 8192), 16, 0, 0); } while (0)
#define PG8_LDA(dst, b, h) do { _Pragma("unroll") for (int m = 0; m < 4; ++m) _Pragma("unroll") for (int k = 0; k < 2; ++k) dst[m][k] = *(const PG8_LAS bf16x8*)(lds + PG8_SA(b, h) + aoff + m * 2048 + k * 1024); } while (0)
#define PG8_LDB(dst, b, h) do { _Pragma("unroll") for (int n = 0; n < 2; ++n) _Pragma("unroll") for (int k = 0; k < 2; ++k) dst[n][k] = *(const PG8_LAS bf16x8*)(lds + PG8_SB(b, h) + boff + n * 2048 + k * 1024); } while (0)
#define PG8_MMA(ai, bj, At, Bt) do { __builtin_amdgcn_s_setprio(1); _Pragma("unroll") for (int m = 0; m < 4; ++m) _Pragma("unroll") for (int n = 0; n < 2; ++n) _Pragma("unroll") for (int k = 0; k < 2; ++k) \
        acc[ai][bj][m][n] = __builtin_amdgcn_mfma_f32_16x16x32_bf16(Bt[n][k], At[m][k], acc[ai][bj][m][n], 0, 0, 0); __builtin_amdgcn_s_setprio(0); } while (0)
#define PG8_WAIT_V(n) asm volatile("s_waitcnt vmcnt(" #n ")" ::: "memory")
#define PG8_WAIT_L(n) asm volatile("s_waitcnt lgkmcnt(" #n ")" ::: "memory")
#define PG8_BAR __builtin_amdgcn_s_barrier()
#define PG8_SCHED __builtin_amdgcn_sched_barrier(0)
    Unit cur, nxt; int ui = 0;
    if (!S.next(0, cur)) return;
    f32x4 acc[2][2][4][2];
#pragma unroll
    for (int a = 0; a < 2; ++a)
#pragma unroll
        for (int b = 0; b < 2; ++b)
#pragma unroll
            for (int m = 0; m < 4; ++m)
#pragma unroll
                for (int n = 0; n < 2; ++n) acc[a][b][m][n] = (f32x4){0.f, 0.f, 0.f, 0.f};
    bf16x8 At[4][2], B0[2][2], B1[2][2];
    const char* cA = (const char*)g.A + (size_t)cur.pm * tstepA; const char* cB = (const char*)g.Bt + (size_t)cur.pn * tstep;
    S.a_ready(cur);
    if constexpr (SP2) {
        PG8_STAGE(PG8_SB(0, 0), cB, voffB); PG8_STAGE(PG8_SB(0, 1), cB + hstep, voffB); PG8_STAGE(PG8_SA(0, 0), cA, voffA); PG8_STAGE(PG8_SA(0, 1), cA + hstep, voffA);
        if (wr == 1) PG8_BAR;
        PG8_WAIT_V(2); PG8_BAR;
        PG8_STAGE(PG8_SB(1, 0), cB + kstep, voffB); PG8_STAGE(PG8_SA(1, 0), cA + kstep, voffA); PG8_STAGE(PG8_SB(1, 1), cB + hstep + kstep, voffB);
        PG8_WAIT_V(6); PG8_BAR;
    } else {
        PG8_STAGE(PG8_SB(0, 0), cB, voffB); PG8_STAGE(PG8_SA(0, 0), cA, voffA); PG8_STAGE(PG8_SB(0, 1), cB + hstep, voffB); PG8_STAGE(PG8_SA(0, 1), cA + hstep, voffA);
        if (wr == 1) PG8_BAR;
        PG8_WAIT_V(4); PG8_BAR;
        PG8_STAGE(PG8_SB(1, 0), cB + kstep, voffB); PG8_STAGE(PG8_SA(1, 0), cA + kstep, voffA); PG8_STAGE(PG8_SB(1, 1), cB + hstep + kstep, voffB);
        PG8_WAIT_V(6); PG8_BAR;
    }
    for (;;) {
        const bool has_next = S.next(ui + 1, nxt);
        const char* nA = has_next ? (const char*)g.A + (size_t)nxt.pm * tstepA : cA; const char* nB = has_next ? (const char*)g.Bt + (size_t)nxt.pn * tstep : cB;
        for (int t = 0; t < nt; t += 2) {
            const bool last = (t == nt - 2);
            const char* a1 = cA + (size_t)(t + 1) * kstep;
            const char* a2 = last ? nA : cA + (size_t)(t + 2) * kstep; const char* b2 = last ? nB : cB + (size_t)(t + 2) * kstep;
            const char* a3 = a2 + kstep; const char* b3 = b2 + kstep;
            if (last && has_next) S.a_ready(nxt);
            if constexpr (SP2) {
            PG8_LDB(B0, 0, 0); PG8_LDB(B1, 0, 1); PG8_SCHED; PG8_LDA(At, 0, 0); PG8_STAGE(PG8_SA(1, 1), a1 + hstep, voffA);
            PG8_WAIT_V(8); PG8_WAIT_L(0); PG8_BAR; PG8_MMA(0, 0, At, B0); PG8_MMA(0, 1, At, B1); PG8_BAR; PG8_SCHED;
            PG8_LDA(At, 0, 1); PG8_STAGE(PG8_SB(0, 0), b2, voffB); PG8_STAGE(PG8_SB(0, 1), b2 + hstep, voffB); PG8_STAGE(PG8_SA(0, 0), a2, voffA);
            PG8_WAIT_V(8); PG8_WAIT_L(0); PG8_BAR; PG8_MMA(1, 0, At, B0); PG8_MMA(1, 1, At, B1); PG8_BAR; PG8_SCHED;
            PG8_LDB(B0, 1, 0); PG8_LDB(B1, 1, 1); PG8_SCHED; PG8_LDA(At, 1, 0); PG8_STAGE(PG8_SA(0, 1), a2 + hstep, voffA);
            PG8_WAIT_V(8); PG8_WAIT_L(0); PG8_BAR; PG8_MMA(0, 0, At, B0); PG8_MMA(0, 1, At, B1); PG8_BAR; PG8_SCHED;
            PG8_LDA(At, 1, 1); PG8_STAGE(PG8_SB(1, 0), b3, voffB); PG8_STAGE(PG8_SB(1, 1), b3 + hstep, voffB); PG8_STAGE(PG8_SA(1, 0), a3, voffA);
            PG8_WAIT_V(8); PG8_WAIT_L(0); PG8_BAR; PG8_MMA(1, 0, At, B0); PG8_MMA(1, 1, At, B1); PG8_BAR; PG8_SCHED;
            } else {
            PG8_LDB(B0, 0, 0); PG8_SCHED; PG8_LDA(At, 0, 0); PG8_STAGE(PG8_SA(1, 1), a1 + hstep, voffA);
            PG8_WAIT_L(8); PG8_BAR; PG8_WAIT_L(0); PG8_MMA(0, 0, At, B0); PG8_BAR; PG8_SCHED;
            PG8_LDB(B1, 0, 1); PG8_STAGE(PG8_SB(0, 0), b2, voffB);
            PG8_BAR; PG8_WAIT_L(0); PG8_MMA(0, 1, At, B1); PG8_BAR;
            PG8_LDA(At, 0, 1); PG8_STAGE(PG8_SA(0, 0), a2, voffA);
            PG8_BAR; PG8_WAIT_L(0); PG8_MMA(1, 0, At, B0); PG8_BAR; PG8_SCHED;
            PG8_STAGE(PG8_SB(0, 1), b2 + hstep, voffB);
            PG8_WAIT_V(6); PG8_BAR; PG8_MMA(1, 1, At, B1); PG8_BAR;
            PG8_LDB(B0, 1, 0); PG8_SCHED; PG8_LDA(At, 1, 0); PG8_STAGE(PG8_SA(0, 1), a2 + hstep, voffA);
            PG8_WAIT_L(8); PG8_BAR; PG8_WAIT_L(0); PG8_MMA(0, 0, At, B0); PG8_BAR; PG8_SCHED;
            PG8_LDB(B1, 1, 1); PG8_STAGE(PG8_SB(1, 0), b3, voffB);
            PG8_BAR; PG8_WAIT_L(0); PG8_MMA(0, 1, At, B1); PG8_BAR;
            PG8_LDA(At, 1, 1); PG8_STAGE(PG8_SA(1, 0), a3, voffA);
            PG8_BAR; PG8_WAIT_L(0); PG8_MMA(1, 0, At, B0); PG8_BAR; PG8_SCHED;
            PG8_STAGE(PG8_SB(1, 1), b3 + hstep, voffB);
            PG8_WAIT_V(6); PG8_BAR; PG8_MMA(1, 1, At, B1); PG8_BAR;
            }
        }
        if constexpr (ALIGN_EPI) { if (wr == 0) PG8_BAR; }
        if constexpr (!Epi::AFTER_DRAIN) { E(acc, cur, wr, wc, fr, fq, wid, lane); S.done(cur); }
        if (!has_next) break;
#pragma unroll
        for (int a = 0; a < 2; ++a)
#pragma unroll
            for (int b = 0; b < 2; ++b)
#pragma unroll
                for (int m = 0; m < 4; ++m)
#pragma unroll
                    for (int n = 0; n < 2; ++n) acc[a][b][m][n] = (f32x4){0.f, 0.f, 0.f, 0.f};
        cur = nxt; cA = nA; cB = nB; ++ui;
        if constexpr (ALIGN_EPI) { if (wr == 1) PG8_BAR; }
    }
    PG8_WAIT_V(0);
    if constexpr (!ALIGN_EPI) { if (wr == 0) PG8_BAR; }
    PG8_BAR;
    if constexpr (Epi::AFTER_DRAIN) { E.fused(acc, cur, wr, wc, fr, fq, lds, wid, lane); S.done(cur); }
#undef PG8_SA
#undef PG8_SB
#undef PG8_STAGE
#undef PG8_LDA
#undef PG8_LDB
#undef PG8_MMA
#undef PG8_WAIT_V
#undef PG8_WAIT_L
#undef PG8_BAR
#undef PG8_SCHED
}
}
#ifndef PG8_SP2
#define PG8_SP2 true
#endif
#ifndef PG8_ALIGN
#define PG8_ALIGN true
#endif

constexpr int NWAVES = 8;
constexpr int DM = 1024, M = 49152, MP = 16384, INW = 2304, DFF = 2816, UPW = 5632;
constexpr int QA_OFF = 0, KA_OFF = 512, VA_OFF = 1024, QB_OFF = 1536, KB_OFF = 2048, VB_OFF = 2176;
constexpr int UP_TILES_M = 194;
constexpr float EPS = 1e-6f, LOG2E = 1.4426950408889634f;

constexpr size_t MiB = 1u << 20;
constexpr size_t WS_SSQ = 0;
constexpr size_t WS_SSQ1 = 512 * 1024;
constexpr size_t WS_BAR = 1 * MiB;
constexpr size_t WS_WIN = 2 * MiB, WS_WOUT = 7 * MiB, WS_WUP = 9 * MiB, WS_WDN = 20 * MiB;
constexpr size_t WS_XN = 32 * MiB;
constexpr size_t WS_PROJ = 130 * MiB;
constexpr size_t WS_OA = 346 * MiB;
constexpr size_t WS_H = 226 * MiB;
constexpr size_t WS_LA = 490 * MiB;
constexpr size_t WS_END = 496 * MiB;
static_assert(WS_XN + (size_t)(M + 256) * DM * 2 <= WS_PROJ && WS_PROJ + (size_t)M * INW * 2 <= WS_OA && WS_OA + 3 * (size_t)M * 512 * 2 <= WS_LA && WS_H + (size_t)M * DFF * 2 <= WS_LA && WS_PROJ + (size_t)M * DM * 2 <= WS_H, "d_ws map");

constexpr int RING_BYTES = 131072, XCH_OFF = RING_BYTES, MISC_OFF = XCH_OFF + 8192, LDS_BYTES = 147456;

#define LAS __attribute__((address_space(3)))
typedef unsigned short bf16;
typedef unsigned v4u __attribute__((ext_vector_type(4)));
typedef float f32x4 __attribute__((ext_vector_type(4)));
typedef float f32x16 __attribute__((ext_vector_type(16)));
typedef short bf16x8 __attribute__((ext_vector_type(8)));
typedef short s16x4 __attribute__((ext_vector_type(4)));
using pg8::cvtpk;
__device__ __forceinline__ float bf_lo(unsigned w) { return __uint_as_float(w << 16); }
__device__ __forceinline__ float bf_hi(unsigned w) { return __uint_as_float(w & 0xffff0000u); }
__device__ __forceinline__ float wave_sum(float v) {
#pragma unroll
    for (int o = 1; o < 64; o <<= 1) v += __shfl_xor(v, o);
    return v;
}
__device__ __forceinline__ float wave_max(float v) {
#pragma unroll
    for (int o = 1; o < 64; o <<= 1) v = fmaxf(v, __shfl_xor(v, o));
    return v;
}

#define GAS __attribute__((address_space(1)))
#define RLX_AGENT __ATOMIC_RELAXED, __HIP_MEMORY_SCOPE_AGENT
#define XB_TMO      128
#define XB_XCNT(j)  (256  + 64 * (j))
#define XB_XSUB(j)  (1280 + 64 * (j))
#define XB_XGEN(j)  (2304 + 64 * (j))
#define XB_TOP      3328
#define XB_TOPGEN   3392
#define XCD_BAR_WORDS 3456
#define XB_SPIN_CAP (1u << 18)

__device__ __forceinline__ unsigned xb_ld(unsigned* p)              { return __hip_atomic_load(p, __ATOMIC_RELAXED, __HIP_MEMORY_SCOPE_AGENT); }
__device__ __forceinline__ unsigned xb_add(unsigned* p, unsigned v) { return __hip_atomic_fetch_add(p, v, __ATOMIC_RELAXED, __HIP_MEMORY_SCOPE_AGENT); }
__device__ __forceinline__ unsigned xb_xcc_id() { return (unsigned)__builtin_amdgcn_s_getreg((3 << 11) | 20) & 0xFu; }
#define XB_SPIN(cond, bar) do { unsigned _sp = 0; while (cond) { __builtin_amdgcn_s_sleep(1); \
    if ((++_sp & 255u) == 0u) { if (xb_ld(&(bar)[XB_TMO])) break; if (_sp > XB_SPIN_CAP) { atomicAdd(&(bar)[XB_TMO], 1u); break; } } } } while (0)

struct XcdBarrier {
    unsigned* bar; unsigned x;
    volatile LAS unsigned* st;
};

__device__ __forceinline__ XcdBarrier xcd_barrier_post(unsigned* bar, volatile LAS unsigned* st) {
    XcdBarrier b; b.bar = bar; b.x = xb_xcc_id(); b.st = st;
    if (threadIdx.x == 0) (void)xb_add(&bar[XB_XCNT(b.x)], 1u);
    return b;
}
__device__ __forceinline__ void xcd_barrier_complete(unsigned* bar, unsigned x, unsigned& nloc, unsigned& nx) {
    const unsigned G = gridDim.x * gridDim.y * gridDim.z;
    unsigned sum, cnt, mine, sp = 0u;
    for (;;) {
        sum = 0u; cnt = 0u; mine = 0u;
#pragma unroll
        for (unsigned j = 0; j < 16; ++j) { const unsigned c = xb_ld(&bar[XB_XCNT(j)]); sum += c; cnt += (c > 0u) ? 1u : 0u; mine = (j == x) ? c : mine; }
        if (sum == G) break;
        __builtin_amdgcn_s_sleep(1);
        if ((++sp & 255u) == 0u) { if (xb_ld(&bar[XB_TMO])) break; if (sp > XB_SPIN_CAP) { atomicAdd(&bar[XB_TMO], 1u); break; } }
    }
    nloc = mine > 0u ? mine : 1u; nx = cnt > 0u ? cnt : 1u;
}

__device__ __forceinline__ void xcd_barrier(const XcdBarrier& b) {
    asm volatile("s_waitcnt vmcnt(0)" ::: "memory");
    __syncthreads();
    if (threadIdx.x == 0) {
        unsigned* bar = b.bar;
        __builtin_amdgcn_s_waitcnt(0);
        unsigned nloc = b.st[0], nx = b.st[1];
        if (nloc == 0u) { xcd_barrier_complete(bar, b.x, nloc, nx); b.st[0] = nloc; b.st[1] = nx; }
        const unsigned old = xb_add(&bar[XB_XSUB(b.x)], 1u);
        const unsigned gen = old / nloc;
        if (old + 1u == (gen + 1u) * nloc) {
            __builtin_amdgcn_fence(__ATOMIC_RELEASE, "agent");
            asm volatile("s_waitcnt vmcnt(0)" ::: "memory");
            const unsigned og = xb_add(&bar[XB_TOP], 1u);
            const unsigned tg = og / nx;
            if (og + 1u == (tg + 1u) * nx) xb_add(&bar[XB_TOPGEN], 1u);
            else XB_SPIN(xb_ld(&bar[XB_TOPGEN]) == tg, bar);
            __builtin_amdgcn_fence(__ATOMIC_ACQUIRE, "agent");
            xb_add(&bar[XB_XGEN(b.x)], 1u);
            asm volatile("s_waitcnt vmcnt(0)" ::: "memory");
        } else {
            XB_SPIN(xb_ld(&bar[XB_XGEN(b.x)]) == gen, bar);
            __builtin_amdgcn_fence(__ATOMIC_ACQUIRE, "agent");
            asm volatile("s_waitcnt vmcnt(0)" ::: "memory");
        }
    }
    __syncthreads();
}

template <int MAP  >
__device__ __forceinline__ void p0_transpose_item(const float* W, int K, int N, bf16* WT, const float* kgain, LAS float* scr, int item, int lane) {
    const int nblk = N / 32, kb = item / nblk, nb = item % nblk, k0 = 64 * kb, n0 = 32 * nb;
#pragma unroll 8
    for (int i = 0; i < 32; ++i) { const int kk = 2 * i + (lane >> 5); float v = W[(size_t)(k0 + kk) * N + n0 + (lane & 31)]; if (kgain) v *= kgain[k0 + kk]; scr[kk * 33 + (lane & 31)] = v; }
    asm volatile("s_waitcnt lgkmcnt(0)" ::: "memory");
    const int c = lane & 7;
    int r0 = n0;
    if (MAP == 2) { const int hs = n0 >> 6; r0 = 256 * (hs >> 2) + 128 * ((n0 >> 5) & 1) + 32 * (hs & 3); }
    if (MAP == 1) r0 = n0 < DFF ? ((n0 >> 7) * 256 + (n0 & 127)) : ((((n0 - DFF) >> 7) * 256) + 128 + ((n0 - DFF) & 127));
#pragma unroll
    for (int j = 0; j < 4; ++j) { const int n = (lane >> 3) + 8 * j; const LAS float* s = scr + (8 * c) * 33 + n;
        v4u o; o.x = cvtpk(s[0 * 33], s[1 * 33]); o.y = cvtpk(s[2 * 33], s[3 * 33]); o.z = cvtpk(s[4 * 33], s[5 * 33]); o.w = cvtpk(s[6 * 33], s[7 * 33]);
        *(v4u*)(WT + (size_t)(r0 + n) * K + k0 + 8 * c) = o; }
    asm volatile("s_waitcnt lgkmcnt(0)" ::: "memory");
}
__device__ __forceinline__ void rows4_to_bf16(const float* xrow, bf16* orow, float* ssq, int lane) {
    f32x4 v[4][4]; float s[4];
#pragma unroll
    for (int k = 0; k < 4; ++k)
#pragma unroll
        for (int j = 0; j < 4; ++j) v[k][j] = ((const f32x4*)(xrow + (size_t)k * DM) + lane)[64 * j];
#pragma unroll
    for (int k = 0; k < 4; ++k) { s[k] = 0.f;
#pragma unroll
        for (int j = 0; j < 4; ++j) s[k] += (v[k][j].x * v[k][j].x + v[k][j].y * v[k][j].y) + (v[k][j].z * v[k][j].z + v[k][j].w * v[k][j].w);
        unsigned long long* o8 = (unsigned long long*)(orow + (size_t)k * DM) + lane;
#pragma unroll
        for (int j = 0; j < 4; ++j) o8[64 * j] = (unsigned long long)cvtpk(v[k][j].x, v[k][j].y) | ((unsigned long long)cvtpk(v[k][j].z, v[k][j].w) << 32); }
#pragma unroll
    for (int o = 1; o < 64; o <<= 1) {
#pragma unroll
        for (int k = 0; k < 4; ++k) s[k] += __shfl_xor(s[k], o); }
    if (lane < 4) ssq[lane] = lane == 0 ? s[0] : lane == 1 ? s[1] : lane == 2 ? s[2] : s[3];
}

template <int NKEYS, int NTHR>
__device__ __forceinline__ void stage_load(v4u (&kr)[NKEYS * 8 / NTHR], v4u (&vr)[NKEYS * 8 / NTHR], const bf16* kbase, const bf16* vbase, int tok0, int dshift, int kidx0, int Ls, int t) {
    constexpr int NIT = NKEYS * 8 / NTHR;
    const int c = t & 7;
#pragma unroll
    for (int it = 0; it < NIT; ++it) { const int rho = (it * NTHR + t) >> 3, kidx = kidx0 + rho; const bool ok = (unsigned)kidx < (unsigned)Ls;
        const size_t off = (size_t)(tok0 + ((ok ? kidx : 0) << dshift)) * 64 + 8 * c;
        kr[it] = *(const v4u*)(kbase + off); vr[it] = *(const v4u*)(vbase + off); }
}
template <int NKEYS, int NTHR>
__device__ __forceinline__ void stage_write(const v4u (&kr)[NKEYS * 8 / NTHR], const v4u (&vr)[NKEYS * 8 / NTHR], LAS unsigned char* Kl, LAS unsigned char* Vl, int t) {
    constexpr int NIT = NKEYS * 8 / NTHR;
    const int c = t & 7;
#pragma unroll
    for (int it = 0; it < NIT; ++it) { const int rho = (it * NTHR + t) >> 3;
        *(LAS v4u*)(Kl + rho * 128 + 16 * (c ^ ((rho >> 1) & 7))) = kr[it];
        *(LAS v4u*)(Vl + (c >> 2) * (NKEYS * 64) + rho * 64 + (c & 3) * 16) = vr[it]; }
}
__device__ __forceinline__ void load_q_raw(v4u (&raw)[4], const bf16* qrow, int lane) {
#pragma unroll
    for (int d0 = 0; d0 < 4; ++d0) raw[d0] = *(const v4u*)(qrow + 16 * d0 + 8 * (lane >> 5));
}
typedef short v4i16_t __attribute__((ext_vector_type(4)));
__device__ __forceinline__ s16x4 vtr(const LAS unsigned char* p) { return __builtin_bit_cast(s16x4, __builtin_amdgcn_ds_read_tr16_b64_v4i16((LAS v4i16_t*)p)); }
template <int R, int CS>
__device__ __forceinline__ void build_bias_table(LAS float* tab, float nslope, float negM, int t, int nthr) {
    for (int idx = t; idx < 4 * CS; idx += nthr) { const int k = idx / CS, m = idx - k * CS, rel = m + k - (R + 32); const int ar = rel < 0 ? -rel : rel;
        tab[idx] = ar <= R ? __builtin_fmaf((float)ar, nslope, negM) : -__builtin_inff(); }
}
__device__ __forceinline__ void attn_tile(const bf16x8 (&kf)[4], const LAS float* tb, unsigned vaddr, int vhs, const bf16x8 (&qf)[4], f32x16 (&o)[2], float& l) {
    s16x4 vl[4], vh[4];
    asm volatile("ds_read_b64_tr_b16 %0, %8\n\tds_read_b64_tr_b16 %1, %8 offset:512\n\tds_read_b64_tr_b16 %2, %8 offset:1024\n\tds_read_b64_tr_b16 %3, %8 offset:1536\n\t"
                 "ds_read_b64_tr_b16 %4, %9\n\tds_read_b64_tr_b16 %5, %9 offset:512\n\tds_read_b64_tr_b16 %6, %9 offset:1024\n\tds_read_b64_tr_b16 %7, %9 offset:1536"
                 : "=&v"(vl[0]), "=&v"(vh[0]), "=&v"(vl[1]), "=&v"(vh[1]), "=&v"(vl[2]), "=&v"(vh[2]), "=&v"(vl[3]), "=&v"(vh[3]) : "v"(vaddr), "v"(vaddr + (unsigned)vhs) : "memory");
    const f32x4 c0 = *(const LAS f32x4*)(tb), c1 = *(const LAS f32x4*)(tb + 8), c2 = *(const LAS f32x4*)(tb + 16), c3 = *(const LAS f32x4*)(tb + 24);
    f32x16 s = {c0[0], c0[1], c0[2], c0[3], c1[0], c1[1], c1[2], c1[3], c2[0], c2[1], c2[2], c2[3], c3[0], c3[1], c3[2], c3[3]};
#pragma unroll
    for (int d0 = 0; d0 < 4; ++d0) s = __builtin_amdgcn_mfma_f32_32x32x16_bf16(kf[d0], qf[d0], s, 0, 0, 0);
    float pr[16];
#pragma unroll
    for (int r = 0; r < 16; ++r) { const float p = __builtin_amdgcn_exp2f(s[r]); l += p; pr[r] = p; }
    v4u w0, w1; w0.x = cvtpk(pr[0], pr[1]); w0.y = cvtpk(pr[2], pr[3]); w0.z = cvtpk(pr[4], pr[5]); w0.w = cvtpk(pr[6], pr[7]);
    w1.x = cvtpk(pr[8], pr[9]); w1.y = cvtpk(pr[10], pr[11]); w1.z = cvtpk(pr[12], pr[13]); w1.w = cvtpk(pr[14], pr[15]);
    const bf16x8 pa0 = __builtin_bit_cast(bf16x8, w0), pa1 = __builtin_bit_cast(bf16x8, w1);
    asm volatile("s_waitcnt lgkmcnt(0)" : "+v"(vl[0]), "+v"(vh[0]), "+v"(vl[1]), "+v"(vh[1]), "+v"(vl[2]), "+v"(vh[2]), "+v"(vl[3]), "+v"(vh[3]) :: "memory");
#pragma unroll
    for (int dh = 0; dh < 2; ++dh)
#pragma unroll
        for (int s2 = 0; s2 < 2; ++s2) { const s16x4 lo = vl[2 * dh + s2], h4 = vh[2 * dh + s2];
            const bf16x8 vf = (bf16x8){lo[0], lo[1], lo[2], lo[3], h4[0], h4[1], h4[2], h4[3]};
            o[dh] = __builtin_amdgcn_mfma_f32_32x32x16_bf16(vf, s2 ? pa1 : pa0, o[dh], 0, 0, 0); }
}
template <int NT, int CS>
__device__ __forceinline__ void attn_task(const LAS unsigned char* Kl, const LAS unsigned char* Vl, int vhs, int row0, int kidx_t0, int Ls, const bf16x8 (&qf)[4], const LAS float* tab, f32x16 (&o)[2], float& l, int lane) {
    const int q = lane & 31, hi = lane >> 5;
    const unsigned va0 = (unsigned)(uintptr_t)(Vl + row0 * 64 + (4 * hi + ((lane & 15) >> 2)) * 64 + (16 * ((lane >> 4) & 1) + 4 * (lane & 3)) * 2);
    const int sw = (q >> 1) & 7;
    const LAS unsigned char* kp0 = Kl + (row0 + q) * 128 + 16 * ((0 + hi) ^ sw); const LAS unsigned char* kp1 = Kl + (row0 + q) * 128 + 16 * ((2 + hi) ^ sw);
    const LAS unsigned char* kp2 = Kl + (row0 + q) * 128 + 16 * ((4 + hi) ^ sw); const LAS unsigned char* kp3 = Kl + (row0 + q) * 128 + 16 * ((6 + hi) ^ sw);
    int b = 32 - q + 4 * hi; asm volatile("" : "+v"(b));
    const LAS float* tb0 = tab + (b & 3) * CS + (b & ~3);
#define LOADK(dst, jj) do { dst[0] = *(const LAS bf16x8*)(kp0 + (jj) * 4096); dst[1] = *(const LAS bf16x8*)(kp1 + (jj) * 4096); dst[2] = *(const LAS bf16x8*)(kp2 + (jj) * 4096); dst[3] = *(const LAS bf16x8*)(kp3 + (jj) * 4096); } while (0)
    bf16x8 kf[4];
#pragma unroll 1
    for (int j = 0; j < NT; ++j) {
        if ((unsigned)(kidx_t0 + 32 * j) < (unsigned)Ls) {
            LOADK(kf, j);
            attn_tile(kf, tb0 + 32 * j, va0 + j * 2048, vhs, qf, o, l); }
    }
#undef LOADK
}
__device__ __forceinline__ void store_partial(const f32x16 (&o)[2], float l, bf16* OBuf, float* LB, int tokq0, int dshift, int h, int lane) {
    const int hi = lane >> 5, q = lane & 31; const size_t row = (size_t)h * M + (size_t)(tokq0 + (q << dshift));
    l += __shfl_xor(l, 32);
    if (hi == 0) LB[row] = l;
    bf16* p = OBuf + row * 64 + 8 * hi;
#pragma unroll
    for (int dh = 0; dh < 2; ++dh)
#pragma unroll
        for (int t = 0; t < 2; ++t) { const int ge = 2 * t, go = 2 * t + 1;
            const unsigned x0 = cvtpk(o[dh][4 * ge], o[dh][4 * ge + 1]), x1 = cvtpk(o[dh][4 * ge + 2], o[dh][4 * ge + 3]);
            const unsigned y0 = cvtpk(o[dh][4 * go], o[dh][4 * go + 1]), y1 = cvtpk(o[dh][4 * go + 2], o[dh][4 * go + 3]);
            const auto r0 = __builtin_amdgcn_permlane32_swap(x0, y0, false, false), r1 = __builtin_amdgcn_permlane32_swap(x1, y1, false, false);
            v4u w; w.x = r0[0]; w.y = r1[0]; w.z = r0[1]; w.w = r1[1];
            *(v4u*)(p + 32 * dh + 16 * t) = w; }
}
struct AUnit { int tok0, dshift, Ls, cc, h, c; };
__device__ __forceinline__ AUnit decode_a(int su) {
    AUnit a; const int sidx = su / 48, k = su % 48, blk = sidx >> 3; a.h = sidx & 7; a.c = 2 - (k >> 4); a.dshift = 2 * a.c; const int kk = k & 15;
    int seq0, S, bis; if (blk < 8) { seq0 = 0; S = 16384; bis = blk; } else { seq0 = MP + 2048 * (blk - 8); S = 2048; bis = 0; }
    a.Ls = S >> a.dshift; const int lcpb = 4 - a.dshift  , res = kk >> lcpb; a.cc = (bis << lcpb) + (kk & ((1 << lcpb) - 1)); a.tok0 = seq0 + res; return a;
}
struct BUnit { int seq0, S, lcb, g2; };
__device__ __forceinline__ BUnit decode_b(int u) {
    BUnit b; b.g2 = u / 768; const int cb = u % 768;
    if (cb < 256) { b.seq0 = 0; b.S = 16384; b.lcb = cb; } else { b.seq0 = MP + 2048 * ((cb - 256) >> 5); b.S = 2048; b.lcb = (cb - 256) & 31; } return b;
}

#define LDS_BAR() asm volatile("s_waitcnt lgkmcnt(0)\n\ts_barrier" ::: "memory")
#define xp (args.in[0])
#define xs (args.in[1])
#define norm1 (args.in[2])
#define w_in (args.in[3])
#define qna (args.in[4])
#define kna (args.in[5])
#define qnb (args.in[6])
#define knb (args.in[7])
#define sinkb (args.in[8])
#define ona (args.in[9])
#define onb (args.in[10])
#define w_out (args.in[11])
#define norm2 (args.in[12])
#define w_up (args.in[13])
#define conv_w (args.in[14])
#define conv_b (args.in[15])
#define w_down (args.in[16])
#define out (args.dout)
#define SSQ ((float*)(args.ws + WS_SSQ))
#define SSQ1 ((float*)(args.ws + WS_SSQ1))
#define WIN ((bf16*)(args.ws + WS_WIN))
#define WOUT ((bf16*)(args.ws + WS_WOUT))
#define WUP ((bf16*)(args.ws + WS_WUP))
#define WDN ((bf16*)(args.ws + WS_WDN))
#define XN ((bf16*)(args.ws + WS_XN) + DM)
#define PROJ ((bf16*)(args.ws + WS_PROJ))
#define Y ((bf16*)(args.ws + WS_PROJ))
#define OA ((bf16*)(args.ws + WS_OA))
#define OB ((bf16*)args.dout)
#define HB ((bf16*)(args.ws + WS_H))
#define LA ((float*)(args.ws + WS_LA))
#define LBp ((float*)(args.ws + WS_LA) + 3 * (size_t)M * 8)
struct Args { const float* in[17]; float* dout; unsigned char* ws; };
__global__ void __launch_bounds__(NWAVES * 64, 2) fwd_megakernel(Args args) {
    extern __shared__ __attribute__((aligned(16))) unsigned char lds_raw[];
    cg::grid_group grid = cg::this_grid();
    LAS unsigned char* lds = (LAS unsigned char*)lds_raw;
    const int tid = threadIdx.x, lane = tid & 63, wave = __builtin_amdgcn_readfirstlane(tid >> 6);
    const int G = gridDim.x, bx = blockIdx.x;
    if (tid < 2) ((LAS unsigned*)(lds + MISC_OFF))[tid] = 0u;
    const int gw = bx * NWAVES + wave, NGW = G * NWAVES;
    __syncthreads();
    XcdBarrier bar = xcd_barrier_post((unsigned*)(args.ws + WS_BAR), (volatile LAS unsigned*)(lds + MISC_OFF));
    if (args.ws == nullptr) grid.sync();

    {
        LAS float* scr = (LAS float*)(lds + wave * 16384);
        constexpr int I_IN = (DM / 64) * (INW / 32), I_OUT = (DM / 64) * (DM / 32), I_UP = (DM / 64) * (UPW / 32), I_DN = (DFF / 64) * (DM / 32);
        for (int it = gw; it < I_IN + I_OUT + I_UP + I_DN; it += NGW) {
            int r = it;
            if (r < I_IN) { p0_transpose_item<2>(w_in, DM, INW, WIN, norm1, scr, r, lane); continue; } r -= I_IN;
            if (r < I_OUT) { p0_transpose_item<0>(w_out, DM, DM, WOUT, nullptr, scr, r, lane); continue; } r -= I_OUT;
            if (r < I_UP) { p0_transpose_item<1>(w_up, DM, UPW, WUP, norm2, scr, r, lane); continue; } r -= I_UP;
            p0_transpose_item<0>(w_down, DFF, DM, WDN, nullptr, scr, r, lane);
        }
        for (int m = gw * 4; m < M; m += NGW * 4) rows4_to_bf16(m < MP ? xp + (size_t)m * DM : xs + (size_t)(m - MP) * DM, XN + (size_t)m * DM, SSQ1 + m, lane);
        for (int i = bx * 512 + tid; i < M; i += G * 512) SSQ[i] = 0.f;
    }
    xcd_barrier(bar);

    {
        pg8::Gemm g{XN, WIN, M, INW, DM, 256}; pg8::StaticOrder S; S.init(M, INW, G, bx);
        pg8::EpiProj E{PROJ, SSQ1, qna, kna, qnb, knb};
        pg8::gemm_phase<pg8::EpiProj, pg8::StaticOrder, PG8_ALIGN, PG8_SP2>(lds, g, S, E);
    }
    xcd_barrier(bar);

    {
        const float gqa = fabsf(qna[lane]), gka = fabsf(kna[lane]);
        const float boundA = __builtin_bit_cast(float, __builtin_amdgcn_readfirstlane(__builtin_bit_cast(int, 8.0f * wave_max(gqa) * wave_max(gka) * LOG2E)));
        const float negMa = boundA > 40.f ? -boundA : 0.f;
        {
            const int half = wave >> 2, w4 = wave & 3, th = tid & 255;
            LAS unsigned char* Kl = lds + half * 65536; LAS unsigned char* Vl = Kl + 32768;
            LAS float* tabA = (LAS float*)(lds + XCH_OFF);
            const int ubase = (G == 256) ? (bx & 7) * 576 + (bx >> 3) : bx, ustep = (G == 256) ? 32 : G, uend = (G == 256) ? (bx & 7) * 576 + 576 : 4608;
            v4u kr[8], vr[8], qraw[4]; AUnit nx = decode_a(2 * ubase + half);
            if (ubase < uend) { stage_load<256, 256>(kr, vr, PROJ + (size_t)(8 + nx.h) * M * 64, PROJ + (size_t)(16 + nx.h) * M * 64, nx.tok0, nx.dshift, 128 * nx.cc - 64, nx.Ls, th);
                load_q_raw(qraw, PROJ + ((size_t)nx.h * M + (nx.tok0 + ((128 * nx.cc + 32 * w4 + (lane & 31)) << nx.dshift))) * 64, lane); }
            for (int u = ubase; u < uend; u += ustep) {
                const AUnit a = nx;
                LDS_BAR();
                stage_write<256, 256>(kr, vr, Kl, Vl, th);
                build_bias_table<64, 208>(tabA, -__builtin_amdgcn_exp2f(-0.5f * (float)(a.h + 9) + (float)a.dshift) * LOG2E, negMa, tid, 512);
                bf16x8 qf[4];
#pragma unroll
                for (int d0 = 0; d0 < 4; ++d0) qf[d0] = __builtin_bit_cast(bf16x8, qraw[d0]);
                LDS_BAR();
                if (u + ustep < uend) { nx = decode_a(2 * (u + ustep) + half);
                    stage_load<256, 256>(kr, vr, PROJ + (size_t)(8 + nx.h) * M * 64, PROJ + (size_t)(16 + nx.h) * M * 64, nx.tok0, nx.dshift, 128 * nx.cc - 64, nx.Ls, th);
                    load_q_raw(qraw, PROJ + ((size_t)nx.h * M + (nx.tok0 + ((128 * nx.cc + 32 * w4 + (lane & 31)) << nx.dshift))) * 64, lane); }
                const int iq0 = 128 * a.cc + 32 * w4;
                f32x16 o[2]; float l = 0.f;
#pragma unroll
                for (int r = 0; r < 16; ++r) { o[0][r] = 0.f; o[1][r] = 0.f; }
                attn_task<5, 208>(Kl, Vl, 256 * 64, 32 * w4, iq0 - 64, a.Ls, qf, tabA, o, l, lane);
                asm volatile("s_nop 15\n\ts_nop 7" ::: "memory");
                store_partial(o, l, OA + (size_t)a.c * M * 512, LA + (size_t)a.c * M * 8, a.tok0 + (iq0 << a.dshift), a.dshift, a.h, lane);
            }
        }
        const float gqb = fabsf(qnb[lane]), gkb = fabsf(knb[lane]);
        const float boundB = __builtin_bit_cast(float, __builtin_amdgcn_readfirstlane(__builtin_bit_cast(int, 8.0f * wave_max(gqb) * wave_max(gkb) * LOG2E)));
        const float negMb = boundB > 40.f ? -boundB : 0.f;
        {
            LAS unsigned char* Kb = lds; LAS unsigned char* Vb = lds + 40960;
            LAS float* tabB = (LAS float*)(lds + 81920);
            const int ubase = (G == 256) ? (bx & 7) * 192 + (bx >> 3) : bx, ustep = (G == 256) ? 32 : G, uend = (G == 256) ? (bx & 7) * 192 + 192 : 1536;
            v4u kr[5], vr[5], qraw[4]; BUnit nx = decode_b(ubase);
            if (ubase < uend) { stage_load<320, 512>(kr, vr, PROJ + (size_t)(32 + nx.g2) * M * 64, PROJ + (size_t)(34 + nx.g2) * M * 64, nx.seq0, 0, 64 * nx.lcb - 128, nx.S, tid);
                load_q_raw(qraw, PROJ + ((size_t)(24 + 4 * nx.g2 + (wave >> 1)) * M + (nx.seq0 + 64 * nx.lcb + 32 * (wave & 1) + (lane & 31))) * 64, lane); }
            for (int u = ubase; u < uend; u += ustep) {
                const BUnit b = nx;
                LDS_BAR();
                stage_write<320, 512>(kr, vr, Kb, Vb, tid);
                build_bias_table<128, 336>(tabB + (tid >> 7) * (4 * 336), -__builtin_amdgcn_exp2f(-0.5f * (float)(4 * b.g2 + (tid >> 7) + 1)) * LOG2E, negMb, tid & 127, 128);
                bf16x8 qf[4];
#pragma unroll
                for (int d0 = 0; d0 < 4; ++d0) qf[d0] = __builtin_bit_cast(bf16x8, qraw[d0]);
                LDS_BAR();
                if (u + ustep < uend) { nx = decode_b(u + ustep);
                    stage_load<320, 512>(kr, vr, PROJ + (size_t)(32 + nx.g2) * M * 64, PROJ + (size_t)(34 + nx.g2) * M * 64, nx.seq0, 0, 64 * nx.lcb - 128, nx.S, tid);
                    load_q_raw(qraw, PROJ + ((size_t)(24 + 4 * nx.g2 + (wave >> 1)) * M + (nx.seq0 + 64 * nx.lcb + 32 * (wave & 1) + (lane & 31))) * 64, lane); }
                const int hb = 4 * b.g2 + (wave >> 1), iq0 = 64 * b.lcb + 32 * (wave & 1);
                f32x16 o[2]; float l = 0.f;
#pragma unroll
                for (int r = 0; r < 16; ++r) { o[0][r] = 0.f; o[1][r] = 0.f; }
                attn_task<9, 336>(Kb, Vb, 320 * 64, 32 * (wave & 1), iq0 - 128, b.S, qf, tabB + (wave >> 1) * (4 * 336), o, l, lane);
                asm volatile("s_nop 15\n\ts_nop 7" ::: "memory");
                store_partial(o, l, OB, LBp, b.seq0 + iq0, 0, hb, lane);
            }
        }
        xcd_barrier(bar);
        {
            const int hh = lane >> 3;
            const float sinkterm = __builtin_amdgcn_exp2f(sinkb[hh] * LOG2E + negMb);
            const f32x4 ga0 = *(const f32x4*)(ona + 8 * lane), ga1 = *(const f32x4*)(ona + 8 * lane + 4), gb0 = *(const f32x4*)(onb + 8 * lane), gb1 = *(const f32x4*)(onb + 8 * lane + 4);
            for (int m0 = gw * 4; m0 < M; m0 += NGW * 4) {
                v4u wa[4][3], wb[4]; float la[4], lb[4];
#pragma unroll
                for (int k = 0; k < 4; ++k) { const int m = m0 + k; la[k] = 0.f;
#pragma unroll
                    for (int c = 0; c < 3; ++c) { wa[k][c] = *(const v4u*)(OA + (((size_t)c * 8 + hh) * M + m) * 64 + 8 * (lane & 7)); la[k] += LA[((size_t)c * 8 + hh) * M + m]; }
                    wb[k] = *(const v4u*)(OB + ((size_t)hh * M + m) * 64 + 8 * (lane & 7)); lb[k] = LBp[(size_t)hh * M + m] + sinkterm; }
                float ya[4][8], yb[4][8], sa[4], sb[4];
#pragma unroll
                for (int k = 0; k < 4; ++k) { const float ia = 1.0f / la[k], ib = 1.0f / lb[k];
                    ya[k][0] = (bf_lo(wa[k][0].x) + bf_lo(wa[k][1].x) + bf_lo(wa[k][2].x)) * ia; ya[k][1] = (bf_hi(wa[k][0].x) + bf_hi(wa[k][1].x) + bf_hi(wa[k][2].x)) * ia;
                    ya[k][2] = (bf_lo(wa[k][0].y) + bf_lo(wa[k][1].y) + bf_lo(wa[k][2].y)) * ia; ya[k][3] = (bf_hi(wa[k][0].y) + bf_hi(wa[k][1].y) + bf_hi(wa[k][2].y)) * ia;
                    ya[k][4] = (bf_lo(wa[k][0].z) + bf_lo(wa[k][1].z) + bf_lo(wa[k][2].z)) * ia; ya[k][5] = (bf_hi(wa[k][0].z) + bf_hi(wa[k][1].z) + bf_hi(wa[k][2].z)) * ia;
                    ya[k][6] = (bf_lo(wa[k][0].w) + bf_lo(wa[k][1].w) + bf_lo(wa[k][2].w)) * ia; ya[k][7] = (bf_hi(wa[k][0].w) + bf_hi(wa[k][1].w) + bf_hi(wa[k][2].w)) * ia;
                    yb[k][0] = bf_lo(wb[k].x) * ib; yb[k][1] = bf_hi(wb[k].x) * ib; yb[k][2] = bf_lo(wb[k].y) * ib; yb[k][3] = bf_hi(wb[k].y) * ib;
                    yb[k][4] = bf_lo(wb[k].z) * ib; yb[k][5] = bf_hi(wb[k].z) * ib; yb[k][6] = bf_lo(wb[k].w) * ib; yb[k][7] = bf_hi(wb[k].w) * ib;
                    sa[k] = 0.f; sb[k] = 0.f;
#pragma unroll
                    for (int i = 0; i < 8; ++i) { sa[k] += ya[k][i] * ya[k][i]; sb[k] += yb[k][i] * yb[k][i]; } }
#pragma unroll
                for (int o = 1; o < 64; o <<= 1) {
#pragma unroll
                    for (int k = 0; k < 4; ++k) { sa[k] += __shfl_xor(sa[k], o); sb[k] += __shfl_xor(sb[k], o); } }
#pragma unroll
                for (int k = 0; k < 4; ++k) { const int m = m0 + k;
                    const float ra = __builtin_amdgcn_rsqf(sa[k] * (1.f / 512.f) + EPS), rb = __builtin_amdgcn_rsqf(sb[k] * (1.f / 512.f) + EPS);
                    v4u oa, ob;
                    oa.x = cvtpk(ya[k][0] * ra * ga0.x, ya[k][1] * ra * ga0.y); oa.y = cvtpk(ya[k][2] * ra * ga0.z, ya[k][3] * ra * ga0.w); oa.z = cvtpk(ya[k][4] * ra * ga1.x, ya[k][5] * ra * ga1.y); oa.w = cvtpk(ya[k][6] * ra * ga1.z, ya[k][7] * ra * ga1.w);
                    ob.x = cvtpk(yb[k][0] * rb * gb0.x, yb[k][1] * rb * gb0.y); ob.y = cvtpk(yb[k][2] * rb * gb0.z, yb[k][3] * rb * gb0.w); ob.z = cvtpk(yb[k][4] * rb * gb1.x, yb[k][5] * rb * gb1.y); ob.w = cvtpk(yb[k][6] * rb * gb1.z, yb[k][7] * rb * gb1.w);
                    *(v4u*)(Y + (size_t)m * DM + 8 * lane) = oa; *(v4u*)(Y + (size_t)m * DM + 512 + 8 * lane) = ob; }
            }
        }
    }
    xcd_barrier(bar);

    {
        pg8::Gemm g{Y, WOUT, M, DM, DM, 256}; pg8::StaticOrder S; S.init(M, DM, G, bx);
        pg8::EpiOut E{XN, SSQ};
        pg8::gemm_phase<pg8::EpiOut, pg8::StaticOrder, PG8_ALIGN, PG8_SP2>(lds, g, S, E);
    }
    xcd_barrier(bar);

    {
        pg8::Gemm g{XN - DM, WUP, UP_TILES_M * 256, UPW, DM, 254}; pg8::StaticOrder S; S.init(UP_TILES_M * 256, UPW, G, bx);
        pg8::EpiUp E{HB, SSQ, conv_w, conv_b, (LAS float*)(lds + XCH_OFF)};
        pg8::gemm_phase<pg8::EpiUp, pg8::StaticOrder, true, PG8_SP2>(lds, g, S, E);
    }
    xcd_barrier(bar);

    {
        pg8::Gemm g{HB, WDN, M, DM, DFF, 256}; pg8::StaticOrder S; S.init(M, DM, G, bx);
        pg8::EpiDown E{XN, out};
        pg8::gemm_phase<pg8::EpiDown, pg8::StaticOrder, PG8_ALIGN, PG8_SP2>(lds, g, S, E);
    }
}

#undef out
#undef xp
#undef xs
extern "C" void kernel_launch(void* const* d_in, const int* in_sizes, int n_in, void* d_out, int out_size, void* d_ws, size_t ws_size, hipStream_t stream) {
    static int grid = 0;
    if (grid == 0) {
        if (n_in != 17 || out_size != M * DM || ws_size < WS_END) { fprintf(stderr, "kernel_launch: unexpected shapes (n_in %d out %d ws %zu)\n", n_in, out_size, ws_size); grid = -1; return; }
        int dev = 0, cus = 0, per_cu = 0;
        hipGetDevice(&dev); hipDeviceGetAttribute(&cus, hipDeviceAttributeMultiprocessorCount, dev);
        if (hipFuncSetAttribute((const void*)fwd_megakernel, hipFuncAttributeMaxDynamicSharedMemorySize, LDS_BYTES) != hipSuccess) { fprintf(stderr, "kernel_launch: hipFuncSetAttribute failed\n"); grid = -1; return; }
        if (hipOccupancyMaxActiveBlocksPerMultiprocessor(&per_cu, (const void*)fwd_megakernel, NWAVES * 64, LDS_BYTES) != hipSuccess || per_cu < 1) { fprintf(stderr, "kernel_launch: occupancy query says %d\n", per_cu); per_cu = 1; }
        (void)hipGetLastError();
        grid = cus;
        fprintf(stderr, "kernel_launch: grid %d (per_cu %d)\n", grid, per_cu);
    }
    if (grid < 0) return;
    Args a{};
    for (int i = 0; i < 17; ++i) a.in[i] = (const float*)d_in[i];
    a.dout = (float*)d_out; a.ws = (unsigned char*)d_ws;
    void* kargs[] = {&a};
    if (hipMemsetAsync((char*)d_ws + WS_BAR, 0, XCD_BAR_WORDS * 4, stream) != hipSuccess) { fprintf(stderr, "kernel_launch: hipMemsetAsync failed\n"); return; }
    hipError_t e = hipLaunchCooperativeKernel((const void*)fwd_megakernel, dim3(grid), dim3(NWAVES * 64), kargs, LDS_BYTES, stream);
    if (e != hipSuccess) fprintf(stderr, "kernel_launch: cooperative launch failed: %s\n", hipGetErrorString(e));
}
```

```cpp
#include <hip/hip_runtime.h>
#include <hip/hip_cooperative_groups.h>
#include <cstdio>
#include <cstdint>
namespace cg = cooperative_groups;
namespace pg8 {
#define PG8_LAS __attribute__((address_space(3)))
typedef unsigned short bf16_t;
typedef short bf16x8 __attribute__((ext_vector_type(8)));
typedef float f32x4 __attribute__((ext_vector_type(4)));
typedef unsigned u32x4 __attribute__((ext_vector_type(4)));
constexpr int BM = 256, BK = 64, HALF = 128, HTB = HALF * BK * 2  , STAGE_BYTES = 8 * HTB, NXCD = 8, WGM = 8;

__host__ __device__ __forceinline__ int lds_byte(int r, int c) { const int st = (r >> 4) * 2 + (c >> 5), rr = r & 15, cc = c & 31, ob = rr * 64 + cc * 2; return st * 1024 + (ob ^ (((ob >> 9) & 1) << 5)); }
__host__ __device__ __forceinline__ void stage_rc(int b, int& R, int& C) { const int st = b / 1024, sb = b % 1024, swz = sb ^ (((sb >> 9) & 1) << 5); R = (st >> 1) * 16 + swz / 64; C = (st & 1) * 32 + (swz % 64) / 2; }
__host__ __device__ __forceinline__ int perm32(int rho) { const int n = rho >> 4, i = rho & 15; return 8 * (i >> 2) + 4 * n + (i & 3); }

struct Unit { int pm, pn; };
struct Gemm { const bf16_t* A; const bf16_t* Bt; int M, N, K; int a_tile_rows; };

struct StaticOrder {
    int nM, nN, nwg, G, c;
    __host__ __device__ void init(int M, int N, int G_, int c_) { nM = M / BM; nN = N / BM; nwg = nM * nN; G = G_; c = c_; }
    __host__ __device__ bool next(int i, Unit& u) const {
        const long L = (long)i * G + c; if (L >= nwg) return false;
        int wgid = (int)L; { const int q = nwg / NXCD, r = nwg % NXCD, xcd = wgid % NXCD, off = wgid / NXCD; wgid = (xcd < r ? xcd * (q + 1) : r * (q + 1) + (xcd - r) * q) + off; }
        const int nig = WGM * nN, gid = wgid / nig, fm = gid * WGM, gsz = (nM - fm) < WGM ? (nM - fm) : WGM;
        u.pm = fm + ((wgid % nig) % gsz); u.pn = (wgid % nig) / gsz; return true;
    }
    __device__ __forceinline__ void a_ready(const Unit&) const {}
    __device__ __forceinline__ void done(const Unit&) const {}
};

__device__ __forceinline__ unsigned cvt_pk_bf16(float lo, float hi) { unsigned r; asm volatile("v_cvt_pk_bf16_f32 %0, %1, %2" : "=v"(r) : "v"(lo), "v"(hi)); return r; }
typedef float f32x2 __attribute__((ext_vector_type(2))); typedef __bf16 bf16x2_t __attribute__((ext_vector_type(2)));
__device__ __forceinline__ unsigned cvtpk(float lo, float hi) { f32x2 v = {lo, hi}; bf16x2_t b = __builtin_convertvector(v, bf16x2_t); return __builtin_bit_cast(unsigned, b); }
constexpr int MTOK = 49152, MPROMPT = 16384, DMODEL = 1024, DFF_ = 2816;
__device__ __forceinline__ u32x4 pack8(const f32x4 a, const f32x4 b) { u32x4 w; w.x = cvtpk(a[0], a[1]); w.y = cvtpk(a[2], a[3]); w.z = cvtpk(b[0], b[1]); w.w = cvtpk(b[2], b[3]); return w; }

struct EpiProj {
    static constexpr bool PERM = true, AFTER_DRAIN = false;
    bf16_t* O; const float* ssq1; const float* gqa; const float* gka; const float* gqb; const float* gkb;
    __device__ __forceinline__ void operator()(f32x4 (&acc)[2][2][4][2], const Unit& u, int wr, int wc, int fr, int fq, int wid, int lane) const {
        const int hs = 4 * u.pn + wc;
        const float* g = nullptr; float sc = 1.f;
        if (hs < 8) { g = gqa; sc = 0.125f * 1.4426950408889634f; } else if (hs < 16) g = gka; else if (hs >= 24 && hs < 32) { g = gqb; sc = 0.125f * 1.4426950408889634f; } else if (hs >= 32 && hs < 34) g = gkb;
        const int row0 = u.pm * BM + wr * 64 + fr;
        bf16_t* obase = O + ((size_t)hs * MTOK + row0) * 64 + 8 * fq;
#pragma unroll
        for (int ai = 0; ai < 2; ++ai)
#pragma unroll
            for (int m = 0; m < 4; ++m) { const float r1 = __builtin_amdgcn_rsqf(ssq1[row0 + ai * HALF + m * 16] * (1.0f / DMODEL) + 1e-6f);
#pragma unroll
                for (int bj = 0; bj < 2; ++bj)
#pragma unroll
                    for (int n = 0; n < 2; ++n) acc[ai][bj][m][n] *= r1; }
        if (g) {
            f32x4 gg[2][2];
#pragma unroll
            for (int bj = 0; bj < 2; ++bj)
#pragma unroll
                for (int n = 0; n < 2; ++n) gg[bj][n] = *(const f32x4*)(g + 32 * bj + 8 * fq + 4 * n) * sc;
#pragma unroll
            for (int ai = 0; ai < 2; ++ai)
#pragma unroll
                for (int m = 0; m < 4; ++m) { float ss = 0.f;
#pragma unroll
                    for (int bj = 0; bj < 2; ++bj)
#pragma unroll
                        for (int n = 0; n < 2; ++n) { const f32x4 a = acc[ai][bj][m][n]; ss += (a[0] * a[0] + a[1] * a[1]) + (a[2] * a[2] + a[3] * a[3]); }
                    ss += __shfl_xor(ss, 16); ss += __shfl_xor(ss, 32);
                    const float rs = __builtin_amdgcn_rsqf(ss * (1.0f / 64.0f) + 1e-6f);
                    bf16_t* rowp = obase + (size_t)(ai * HALF + m * 16) * 64;
#pragma unroll
                    for (int bj = 0; bj < 2; ++bj) *(u32x4*)(rowp + 32 * bj) = pack8(acc[ai][bj][m][0] * rs * gg[bj][0], acc[ai][bj][m][1] * rs * gg[bj][1]); }
        } else {
#pragma unroll
            for (int ai = 0; ai < 2; ++ai)
#pragma unroll
                for (int m = 0; m < 4; ++m) { bf16_t* rowp = obase + (size_t)(ai * HALF + m * 16) * 64;
#pragma unroll
                    for (int bj = 0; bj < 2; ++bj) *(u32x4*)(rowp + 32 * bj) = pack8(acc[ai][bj][m][0], acc[ai][bj][m][1]); }
        }
    }
};
struct EpiOut {
    static constexpr bool PERM = true, AFTER_DRAIN = false;
    bf16_t* xb; float* ssq;
    __device__ __forceinline__ void operator()(f32x4 (&acc)[2][2][4][2], const Unit& u, int wr, int wc, int fr, int fq, int wid, int lane) const {
        const int col0 = u.pn * BM + wc * 32 + 8 * fq; const int gr0 = u.pm * BM + wr * 64 + fr;
        u32x4 w[2][4][2];
#pragma unroll
        for (int ai = 0; ai < 2; ++ai)
#pragma unroll
            for (int m = 0; m < 4; ++m)
#pragma unroll
                for (int bj = 0; bj < 2; ++bj) w[ai][m][bj] = *(const u32x4*)(xb + (size_t)(gr0 + ai * HALF + m * 16) * DMODEL + col0 + bj * HALF);
#pragma unroll
        for (int ai = 0; ai < 2; ++ai)
#pragma unroll
            for (int m = 0; m < 4; ++m) { const int gr = gr0 + ai * HALF + m * 16;
                float s = 0.f;
#pragma unroll
                for (int bj = 0; bj < 2; ++bj) { const u32x4 v = w[ai][m][bj];
                    f32x4 a = {__uint_as_float(v.x << 16), __uint_as_float(v.x & 0xffff0000u), __uint_as_float(v.y << 16), __uint_as_float(v.y & 0xffff0000u)};
                    f32x4 b = {__uint_as_float(v.z << 16), __uint_as_float(v.z & 0xffff0000u), __uint_as_float(v.w << 16), __uint_as_float(v.w & 0xffff0000u)};
                    a += acc[ai][bj][m][0]; b += acc[ai][bj][m][1];
                    s += (a[0] * a[0] + a[1] * a[1]) + (a[2] * a[2] + a[3] * a[3]) + (b[0] * b[0] + b[1] * b[1]) + (b[2] * b[2] + b[3] * b[3]);
                    *(u32x4*)(xb + (size_t)gr * DMODEL + col0 + bj * HALF) = pack8(a, b); }
                s += __shfl_xor(s, 16); s += __shfl_xor(s, 32);
                if (fq == 0) unsafeAtomicAdd(ssq + gr, s); }
    }
};
struct EpiDown {
    static constexpr bool PERM = true, AFTER_DRAIN = false;
    const bf16_t* xb; float* out;
    __device__ __forceinline__ void operator()(f32x4 (&acc)[2][2][4][2], const Unit& u, int wr, int wc, int fr, int fq, int wid, int lane) const {
        const int col0 = u.pn * BM + wc * 32 + 8 * fq; const int gr0 = u.pm * BM + wr * 64 + fr;
        u32x4 w[2][4][2];
#pragma unroll
        for (int ai = 0; ai < 2; ++ai)
#pragma unroll
            for (int m = 0; m < 4; ++m)
#pragma unroll
                for (int bj = 0; bj < 2; ++bj) w[ai][m][bj] = *(const u32x4*)(xb + (size_t)(gr0 + ai * HALF + m * 16) * DMODEL + col0 + bj * HALF);
#pragma unroll
        for (int ai = 0; ai < 2; ++ai)
#pragma unroll
            for (int m = 0; m < 4; ++m) { float* o = out + (size_t)(gr0 + ai * HALF + m * 16) * DMODEL + col0;
#pragma unroll
                for (int bj = 0; bj < 2; ++bj) { const u32x4 v = w[ai][m][bj];
                    f32x4 a = {__uint_as_float(v.x << 16), __uint_as_float(v.x & 0xffff0000u), __uint_as_float(v.y << 16), __uint_as_float(v.y & 0xffff0000u)};
                    f32x4 b = {__uint_as_float(v.z << 16), __uint_as_float(v.z & 0xffff0000u), __uint_as_float(v.w << 16), __uint_as_float(v.w & 0xffff0000u)};
                    a += acc[ai][bj][m][0]; b += acc[ai][bj][m][1]; *(f32x4*)(o + bj * HALF) = a; *(f32x4*)(o + bj * HALF + 4) = b; } }
    }
};
__device__ __forceinline__ bool seq_first(int gr) { return gr == 0 || (gr >= MPROMPT && (gr & 2047) == 0); }
__device__ __forceinline__ bool seq_last(int gr) { return gr >= MPROMPT - 1 && (gr & 2047) == 2047; }
struct EpiUp {
    static constexpr bool PERM = true, AFTER_DRAIN = false;
    bf16_t* H; const float* ssq; const float* cw; const float* cb; PG8_LAS float* xch;
    __device__ __forceinline__ void operator()(f32x4 (&acc)[2][2][4][2], const Unit& u, int wr, int wc, int fr, int fq, int wid, int lane) const {
        const int lr0 = wr * 64 + fr, gr0 = 254 * u.pm - 1 + lr0;
#pragma unroll
        for (int ai = 0; ai < 2; ++ai)
#pragma unroll
            for (int m = 0; m < 4; ++m) { int gr = gr0 + ai * HALF + m * 16; gr = gr < 0 ? 0 : (gr > MTOK - 1 ? MTOK - 1 : gr);
                const float rs = __builtin_amdgcn_rsqf(ssq[gr] * (1.0f / DMODEL) + 1e-6f);
#pragma unroll
                for (int bj = 0; bj < 2; ++bj)
#pragma unroll
                    for (int n = 0; n < 2; ++n) acc[ai][bj][m][n] *= rs; }
#pragma unroll
        for (int ai = 0; ai < 2; ++ai) {
            if (fr == 0) { PG8_LAS float* p = xch + ((wid * 2 + ai) * 2 + 0) * 64 + 8 * fq;
#pragma unroll
                for (int bj = 0; bj < 2; ++bj)
#pragma unroll
                    for (int n = 0; n < 2; ++n) *(PG8_LAS f32x4*)(p + bj * 32 + 4 * n) = acc[ai][bj][0][n]; }
            if (fr == 15) { PG8_LAS float* p = xch + ((wid * 2 + ai) * 2 + 1) * 64 + 8 * fq;
#pragma unroll
                for (int bj = 0; bj < 2; ++bj)
#pragma unroll
                    for (int n = 0; n < 2; ++n) *(PG8_LAS f32x4*)(p + bj * 32 + 4 * n) = acc[ai][bj][3][n]; }
        }
        asm volatile("s_waitcnt lgkmcnt(0)" ::: "memory"); __builtin_amdgcn_s_barrier(); asm volatile("" ::: "memory");
        const int tlo = 254 * u.pm - 1, thi = tlo + 255; const bool anyb = (tlo <= 0) || (((thi + 1) >> 11) != ((tlo - 1) >> 11));
        unsigned hold0 = 0u, hold1 = 0u;
        const int ow = (1 - wr) * 4 + wc;
        const int chb = 128 * u.pn + 32 * wc + 16 * (fq >> 1);
#pragma unroll
        for (int n = 0; n < 2; ++n) {
            f32x4 w0[2], w1[2], w2[2], bb[2];
#pragma unroll
            for (int bj = 0; bj < 2; ++bj) { const int ch = chb + 8 * n + 4 * (fq & 1) + bj * DFF_;
                w0[bj] = *(const f32x4*)(cw + ch); w1[bj] = *(const f32x4*)(cw + 2 * DFF_ + ch); w2[bj] = *(const f32x4*)(cw + 4 * DFF_ + ch); bb[bj] = *(const f32x4*)(cb + ch); }
#pragma unroll
            for (int ai = 0; ai < 2; ++ai) {
                const int aiT = wr == 1 ? ai : ai - 1, aiB = wr == 0 ? ai : ai + 1;
#pragma unroll
                for (int m = 0; m < 4; ++m) {
                    const int lr = lr0 + ai * HALF + m * 16, gr = gr0 + ai * HALF + m * 16;
                    const bool first = seq_first(gr), last = seq_last(gr);
                    f32x4 c[2];
#pragma unroll
                    for (int bj = 0; bj < 2; ++bj) {
                        const f32x4 cur = acc[ai][bj][m][n];
                        f32x4 pv, nx;
#pragma unroll
                        for (int e = 0; e < 4; ++e) {
                            const float sP = (m > 0 && fr == 15) ? acc[ai][bj][m > 0 ? m - 1 : 0][n][e] : cur[e];
                            const float sN = (m < 3 && fr == 0) ? acc[ai][bj][m < 3 ? m + 1 : 3][n][e] : cur[e];
                            pv[e] = __builtin_bit_cast(float, __builtin_amdgcn_mov_dpp(__builtin_bit_cast(int, sP), 0x121  , 0xf, 0xf, true));
                            nx[e] = __builtin_bit_cast(float, __builtin_amdgcn_mov_dpp(__builtin_bit_cast(int, sN), 0x12f  , 0xf, 0xf, true)); }
                        if (m == 0) { const f32x4 top = (aiT >= 0) ? *(const PG8_LAS f32x4*)(xch + ((ow * 2 + (aiT < 0 ? 0 : aiT)) * 2 + 1) * 64 + 8 * fq + bj * 32 + 4 * n) : (f32x4){0.f, 0.f, 0.f, 0.f}; if (fr == 0) pv = top; }
                        if (m == 3) { const f32x4 bot = (aiB <= 1) ? *(const PG8_LAS f32x4*)(xch + ((ow * 2 + (aiB > 1 ? 1 : aiB)) * 2 + 0) * 64 + 8 * fq + bj * 32 + 4 * n) : (f32x4){0.f, 0.f, 0.f, 0.f}; if (fr == 15) nx = bot; }
                        if (anyb) { if (first) pv = (f32x4){0.f, 0.f, 0.f, 0.f}; if (last) nx = (f32x4){0.f, 0.f, 0.f, 0.f}; }
                        c[bj] = bb[bj] + w0[bj] * pv + w1[bj] * cur + w2[bj] * nx;
                    }
                    f32x4 hv;
#pragma unroll
                    for (int e = 0; e < 4; ++e) { const float g = c[0][e]; hv[e] = g * __builtin_amdgcn_rcpf(1.0f + __builtin_amdgcn_exp2f(-1.4426950408889634f * g)) * c[1][e]; }
                    const unsigned pkx = cvtpk(hv[0], hv[1]), pky = cvtpk(hv[2], hv[3]);
                    if ((m & 1) == 0) { hold0 = pkx; hold1 = pky; }
                    else { const auto r0 = __builtin_amdgcn_permlane16_swap(hold0, pkx, false, false), r1 = __builtin_amdgcn_permlane16_swap(hold1, pky, false, false);
                        u32x4 w; w.x = r0[0]; w.y = r1[0]; w.z = r0[1]; w.w = r1[1];
                        const int ms = (fq & 1) ? m : m - 1, lrS = lr0 + ai * HALF + ms * 16, grS = gr0 + ai * HALF + ms * 16;
                        if (lrS >= 1 && lrS <= 254 && grS < MTOK) *(u32x4*)(H + (size_t)grS * DFF_ + chb + 8 * n) = w; }
                    asm volatile("" ::: "memory");
                }
            }
        }
    }
};
template <class Epi, class Sched, bool ALIGN_EPI = false, bool SP2 = false>
__device__ __forceinline__ void gemm_phase(PG8_LAS unsigned char* lds, const Gemm g, const Sched& S, const Epi& E) {
    int tid_ = threadIdx.x; asm volatile("" : "+v"(tid_));
    const int tid = tid_, wid = __builtin_amdgcn_readfirstlane(tid >> 6), lane = tid & 63, wr = wid >> 2, wc = wid & 3, fr = lane & 15, fq = lane >> 4;
    const int K = g.K, nt = K / BK;
    unsigned voffA[2], voffB[2];
#pragma unroll
    for (int i = 0; i < 2; ++i) { int R, C; stage_rc(tid * 16 + i * 8192, R, C); const int Rb = Epi::PERM ? ((R & ~31) + perm32(R & 31)) : R;
        voffA[i] = (unsigned)(R * K + C) * 2u; voffB[i] = (unsigned)(Rb * K + C) * 2u; }
    const size_t kstep = (size_t)(BK * 2);
    const size_t hstep = (size_t)HALF * K * 2;
    const size_t tstep = 2 * hstep; const size_t tstepA = (size_t)g.a_tile_rows * K * 2;
    const unsigned ldsw = (unsigned)wid * 1024u;
    const int aoff = lds_byte(wr * 64 + fr, fq * 8), boff = lds_byte(wc * 32 + fr, fq * 8);
#define PG8_SA(b, h) (((b) * 2 + (h)) * HTB)
#define PG8_SB(b, h) ((4 + (b) * 2 + (h)) * HTB)
#define PG8_STAGE(bufoff, gbase, voff) do { _Pragma("unroll") for (int _i = 0; _i < 2; ++_i) \
        __builtin_amdgcn_global_load_lds((const unsigned*)((const char*)(gbase) + (voff)[_i]), (PG8_LAS unsigned*)(lds + (bufoff) + ldsw + _i * 8192), 16, 0, 0); } while (0)
#define PG8_LDA(dst, b, h) do { _Pragma("unroll") for (int m = 0; m < 4; ++m) _Pragma("unroll") for (int k = 0; k < 2; ++k) dst[m][k] = *(const PG8_LAS bf16x8*)(lds + PG8_SA(b, h) + aoff + m * 2048 + k * 1024); } while (0)
#define PG8_LDB(dst, b, h) do { _Pragma("unroll") for (int n = 0; n < 2; ++n) _Pragma("unroll") for (int k = 0; k < 2; ++k) dst[n][k] = *(const PG8_LAS bf16x8*)(lds + PG8_SB(b, h) + boff + n * 2048 + k * 1024); } while (0)
#define PG8_MMA(ai, bj, At, Bt) do { __builtin_amdgcn_s_setprio(1); _Pragma("unroll") for (int m = 0; m < 4; ++m) _Pragma("unroll") for (int n = 0; n < 2; ++n) _Pragma("unroll") for (int k = 0; k < 2; ++k) \
        acc[ai][bj][m][n] = __builtin_amdgcn_mfma_f32_16x16x32_bf16(Bt[n][k], At[m][k], acc[ai][bj][m][n], 0, 0, 0); __builtin_amdgcn_s_setprio(0); } while (0)
#define PG8_WAIT_V(n) asm volatile("s_waitcnt vmcnt(" #n ")" ::: "memory")
#define PG8_WAIT_L(n) asm volatile("s_waitcnt lgkmcnt(" #n ")" ::: "memory")
#define PG8_BAR __builtin_amdgcn_s_barrier()
#define PG8_SCHED __builtin_amdgcn_sched_barrier(0)
    Unit cur, nxt; int ui = 0;
    if (!S.next(0, cur)) return;
    f32x4 acc[2][2][4][2];
#pragma unroll
    for (int a = 0; a < 2; ++a)
#pragma unroll
        for (int b = 0; b < 2; ++b)
#pragma unroll
            for (int m = 0; m < 4; ++m)
#pragma unroll
                for (int n = 0; n < 2; ++n) acc[a][b][m][n] = (f32x4){0.f, 0.f, 0.f, 0.f};
    bf16x8 At[4][2], B0[2][2], B1[2][2];
    const char* cA = (const char*)g.A + (size_t)cur.pm * tstepA; const char* cB = (const char*)g.Bt + (size_t)cur.pn * tstep;
    S.a_ready(cur);
    if constexpr (SP2) {
        PG8_STAGE(PG8_SB(0, 0), cB, voffB); PG8_STAGE(PG8_SB(0, 1), cB + hstep, voffB); PG8_STAGE(PG8_SA(0, 0), cA, voffA); PG8_STAGE(PG8_SA(0, 1), cA + hstep, voffA);
        if (wr == 1) PG8_BAR;
        PG8_WAIT_V(2); PG8_BAR;
        PG8_STAGE(PG8_SB(1, 0), cB + kstep, voffB); PG8_STAGE(PG8_SA(1, 0), cA + kstep, voffA); PG8_STAGE(PG8_SB(1, 1), cB + hstep + kstep, voffB);
        PG8_WAIT_V(6); PG8_BAR;
    } else {
        PG8_STAGE(PG8_SB(0, 0), cB, voffB); PG8_STAGE(PG8_SA(0, 0), cA, voffA); PG8_STAGE(PG8_SB(0, 1), cB + hstep, voffB); PG8_STAGE(PG8_SA(0, 1), cA + hstep, voffA);
        if (wr == 1) PG8_BAR;
        PG8_WAIT_V(4); PG8_BAR;
        PG8_STAGE(PG8_SB(1, 0), cB + kstep, voffB); PG8_STAGE(PG8_SA(1, 0), cA + kstep, voffA); PG8_STAGE(PG8_SB(1, 1), cB + hstep + kstep, voffB);
        PG8_WAIT_V(6); PG8_BAR;
    }
    for (;;) {
        const bool has_next = S.next(ui + 1, nxt);
        const char* nA = has_next ? (const char*)g.A + (size_t)nxt.pm * tstepA : cA; const char* nB = has_next ? (const char*)g.Bt + (size_t)nxt.pn * tstep : cB;
        for (int t = 0; t < nt; t += 2) {
            const bool last = (t == nt - 2);
            const char* a1 = cA + (size_t)(t + 1) * kstep;
            const char* a2 = last ? nA : cA + (size_t)(t + 2) * kstep; const char* b2 = last ? nB : cB + (size_t)(t + 2) * kstep;
            const char* a3 = a2 + kstep; const char* b3 = b2 + kstep;
            if (last && has_next) S.a_ready(nxt);
            if constexpr (SP2) {
            PG8_LDB(B0, 0, 0); PG8_LDB(B1, 0, 1); PG8_SCHED; PG8_LDA(At, 0, 0); PG8_STAGE(PG8_SA(1, 1), a1 + hstep, voffA);
            PG8_WAIT_V(8); PG8_WAIT_L(0); PG8_BAR; PG8_MMA(0, 0, At, B0); PG8_MMA(0, 1, At, B1); PG8_BAR; PG8_SCHED;
            PG8_LDA(At, 0, 1); PG8_STAGE(PG8_SB(0, 0), b2, voffB); PG8_STAGE(PG8_SB(0, 1), b2 + hstep, voffB); PG8_STAGE(PG8_SA(0, 0), a2, voffA);
            PG8_WAIT_V(8); PG8_WAIT_L(0); PG8_BAR; PG8_MMA(1, 0, At, B0); PG8_MMA(1, 1, At, B1); PG8_BAR; PG8_SCHED;
            PG8_LDB(B0, 1, 0); PG8_LDB(B1, 1, 1); PG8_SCHED; PG8_LDA(At, 1, 0); PG8_STAGE(PG8_SA(0, 1), a2 + hstep, voffA);
            PG8_WAIT_V(8); PG8_WAIT_L(0); PG8_BAR; PG8_MMA(0, 0, At, B0); PG8_MMA(0, 1, At, B1); PG8_BAR; PG8_SCHED;
            PG8_LDA(At, 1, 1); PG8_STAGE(PG8_SB(1, 0), b3, voffB); PG8_STAGE(PG8_SB(1, 1), b3 + hstep, voffB); PG8_STAGE(PG8_SA(1, 0), a3, voffA);
            PG8_WAIT_V(8); PG8_WAIT_L(0); PG8_BAR; PG8_MMA(1, 0, At, B0); PG8_MMA(1, 1, At, B1); PG8_BAR; PG8_SCHED;
            } else {
            PG8_LDB(B0, 0, 0); PG8_SCHED; PG8_LDA(At, 0, 0); PG8_STAGE(PG8_SA(1, 1), a1 + hstep, voffA);
            PG8_WAIT_L(8); PG8_BAR; PG8_WAIT_L(0); PG8_MMA(0, 0, At, B0); PG8_BAR; PG8_SCHED;
            PG8_LDB(B1, 0, 1); PG8_STAGE(PG8_SB(0, 0), b2, voffB);
            PG8_BAR; PG8_WAIT_L(0); PG8_MMA(0, 1, At, B1); PG8_BAR;
            PG8_LDA(At, 0, 1); PG8_STAGE(PG8_SA(0, 0), a2, voffA);
            PG8_BAR; PG8_WAIT_L(0); PG8_MMA(1, 0, At, B0); PG8_BAR; PG8_SCHED;
            PG8_STAGE(PG8_SB(0, 1), b2 + hstep, voffB);
            PG8_WAIT_V(6); PG8_BAR; PG8_MMA(1, 1, At, B1); PG8_BAR;
            PG8_LDB(B0, 1, 0); PG8_SCHED; PG8_LDA(At, 1, 0); PG8_STAGE(PG8_SA(0, 1), a2 + hstep, voffA);
            PG8_WAIT_L(8); PG8_BAR; PG8_WAIT_L(0); PG8_MMA(0, 0, At, B0); PG8_BAR; PG8_SCHED;
            PG8_LDB(B1, 1, 1); PG8_STAGE(PG8_SB(1, 0), b3, voffB);
            PG8_BAR; PG8_WAIT_L(0); PG8_MMA(0, 1, At, B1); PG8_BAR;
            PG8_LDA(At, 1, 1); PG8_STAGE(PG8_SA(1, 0), a3, voffA);
            PG8_BAR; PG8_WAIT_L(0); PG8_MMA(1, 0, At, B0); PG8_BAR; PG8_SCHED;
            PG8_STAGE(PG8_SB(1, 1), b3 + hstep, voffB);
            PG8_WAIT_V(6); PG8_BAR; PG8_MMA(1, 1, At, B1); PG8_BAR;
            }
        }
        if constexpr (ALIGN_EPI) { if (wr == 0) PG8_BAR; }
        if constexpr (!Epi::AFTER_DRAIN) { E(acc, cur, wr, wc, fr, fq, wid, lane); S.done(cur); }
        if (!has_next) break;
#pragma unroll
        for (int a = 0; a < 2; ++a)
#pragma unroll
            for (int b = 0; b < 2; ++b)
#pragma unroll
                for (int m = 0; m < 4; ++m)
#pragma unroll
                    for (int n = 0; n < 2; ++n) acc[a][b][m][n] = (f32x4){0.f, 0.f, 0.f, 0.f};
        cur = nxt; cA = nA; cB = nB; ++ui;
        if constexpr (ALIGN_EPI) { if (wr == 1) PG8_BAR; }
    }
    PG8_WAIT_V(0);
    if constexpr (!ALIGN_EPI) { if (wr == 0) PG8_BAR; }
    PG8_BAR;
    if constexpr (Epi::AFTER_DRAIN) { E.fused(acc, cur, wr, wc, fr, fq, lds, wid, lane); S.done(cur); }
#undef PG8_SA
#undef PG8_SB
#undef PG8_STAGE
#undef PG8_LDA
#undef PG8_LDB
#undef PG8_MMA
#undef PG8_WAIT_V
#undef PG8_WAIT_L
#undef PG8_BAR
#undef PG8_SCHED
}
}
#ifndef PG8_SP2
#define PG8_SP2 true
#endif
#ifndef PG8_ALIGN
#define PG8_ALIGN true
#endif

constexpr int NWAVES = 8;
constexpr int DM = 1024, M = 49152, MP = 16384, INW = 2304, DFF = 2816, UPW = 5632;
constexpr int QA_OFF = 0, KA_OFF = 512, VA_OFF = 1024, QB_OFF = 1536, KB_OFF = 2048, VB_OFF = 2176;
constexpr int UP_TILES_M = 194;
constexpr float EPS = 1e-6f, LOG2E = 1.4426950408889634f;

constexpr size_t MiB = 1u << 20;
constexpr size_t WS_SSQ = 0;
constexpr size_t WS_SSQ1 = 512 * 1024;
constexpr size_t WS_BAR = 1 * MiB;
constexpr size_t WS_WIN = 2 * MiB, WS_WOUT = 7 * MiB, WS_WUP = 9 * MiB, WS_WDN = 20 * MiB;
constexpr size_t WS_XN = 32 * MiB;
constexpr size_t WS_PROJ = 130 * MiB;
constexpr size_t WS_OA = 346 * MiB;
constexpr size_t WS_H = 226 * MiB;
constexpr size_t WS_LA = 490 * MiB;
constexpr size_t WS_END = 496 * MiB;
static_assert(WS_XN + (size_t)(M + 256) * DM * 2 <= WS_PROJ && WS_PROJ + (size_t)M * INW * 2 <= WS_OA && WS_OA + 3 * (size_t)M * 512 * 2 <= WS_LA && WS_H + (size_t)M * DFF * 2 <= WS_LA && WS_PROJ + (size_t)M * DM * 2 <= WS_H, "d_ws map");

constexpr int RING_BYTES = 131072, XCH_OFF = RING_BYTES, MISC_OFF = XCH_OFF + 8192, LDS_BYTES = 147456;

#define LAS __attribute__((address_space(3)))
typedef unsigned short bf16;
typedef unsigned v4u __attribute__((ext_vector_type(4)));
typedef float f32x4 __attribute__((ext_vector_type(4)));
typedef float f32x16 __attribute__((ext_vector_type(16)));
typedef short bf16x8 __attribute__((ext_vector_type(8)));
typedef short s16x4 __attribute__((ext_vector_type(4)));
using pg8::cvtpk;
__device__ __forceinline__ float bf_lo(unsigned w) { return __uint_as_float(w << 16); }
__device__ __forceinline__ float bf_hi(unsigned w) { return __uint_as_float(w & 0xffff0000u); }
__device__ __forceinline__ float wave_sum(float v) {
#pragma unroll
    for (int o = 1; o < 64; o <<= 1) v += __shfl_xor(v, o);
    return v;
}
__device__ __forceinline__ float wave_max(float v) {
#pragma unroll
    for (int o = 1; o < 64; o <<= 1) v = fmaxf(v, __shfl_xor(v, o));
    return v;
}

#define GAS __attribute__((address_space(1)))
#define RLX_AGENT __ATOMIC_RELAXED, __HIP_MEMORY_SCOPE_AGENT
#define XB_TMO      128
#define XB_XCNT(j)  (256  + 64 * (j))
#define XB_XSUB(j)  (1280 + 64 * (j))
#define XB_XGEN(j)  (2304 + 64 * (j))
#define XB_TOP      3328
#define XB_TOPGEN   3392
#define XCD_BAR_WORDS 3456
#define XB_SPIN_CAP (1u << 18)

__device__ __forceinline__ unsigned xb_ld(unsigned* p)              { return __hip_atomic_load(p, __ATOMIC_RELAXED, __HIP_MEMORY_SCOPE_AGENT); }
__device__ __forceinline__ unsigned xb_add(unsigned* p, unsigned v) { return __hip_atomic_fetch_add(p, v, __ATOMIC_RELAXED, __HIP_MEMORY_SCOPE_AGENT); }
__device__ __forceinline__ unsigned xb_xcc_id() { return (unsigned)__builtin_amdgcn_s_getreg((3 << 11) | 20) & 0xFu; }
#define XB_SPIN(cond, bar) do { unsigned _sp = 0; while (cond) { __builtin_amdgcn_s_sleep(1); \
    if ((++_sp & 255u) == 0u) { if (xb_ld(&(bar)[XB_TMO])) break; if (_sp > XB_SPIN_CAP) { atomicAdd(&(bar)[XB_TMO], 1u); break; } } } } while (0)

struct XcdBarrier {
    unsigned* bar; unsigned x;
    volatile LAS unsigned* st;
};

__device__ __forceinline__ XcdBarrier xcd_barrier_post(unsigned* bar, volatile LAS unsigned* st) {
    XcdBarrier b; b.bar = bar; b.x = xb_xcc_id(); b.st = st;
    if (threadIdx.x == 0) (void)xb_add(&bar[XB_XCNT(b.x)], 1u);
    return b;
}
__device__ __forceinline__ void xcd_barrier_complete(unsigned* bar, unsigned x, unsigned& nloc, unsigned& nx) {
    const unsigned G = gridDim.x * gridDim.y * gridDim.z;
    unsigned sum, cnt, mine, sp = 0u;
    for (;;) {
        sum = 0u; cnt = 0u; mine = 0u;
#pragma unroll
        for (unsigned j = 0; j < 16; ++j) { const unsigned c = xb_ld(&bar[XB_XCNT(j)]); sum += c; cnt += (c > 0u) ? 1u : 0u; mine = (j == x) ? c : mine; }
        if (sum == G) break;
        __builtin_amdgcn_s_sleep(1);
        if ((++sp & 255u) == 0u) { if (xb_ld(&bar[XB_TMO])) break; if (sp > XB_SPIN_CAP) { atomicAdd(&bar[XB_TMO], 1u); break; } }
    }
    nloc = mine > 0u ? mine : 1u; nx = cnt > 0u ? cnt : 1u;
}

__device__ __forceinline__ void xcd_barrier(const XcdBarrier& b) {
    asm volatile("s_waitcnt vmcnt(0)" ::: "memory");
    __syncthreads();
    if (threadIdx.x == 0) {
        unsigned* bar = b.bar;
        __builtin_amdgcn_s_waitcnt(0);
        unsigned nloc = b.st[0], nx = b.st[1];
        if (nloc == 0u) { xcd_barrier_complete(bar, b.x, nloc, nx); b.st[0] = nloc; b.st[1] = nx; }
        const unsigned old = xb_add(&bar[XB_XSUB(b.x)], 1u);
        const unsigned gen = old / nloc;
        if (old + 1u == (gen + 1u) * nloc) {
            __builtin_amdgcn_fence(__ATOMIC_RELEASE, "agent");
            asm volatile("s_waitcnt vmcnt(0)" ::: "memory");
            const unsigned og = xb_add(&bar[XB_TOP], 1u);
            const unsigned tg = og / nx;
            if (og + 1u == (tg + 1u) * nx) xb_add(&bar[XB_TOPGEN], 1u);
            else XB_SPIN(xb_ld(&bar[XB_TOPGEN]) == tg, bar);
            __builtin_amdgcn_fence(__ATOMIC_ACQUIRE, "agent");
            xb_add(&bar[XB_XGEN(b.x)], 1u);
            asm volatile("s_waitcnt vmcnt(0)" ::: "memory");
        } else {
            XB_SPIN(xb_ld(&bar[XB_XGEN(b.x)]) == gen, bar);
            __builtin_amdgcn_fence(__ATOMIC_ACQUIRE, "agent");
            asm volatile("s_waitcnt vmcnt(0)" ::: "memory");
        }
    }
    __syncthreads();
}

template <int MAP  >
__device__ __forceinline__ void p0_transpose_item(const float* W, int K, int N, bf16* WT, const float* kgain, LAS float* scr, int item, int lane) {
    const int nblk = N / 32, kb = item / nblk, nb = item % nblk, k0 = 64 * kb, n0 = 32 * nb;
#pragma unroll 8
    for (int i = 0; i < 32; ++i) { const int kk = 2 * i + (lane >> 5); float v = W[(size_t)(k0 + kk) * N + n0 + (lane & 31)]; if (kgain) v *= kgain[k0 + kk]; scr[kk * 33 + (lane & 31)] = v; }
    asm volatile("s_waitcnt lgkmcnt(0)" ::: "memory");
    const int c = lane & 7;
    int r0 = n0;
    if (MAP == 2) { const int hs = n0 >> 6; r0 = 256 * (hs >> 2) + 128 * ((n0 >> 5) & 1) + 32 * (hs & 3); }
    if (MAP == 1) r0 = n0 < DFF ? ((n0 >> 7) * 256 + (n0 & 127)) : ((((n0 - DFF) >> 7) * 256) + 128 + ((n0 - DFF) & 127));
#pragma unroll
    for (int j = 0; j < 4; ++j) { const int n = (lane >> 3) + 8 * j; const LAS float* s = scr + (8 * c) * 33 + n;
        v4u o; o.x = cvtpk(s[0 * 33], s[1 * 33]); o.y = cvtpk(s[2 * 33], s[3 * 33]); o.z = cvtpk(s[4 * 33], s[5 * 33]); o.w = cvtpk(s[6 * 33], s[7 * 33]);
        const int nr = (MAP == 1) ? (8 * (2 * (n >> 4) + ((n >> 2) & 1)) + 4 * ((n >> 3) & 1) + (n & 3)) : n;
        *(v4u*)(WT + (size_t)(r0 + nr) * K + k0 + 8 * c) = o; }
    asm volatile("s_waitcnt lgkmcnt(0)" ::: "memory");
}
__device__ __forceinline__ void rows4_to_bf16(const float* xrow, bf16* orow, float* ssq, int lane) {
    f32x4 v[4][4]; float s[4];
#pragma unroll
    for (int k = 0; k < 4; ++k)
#pragma unroll
        for (int j = 0; j < 4; ++j) v[k][j] = ((const f32x4*)(xrow + (size_t)k * DM) + lane)[64 * j];
#pragma unroll
    for (int k = 0; k < 4; ++k) { s[k] = 0.f;
#pragma unroll
        for (int j = 0; j < 4; ++j) s[k] += (v[k][j].x * v[k][j].x + v[k][j].y * v[k][j].y) + (v[k][j].z * v[k][j].z + v[k][j].w * v[k][j].w);
        unsigned long long* o8 = (unsigned long long*)(orow + (size_t)k * DM) + lane;
#pragma unroll
        for (int j = 0; j < 4; ++j) o8[64 * j] = (unsigned long long)cvtpk(v[k][j].x, v[k][j].y) | ((unsigned long long)cvtpk(v[k][j].z, v[k][j].w) << 32); }
#pragma unroll
    for (int o = 1; o < 64; o <<= 1) {
#pragma unroll
        for (int k = 0; k < 4; ++k) s[k] += __shfl_xor(s[k], o); }
    if (lane < 4) ssq[lane] = lane == 0 ? s[0] : lane == 1 ? s[1] : lane == 2 ? s[2] : s[3];
}

template <int NKEYS, int NTHR>
__device__ __forceinline__ void stage_load(v4u (&kr)[NKEYS * 8 / NTHR], v4u (&vr)[NKEYS * 8 / NTHR], const bf16* kbase, const bf16* vbase, int tok0, int dshift, int kidx0, int Ls, int t) {
    constexpr int NIT = NKEYS * 8 / NTHR;
    const int c = t & 7;
#pragma unroll
    for (int it = 0; it < NIT; ++it) { const int rho = (it * NTHR + t) >> 3, kidx = kidx0 + rho; const bool ok = (unsigned)kidx < (unsigned)Ls;
        const size_t off = (size_t)(tok0 + ((ok ? kidx : 0) << dshift)) * 64 + 8 * c;
        kr[it] = *(const v4u*)(kbase + off); vr[it] = *(const v4u*)(vbase + off); }
}
template <int NKEYS, int NTHR>
__device__ __forceinline__ void stage_write(const v4u (&kr)[NKEYS * 8 / NTHR], const v4u (&vr)[NKEYS * 8 / NTHR], LAS unsigned char* Kl, LAS unsigned char* Vl, int t) {
    constexpr int NIT = NKEYS * 8 / NTHR;
    const int c = t & 7;
#pragma unroll
    for (int it = 0; it < NIT; ++it) { const int rho = (it * NTHR + t) >> 3;
        *(LAS v4u*)(Kl + rho * 128 + 16 * (c ^ ((rho >> 1) & 7))) = kr[it];
        *(LAS v4u*)(Vl + (c >> 2) * (NKEYS * 64) + rho * 64 + (c & 3) * 16) = vr[it]; }
}
__device__ __forceinline__ void load_q_raw(v4u (&raw)[4], const bf16* qrow, int lane) {
#pragma unroll
    for (int d0 = 0; d0 < 4; ++d0) raw[d0] = *(const v4u*)(qrow + 16 * d0 + 8 * (lane >> 5));
}
typedef short v4i16_t __attribute__((ext_vector_type(4)));
__device__ __forceinline__ s16x4 vtr(const LAS unsigned char* p) { return __builtin_bit_cast(s16x4, __builtin_amdgcn_ds_read_tr16_b64_v4i16((LAS v4i16_t*)p)); }
template <int R, int CS>
__device__ __forceinline__ void build_bias_table(LAS float* tab, float nslope, float negM, int t, int nthr) {
    for (int idx = t; idx < 4 * CS; idx += nthr) { const int k = idx / CS, m = idx - k * CS, rel = m + k - (R + 32); const int ar = rel < 0 ? -rel : rel;
        tab[idx] = ar <= R ? __builtin_fmaf((float)ar, nslope, negM) : -__builtin_inff(); }
}
__device__ __forceinline__ void attn_tile(const bf16x8 (&kf)[4], const LAS float* tb, unsigned vaddr, int vhs, const bf16x8 (&qf)[4], f32x16 (&o)[2], float& l) {
    s16x4 vl[4], vh[4];
    asm volatile("ds_read_b64_tr_b16 %0, %8\n\tds_read_b64_tr_b16 %1, %8 offset:512\n\tds_read_b64_tr_b16 %2, %8 offset:1024\n\tds_read_b64_tr_b16 %3, %8 offset:1536\n\t"
                 "ds_read_b64_tr_b16 %4, %9\n\tds_read_b64_tr_b16 %5, %9 offset:512\n\tds_read_b64_tr_b16 %6, %9 offset:1024\n\tds_read_b64_tr_b16 %7, %9 offset:1536"
                 : "=&v"(vl[0]), "=&v"(vh[0]), "=&v"(vl[1]), "=&v"(vh[1]), "=&v"(vl[2]), "=&v"(vh[2]), "=&v"(vl[3]), "=&v"(vh[3]) : "v"(vaddr), "v"(vaddr + (unsigned)vhs) : "memory");
    const f32x4 c0 = *(const LAS f32x4*)(tb), c1 = *(const LAS f32x4*)(tb + 8), c2 = *(const LAS f32x4*)(tb + 16), c3 = *(const LAS f32x4*)(tb + 24);
    f32x16 s = {c0[0], c0[1], c0[2], c0[3], c1[0], c1[1], c1[2], c1[3], c2[0], c2[1], c2[2], c2[3], c3[0], c3[1], c3[2], c3[3]};
#pragma unroll
    for (int d0 = 0; d0 < 4; ++d0) s = __builtin_amdgcn_mfma_f32_32x32x16_bf16(kf[d0], qf[d0], s, 0, 0, 0);
    float pr[16];
#pragma unroll
    for (int r = 0; r < 16; ++r) { const float p = __builtin_amdgcn_exp2f(s[r]); l += p; pr[r] = p; }
    v4u w0, w1; w0.x = cvtpk(pr[0], pr[1]); w0.y = cvtpk(pr[2], pr[3]); w0.z = cvtpk(pr[4], pr[5]); w0.w = cvtpk(pr[6], pr[7]);
    w1.x = cvtpk(pr[8], pr[9]); w1.y = cvtpk(pr[10], pr[11]); w1.z = cvtpk(pr[12], pr[13]); w1.w = cvtpk(pr[14], pr[15]);
    const bf16x8 pa0 = __builtin_bit_cast(bf16x8, w0), pa1 = __builtin_bit_cast(bf16x8, w1);
    asm volatile("s_waitcnt lgkmcnt(0)" : "+v"(vl[0]), "+v"(vh[0]), "+v"(vl[1]), "+v"(vh[1]), "+v"(vl[2]), "+v"(vh[2]), "+v"(vl[3]), "+v"(vh[3]) :: "memory");
#pragma unroll
    for (int dh = 0; dh < 2; ++dh)
#pragma unroll
        for (int s2 = 0; s2 < 2; ++s2) { const s16x4 lo = vl[2 * dh + s2], h4 = vh[2 * dh + s2];
            const bf16x8 vf = (bf16x8){lo[0], lo[1], lo[2], lo[3], h4[0], h4[1], h4[2], h4[3]};
            o[dh] = __builtin_amdgcn_mfma_f32_32x32x16_bf16(vf, s2 ? pa1 : pa0, o[dh], 0, 0, 0); }
}
template <int NT, int CS>
__device__ __forceinline__ void attn_task(const LAS unsigned char* Kl, const LAS unsigned char* Vl, int vhs, int row0, int kidx_t0, int Ls, const bf16x8 (&qf)[4], const LAS float* tab, f32x16 (&o)[2], float& l, int lane) {
    const int q = lane & 31, hi = lane >> 5;
    const unsigned va0 = (unsigned)(uintptr_t)(Vl + row0 * 64 + (4 * hi + ((lane & 15) >> 2)) * 64 + (16 * ((lane >> 4) & 1) + 4 * (lane & 3)) * 2);
    const int sw = (q >> 1) & 7;
    const LAS unsigned char* kp0 = Kl + (row0 + q) * 128 + 16 * ((0 + hi) ^ sw); const LAS unsigned char* kp1 = Kl + (row0 + q) * 128 + 16 * ((2 + hi) ^ sw);
    const LAS unsigned char* kp2 = Kl + (row0 + q) * 128 + 16 * ((4 + hi) ^ sw); const LAS unsigned char* kp3 = Kl + (row0 + q) * 128 + 16 * ((6 + hi) ^ sw);
    int b = 32 - q + 4 * hi; asm volatile("" : "+v"(b));
    const LAS float* tb0 = tab + (b & 3) * CS + (b & ~3);
#define LOADK(dst, jj) do { dst[0] = *(const LAS bf16x8*)(kp0 + (jj) * 4096); dst[1] = *(const LAS bf16x8*)(kp1 + (jj) * 4096); dst[2] = *(const LAS bf16x8*)(kp2 + (jj) * 4096); dst[3] = *(const LAS bf16x8*)(kp3 + (jj) * 4096); } while (0)
    bf16x8 kf[4];
#pragma unroll 1
    for (int j = 0; j < NT; ++j) {
        if ((unsigned)(kidx_t0 + 32 * j) < (unsigned)Ls) {
            LOADK(kf, j);
            attn_tile(kf, tb0 + 32 * j, va0 + j * 2048, vhs, qf, o, l); }
    }
#undef LOADK
}
__device__ __forceinline__ void store_partial(const f32x16 (&o)[2], float l, bf16* OBuf, float* LB, int tokq0, int dshift, int h, int lane) {
    const int hi = lane >> 5, q = lane & 31; const size_t row = (size_t)h * M + (size_t)(tokq0 + (q << dshift));
    l += __shfl_xor(l, 32);
    if (hi == 0) LB[row] = l;
    bf16* p = OBuf + row * 64 + 8 * hi;
#pragma unroll
    for (int dh = 0; dh < 2; ++dh)
#pragma unroll
        for (int t = 0; t < 2; ++t) { const int ge = 2 * t, go = 2 * t + 1;
            const unsigned x0 = cvtpk(o[dh][4 * ge], o[dh][4 * ge + 1]), x1 = cvtpk(o[dh][4 * ge + 2], o[dh][4 * ge + 3]);
            const unsigned y0 = cvtpk(o[dh][4 * go], o[dh][4 * go + 1]), y1 = cvtpk(o[dh][4 * go + 2], o[dh][4 * go + 3]);
            const auto r0 = __builtin_amdgcn_permlane32_swap(x0, y0, false, false), r1 = __builtin_amdgcn_permlane32_swap(x1, y1, false, false);
            v4u w; w.x = r0[0]; w.y = r1[0]; w.z = r0[1]; w.w = r1[1];
            *(v4u*)(p + 32 * dh + 16 * t) = w; }
}
struct AUnit { int tok0, dshift, Ls, cc, h, c; };
__device__ __forceinline__ AUnit decode_a(int su) {
    AUnit a; const int sidx = su / 48, k = su % 48, blk = sidx >> 3; a.h = sidx & 7; a.c = 2 - (k >> 4); a.dshift = 2 * a.c; const int kk = k & 15;
    int seq0, S, bis; if (blk < 8) { seq0 = 0; S = 16384; bis = blk; } else { seq0 = MP + 2048 * (blk - 8); S = 2048; bis = 0; }
    a.Ls = S >> a.dshift; const int lcpb = 4 - a.dshift  , res = kk >> lcpb; a.cc = (bis << lcpb) + (kk & ((1 << lcpb) - 1)); a.tok0 = seq0 + res; return a;
}
struct BUnit { int seq0, S, lcb, g2; };
__device__ __forceinline__ BUnit decode_b(int u) {
    BUnit b; b.g2 = u / 768; const int cb = u % 768;
    if (cb < 256) { b.seq0 = 0; b.S = 16384; b.lcb = cb; } else { b.seq0 = MP + 2048 * ((cb - 256) >> 5); b.S = 2048; b.lcb = (cb - 256) & 31; } return b;
}

#define LDS_BAR() asm volatile("s_waitcnt lgkmcnt(0)\n\ts_barrier" ::: "memory")
#define xp (args.in[0])
#define xs (args.in[1])
#define norm1 (args.in[2])
#define w_in (args.in[3])
#define qna (args.in[4])
#define kna (args.in[5])
#define qnb (args.in[6])
#define knb (args.in[7])
#define sinkb (args.in[8])
#define ona (args.in[9])
#define onb (args.in[10])
#define w_out (args.in[11])
#define norm2 (args.in[12])
#define w_up (args.in[13])
#define conv_w (args.in[14])
#define conv_b (args.in[15])
#define w_down (args.in[16])
#define out (args.dout)
#define SSQ ((float*)(args.ws + WS_SSQ))
#define SSQ1 ((float*)(args.ws + WS_SSQ1))
#define WIN ((bf16*)(args.ws + WS_WIN))
#define WOUT ((bf16*)(args.ws + WS_WOUT))
#define WUP ((bf16*)(args.ws + WS_WUP))
#define WDN ((bf16*)(args.ws + WS_WDN))
#define XN ((bf16*)(args.ws + WS_XN) + DM)
#define PROJ ((bf16*)(args.ws + WS_PROJ))
#define Y ((bf16*)(args.ws + WS_PROJ))
#define OA ((bf16*)(args.ws + WS_OA))
#define OB ((bf16*)args.dout)
#define HB ((bf16*)(args.ws + WS_H))
#define LA ((float*)(args.ws + WS_LA))
#define LBp ((float*)(args.ws + WS_LA) + 3 * (size_t)M * 8)
struct Args { const float* in[17]; float* dout; unsigned char* ws; };
__global__ void __launch_bounds__(NWAVES * 64, 2) fwd_megakernel(Args args) {
    extern __shared__ __attribute__((aligned(16))) unsigned char lds_raw[];
    cg::grid_group grid = cg::this_grid();
    LAS unsigned char* lds = (LAS unsigned char*)lds_raw;
    const int tid = threadIdx.x, lane = tid & 63, wave = __builtin_amdgcn_readfirstlane(tid >> 6);
    const int G = gridDim.x, bx = blockIdx.x;
    if (tid < 2) ((LAS unsigned*)(lds + MISC_OFF))[tid] = 0u;
    const int gw = bx * NWAVES + wave, NGW = G * NWAVES;
    __syncthreads();
    XcdBarrier bar = xcd_barrier_post((unsigned*)(args.ws + WS_BAR), (volatile LAS unsigned*)(lds + MISC_OFF));
    if (args.ws == nullptr) grid.sync();

    {
        LAS float* scr = (LAS float*)(lds + wave * 16384);
        constexpr int I_IN = (DM / 64) * (INW / 32), I_OUT = (DM / 64) * (DM / 32), I_UP = (DM / 64) * (UPW / 32), I_DN = (DFF / 64) * (DM / 32);
        for (int it = gw; it < I_IN + I_OUT + I_UP + I_DN; it += NGW) {
            int r = it;
            if (r < I_IN) { p0_transpose_item<2>(w_in, DM, INW, WIN, norm1, scr, r, lane); continue; } r -= I_IN;
            if (r < I_OUT) { p0_transpose_item<0>(w_out, DM, DM, WOUT, nullptr, scr, r, lane); continue; } r -= I_OUT;
            if (r < I_UP) { p0_transpose_item<1>(w_up, DM, UPW, WUP, norm2, scr, r, lane); continue; } r -= I_UP;
            p0_transpose_item<0>(w_down, DFF, DM, WDN, nullptr, scr, r, lane);
        }
        for (int m = gw * 4; m < M; m += NGW * 4) rows4_to_bf16(m < MP ? xp + (size_t)m * DM : xs + (size_t)(m - MP) * DM, XN + (size_t)m * DM, SSQ1 + m, lane);
        for (int i = bx * 512 + tid; i < M; i += G * 512) SSQ[i] = 0.f;
    }
    xcd_barrier(bar);

    {
        pg8::Gemm g{XN, WIN, M, INW, DM, 256}; pg8::StaticOrder S; S.init(M, INW, G, bx);
        pg8::EpiProj E{PROJ, SSQ1, qna, kna, qnb, knb};
        pg8::gemm_phase<pg8::EpiProj, pg8::StaticOrder, PG8_ALIGN, PG8_SP2>(lds, g, S, E);
    }
    xcd_barrier(bar);

    {
        const float gqa = fabsf(qna[lane]), gka = fabsf(kna[lane]);
        const float boundA = __builtin_bit_cast(float, __builtin_amdgcn_readfirstlane(__builtin_bit_cast(int, 8.0f * wave_max(gqa) * wave_max(gka) * LOG2E)));
        const float negMa = boundA > 40.f ? -boundA : 0.f;
        {
            const int half = wave >> 2, w4 = wave & 3, th = tid & 255;
            LAS unsigned char* Kl = lds + half * 65536; LAS unsigned char* Vl = Kl + 32768;
            LAS float* tabA = (LAS float*)(lds + XCH_OFF);
            const int ubase = (G == 256) ? (bx & 7) * 576 + (bx >> 3) : bx, ustep = (G == 256) ? 32 : G, uend = (G == 256) ? (bx & 7) * 576 + 576 : 4608;
            v4u kr[8], vr[8], qraw[4]; AUnit nx = decode_a(2 * ubase + half);
            if (ubase < uend) { stage_load<256, 256>(kr, vr, PROJ + (size_t)(8 + nx.h) * M * 64, PROJ + (size_t)(16 + nx.h) * M * 64, nx.tok0, nx.dshift, 128 * nx.cc - 64, nx.Ls, th);
                load_q_raw(qraw, PROJ + ((size_t)nx.h * M + (nx.tok0 + ((128 * nx.cc + 32 * w4 + (lane & 31)) << nx.dshift))) * 64, lane); }
            for (int u = ubase; u < uend; u += ustep) {
                const AUnit a = nx;
                LDS_BAR();
                stage_write<256, 256>(kr, vr, Kl, Vl, th);
                build_bias_table<64, 208>(tabA, -__builtin_amdgcn_exp2f(-0.5f * (float)(a.h + 9) + (float)a.dshift) * LOG2E, negMa, tid, 512);
                bf16x8 qf[4];
#pragma unroll
                for (int d0 = 0; d0 < 4; ++d0) qf[d0] = __builtin_bit_cast(bf16x8, qraw[d0]);
                LDS_BAR();
                if (u + ustep < uend) { nx = decode_a(2 * (u + ustep) + half);
                    stage_load<256, 256>(kr, vr, PROJ + (size_t)(8 + nx.h) * M * 64, PROJ + (size_t)(16 + nx.h) * M * 64, nx.tok0, nx.dshift, 128 * nx.cc - 64, nx.Ls, th);
                    load_q_raw(qraw, PROJ + ((size_t)nx.h * M + (nx.tok0 + ((128 * nx.cc + 32 * w4 + (lane & 31)) << nx.dshift))) * 64, lane); }
                const int iq0 = 128 * a.cc + 32 * w4;
                f32x16 o[2]; float l = 0.f;
#pragma unroll
                for (int r = 0; r < 16; ++r) { o[0][r] = 0.f; o[1][r] = 0.f; }
                attn_task<5, 208>(Kl, Vl, 256 * 64, 32 * w4, iq0 - 64, a.Ls, qf, tabA, o, l, lane);
                asm volatile("s_nop 15\n\ts_nop 7" ::: "memory");
                store_partial(o, l, OA + (size_t)a.c * M * 512, LA + (size_t)a.c * M * 8, a.tok0 + (iq0 << a.dshift), a.dshift, a.h, lane);
            }
        }
        const float gqb = fabsf(qnb[lane]), gkb = fabsf(knb[lane]);
        const float boundB = __builtin_bit_cast(float, __builtin_amdgcn_readfirstlane(__builtin_bit_cast(int, 8.0f * wave_max(gqb) * wave_max(gkb) * LOG2E)));
        const float negMb = boundB > 40.f ? -boundB : 0.f;
        {
            LAS unsigned char* Kb = lds; LAS unsigned char* Vb = lds + 40960;
            LAS float* tabB = (LAS float*)(lds + 81920);
            const int ubase = (G == 256) ? (bx & 7) * 192 + (bx >> 3) : bx, ustep = (G == 256) ? 32 : G, uend = (G == 256) ? (bx & 7) * 192 + 192 : 1536;
            v4u kr[5], vr[5], qraw[4]; BUnit nx = decode_b(ubase);
            if (ubase < uend) { stage_load<320, 512>(kr, vr, PROJ + (size_t)(32 + nx.g2) * M * 64, PROJ + (size_t)(34 + nx.g2) * M * 64, nx.seq0, 0, 64 * nx.lcb - 128, nx.S, tid);
                load_q_raw(qraw, PROJ + ((size_t)(24 + 4 * nx.g2 + (wave >> 1)) * M + (nx.seq0 + 64 * nx.lcb + 32 * (wave & 1) + (lane & 31))) * 64, lane); }
            for (int u = ubase; u < uend; u += ustep) {
                const BUnit b = nx;
                LDS_BAR();
                stage_write<320, 512>(kr, vr, Kb, Vb, tid);
                build_bias_table<128, 336>(tabB + (tid >> 7) * (4 * 336), -__builtin_amdgcn_exp2f(-0.5f * (float)(4 * b.g2 + (tid >> 7) + 1)) * LOG2E, negMb, tid & 127, 128);
                bf16x8 qf[4];
#pragma unroll
                for (int d0 = 0; d0 < 4; ++d0) qf[d0] = __builtin_bit_cast(bf16x8, qraw[d0]);
                LDS_BAR();
                if (u + ustep < uend) { nx = decode_b(u + ustep);
                    stage_load<320, 512>(kr, vr, PROJ + (size_t)(32 + nx.g2) * M * 64, PROJ + (size_t)(34 + nx.g2) * M * 64, nx.seq0, 0, 64 * nx.lcb - 128, nx.S, tid);
                    load_q_raw(qraw, PROJ + ((size_t)(24 + 4 * nx.g2 + (wave >> 1)) * M + (nx.seq0 + 64 * nx.lcb + 32 * (wave & 1) + (lane & 31))) * 64, lane); }
                const int hb = 4 * b.g2 + (wave >> 1), iq0 = 64 * b.lcb + 32 * (wave & 1);
                f32x16 o[2]; float l = 0.f;
#pragma unroll
                for (int r = 0; r < 16; ++r) { o[0][r] = 0.f; o[1][r] = 0.f; }
                attn_task<9, 336>(Kb, Vb, 320 * 64, 32 * (wave & 1), iq0 - 128, b.S, qf, tabB + (wave >> 1) * (4 * 336), o, l, lane);
                asm volatile("s_nop 15\n\ts_nop 7" ::: "memory");
                store_partial(o, l, OB, LBp, b.seq0 + iq0, 0, hb, lane);
            }
        }
        xcd_barrier(bar);
        {
            const int hh = lane >> 3;
            const float sinkterm = __builtin_amdgcn_exp2f(sinkb[hh] * LOG2E + negMb);
            const f32x4 ga0 = *(const f32x4*)(ona + 8 * lane), ga1 = *(const f32x4*)(ona + 8 * lane + 4), gb0 = *(const f32x4*)(onb + 8 * lane), gb1 = *(const f32x4*)(onb + 8 * lane + 4);
            for (int m0 = gw * 4; m0 < M; m0 += NGW * 4) {
                v4u wa[4][3], wb[4]; float la[4], lb[4];
#pragma unroll
                for (int k = 0; k < 4; ++k) { const int m = m0 + k; la[k] = 0.f;
#pragma unroll
                    for (int c = 0; c < 3; ++c) { wa[k][c] = *(const v4u*)(OA + (((size_t)c * 8 + hh) * M + m) * 64 + 8 * (lane & 7)); la[k] += LA[((size_t)c * 8 + hh) * M + m]; }
                    wb[k] = *(const v4u*)(OB + ((size_t)hh * M + m) * 64 + 8 * (lane & 7)); lb[k] = LBp[(size_t)hh * M + m] + sinkterm; }
                float ya[4][8], yb[4][8], sa[4], sb[4];
#pragma unroll
                for (int k = 0; k < 4; ++k) { const float ia = 1.0f / la[k], ib = 1.0f / lb[k];
                    ya[k][0] = (bf_lo(wa[k][0].x) + bf_lo(wa[k][1].x) + bf_lo(wa[k][2].x)) * ia; ya[k][1] = (bf_hi(wa[k][0].x) + bf_hi(wa[k][1].x) + bf_hi(wa[k][2].x)) * ia;
                    ya[k][2] = (bf_lo(wa[k][0].y) + bf_lo(wa[k][1].y) + bf_lo(wa[k][2].y)) * ia; ya[k][3] = (bf_hi(wa[k][0].y) + bf_hi(wa[k][1].y) + bf_hi(wa[k][2].y)) * ia;
                    ya[k][4] = (bf_lo(wa[k][0].z) + bf_lo(wa[k][1].z) + bf_lo(wa[k][2].z)) * ia; ya[k][5] = (bf_hi(wa[k][0].z) + bf_hi(wa[k][1].z) + bf_hi(wa[k][2].z)) * ia;
                    ya[k][6] = (bf_lo(wa[k][0].w) + bf_lo(wa[k][1].w) + bf_lo(wa[k][2].w)) * ia; ya[k][7] = (bf_hi(wa[k][0].w) + bf_hi(wa[k][1].w) + bf_hi(wa[k][2].w)) * ia;
                    yb[k][0] = bf_lo(wb[k].x) * ib; yb[k][1] = bf_hi(wb[k].x) * ib; yb[k][2] = bf_lo(wb[k].y) * ib; yb[k][3] = bf_hi(wb[k].y) * ib;
                    yb[k][4] = bf_lo(wb[k].z) * ib; yb[k][5] = bf_hi(wb[k].z) * ib; yb[k][6] = bf_lo(wb[k].w) * ib; yb[k][7] = bf_hi(wb[k].w) * ib;
                    sa[k] = 0.f; sb[k] = 0.f;
#pragma unroll
                    for (int i = 0; i < 8; ++i) { sa[k] += ya[k][i] * ya[k][i]; sb[k] += yb[k][i] * yb[k][i]; } }
#pragma unroll
                for (int o = 1; o < 64; o <<= 1) {
#pragma unroll
                    for (int k = 0; k < 4; ++k) { sa[k] += __shfl_xor(sa[k], o); sb[k] += __shfl_xor(sb[k], o); } }
#pragma unroll
                for (int k = 0; k < 4; ++k) { const int m = m0 + k;
                    const float ra = __builtin_amdgcn_rsqf(sa[k] * (1.f / 512.f) + EPS), rb = __builtin_amdgcn_rsqf(sb[k] * (1.f / 512.f) + EPS);
                    v4u oa, ob;
                    oa.x = cvtpk(ya[k][0] * ra * ga0.x, ya[k][1] * ra * ga0.y); oa.y = cvtpk(ya[k][2] * ra * ga0.z, ya[k][3] * ra * ga0.w); oa.z = cvtpk(ya[k][4] * ra * ga1.x, ya[k][5] * ra * ga1.y); oa.w = cvtpk(ya[k][6] * ra * ga1.z, ya[k][7] * ra * ga1.w);
                    ob.x = cvtpk(yb[k][0] * rb * gb0.x, yb[k][1] * rb * gb0.y); ob.y = cvtpk(yb[k][2] * rb * gb0.z, yb[k][3] * rb * gb0.w); ob.z = cvtpk(yb[k][4] * rb * gb1.x, yb[k][5] * rb * gb1.y); ob.w = cvtpk(yb[k][6] * rb * gb1.z, yb[k][7] * rb * gb1.w);
                    *(v4u*)(Y + (size_t)m * DM + 8 * lane) = oa; *(v4u*)(Y + (size_t)m * DM + 512 + 8 * lane) = ob; }
            }
        }
    }
    xcd_barrier(bar);

    {
        pg8::Gemm g{Y, WOUT, M, DM, DM, 256}; pg8::StaticOrder S; S.init(M, DM, G, bx);
        pg8::EpiOut E{XN, SSQ};
        pg8::gemm_phase<pg8::EpiOut, pg8::StaticOrder, PG8_ALIGN, PG8_SP2>(lds, g, S, E);
    }
    xcd_barrier(bar);

    {
        pg8::Gemm g{XN - DM, WUP, UP_TILES_M * 256, UPW, DM, 254}; pg8::StaticOrder S; S.init(UP_TILES_M * 256, UPW, G, bx);
        pg8::EpiUp E{HB, SSQ, conv_w, conv_b, (LAS float*)(lds + XCH_OFF)};
        pg8::gemm_phase<pg8::EpiUp, pg8::StaticOrder, true, PG8_SP2>(lds, g, S, E);
    }
    xcd_barrier(bar);

    {
        pg8::Gemm g{HB, WDN, M, DM, DFF, 256}; pg8::StaticOrder S; S.init(M, DM, G, bx);
        pg8::EpiDown E{XN, out};
        pg8::gemm_phase<pg8::EpiDown, pg8::StaticOrder, PG8_ALIGN, PG8_SP2>(lds, g, S, E);
    }
}

#undef out
#undef xp
#undef xs
extern "C" void kernel_launch(void* const* d_in, const int* in_sizes, int n_in, void* d_out, int out_size, void* d_ws, size_t ws_size, hipStream_t stream) {
    static int grid = 0;
    if (grid == 0) {
        if (n_in != 17 || out_size != M * DM || ws_size < WS_END) { fprintf(stderr, "kernel_launch: unexpected shapes (n_in %d out %d ws %zu)\n", n_in, out_size, ws_size); grid = -1; return; }
        int dev = 0, cus = 0, per_cu = 0;
        hipGetDevice(&dev); hipDeviceGetAttribute(&cus, hipDeviceAttributeMultiprocessorCount, dev);
        if (hipFuncSetAttribute((const void*)fwd_megakernel, hipFuncAttributeMaxDynamicSharedMemorySize, LDS_BYTES) != hipSuccess) { fprintf(stderr, "kernel_launch: hipFuncSetAttribute failed\n"); grid = -1; return; }
        if (hipOccupancyMaxActiveBlocksPerMultiprocessor(&per_cu, (const void*)fwd_megakernel, NWAVES * 64, LDS_BYTES) != hipSuccess || per_cu < 1) { fprintf(stderr, "kernel_launch: occupancy query says %d\n", per_cu); per_cu = 1; }
        (void)hipGetLastError();
        grid = cus;
        fprintf(stderr, "kernel_launch: grid %d (per_cu %d)\n", grid, per_cu);
    }
    if (grid < 0) return;
    Args a{};
    for (int i = 0; i < 17; ++i) a.in[i] = (const float*)d_in[i];
    a.dout = (float*)d_out; a.ws = (unsigned char*)d_ws;
    void* kargs[] = {&a};
    if (hipMemsetAsync((char*)d_ws + WS_BAR, 0, XCD_BAR_WORDS * 4, stream) != hipSuccess) { fprintf(stderr, "kernel_launch: hipMemsetAsync failed\n"); return; }
    hipError_t e = hipLaunchCooperativeKernel((const void*)fwd_megakernel, dim3(grid), dim3(NWAVES * 64), kargs, LDS_BYTES, stream);
    if (e != hipSuccess) fprintf(stderr, "kernel_launch: cooperative launch failed: %s\n", hipGetErrorString(e));
}
```

```cpp
#include <hip/hip_runtime.h>
#include <hip/hip_cooperative_groups.h>
#include <cstdio>
#include <cstdint>
namespace cg = cooperative_groups;
namespace pg8 {
#define PG8_LAS __attribute__((address_space(3)))
typedef unsigned short bf16_t;
typedef short bf16x8 __attribute__((ext_vector_type(8)));
typedef float f32x4 __attribute__((ext_vector_type(4)));
typedef unsigned u32x4 __attribute__((ext_vector_type(4)));
constexpr int BM = 256, BK = 64, HALF = 128, HTB = HALF * BK * 2  , STAGE_BYTES = 8 * HTB, NXCD = 8, WGM = 8;

__host__ __device__ __forceinline__ int lds_byte(int r, int c) { const int st = (r >> 4) * 2 + (c >> 5), rr = r & 15, cc = c & 31, ob = rr * 64 + cc * 2; return st * 1024 + (ob ^ (((ob >> 9) & 1) << 5)); }
__host__ __device__ __forceinline__ void stage_rc(int b, int& R, int& C) { const int st = b / 1024, sb = b % 1024, swz = sb ^ (((sb >> 9) & 1) << 5); R = (st >> 1) * 16 + swz / 64; C = (st & 1) * 32 + (swz % 64) / 2; }
__host__ __device__ __forceinline__ int perm32(int rho) { const int n = rho >> 4, i = rho & 15; return 8 * (i >> 2) + 4 * n + (i & 3); }

struct Unit { int pm, pn; };
struct Gemm { const bf16_t* A; const bf16_t* Bt; int M, N, K; int a_tile_rows; };

struct StaticOrder {
    int nM, nN, nwg, G, c;
    __host__ __device__ void init(int M, int N, int G_, int c_) { nM = M / BM; nN = N / BM; nwg = nM * nN; G = G_; c = c_; }
    __host__ __device__ bool next(int i, Unit& u) const {
        const long L = (long)i * G + c; if (L >= nwg) return false;
        int wgid = (int)L; { const int q = nwg / NXCD, r = nwg % NXCD, xcd = wgid % NXCD, off = wgid / NXCD; wgid = (xcd < r ? xcd * (q + 1) : r * (q + 1) + (xcd - r) * q) + off; }
        const int nig = WGM * nN, gid = wgid / nig, fm = gid * WGM, gsz = (nM - fm) < WGM ? (nM - fm) : WGM;
        u.pm = fm + ((wgid % nig) % gsz); u.pn = (wgid % nig) / gsz; return true;
    }
    __device__ __forceinline__ void a_ready(const Unit&) const {}
    __device__ __forceinline__ void done(const Unit&) const {}
};

__device__ __forceinline__ unsigned cvt_pk_bf16(float lo, float hi) { unsigned r; asm volatile("v_cvt_pk_bf16_f32 %0, %1, %2" : "=v"(r) : "v"(lo), "v"(hi)); return r; }
typedef float f32x2 __attribute__((ext_vector_type(2))); typedef __bf16 bf16x2_t __attribute__((ext_vector_type(2)));
__device__ __forceinline__ unsigned cvtpk(float lo, float hi) { f32x2 v = {lo, hi}; bf16x2_t b = __builtin_convertvector(v, bf16x2_t); return __builtin_bit_cast(unsigned, b); }
constexpr int MTOK = 49152, MPROMPT = 16384, DMODEL = 1024, DFF_ = 2816;
__device__ __forceinline__ u32x4 pack8(const f32x4 a, const f32x4 b) { u32x4 w; w.x = cvtpk(a[0], a[1]); w.y = cvtpk(a[2], a[3]); w.z = cvtpk(b[0], b[1]); w.w = cvtpk(b[2], b[3]); return w; }

struct EpiProj {
    static constexpr bool PERM = true, AFTER_DRAIN = false; static constexpr int MIDK = 0;
    bf16_t* O; const float* ssq1; const float* gqa; const float* gka; const float* gqb; const float* gkb;
    __device__ __forceinline__ void operator()(f32x4 (&acc)[2][2][4][2], const Unit& u, int wr, int wc, int fr, int fq, int wid, int lane) const {
        const int hs = 4 * u.pn + wc;
        const float* g = nullptr; float sc = 1.f;
        if (hs < 8) { g = gqa; sc = 0.125f * 1.4426950408889634f; } else if (hs < 16) g = gka; else if (hs >= 24 && hs < 32) { g = gqb; sc = 0.125f * 1.4426950408889634f; } else if (hs >= 32 && hs < 34) g = gkb;
        const int row0 = u.pm * BM + wr * 64 + fr;
        bf16_t* obase = O + ((size_t)hs * MTOK + row0) * 64 + 8 * fq;
#pragma unroll
        for (int ai = 0; ai < 2; ++ai)
#pragma unroll
            for (int m = 0; m < 4; ++m) { const float r1 = __builtin_amdgcn_rsqf(ssq1[row0 + ai * HALF + m * 16] * (1.0f / DMODEL) + 1e-6f);
#pragma unroll
                for (int bj = 0; bj < 2; ++bj)
#pragma unroll
                    for (int n = 0; n < 2; ++n) acc[ai][bj][m][n] *= r1; }
        if (g) {
            f32x4 gg[2][2];
#pragma unroll
            for (int bj = 0; bj < 2; ++bj)
#pragma unroll
                for (int n = 0; n < 2; ++n) gg[bj][n] = *(const f32x4*)(g + 32 * bj + 8 * fq + 4 * n) * sc;
#pragma unroll
            for (int ai = 0; ai < 2; ++ai)
#pragma unroll
                for (int m = 0; m < 4; ++m) { float ss = 0.f;
#pragma unroll
                    for (int bj = 0; bj < 2; ++bj)
#pragma unroll
                        for (int n = 0; n < 2; ++n) { const f32x4 a = acc[ai][bj][m][n]; ss += (a[0] * a[0] + a[1] * a[1]) + (a[2] * a[2] + a[3] * a[3]); }
                    ss += __shfl_xor(ss, 16); ss += __shfl_xor(ss, 32);
                    const float rs = __builtin_amdgcn_rsqf(ss * (1.0f / 64.0f) + 1e-6f);
                    bf16_t* rowp = obase + (size_t)(ai * HALF + m * 16) * 64;
#pragma unroll
                    for (int bj = 0; bj < 2; ++bj) *(u32x4*)(rowp + 32 * bj) = pack8(acc[ai][bj][m][0] * rs * gg[bj][0], acc[ai][bj][m][1] * rs * gg[bj][1]); }
        } else {
#pragma unroll
            for (int ai = 0; ai < 2; ++ai)
#pragma unroll
                for (int m = 0; m < 4; ++m) { bf16_t* rowp = obase + (size_t)(ai * HALF + m * 16) * 64;
#pragma unroll
                    for (int bj = 0; bj < 2; ++bj) *(u32x4*)(rowp + 32 * bj) = pack8(acc[ai][bj][m][0], acc[ai][bj][m][1]); }
        }
    }
};
struct EpiOut {
    static constexpr bool PERM = true, AFTER_DRAIN = false; static constexpr int MIDK = 8;
    bf16_t* xb; float* ssq; const float* ssqb;
    __device__ __forceinline__ void mid(f32x4 (&acc)[2][2][4][2], const Unit& u, int wr, int wc, int fr, int fq) const {
        const float* sp = ssqb + (u.pm * BM + wr * 64 + fr);
        asm volatile("s_nop 15\n\ts_nop 15" ::: "memory");
#pragma unroll
        for (int ai = 0; ai < 2; ++ai) {
            float f[4];
#pragma unroll
            for (int m = 0; m < 4; ++m) f[m] = __builtin_amdgcn_sqrtf(sp[ai * HALF + m * 16] * (1.0f / 512.0f) + 1e-6f);
#pragma unroll
            for (int bj = 0; bj < 2; ++bj)
#pragma unroll
                for (int m = 0; m < 4; ++m)
#pragma unroll
                    for (int n = 0; n < 2; ++n) acc[ai][bj][m][n] *= f[m];
            asm volatile("" ::: "memory"); }
        asm volatile("s_nop 7" ::: "memory");
    }
    __device__ __forceinline__ void operator()(f32x4 (&acc)[2][2][4][2], const Unit& u, int wr, int wc, int fr, int fq, int wid, int lane) const {
        const int col0 = u.pn * BM + wc * 32 + 8 * fq; const int gr0 = u.pm * BM + wr * 64 + fr;
#pragma unroll
        for (int ai = 0; ai < 2; ++ai) {
            u32x4 w[4][2]; float rb[4];
#pragma unroll
            for (int m = 0; m < 4; ++m) { rb[m] = ssqb[gr0 + ai * HALF + m * 16];
#pragma unroll
                for (int bj = 0; bj < 2; ++bj) w[m][bj] = *(const u32x4*)(xb + (size_t)(gr0 + ai * HALF + m * 16) * DMODEL + col0 + bj * HALF); }
#pragma unroll
            for (int m = 0; m < 4; ++m) { const int gr = gr0 + ai * HALF + m * 16;
                float s = 0.f; const float r = __builtin_amdgcn_rsqf(rb[m] * (1.0f / 512.0f) + 1e-6f);
#pragma unroll
                for (int bj = 0; bj < 2; ++bj) { const u32x4 v = w[m][bj];
                    f32x4 a = {__uint_as_float(v.x << 16), __uint_as_float(v.x & 0xffff0000u), __uint_as_float(v.y << 16), __uint_as_float(v.y & 0xffff0000u)};
                    f32x4 b = {__uint_as_float(v.z << 16), __uint_as_float(v.z & 0xffff0000u), __uint_as_float(v.w << 16), __uint_as_float(v.w & 0xffff0000u)};
                    a += acc[ai][bj][m][0] * r; b += acc[ai][bj][m][1] * r;
                    s += (a[0] * a[0] + a[1] * a[1]) + (a[2] * a[2] + a[3] * a[3]) + (b[0] * b[0] + b[1] * b[1]) + (b[2] * b[2] + b[3] * b[3]);
                    *(u32x4*)(xb + (size_t)gr * DMODEL + col0 + bj * HALF) = pack8(a, b); }
                s += __shfl_xor(s, 16); s += __shfl_xor(s, 32);
                if (fq == 0) unsafeAtomicAdd(ssq + gr, s); }
            asm volatile("" ::: "memory"); }
    }
};
struct EpiDown {
    static constexpr bool PERM = true, AFTER_DRAIN = false; static constexpr int MIDK = 0;
    const bf16_t* xb; float* out;
    __device__ __forceinline__ void operator()(f32x4 (&acc)[2][2][4][2], const Unit& u, int wr, int wc, int fr, int fq, int wid, int lane) const {
        const int col0 = u.pn * BM + wc * 32 + 8 * fq; const int gr0 = u.pm * BM + wr * 64 + fr;
        u32x4 w[2][4][2];
#pragma unroll
        for (int ai = 0; ai < 2; ++ai)
#pragma unroll
            for (int m = 0; m < 4; ++m)
#pragma unroll
                for (int bj = 0; bj < 2; ++bj) w[ai][m][bj] = *(const u32x4*)(xb + (size_t)(gr0 + ai * HALF + m * 16) * DMODEL + col0 + bj * HALF);
#pragma unroll
        for (int ai = 0; ai < 2; ++ai)
#pragma unroll
            for (int m = 0; m < 4; ++m) { float* o = out + (size_t)(gr0 + ai * HALF + m * 16) * DMODEL + col0;
#pragma unroll
                for (int bj = 0; bj < 2; ++bj) { const u32x4 v = w[ai][m][bj];
                    f32x4 a = {__uint_as_float(v.x << 16), __uint_as_float(v.x & 0xffff0000u), __uint_as_float(v.y << 16), __uint_as_float(v.y & 0xffff0000u)};
                    f32x4 b = {__uint_as_float(v.z << 16), __uint_as_float(v.z & 0xffff0000u), __uint_as_float(v.w << 16), __uint_as_float(v.w & 0xffff0000u)};
                    a += acc[ai][bj][m][0]; b += acc[ai][bj][m][1]; *(f32x4*)(o + bj * HALF) = a; *(f32x4*)(o + bj * HALF + 4) = b; } }
    }
};
__device__ __forceinline__ bool seq_first(int gr) { return gr == 0 || (gr >= MPROMPT && (gr & 2047) == 0); }
__device__ __forceinline__ bool seq_last(int gr) { return gr >= MPROMPT - 1 && (gr & 2047) == 2047; }
struct EpiUp {
    static constexpr bool PERM = true, AFTER_DRAIN = false; static constexpr int MIDK = 0;
    bf16_t* H; const float* ssq; const float* cw; const float* cb; PG8_LAS float* xch;
    __device__ __forceinline__ void operator()(f32x4 (&acc)[2][2][4][2], const Unit& u, int wr, int wc, int fr, int fq, int wid, int lane) const {
        const int lr0 = wr * 64 + fr, gr0 = 254 * u.pm - 1 + lr0;
#pragma unroll
        for (int ai = 0; ai < 2; ++ai)
#pragma unroll
            for (int m = 0; m < 4; ++m) { int gr = gr0 + ai * HALF + m * 16; gr = gr < 0 ? 0 : (gr > MTOK - 1 ? MTOK - 1 : gr);
                const float rs = __builtin_amdgcn_rsqf(ssq[gr] * (1.0f / DMODEL) + 1e-6f);
#pragma unroll
                for (int bj = 0; bj < 2; ++bj)
#pragma unroll
                    for (int n = 0; n < 2; ++n) acc[ai][bj][m][n] *= rs; }
#pragma unroll
        for (int ai = 0; ai < 2; ++ai) {
            if (fr == 0) { PG8_LAS float* p = xch + ((wid * 2 + ai) * 2 + 0) * 64 + 8 * fq;
#pragma unroll
                for (int bj = 0; bj < 2; ++bj)
#pragma unroll
                    for (int n = 0; n < 2; ++n) *(PG8_LAS f32x4*)(p + bj * 32 + 4 * n) = acc[ai][bj][0][n]; }
            if (fr == 15) { PG8_LAS float* p = xch + ((wid * 2 + ai) * 2 + 1) * 64 + 8 * fq;
#pragma unroll
                for (int bj = 0; bj < 2; ++bj)
#pragma unroll
                    for (int n = 0; n < 2; ++n) *(PG8_LAS f32x4*)(p + bj * 32 + 4 * n) = acc[ai][bj][3][n]; }
        }
        asm volatile("s_waitcnt lgkmcnt(0)" ::: "memory"); __builtin_amdgcn_s_barrier(); asm volatile("" ::: "memory");
        const int tlo = 254 * u.pm - 1, thi = tlo + 255; const bool anyb = (tlo <= 0) || (((thi + 1) >> 11) != ((tlo - 1) >> 11));
        unsigned hold0 = 0u, hold1 = 0u;
        const int ow = (1 - wr) * 4 + wc;
        const int chb = 128 * u.pn + 32 * wc + 16 * (fq >> 1);
#pragma unroll
        for (int n = 0; n < 2; ++n) {
            f32x4 w0[2], w1[2], w2[2], bb[2];
#pragma unroll
            for (int bj = 0; bj < 2; ++bj) { const int ch = chb + 8 * n + 4 * (fq & 1) + bj * DFF_;
                w0[bj] = *(const f32x4*)(cw + ch); w1[bj] = *(const f32x4*)(cw + 2 * DFF_ + ch); w2[bj] = *(const f32x4*)(cw + 4 * DFF_ + ch); bb[bj] = *(const f32x4*)(cb + ch); }
#pragma unroll
            for (int ai = 0; ai < 2; ++ai) {
                const int aiT = wr == 1 ? ai : ai - 1, aiB = wr == 0 ? ai : ai + 1;
#pragma unroll
                for (int m = 0; m < 4; ++m) {
                    const int lr = lr0 + ai * HALF + m * 16, gr = gr0 + ai * HALF + m * 16;
                    const bool first = seq_first(gr), last = seq_last(gr);
                    f32x4 c[2];
#pragma unroll
                    for (int bj = 0; bj < 2; ++bj) {
                        const f32x4 cur = acc[ai][bj][m][n];
                        f32x4 pv, nx;
#pragma unroll
                        for (int e = 0; e < 4; ++e) {
                            const float sP = (m > 0 && fr == 15) ? acc[ai][bj][m > 0 ? m - 1 : 0][n][e] : cur[e];
                            const float sN = (m < 3 && fr == 0) ? acc[ai][bj][m < 3 ? m + 1 : 3][n][e] : cur[e];
                            pv[e] = __builtin_bit_cast(float, __builtin_amdgcn_mov_dpp(__builtin_bit_cast(int, sP), 0x121  , 0xf, 0xf, true));
                            nx[e] = __builtin_bit_cast(float, __builtin_amdgcn_mov_dpp(__builtin_bit_cast(int, sN), 0x12f  , 0xf, 0xf, true)); }
                        if (m == 0) { const f32x4 top = (aiT >= 0) ? *(const PG8_LAS f32x4*)(xch + ((ow * 2 + (aiT < 0 ? 0 : aiT)) * 2 + 1) * 64 + 8 * fq + bj * 32 + 4 * n) : (f32x4){0.f, 0.f, 0.f, 0.f}; if (fr == 0) pv = top; }
                        if (m == 3) { const f32x4 bot = (aiB <= 1) ? *(const PG8_LAS f32x4*)(xch + ((ow * 2 + (aiB > 1 ? 1 : aiB)) * 2 + 0) * 64 + 8 * fq + bj * 32 + 4 * n) : (f32x4){0.f, 0.f, 0.f, 0.f}; if (fr == 15) nx = bot; }
                        if (anyb) { if (first) pv = (f32x4){0.f, 0.f, 0.f, 0.f}; if (last) nx = (f32x4){0.f, 0.f, 0.f, 0.f}; }
                        c[bj] = bb[bj] + w0[bj] * pv + w1[bj] * cur + w2[bj] * nx;
                    }
                    f32x4 hv;
#pragma unroll
                    for (int e = 0; e < 4; ++e) { const float g = c[0][e]; hv[e] = g * __builtin_amdgcn_rcpf(1.0f + __builtin_amdgcn_exp2f(-1.4426950408889634f * g)) * c[1][e]; }
                    const unsigned pkx = cvtpk(hv[0], hv[1]), pky = cvtpk(hv[2], hv[3]);
                    if ((m & 1) == 0) { hold0 = pkx; hold1 = pky; }
                    else { const auto r0 = __builtin_amdgcn_permlane16_swap(hold0, pkx, false, false), r1 = __builtin_amdgcn_permlane16_swap(hold1, pky, false, false);
                        u32x4 w; w.x = r0[0]; w.y = r1[0]; w.z = r0[1]; w.w = r1[1];
                        const int ms = (fq & 1) ? m : m - 1, lrS = lr0 + ai * HALF + ms * 16, grS = gr0 + ai * HALF + ms * 16;
                        if (lrS >= 1 && lrS <= 254 && grS < MTOK) *(u32x4*)(H + (size_t)grS * DFF_ + chb + 8 * n) = w; }
                    asm volatile("" ::: "memory");
                }
            }
        }
    }
};
template <class Epi, class Sched, bool ALIGN_EPI = false, bool SP2 = false>
__device__ __forceinline__ void gemm_phase(PG8_LAS unsigned char* lds, const Gemm g, const Sched& S, const Epi& E) {
    int tid_ = threadIdx.x; asm volatile("" : "+v"(tid_));
    const int tid = tid_, wid = __builtin_amdgcn_readfirstlane(tid >> 6), lane = tid & 63, wr = wid >> 2, wc = wid & 3, fr = lane & 15, fq = lane >> 4;
    const int K = g.K, nt = K / BK;
    unsigned voffA[2], voffB[2];
#pragma unroll
    for (int i = 0; i < 2; ++i) { int R, C; stage_rc(tid * 16 + i * 8192, R, C); const int Rb = Epi::PERM ? ((R & ~31) + perm32(R & 31)) : R;
        voffA[i] = (unsigned)(R * K + C) * 2u; voffB[i] = (unsigned)(Rb * K + C) * 2u; }
    const size_t kstep = (size_t)(BK * 2);
    const size_t hstep = (size_t)HALF * K * 2;
    const size_t tstep = 2 * hstep; const size_t tstepA = (size_t)g.a_tile_rows * K * 2;
    const unsigned ldsw = (unsigned)wid * 1024u;
    const int aoff = lds_byte(wr * 64 + fr, fq * 8), boff = lds_byte(wc * 32 + fr, fq * 8);
#define PG8_SA(b, h) (((b) * 2 + (h)) * HTB)
#define PG8_SB(b, h) ((4 + (b) * 2 + (h)) * HTB)
#define PG8_STAGE(bufoff, gbase, voff) do { _Pragma("unroll") for (int _i = 0; _i < 2; ++_i) \
        __builtin_amdgcn_global_load_lds((const unsigned*)((const char*)(gbase) + (voff)[_i]), (PG8_LAS unsigned*)(lds + (bufoff) + ldsw + _i * 8192), 16, 0, 0); } while (0)
#define PG8_LDA(dst, b, h) do { _Pragma("unroll") for (int m = 0; m < 4; ++m) _Pragma("unroll") for (int k = 0; k < 2; ++k) dst[m][k] = *(const PG8_LAS bf16x8*)(lds + PG8_SA(b, h) + aoff + m * 2048 + k * 1024); } while (0)
#define PG8_LDB(dst, b, h) do { _Pragma("unroll") for (int n = 0; n < 2; ++n) _Pragma("unroll") for (int k = 0; k < 2; ++k) dst[n][k] = *(const PG8_LAS bf16x8*)(lds + PG8_SB(b, h) + boff + n * 2048 + k * 1024); } while (0)
#define PG8_MMA(ai, bj, At, Bt) do { __builtin_amdgcn_s_setprio(1); _Pragma("unroll") for (int m = 0; m < 4; ++m) _Pragma("unroll") for (int n = 0; n < 2; ++n) _Pragma("unroll") for (int k = 0; k < 2; ++k) \
        acc[ai][bj][m][n] = __builtin_amdgcn_mfma_f32_16x16x32_bf16(Bt[n][k], At[m][k], acc[ai][bj][m][n], 0, 0, 0); __builtin_amdgcn_s_setprio(0); } while (0)
#define PG8_WAIT_V(n) asm volatile("s_waitcnt vmcnt(" #n ")" ::: "memory")
#define PG8_WAIT_L(n) asm volatile("s_waitcnt lgkmcnt(" #n ")" ::: "memory")
#define PG8_BAR __builtin_amdgcn_s_barrier()
#define PG8_SCHED __builtin_amdgcn_sched_barrier(0)
    Unit cur, nxt; int ui = 0;
    if (!S.next(0, cur)) return;
    f32x4 acc[2][2][4][2];
#pragma unroll
    for (int a = 0; a < 2; ++a)
#pragma unroll
        for (int b = 0; b < 2; ++b)
#pragma unroll
            for (int m = 0; m < 4; ++m)
#pragma unroll
                for (int n = 0; n < 2; ++n) acc[a][b][m][n] = (f32x4){0.f, 0.f, 0.f, 0.f};
    bf16x8 At[4][2], B0[2][2], B1[2][2];
    const char* cA = (const char*)g.A + (size_t)cur.pm * tstepA; const char* cB = (const char*)g.Bt + (size_t)cur.pn * tstep;
    S.a_ready(cur);
    if constexpr (SP2) {
        PG8_STAGE(PG8_SB(0, 0), cB, voffB); PG8_STAGE(PG8_SB(0, 1), cB + hstep, voffB); PG8_STAGE(PG8_SA(0, 0), cA, voffA); PG8_STAGE(PG8_SA(0, 1), cA + hstep, voffA);
        if (wr == 1) PG8_BAR;
        PG8_WAIT_V(2); PG8_BAR;
        PG8_STAGE(PG8_SB(1, 0), cB + kstep, voffB); PG8_STAGE(PG8_SA(1, 0), cA + kstep, voffA); PG8_STAGE(PG8_SB(1, 1), cB + hstep + kstep, voffB);
        PG8_WAIT_V(6); PG8_BAR;
    } else {
        PG8_STAGE(PG8_SB(0, 0), cB, voffB); PG8_STAGE(PG8_SA(0, 0), cA, voffA); PG8_STAGE(PG8_SB(0, 1), cB + hstep, voffB); PG8_STAGE(PG8_SA(0, 1), cA + hstep, voffA);
        if (wr == 1) PG8_BAR;
        PG8_WAIT_V(4); PG8_BAR;
        PG8_STAGE(PG8_SB(1, 0), cB + kstep, voffB); PG8_STAGE(PG8_SA(1, 0), cA + kstep, voffA); PG8_STAGE(PG8_SB(1, 1), cB + hstep + kstep, voffB);
        PG8_WAIT_V(6); PG8_BAR;
    }
    for (;;) {
        const bool has_next = S.next(ui + 1, nxt);
        const char* nA = has_next ? (const char*)g.A + (size_t)nxt.pm * tstepA : cA; const char* nB = has_next ? (const char*)g.Bt + (size_t)nxt.pn * tstep : cB;
        for (int t = 0; t < nt; t += 2) {
            if constexpr (Epi::MIDK > 0) { if (t == Epi::MIDK) E.mid(acc, cur, wr, wc, fr, fq); }
            const bool last = (t == nt - 2);
            const char* a1 = cA + (size_t)(t + 1) * kstep;
            const char* a2 = last ? nA : cA + (size_t)(t + 2) * kstep; const char* b2 = last ? nB : cB + (size_t)(t + 2) * kstep;
            const char* a3 = a2 + kstep; const char* b3 = b2 + kstep;
            if (last && has_next) S.a_ready(nxt);
            if constexpr (SP2) {
            PG8_LDB(B0, 0, 0); PG8_LDB(B1, 0, 1); PG8_SCHED; PG8_LDA(At, 0, 0); PG8_STAGE(PG8_SA(1, 1), a1 + hstep, voffA);
            PG8_WAIT_V(8); PG8_WAIT_L(0); PG8_BAR; PG8_MMA(0, 0, At, B0); PG8_MMA(0, 1, At, B1); PG8_BAR; PG8_SCHED;
            PG8_LDA(At, 0, 1); PG8_STAGE(PG8_SB(0, 0), b2, voffB); PG8_STAGE(PG8_SB(0, 1), b2 + hstep, voffB); PG8_STAGE(PG8_SA(0, 0), a2, voffA);
            PG8_WAIT_V(8); PG8_WAIT_L(0); PG8_BAR; PG8_MMA(1, 0, At, B0); PG8_MMA(1, 1, At, B1); PG8_BAR; PG8_SCHED;
            PG8_LDB(B0, 1, 0); PG8_LDB(B1, 1, 1); PG8_SCHED; PG8_LDA(At, 1, 0); PG8_STAGE(PG8_SA(0, 1), a2 + hstep, voffA);
            PG8_WAIT_V(8); PG8_WAIT_L(0); PG8_BAR; PG8_MMA(0, 0, At, B0); PG8_MMA(0, 1, At, B1); PG8_BAR; PG8_SCHED;
            PG8_LDA(At, 1, 1); PG8_STAGE(PG8_SB(1, 0), b3, voffB); PG8_STAGE(PG8_SB(1, 1), b3 + hstep, voffB); PG8_STAGE(PG8_SA(1, 0), a3, voffA);
            PG8_WAIT_V(8); PG8_WAIT_L(0); PG8_BAR; PG8_MMA(1, 0, At, B0); PG8_MMA(1, 1, At, B1); PG8_BAR; PG8_SCHED;
            } else {
            PG8_LDB(B0, 0, 0); PG8_SCHED; PG8_LDA(At, 0, 0); PG8_STAGE(PG8_SA(1, 1), a1 + hstep, voffA);
            PG8_WAIT_L(8); PG8_BAR; PG8_WAIT_L(0); PG8_MMA(0, 0, At, B0); PG8_BAR; PG8_SCHED;
            PG8_LDB(B1, 0, 1); PG8_STAGE(PG8_SB(0, 0), b2, voffB);
            PG8_BAR; PG8_WAIT_L(0); PG8_MMA(0, 1, At, B1); PG8_BAR;
            PG8_LDA(At, 0, 1); PG8_STAGE(PG8_SA(0, 0), a2, voffA);
            PG8_BAR; PG8_WAIT_L(0); PG8_MMA(1, 0, At, B0); PG8_BAR; PG8_SCHED;
            PG8_STAGE(PG8_SB(0, 1), b2 + hstep, voffB);
            PG8_WAIT_V(6); PG8_BAR; PG8_MMA(1, 1, At, B1); PG8_BAR;
            PG8_LDB(B0, 1, 0); PG8_SCHED; PG8_LDA(At, 1, 0); PG8_STAGE(PG8_SA(0, 1), a2 + hstep, voffA);
            PG8_WAIT_L(8); PG8_BAR; PG8_WAIT_L(0); PG8_MMA(0, 0, At, B0); PG8_BAR; PG8_SCHED;
            PG8_LDB(B1, 1, 1); PG8_STAGE(PG8_SB(1, 0), b3, voffB);
            PG8_BAR; PG8_WAIT_L(0); PG8_MMA(0, 1, At, B1); PG8_BAR;
            PG8_LDA(At, 1, 1); PG8_STAGE(PG8_SA(1, 0), a3, voffA);
            PG8_BAR; PG8_WAIT_L(0); PG8_MMA(1, 0, At, B0); PG8_BAR; PG8_SCHED;
            PG8_STAGE(PG8_SB(1, 1), b3 + hstep, voffB);
            PG8_WAIT_V(6); PG8_BAR; PG8_MMA(1, 1, At, B1); PG8_BAR;
            }
        }
        if constexpr (ALIGN_EPI) { if (wr == 0) PG8_BAR; }
        if constexpr (!Epi::AFTER_DRAIN) { E(acc, cur, wr, wc, fr, fq, wid, lane); S.done(cur); }
        if (!has_next) break;
#pragma unroll
        for (int a = 0; a < 2; ++a)
#pragma unroll
            for (int b = 0; b < 2; ++b)
#pragma unroll
                for (int m = 0; m < 4; ++m)
#pragma unroll
                    for (int n = 0; n < 2; ++n) acc[a][b][m][n] = (f32x4){0.f, 0.f, 0.f, 0.f};
        cur = nxt; cA = nA; cB = nB; ++ui;
        if constexpr (ALIGN_EPI) { if (wr == 1) PG8_BAR; }
    }
    PG8_WAIT_V(0);
    if constexpr (!ALIGN_EPI) { if (wr == 0) PG8_BAR; }
    PG8_BAR;
    if constexpr (Epi::AFTER_DRAIN) { E.fused(acc, cur, wr, wc, fr, fq, lds, wid, lane); S.done(cur); }
#undef PG8_SA
#undef PG8_SB
#undef PG8_STAGE
#undef PG8_LDA
#undef PG8_LDB
#undef PG8_MMA
#undef PG8_WAIT_V
#undef PG8_WAIT_L
#undef PG8_BAR
#undef PG8_SCHED
}
}
#ifndef PG8_SP2
#define PG8_SP2 true
#endif
#ifndef PG8_ALIGN
#define PG8_ALIGN true
#endif

constexpr int NWAVES = 8;
constexpr int DM = 1024, M = 49152, MP = 16384, INW = 2304, DFF = 2816, UPW = 5632;
constexpr int QA_OFF = 0, KA_OFF = 512, VA_OFF = 1024, QB_OFF = 1536, KB_OFF = 2048, VB_OFF = 2176;
constexpr int UP_TILES_M = 194;
constexpr float EPS = 1e-6f, LOG2E = 1.4426950408889634f;

constexpr size_t MiB = 1u << 20;
constexpr size_t WS_SSQ = 0;
constexpr size_t WS_SSQB = 768 * 1024;
constexpr size_t WS_SSQ1 = 512 * 1024;
constexpr size_t WS_BAR = 1 * MiB;
constexpr size_t WS_WIN = 2 * MiB, WS_WOUT = 7 * MiB, WS_WUP = 9 * MiB, WS_WDN = 20 * MiB;
constexpr size_t WS_XN = 32 * MiB;
constexpr size_t WS_PROJ = 130 * MiB;
constexpr size_t WS_OA = 346 * MiB;
constexpr size_t WS_H = 226 * MiB;
constexpr size_t WS_LA = 490 * MiB;
constexpr size_t WS_END = 496 * MiB;
static_assert(WS_XN + (size_t)(M + 256) * DM * 2 <= WS_PROJ && WS_PROJ + (size_t)M * INW * 2 <= WS_OA && WS_OA + 3 * (size_t)M * 512 * 2 <= WS_LA && WS_H + (size_t)M * DFF * 2 <= WS_LA && WS_PROJ + (size_t)M * DM * 2 <= WS_H, "d_ws map");

constexpr int RING_BYTES = 131072, XCH_OFF = RING_BYTES, MISC_OFF = XCH_OFF + 8192, LDS_BYTES = 147456;

#define LAS __attribute__((address_space(3)))
typedef unsigned short bf16;
typedef unsigned v4u __attribute__((ext_vector_type(4)));
typedef float f32x4 __attribute__((ext_vector_type(4)));
typedef float f32x16 __attribute__((ext_vector_type(16)));
typedef short bf16x8 __attribute__((ext_vector_type(8)));
typedef short s16x4 __attribute__((ext_vector_type(4)));
using pg8::cvtpk;
__device__ __forceinline__ float bf_lo(unsigned w) { return __uint_as_float(w << 16); }
__device__ __forceinline__ float bf_hi(unsigned w) { return __uint_as_float(w & 0xffff0000u); }
__device__ __forceinline__ float wave_sum(float v) {
#pragma unroll
    for (int o = 1; o < 64; o <<= 1) v += __shfl_xor(v, o);
    return v;
}
__device__ __forceinline__ float wave_max(float v) {
#pragma unroll
    for (int o = 1; o < 64; o <<= 1) v = fmaxf(v, __shfl_xor(v, o));
    return v;
}

#define GAS __attribute__((address_space(1)))
#define RLX_AGENT __ATOMIC_RELAXED, __HIP_MEMORY_SCOPE_AGENT
#define XB_TMO      128
#define XB_XCNT(j)  (256  + 64 * (j))
#define XB_XSUB(j)  (1280 + 64 * (j))
#define XB_XGEN(j)  (2304 + 64 * (j))
#define XB_TOP      3328
#define XB_TOPGEN   3392
#define XCD_BAR_WORDS 3456
#define XB_SPIN_CAP (1u << 18)

__device__ __forceinline__ unsigned xb_ld(unsigned* p)              { return __hip_atomic_load(p, __ATOMIC_RELAXED, __HIP_MEMORY_SCOPE_AGENT); }
__device__ __forceinline__ unsigned xb_add(unsigned* p, unsigned v) { return __hip_atomic_fetch_add(p, v, __ATOMIC_RELAXED, __HIP_MEMORY_SCOPE_AGENT); }
__device__ __forceinline__ unsigned xb_xcc_id() { return (unsigned)__builtin_amdgcn_s_getreg((3 << 11) | 20) & 0xFu; }
#define XB_SPIN(cond, bar) do { unsigned _sp = 0; while (cond) { __builtin_amdgcn_s_sleep(1); \
    if ((++_sp & 255u) == 0u) { if (xb_ld(&(bar)[XB_TMO])) break; if (_sp > XB_SPIN_CAP) { atomicAdd(&(bar)[XB_TMO], 1u); break; } } } } while (0)

struct XcdBarrier {
    unsigned* bar; unsigned x;
    volatile LAS unsigned* st;
};

__device__ __forceinline__ XcdBarrier xcd_barrier_post(unsigned* bar, volatile LAS unsigned* st) {
    XcdBarrier b; b.bar = bar; b.x = xb_xcc_id(); b.st = st;
    if (threadIdx.x == 0) (void)xb_add(&bar[XB_XCNT(b.x)], 1u);
    return b;
}
__device__ __forceinline__ void xcd_barrier_complete(unsigned* bar, unsigned x, unsigned& nloc, unsigned& nx) {
    const unsigned G = gridDim.x * gridDim.y * gridDim.z;
    unsigned sum, cnt, mine, sp = 0u;
    for (;;) {
        sum = 0u; cnt = 0u; mine = 0u;
#pragma unroll
        for (unsigned j = 0; j < 16; ++j) { const unsigned c = xb_ld(&bar[XB_XCNT(j)]); sum += c; cnt += (c > 0u) ? 1u : 0u; mine = (j == x) ? c : mine; }
        if (sum == G) break;
        __builtin_amdgcn_s_sleep(1);
        if ((++sp & 255u) == 0u) { if (xb_ld(&bar[XB_TMO])) break; if (sp > XB_SPIN_CAP) { atomicAdd(&bar[XB_TMO], 1u); break; } }
    }
    nloc = mine > 0u ? mine : 1u; nx = cnt > 0u ? cnt : 1u;
}

__device__ __forceinline__ void xcd_barrier(const XcdBarrier& b) {
    asm volatile("s_waitcnt vmcnt(0)" ::: "memory");
    __syncthreads();
    if (threadIdx.x == 0) {
        unsigned* bar = b.bar;
        __builtin_amdgcn_s_waitcnt(0);
        unsigned nloc = b.st[0], nx = b.st[1];
        if (nloc == 0u) { xcd_barrier_complete(bar, b.x, nloc, nx); b.st[0] = nloc; b.st[1] = nx; }
        const unsigned old = xb_add(&bar[XB_XSUB(b.x)], 1u);
        const unsigned gen = old / nloc;
        if (old + 1u == (gen + 1u) * nloc) {
            __builtin_amdgcn_fence(__ATOMIC_RELEASE, "agent");
            asm volatile("s_waitcnt vmcnt(0)" ::: "memory");
            const unsigned og = xb_add(&bar[XB_TOP], 1u);
            const unsigned tg = og / nx;
            if (og + 1u == (tg + 1u) * nx) xb_add(&bar[XB_TOPGEN], 1u);
            else XB_SPIN(xb_ld(&bar[XB_TOPGEN]) == tg, bar);
            __builtin_amdgcn_fence(__ATOMIC_ACQUIRE, "agent");
            xb_add(&bar[XB_XGEN(b.x)], 1u);
            asm volatile("s_waitcnt vmcnt(0)" ::: "memory");
        } else {
            XB_SPIN(xb_ld(&bar[XB_XGEN(b.x)]) == gen, bar);
            __builtin_amdgcn_fence(__ATOMIC_ACQUIRE, "agent");
            asm volatile("s_waitcnt vmcnt(0)" ::: "memory");
        }
    }
    __syncthreads();
}

template <int MAP  >
__device__ __forceinline__ void p0_transpose_item(const float* W, int K, int N, bf16* WT, const float* kgain, LAS float* scr, int item, int lane) {
    const int nblk = N / 32, kb = item / nblk, nb = item % nblk, k0 = 64 * kb, n0 = 32 * nb;
#pragma unroll 8
    for (int i = 0; i < 32; ++i) { const int kk = 2 * i + (lane >> 5); float v = W[(size_t)(k0 + kk) * N + n0 + (lane & 31)]; if (kgain) v *= kgain[k0 + kk]; scr[kk * 33 + (lane & 31)] = v; }
    asm volatile("s_waitcnt lgkmcnt(0)" ::: "memory");
    const int c = lane & 7;
    int r0 = n0;
    if (MAP == 2) { const int hs = n0 >> 6; r0 = 256 * (hs >> 2) + 128 * ((n0 >> 5) & 1) + 32 * (hs & 3); }
    if (MAP == 1) r0 = n0 < DFF ? ((n0 >> 7) * 256 + (n0 & 127)) : ((((n0 - DFF) >> 7) * 256) + 128 + ((n0 - DFF) & 127));
#pragma unroll
    for (int j = 0; j < 4; ++j) { const int n = (lane >> 3) + 8 * j; const LAS float* s = scr + (8 * c) * 33 + n;
        v4u o; o.x = cvtpk(s[0 * 33], s[1 * 33]); o.y = cvtpk(s[2 * 33], s[3 * 33]); o.z = cvtpk(s[4 * 33], s[5 * 33]); o.w = cvtpk(s[6 * 33], s[7 * 33]);
        const int nr = (MAP == 1) ? (8 * (2 * (n >> 4) + ((n >> 2) & 1)) + 4 * ((n >> 3) & 1) + (n & 3)) : n;
        *(v4u*)(WT + (size_t)(r0 + nr) * K + k0 + 8 * c) = o; }
    asm volatile("s_waitcnt lgkmcnt(0)" ::: "memory");
}
__device__ __forceinline__ void rows4_to_bf16(const float* xrow, bf16* orow, float* ssq, int lane) {
    f32x4 v[4][4]; float s[4];
#pragma unroll
    for (int k = 0; k < 4; ++k)
#pragma unroll
        for (int j = 0; j < 4; ++j) v[k][j] = ((const f32x4*)(xrow + (size_t)k * DM) + lane)[64 * j];
#pragma unroll
    for (int k = 0; k < 4; ++k) { s[k] = 0.f;
#pragma unroll
        for (int j = 0; j < 4; ++j) s[k] += (v[k][j].x * v[k][j].x + v[k][j].y * v[k][j].y) + (v[k][j].z * v[k][j].z + v[k][j].w * v[k][j].w);
        unsigned long long* o8 = (unsigned long long*)(orow + (size_t)k * DM) + lane;
#pragma unroll
        for (int j = 0; j < 4; ++j) o8[64 * j] = (unsigned long long)cvtpk(v[k][j].x, v[k][j].y) | ((unsigned long long)cvtpk(v[k][j].z, v[k][j].w) << 32); }
#pragma unroll
    for (int o = 1; o < 64; o <<= 1) {
#pragma unroll
        for (int k = 0; k < 4; ++k) s[k] += __shfl_xor(s[k], o); }
    if (lane < 4) ssq[lane] = lane == 0 ? s[0] : lane == 1 ? s[1] : lane == 2 ? s[2] : s[3];
}

template <int NKEYS, int NTHR>
__device__ __forceinline__ void stage_load(v4u (&kr)[NKEYS * 8 / NTHR], v4u (&vr)[NKEYS * 8 / NTHR], const bf16* kbase, const bf16* vbase, int tok0, int dshift, int kidx0, int Ls, int t) {
    constexpr int NIT = NKEYS * 8 / NTHR;
    const int c = t & 7;
#pragma unroll
    for (int it = 0; it < NIT; ++it) { const int rho = (it * NTHR + t) >> 3, kidx = kidx0 + rho; const bool ok = (unsigned)kidx < (unsigned)Ls;
        const size_t off = (size_t)(tok0 + ((ok ? kidx : 0) << dshift)) * 64 + 8 * c;
        kr[it] = *(const v4u*)(kbase + off); vr[it] = *(const v4u*)(vbase + off); }
}
template <int NKEYS, int NTHR>
__device__ __forceinline__ void stage_write(const v4u (&kr)[NKEYS * 8 / NTHR], const v4u (&vr)[NKEYS * 8 / NTHR], LAS unsigned char* Kl, LAS unsigned char* Vl, int t) {
    constexpr int NIT = NKEYS * 8 / NTHR;
    const int c = t & 7;
#pragma unroll
    for (int it = 0; it < NIT; ++it) { const int rho = (it * NTHR + t) >> 3;
        *(LAS v4u*)(Kl + rho * 128 + 16 * (c ^ ((rho >> 1) & 7))) = kr[it];
        *(LAS v4u*)(Vl + (c >> 2) * (NKEYS * 64) + rho * 64 + (c & 3) * 16) = vr[it]; }
}
__device__ __forceinline__ void load_q_raw(v4u (&raw)[4], const bf16* qrow, int lane) {
#pragma unroll
    for (int d0 = 0; d0 < 4; ++d0) raw[d0] = *(const v4u*)(qrow + 16 * d0 + 8 * (lane >> 5));
}
typedef short v4i16_t __attribute__((ext_vector_type(4)));
__device__ __forceinline__ s16x4 vtr(const LAS unsigned char* p) { return __builtin_bit_cast(s16x4, __builtin_amdgcn_ds_read_tr16_b64_v4i16((LAS v4i16_t*)p)); }
template <int R, int CS>
__device__ __forceinline__ void build_bias_table(LAS float* tab, float nslope, float negM, int t, int nthr) {
    for (int idx = t; idx < 4 * CS; idx += nthr) { const int k = idx / CS, m = idx - k * CS, rel = m + k - (R + 32); const int ar = rel < 0 ? -rel : rel;
        tab[idx] = ar <= R ? __builtin_fmaf((float)ar, nslope, negM) : -__builtin_inff(); }
}
__device__ __forceinline__ void attn_tile(const bf16x8 (&kf)[4], const LAS float* tb, unsigned vaddr, int vhs, const bf16x8 (&qf)[4], f32x16 (&o)[2], float& l) {
    s16x4 vl[4], vh[4];
    asm volatile("ds_read_b64_tr_b16 %0, %8\n\tds_read_b64_tr_b16 %1, %8 offset:512\n\tds_read_b64_tr_b16 %2, %8 offset:1024\n\tds_read_b64_tr_b16 %3, %8 offset:1536\n\t"
                 "ds_read_b64_tr_b16 %4, %9\n\tds_read_b64_tr_b16 %5, %9 offset:512\n\tds_read_b64_tr_b16 %6, %9 offset:1024\n\tds_read_b64_tr_b16 %7, %9 offset:1536"
                 : "=&v"(vl[0]), "=&v"(vh[0]), "=&v"(vl[1]), "=&v"(vh[1]), "=&v"(vl[2]), "=&v"(vh[2]), "=&v"(vl[3]), "=&v"(vh[3]) : "v"(vaddr), "v"(vaddr + (unsigned)vhs) : "memory");
    const f32x4 c0 = *(const LAS f32x4*)(tb), c1 = *(const LAS f32x4*)(tb + 8), c2 = *(const LAS f32x4*)(tb + 16), c3 = *(const LAS f32x4*)(tb + 24);
    f32x16 s = {c0[0], c0[1], c0[2], c0[3], c1[0], c1[1], c1[2], c1[3], c2[0], c2[1], c2[2], c2[3], c3[0], c3[1], c3[2], c3[3]};
#pragma unroll
    for (int d0 = 0; d0 < 4; ++d0) s = __builtin_amdgcn_mfma_f32_32x32x16_bf16(kf[d0], qf[d0], s, 0, 0, 0);
    float pr[16];
#pragma unroll
    for (int r = 0; r < 16; ++r) { const float p = __builtin_amdgcn_exp2f(s[r]); l += p; pr[r] = p; }
    v4u w0, w1; w0.x = cvtpk(pr[0], pr[1]); w0.y = cvtpk(pr[2], pr[3]); w0.z = cvtpk(pr[4], pr[5]); w0.w = cvtpk(pr[6], pr[7]);
    w1.x = cvtpk(pr[8], pr[9]); w1.y = cvtpk(pr[10], pr[11]); w1.z = cvtpk(pr[12], pr[13]); w1.w = cvtpk(pr[14], pr[15]);
    const bf16x8 pa0 = __builtin_bit_cast(bf16x8, w0), pa1 = __builtin_bit_cast(bf16x8, w1);
    asm volatile("s_waitcnt lgkmcnt(0)" : "+v"(vl[0]), "+v"(vh[0]), "+v"(vl[1]), "+v"(vh[1]), "+v"(vl[2]), "+v"(vh[2]), "+v"(vl[3]), "+v"(vh[3]) :: "memory");
#pragma unroll
    for (int dh = 0; dh < 2; ++dh)
#pragma unroll
        for (int s2 = 0; s2 < 2; ++s2) { const s16x4 lo = vl[2 * dh + s2], h4 = vh[2 * dh + s2];
            const bf16x8 vf = (bf16x8){lo[0], lo[1], lo[2], lo[3], h4[0], h4[1], h4[2], h4[3]};
            o[dh] = __builtin_amdgcn_mfma_f32_32x32x16_bf16(vf, s2 ? pa1 : pa0, o[dh], 0, 0, 0); }
}
template <int NT, int CS>
__device__ __forceinline__ void attn_task(const LAS unsigned char* Kl, const LAS unsigned char* Vl, int vhs, int row0, int kidx_t0, int Ls, const bf16x8 (&qf)[4], const LAS float* tab, f32x16 (&o)[2], float& l, int lane) {
    const int q = lane & 31, hi = lane >> 5;
    const unsigned va0 = (unsigned)(uintptr_t)(Vl + row0 * 64 + (4 * hi + ((lane & 15) >> 2)) * 64 + (16 * ((lane >> 4) & 1) + 4 * (lane & 3)) * 2);
    const int sw = (q >> 1) & 7;
    const LAS unsigned char* kp0 = Kl + (row0 + q) * 128 + 16 * ((0 + hi) ^ sw); const LAS unsigned char* kp1 = Kl + (row0 + q) * 128 + 16 * ((2 + hi) ^ sw);
    const LAS unsigned char* kp2 = Kl + (row0 + q) * 128 + 16 * ((4 + hi) ^ sw); const LAS unsigned char* kp3 = Kl + (row0 + q) * 128 + 16 * ((6 + hi) ^ sw);
    int b = 32 - q + 4 * hi; asm volatile("" : "+v"(b));
    const LAS float* tb0 = tab + (b & 3) * CS + (b & ~3);
#define LOADK(dst, jj) do { dst[0] = *(const LAS bf16x8*)(kp0 + (jj) * 4096); dst[1] = *(const LAS bf16x8*)(kp1 + (jj) * 4096); dst[2] = *(const LAS bf16x8*)(kp2 + (jj) * 4096); dst[3] = *(const LAS bf16x8*)(kp3 + (jj) * 4096); } while (0)
    bf16x8 kf[4];
#pragma unroll 1
    for (int j = 0; j < NT; ++j) {
        if ((unsigned)(kidx_t0 + 32 * j) < (unsigned)Ls) {
            LOADK(kf, j);
            attn_tile(kf, tb0 + 32 * j, va0 + j * 2048, vhs, qf, o, l); }
    }
#undef LOADK
}
__device__ __forceinline__ void store_partial(const f32x16 (&o)[2], float l, bf16* OBuf, float* LB, int tokq0, int dshift, int h, int lane) {
    const int hi = lane >> 5, q = lane & 31; const size_t row = (size_t)h * M + (size_t)(tokq0 + (q << dshift));
    l += __shfl_xor(l, 32);
    if (hi == 0) LB[row] = l;
    bf16* p = OBuf + row * 64 + 8 * hi;
#pragma unroll
    for (int dh = 0; dh < 2; ++dh)
#pragma unroll
        for (int t = 0; t < 2; ++t) { const int ge = 2 * t, go = 2 * t + 1;
            const unsigned x0 = cvtpk(o[dh][4 * ge], o[dh][4 * ge + 1]), x1 = cvtpk(o[dh][4 * ge + 2], o[dh][4 * ge + 3]);
            const unsigned y0 = cvtpk(o[dh][4 * go], o[dh][4 * go + 1]), y1 = cvtpk(o[dh][4 * go + 2], o[dh][4 * go + 3]);
            const auto r0 = __builtin_amdgcn_permlane32_swap(x0, y0, false, false), r1 = __builtin_amdgcn_permlane32_swap(x1, y1, false, false);
            v4u w; w.x = r0[0]; w.y = r1[0]; w.z = r0[1]; w.w = r1[1];
            *(v4u*)(p + 32 * dh + 16 * t) = w; }
}
__device__ __forceinline__ void store_final_b(f32x16 (&o)[2], float l, float sinkterm, bf16* Yb, float* ssqb, int tokq0, int h, int lane) {
    const int hi = lane >> 5, q = lane & 31; const size_t tok = (size_t)(tokq0 + q);
    l += __shfl_xor(l, 32);
    const float inv = __builtin_amdgcn_rcpf(l + sinkterm);
    float ss = 0.f;
#pragma unroll
    for (int dh = 0; dh < 2; ++dh)
#pragma unroll
        for (int r = 0; r < 16; ++r) { o[dh][r] *= inv; ss += o[dh][r] * o[dh][r]; }
    ss += __shfl_xor(ss, 32);
    if (hi == 0) unsafeAtomicAdd(ssqb + tok, ss);
    bf16* p = Yb + tok * DM + 512 + h * 64 + 8 * hi;
#pragma unroll
    for (int dh = 0; dh < 2; ++dh)
#pragma unroll
        for (int t = 0; t < 2; ++t) { const int ge = 2 * t, go = 2 * t + 1;
            const unsigned x0 = cvtpk(o[dh][4 * ge], o[dh][4 * ge + 1]), x1 = cvtpk(o[dh][4 * ge + 2], o[dh][4 * ge + 3]);
            const unsigned y0 = cvtpk(o[dh][4 * go], o[dh][4 * go + 1]), y1 = cvtpk(o[dh][4 * go + 2], o[dh][4 * go + 3]);
            const auto r0 = __builtin_amdgcn_permlane32_swap(x0, y0, false, false), r1 = __builtin_amdgcn_permlane32_swap(x1, y1, false, false);
            v4u w; w.x = r0[0]; w.y = r1[0]; w.z = r0[1]; w.w = r1[1];
            *(v4u*)(p + 32 * dh + 16 * t) = w; }
}
struct AUnit { int tok0, dshift, Ls, cc, h, c; };
__device__ __forceinline__ AUnit decode_a(int su) {
    AUnit a; const int sidx = su / 48, k = su % 48, blk = sidx >> 3; a.h = sidx & 7; a.c = 2 - (k >> 4); a.dshift = 2 * a.c; const int kk = k & 15;
    int seq0, S, bis; if (blk < 8) { seq0 = 0; S = 16384; bis = blk; } else { seq0 = MP + 2048 * (blk - 8); S = 2048; bis = 0; }
    a.Ls = S >> a.dshift; const int lcpb = 4 - a.dshift  , res = kk >> lcpb; a.cc = (bis << lcpb) + (kk & ((1 << lcpb) - 1)); a.tok0 = seq0 + res; return a;
}
struct BUnit { int seq0, S, lcb, g2; };
__device__ __forceinline__ BUnit decode_b(int u) {
    BUnit b; b.g2 = u / 768; const int cb = u % 768;
    if (cb < 256) { b.seq0 = 0; b.S = 16384; b.lcb = cb; } else { b.seq0 = MP + 2048 * ((cb - 256) >> 5); b.S = 2048; b.lcb = (cb - 256) & 31; } return b;
}

#define LDS_BAR() asm volatile("s_waitcnt lgkmcnt(0)\n\ts_barrier" ::: "memory")
#define xp (args.in[0])
#define xs (args.in[1])
#define norm1 (args.in[2])
#define w_in (args.in[3])
#define qna (args.in[4])
#define kna (args.in[5])
#define qnb (args.in[6])
#define knb (args.in[7])
#define sinkb (args.in[8])
#define ona (args.in[9])
#define onb (args.in[10])
#define w_out (args.in[11])
#define norm2 (args.in[12])
#define w_up (args.in[13])
#define conv_w (args.in[14])
#define conv_b (args.in[15])
#define w_down (args.in[16])
#define out (args.dout)
#define SSQ ((float*)(args.ws + WS_SSQ))
#define SSQ1 ((float*)(args.ws + WS_SSQ1))
#define SSQB ((float*)(args.ws + WS_SSQB))
#define WIN ((bf16*)(args.ws + WS_WIN))
#define WOUT ((bf16*)(args.ws + WS_WOUT))
#define WUP ((bf16*)(args.ws + WS_WUP))
#define WDN ((bf16*)(args.ws + WS_WDN))
#define XN ((bf16*)(args.ws + WS_XN) + DM)
#define PROJ ((bf16*)(args.ws + WS_PROJ))
#define Y ((bf16*)args.dout)
#define OA ((bf16*)(args.ws + WS_OA))
#define OB ((bf16*)args.dout)
#define HB ((bf16*)(args.ws + WS_H))
#define LA ((float*)(args.ws + WS_LA))
#define LBp ((float*)(args.ws + WS_LA) + 3 * (size_t)M * 8)
struct Args { const float* in[17]; float* dout; unsigned char* ws; };
__global__ void __launch_bounds__(NWAVES * 64, 2) fwd_megakernel(Args args) {
    extern __shared__ __attribute__((aligned(16))) unsigned char lds_raw[];
    cg::grid_group grid = cg::this_grid();
    LAS unsigned char* lds = (LAS unsigned char*)lds_raw;
    const int tid = threadIdx.x, lane = tid & 63, wave = __builtin_amdgcn_readfirstlane(tid >> 6);
    const int G = gridDim.x, bx = blockIdx.x;
    if (tid < 2) ((LAS unsigned*)(lds + MISC_OFF))[tid] = 0u;
    const int gw = bx * NWAVES + wave, NGW = G * NWAVES;
    __syncthreads();
    XcdBarrier bar = xcd_barrier_post((unsigned*)(args.ws + WS_BAR), (volatile LAS unsigned*)(lds + MISC_OFF));
    if (args.ws == nullptr) grid.sync();

    {
        LAS float* scr = (LAS float*)(lds + wave * 16384);
        constexpr int I_IN = (DM / 64) * (INW / 32), I_OUT = (DM / 64) * (DM / 32), I_UP = (DM / 64) * (UPW / 32), I_DN = (DFF / 64) * (DM / 32);
        for (int it = gw; it < I_IN + I_OUT + I_UP + I_DN; it += NGW) {
            int r = it;
            if (r < I_IN) { p0_transpose_item<2>(w_in, DM, INW, WIN, norm1, scr, r, lane); continue; } r -= I_IN;
            if (r < I_OUT) { p0_transpose_item<0>(w_out, DM, DM, WOUT, (r / (DM / 32)) >= 8 ? onb - 512 : nullptr, scr, r, lane); continue; } r -= I_OUT;
            if (r < I_UP) { p0_transpose_item<1>(w_up, DM, UPW, WUP, norm2, scr, r, lane); continue; } r -= I_UP;
            p0_transpose_item<0>(w_down, DFF, DM, WDN, nullptr, scr, r, lane);
        }
        for (int m = gw * 4; m < M; m += NGW * 4) rows4_to_bf16(m < MP ? xp + (size_t)m * DM : xs + (size_t)(m - MP) * DM, XN + (size_t)m * DM, SSQ1 + m, lane);
        for (int i = bx * 512 + tid; i < M; i += G * 512) { SSQ[i] = 0.f; SSQB[i] = 0.f; }
    }
    xcd_barrier(bar);

    {
        pg8::Gemm g{XN, WIN, M, INW, DM, 256}; pg8::StaticOrder S; S.init(M, INW, G, bx);
        pg8::EpiProj E{PROJ, SSQ1, qna, kna, qnb, knb};
        pg8::gemm_phase<pg8::EpiProj, pg8::StaticOrder, PG8_ALIGN, PG8_SP2>(lds, g, S, E);
    }
    xcd_barrier(bar);

    {
        const float gqa = fabsf(qna[lane]), gka = fabsf(kna[lane]);
        const float boundA = __builtin_bit_cast(float, __builtin_amdgcn_readfirstlane(__builtin_bit_cast(int, 8.0f * wave_max(gqa) * wave_max(gka) * LOG2E)));
        const float negMa = boundA > 40.f ? -boundA : 0.f;
        {
            const int half = wave >> 2, w4 = wave & 3, th = tid & 255;
            LAS unsigned char* Kl = lds + half * 65536; LAS unsigned char* Vl = Kl + 32768;
            LAS float* tabA = (LAS float*)(lds + XCH_OFF);
            const int ubase = (G == 256) ? (bx & 7) * 576 + (bx >> 3) : bx, ustep = (G == 256) ? 32 : G, uend = (G == 256) ? (bx & 7) * 576 + 576 : 4608;
            v4u kr[8], vr[8], qraw[4]; AUnit nx = decode_a(2 * ubase + half);
            if (ubase < uend) { stage_load<256, 256>(kr, vr, PROJ + (size_t)(8 + nx.h) * M * 64, PROJ + (size_t)(16 + nx.h) * M * 64, nx.tok0, nx.dshift, 128 * nx.cc - 64, nx.Ls, th);
                load_q_raw(qraw, PROJ + ((size_t)nx.h * M + (nx.tok0 + ((128 * nx.cc + 32 * w4 + (lane & 31)) << nx.dshift))) * 64, lane); }
            for (int u = ubase; u < uend; u += ustep) {
                const AUnit a = nx;
                LDS_BAR();
                stage_write<256, 256>(kr, vr, Kl, Vl, th);
                build_bias_table<64, 208>(tabA, -__builtin_amdgcn_exp2f(-0.5f * (float)(a.h + 9) + (float)a.dshift) * LOG2E, negMa, tid, 512);
                bf16x8 qf[4];
#pragma unroll
                for (int d0 = 0; d0 < 4; ++d0) qf[d0] = __builtin_bit_cast(bf16x8, qraw[d0]);
                LDS_BAR();
                if (u + ustep < uend) { nx = decode_a(2 * (u + ustep) + half);
                    stage_load<256, 256>(kr, vr, PROJ + (size_t)(8 + nx.h) * M * 64, PROJ + (size_t)(16 + nx.h) * M * 64, nx.tok0, nx.dshift, 128 * nx.cc - 64, nx.Ls, th);
                    load_q_raw(qraw, PROJ + ((size_t)nx.h * M + (nx.tok0 + ((128 * nx.cc + 32 * w4 + (lane & 31)) << nx.dshift))) * 64, lane); }
                const int iq0 = 128 * a.cc + 32 * w4;
                f32x16 o[2]; float l = 0.f;
#pragma unroll
                for (int r = 0; r < 16; ++r) { o[0][r] = 0.f; o[1][r] = 0.f; }
                attn_task<5, 208>(Kl, Vl, 256 * 64, 32 * w4, iq0 - 64, a.Ls, qf, tabA, o, l, lane);
                asm volatile("s_nop 15\n\ts_nop 7" ::: "memory");
                store_partial(o, l, OA + (size_t)a.c * M * 512, LA + (size_t)a.c * M * 8, a.tok0 + (iq0 << a.dshift), a.dshift, a.h, lane);
            }
        }
        const float gqb = fabsf(qnb[lane]), gkb = fabsf(knb[lane]);
        const float boundB = __builtin_bit_cast(float, __builtin_amdgcn_readfirstlane(__builtin_bit_cast(int, 8.0f * wave_max(gqb) * wave_max(gkb) * LOG2E)));
        const float negMb = boundB > 40.f ? -boundB : 0.f;
        {
            LAS unsigned char* Kb = lds; LAS unsigned char* Vb = lds + 40960;
            LAS float* tabB = (LAS float*)(lds + 81920);
            const int ubase = (G == 256) ? (bx & 7) * 192 + (bx >> 3) : bx, ustep = (G == 256) ? 32 : G, uend = (G == 256) ? (bx & 7) * 192 + 192 : 1536;
            v4u kr[5], vr[5], qraw[4]; BUnit nx = decode_b(ubase);
            if (ubase < uend) { stage_load<320, 512>(kr, vr, PROJ + (size_t)(32 + nx.g2) * M * 64, PROJ + (size_t)(34 + nx.g2) * M * 64, nx.seq0, 0, 64 * nx.lcb - 128, nx.S, tid);
                load_q_raw(qraw, PROJ + ((size_t)(24 + 4 * nx.g2 + (wave >> 1)) * M + (nx.seq0 + 64 * nx.lcb + 32 * (wave & 1) + (lane & 31))) * 64, lane); }
            for (int u = ubase; u < uend; u += ustep) {
                const BUnit b = nx;
                LDS_BAR();
                stage_write<320, 512>(kr, vr, Kb, Vb, tid);
                build_bias_table<128, 336>(tabB + (tid >> 7) * (4 * 336), -__builtin_amdgcn_exp2f(-0.5f * (float)(4 * b.g2 + (tid >> 7) + 1)) * LOG2E, negMb, tid & 127, 128);
                bf16x8 qf[4];
#pragma unroll
                for (int d0 = 0; d0 < 4; ++d0) qf[d0] = __builtin_bit_cast(bf16x8, qraw[d0]);
                LDS_BAR();
                if (u + ustep < uend) { nx = decode_b(u + ustep);
                    stage_load<320, 512>(kr, vr, PROJ + (size_t)(32 + nx.g2) * M * 64, PROJ + (size_t)(34 + nx.g2) * M * 64, nx.seq0, 0, 64 * nx.lcb - 128, nx.S, tid);
                    load_q_raw(qraw, PROJ + ((size_t)(24 + 4 * nx.g2 + (wave >> 1)) * M + (nx.seq0 + 64 * nx.lcb + 32 * (wave & 1) + (lane & 31))) * 64, lane); }
                const int hb = 4 * b.g2 + (wave >> 1), iq0 = 64 * b.lcb + 32 * (wave & 1);
                f32x16 o[2]; float l = 0.f;
#pragma unroll
                for (int r = 0; r < 16; ++r) { o[0][r] = 0.f; o[1][r] = 0.f; }
                attn_task<9, 336>(Kb, Vb, 320 * 64, 32 * (wave & 1), iq0 - 128, b.S, qf, tabB + (wave >> 1) * (4 * 336), o, l, lane);
                asm volatile("s_nop 15\n\ts_nop 7" ::: "memory");
                store_final_b(o, l, __builtin_amdgcn_exp2f(sinkb[hb] * LOG2E + negMb), Y, SSQB, b.seq0 + iq0, hb, lane);
            }
        }
        xcd_barrier(bar);
        {
            const int hh = lane >> 3;
            const f32x4 ga0 = *(const f32x4*)(ona + 8 * lane), ga1 = *(const f32x4*)(ona + 8 * lane + 4);
            for (int m0 = gw * 4; m0 < M; m0 += NGW * 4) {
                v4u wa[4][3]; float la[4];
#pragma unroll
                for (int k = 0; k < 4; ++k) { const int m = m0 + k; la[k] = 0.f;
#pragma unroll
                    for (int c = 0; c < 3; ++c) { wa[k][c] = *(const v4u*)(OA + (((size_t)c * 8 + hh) * M + m) * 64 + 8 * (lane & 7)); la[k] += LA[((size_t)c * 8 + hh) * M + m]; } }
                float ya[4][8], sa[4];
#pragma unroll
                for (int k = 0; k < 4; ++k) { const float ia = __builtin_amdgcn_rcpf(la[k]);
                    ya[k][0] = (bf_lo(wa[k][0].x) + bf_lo(wa[k][1].x) + bf_lo(wa[k][2].x)) * ia; ya[k][1] = (bf_hi(wa[k][0].x) + bf_hi(wa[k][1].x) + bf_hi(wa[k][2].x)) * ia;
                    ya[k][2] = (bf_lo(wa[k][0].y) + bf_lo(wa[k][1].y) + bf_lo(wa[k][2].y)) * ia; ya[k][3] = (bf_hi(wa[k][0].y) + bf_hi(wa[k][1].y) + bf_hi(wa[k][2].y)) * ia;
                    ya[k][4] = (bf_lo(wa[k][0].z) + bf_lo(wa[k][1].z) + bf_lo(wa[k][2].z)) * ia; ya[k][5] = (bf_hi(wa[k][0].z) + bf_hi(wa[k][1].z) + bf_hi(wa[k][2].z)) * ia;
                    ya[k][6] = (bf_lo(wa[k][0].w) + bf_lo(wa[k][1].w) + bf_lo(wa[k][2].w)) * ia; ya[k][7] = (bf_hi(wa[k][0].w) + bf_hi(wa[k][1].w) + bf_hi(wa[k][2].w)) * ia;
                    sa[k] = 0.f;
#pragma unroll
                    for (int i = 0; i < 8; ++i) sa[k] += ya[k][i] * ya[k][i]; }
#pragma unroll
                for (int o = 1; o < 64; o <<= 1) {
#pragma unroll
                    for (int k = 0; k < 4; ++k) sa[k] += __shfl_xor(sa[k], o); }
#pragma unroll
                for (int k = 0; k < 4; ++k) { const int m = m0 + k;
                    const float ra = __builtin_amdgcn_rsqf(sa[k] * (1.f / 512.f) + EPS);
                    v4u oa;
                    oa.x = cvtpk(ya[k][0] * ra * ga0.x, ya[k][1] * ra * ga0.y); oa.y = cvtpk(ya[k][2] * ra * ga0.z, ya[k][3] * ra * ga0.w); oa.z = cvtpk(ya[k][4] * ra * ga1.x, ya[k][5] * ra * ga1.y); oa.w = cvtpk(ya[k][6] * ra * ga1.z, ya[k][7] * ra * ga1.w);
                    *(v4u*)(Y + (size_t)m * DM + 8 * lane) = oa; }
            }
        }
    }
    xcd_barrier(bar);

    {
        pg8::Gemm g{Y, WOUT, M, DM, DM, 256}; pg8::StaticOrder S; S.init(M, DM, G, bx);
        pg8::EpiOut E{XN, SSQ, SSQB};
        pg8::gemm_phase<pg8::EpiOut, pg8::StaticOrder, PG8_ALIGN, PG8_SP2>(lds, g, S, E);
    }
    xcd_barrier(bar);

    {
        pg8::Gemm g{XN - DM, WUP, UP_TILES_M * 256, UPW, DM, 254}; pg8::StaticOrder S; S.init(UP_TILES_M * 256, UPW, G, bx);
        pg8::EpiUp E{HB, SSQ, conv_w, conv_b, (LAS float*)(lds + XCH_OFF)};
        pg8::gemm_phase<pg8::EpiUp, pg8::StaticOrder, true, PG8_SP2>(lds, g, S, E);
    }
    xcd_barrier(bar);

    {
        pg8::Gemm g{HB, WDN, M, DM, DFF, 256}; pg8::StaticOrder S; S.init(M, DM, G, bx);
        pg8::EpiDown E{XN, out};
        pg8::gemm_phase<pg8::EpiDown, pg8::StaticOrder, PG8_ALIGN, PG8_SP2>(lds, g, S, E);
    }
}

#undef out
#undef xp
#undef xs
extern "C" void kernel_launch(void* const* d_in, const int* in_sizes, int n_in, void* d_out, int out_size, void* d_ws, size_t ws_size, hipStream_t stream) {
    static int grid = 0;
    if (grid == 0) {
        if (n_in != 17 || out_size != M * DM || ws_size < WS_END) { fprintf(stderr, "kernel_launch: unexpected shapes (n_in %d out %d ws %zu)\n", n_in, out_size, ws_size); grid = -1; return; }
        int dev = 0, cus = 0, per_cu = 0;
        hipGetDevice(&dev); hipDeviceGetAttribute(&cus, hipDeviceAttributeMultiprocessorCount, dev);
        if (hipFuncSetAttribute((const void*)fwd_megakernel, hipFuncAttributeMaxDynamicSharedMemorySize, LDS_BYTES) != hipSuccess) { fprintf(stderr, "kernel_launch: hipFuncSetAttribute failed\n"); grid = -1; return; }
        if (hipOccupancyMaxActiveBlocksPerMultiprocessor(&per_cu, (const void*)fwd_megakernel, NWAVES * 64, LDS_BYTES) != hipSuccess || per_cu < 1) { fprintf(stderr, "kernel_launch: occupancy query says %d\n", per_cu); per_cu = 1; }
        (void)hipGetLastError();
        grid = cus;
        fprintf(stderr, "kernel_launch: grid %d (per_cu %d)\n", grid, per_cu);
    }
    if (grid < 0) return;
    Args a{};
    for (int i = 0; i < 17; ++i) a.in[i] = (const float*)d_in[i];
    a.dout = (float*)d_out; a.ws = (unsigned char*)d_ws;
    void* kargs[] = {&a};
    if (hipMemsetAsync((char*)d_ws + WS_BAR, 0, XCD_BAR_WORDS * 4, stream) != hipSuccess) { fprintf(stderr, "kernel_launch: hipMemsetAsync failed\n"); return; }
    hipError_t e = hipLaunchCooperativeKernel((const void*)fwd_megakernel, dim3(grid), dim3(NWAVES * 64), kargs, LDS_BYTES, stream);
    if (e != hipSuccess) fprintf(stderr, "kernel_launch: cooperative launch failed: %s\n", hipGetErrorString(e));
}
```

```cpp
#include <hip/hip_runtime.h>
#include <hip/hip_cooperative_groups.h>
#include <cstdio>
#include <cstdint>
namespace cg = cooperative_groups;
namespace pg8 {
#define PG8_LAS __attribute__((address_space(3)))
typedef unsigned short bf16_t;
typedef short bf16x8 __attribute__((ext_vector_type(8)));
typedef float f32x4 __attribute__((ext_vector_type(4)));
typedef unsigned u32x4 __attribute__((ext_vector_type(4)));
constexpr int BM = 256, BK = 64, HALF = 128, HTB = HALF * BK * 2  , STAGE_BYTES = 8 * HTB, NXCD = 8, WGM = 8;

__host__ __device__ __forceinline__ int lds_byte(int r, int c) { const int st = (r >> 4) * 2 + (c >> 5), rr = r & 15, cc = c & 31, ob = rr * 64 + cc * 2; return st * 1024 + (ob ^ (((ob >> 9) & 1) << 5)); }
__host__ __device__ __forceinline__ void stage_rc(int b, int& R, int& C) { const int st = b / 1024, sb = b % 1024, swz = sb ^ (((sb >> 9) & 1) << 5); R = (st >> 1) * 16 + swz / 64; C = (st & 1) * 32 + (swz % 64) / 2; }
__host__ __device__ __forceinline__ int perm32(int rho) { const int n = rho >> 4, i = rho & 15; return 8 * (i >> 2) + 4 * n + (i & 3); }

struct Unit { int pm, pn; };
struct Gemm { const bf16_t* A; const bf16_t* Bt; int M, N, K; int a_tile_rows; };

struct StaticOrder {
    int nM, nN, nwg, G, c;
    __host__ __device__ void init(int M, int N, int G_, int c_) { nM = M / BM; nN = N / BM; nwg = nM * nN; G = G_; c = c_; }
    __host__ __device__ bool next(int i, Unit& u) const {
        const long L = (long)i * G + c; if (L >= nwg) return false;
        int wgid = (int)L; { const int q = nwg / NXCD, r = nwg % NXCD, xcd = wgid % NXCD, off = wgid / NXCD; wgid = (xcd < r ? xcd * (q + 1) : r * (q + 1) + (xcd - r) * q) + off; }
        const int nig = WGM * nN, gid = wgid / nig, fm = gid * WGM, gsz = (nM - fm) < WGM ? (nM - fm) : WGM;
        u.pm = fm + ((wgid % nig) % gsz); u.pn = (wgid % nig) / gsz; return true;
    }
    __device__ __forceinline__ void a_ready(const Unit&) const {}
    __device__ __forceinline__ void done(const Unit&) const {}
};

__device__ __forceinline__ unsigned cvt_pk_bf16(float lo, float hi) { unsigned r; asm volatile("v_cvt_pk_bf16_f32 %0, %1, %2" : "=v"(r) : "v"(lo), "v"(hi)); return r; }
typedef float f32x2 __attribute__((ext_vector_type(2))); typedef __bf16 bf16x2_t __attribute__((ext_vector_type(2)));
__device__ __forceinline__ unsigned cvtpk(float lo, float hi) { f32x2 v = {lo, hi}; bf16x2_t b = __builtin_convertvector(v, bf16x2_t); return __builtin_bit_cast(unsigned, b); }
constexpr int MTOK = 49152, MPROMPT = 16384, DMODEL = 1024, DFF_ = 2816;
__device__ __forceinline__ u32x4 pack8(const f32x4 a, const f32x4 b) { u32x4 w; w.x = cvtpk(a[0], a[1]); w.y = cvtpk(a[2], a[3]); w.z = cvtpk(b[0], b[1]); w.w = cvtpk(b[2], b[3]); return w; }

struct EpiProj {
    static constexpr bool PERM = true, AFTER_DRAIN = false; static constexpr int MIDK = 0;
    bf16_t* O; const float* ssq1; const float* gqa; const float* gka; const float* gqb; const float* gkb;
    __device__ __forceinline__ void operator()(f32x4 (&acc)[2][2][4][2], const Unit& u, int wr, int wc, int fr, int fq, int wid, int lane) const {
        const int hs = 4 * u.pn + wc;
        const float* g = nullptr; float sc = 1.f;
        if (hs < 8) { g = gqa; sc = 0.125f * 1.4426950408889634f; } else if (hs < 16) g = gka; else if (hs >= 24 && hs < 32) { g = gqb; sc = 0.125f * 1.4426950408889634f; } else if (hs >= 32 && hs < 34) g = gkb;
        const int row0 = u.pm * BM + wr * 64 + fr;
        bf16_t* obase = O + ((size_t)hs * MTOK + row0) * 64 + 8 * fq;
#pragma unroll
        for (int ai = 0; ai < 2; ++ai)
#pragma unroll
            for (int m = 0; m < 4; ++m) { const float r1 = __builtin_amdgcn_rsqf(ssq1[row0 + ai * HALF + m * 16] * (1.0f / DMODEL) + 1e-6f);
#pragma unroll
                for (int bj = 0; bj < 2; ++bj)
#pragma unroll
                    for (int n = 0; n < 2; ++n) acc[ai][bj][m][n] *= r1; }
        if (g) {
            f32x4 gg[2][2];
#pragma unroll
            for (int bj = 0; bj < 2; ++bj)
#pragma unroll
                for (int n = 0; n < 2; ++n) gg[bj][n] = *(const f32x4*)(g + 32 * bj + 8 * fq + 4 * n) * sc;
#pragma unroll
            for (int ai = 0; ai < 2; ++ai)
#pragma unroll
                for (int m = 0; m < 4; ++m) { float ss = 0.f;
#pragma unroll
                    for (int bj = 0; bj < 2; ++bj)
#pragma unroll
                        for (int n = 0; n < 2; ++n) { const f32x4 a = acc[ai][bj][m][n]; ss += (a[0] * a[0] + a[1] * a[1]) + (a[2] * a[2] + a[3] * a[3]); }
                    ss += __shfl_xor(ss, 16); ss += __shfl_xor(ss, 32);
                    const float rs = __builtin_amdgcn_rsqf(ss * (1.0f / 64.0f) + 1e-6f);
                    bf16_t* rowp = obase + (size_t)(ai * HALF + m * 16) * 64;
#pragma unroll
                    for (int bj = 0; bj < 2; ++bj) *(u32x4*)(rowp + 32 * bj) = pack8(acc[ai][bj][m][0] * rs * gg[bj][0], acc[ai][bj][m][1] * rs * gg[bj][1]); }
        } else {
#pragma unroll
            for (int ai = 0; ai < 2; ++ai)
#pragma unroll
                for (int m = 0; m < 4; ++m) { bf16_t* rowp = obase + (size_t)(ai * HALF + m * 16) * 64;
#pragma unroll
                    for (int bj = 0; bj < 2; ++bj) *(u32x4*)(rowp + 32 * bj) = pack8(acc[ai][bj][m][0], acc[ai][bj][m][1]); }
        }
    }
};
struct EpiOut {
    static constexpr bool PERM = true, AFTER_DRAIN = false; static constexpr int MIDK = 8;
    bf16_t* xb; float* ssq; const float* ssqb;
    __device__ __forceinline__ void mid(f32x4 (&acc)[2][2][4][2], const Unit& u, int wr, int wc, int fr, int fq) const {
        const float* sp = ssqb + (u.pm * BM + wr * 64 + fr);
        asm volatile("s_nop 15\n\ts_nop 15" ::: "memory");
#pragma unroll
        for (int ai = 0; ai < 2; ++ai) {
            float f[4];
#pragma unroll
            for (int m = 0; m < 4; ++m) f[m] = __builtin_amdgcn_sqrtf(sp[ai * HALF + m * 16] * (1.0f / 512.0f) + 1e-6f);
#pragma unroll
            for (int bj = 0; bj < 2; ++bj)
#pragma unroll
                for (int m = 0; m < 4; ++m)
#pragma unroll
                    for (int n = 0; n < 2; ++n) acc[ai][bj][m][n] *= f[m];
            asm volatile("" ::: "memory"); }
        asm volatile("s_nop 7" ::: "memory");
    }
    __device__ __forceinline__ void operator()(f32x4 (&acc)[2][2][4][2], const Unit& u, int wr, int wc, int fr, int fq, int wid, int lane) const {
        const int col0 = u.pn * BM + wc * 32 + 8 * fq; const int gr0 = u.pm * BM + wr * 64 + fr;
#pragma unroll
        for (int ai = 0; ai < 2; ++ai) {
            u32x4 w[4][2]; float rb[4];
#pragma unroll
            for (int m = 0; m < 4; ++m) { rb[m] = ssqb[gr0 + ai * HALF + m * 16];
#pragma unroll
                for (int bj = 0; bj < 2; ++bj) w[m][bj] = *(const u32x4*)(xb + (size_t)(gr0 + ai * HALF + m * 16) * DMODEL + col0 + bj * HALF); }
#pragma unroll
            for (int m = 0; m < 4; ++m) { const int gr = gr0 + ai * HALF + m * 16;
                float s = 0.f; const float r = __builtin_amdgcn_rsqf(rb[m] * (1.0f / 512.0f) + 1e-6f);
#pragma unroll
                for (int bj = 0; bj < 2; ++bj) { const u32x4 v = w[m][bj];
                    f32x4 a = {__uint_as_float(v.x << 16), __uint_as_float(v.x & 0xffff0000u), __uint_as_float(v.y << 16), __uint_as_float(v.y & 0xffff0000u)};
                    f32x4 b = {__uint_as_float(v.z << 16), __uint_as_float(v.z & 0xffff0000u), __uint_as_float(v.w << 16), __uint_as_float(v.w & 0xffff0000u)};
                    a += acc[ai][bj][m][0] * r; b += acc[ai][bj][m][1] * r;
                    s += (a[0] * a[0] + a[1] * a[1]) + (a[2] * a[2] + a[3] * a[3]) + (b[0] * b[0] + b[1] * b[1]) + (b[2] * b[2] + b[3] * b[3]);
                    *(u32x4*)(xb + (size_t)gr * DMODEL + col0 + bj * HALF) = pack8(a, b); }
                s += __shfl_xor(s, 16); s += __shfl_xor(s, 32);
                if (fq == 0) unsafeAtomicAdd(ssq + gr, s); }
            asm volatile("" ::: "memory"); }
    }
};
struct EpiDown {
    static constexpr bool PERM = true, AFTER_DRAIN = false; static constexpr int MIDK = 0;
    const bf16_t* xb; float* out;
    __device__ __forceinline__ void operator()(f32x4 (&acc)[2][2][4][2], const Unit& u, int wr, int wc, int fr, int fq, int wid, int lane) const {
        const int col0 = u.pn * BM + wc * 32 + 8 * fq; const int gr0 = u.pm * BM + wr * 64 + fr;
        u32x4 w[2][4][2];
#pragma unroll
        for (int ai = 0; ai < 2; ++ai)
#pragma unroll
            for (int m = 0; m < 4; ++m)
#pragma unroll
                for (int bj = 0; bj < 2; ++bj) w[ai][m][bj] = *(const u32x4*)(xb + (size_t)(gr0 + ai * HALF + m * 16) * DMODEL + col0 + bj * HALF);
#pragma unroll
        for (int ai = 0; ai < 2; ++ai)
#pragma unroll
            for (int m = 0; m < 4; ++m) { float* o = out + (size_t)(gr0 + ai * HALF + m * 16) * DMODEL + col0;
#pragma unroll
                for (int bj = 0; bj < 2; ++bj) { const u32x4 v = w[ai][m][bj];
                    f32x4 a = {__uint_as_float(v.x << 16), __uint_as_float(v.x & 0xffff0000u), __uint_as_float(v.y << 16), __uint_as_float(v.y & 0xffff0000u)};
                    f32x4 b = {__uint_as_float(v.z << 16), __uint_as_float(v.z & 0xffff0000u), __uint_as_float(v.w << 16), __uint_as_float(v.w & 0xffff0000u)};
                    a += acc[ai][bj][m][0]; b += acc[ai][bj][m][1]; *(f32x4*)(o + bj * HALF) = a; *(f32x4*)(o + bj * HALF + 4) = b; } }
    }
};
__device__ __forceinline__ bool seq_first(int gr) { return gr == 0 || (gr >= MPROMPT && (gr & 2047) == 0); }
__device__ __forceinline__ bool seq_last(int gr) { return gr >= MPROMPT - 1 && (gr & 2047) == 2047; }
struct EpiUp {
    static constexpr bool PERM = true, AFTER_DRAIN = false; static constexpr int MIDK = 0;
    bf16_t* H; const float* ssq; const float* cw; const float* cb; PG8_LAS float* xch;
    __device__ __forceinline__ void operator()(f32x4 (&acc)[2][2][4][2], const Unit& u, int wr, int wc, int fr, int fq, int wid, int lane) const {
        const int lr0 = wr * 64 + fr, gr0 = 254 * u.pm - 1 + lr0;
#pragma unroll
        for (int ai = 0; ai < 2; ++ai)
#pragma unroll
            for (int m = 0; m < 4; ++m) { int gr = gr0 + ai * HALF + m * 16; gr = gr < 0 ? 0 : (gr > MTOK - 1 ? MTOK - 1 : gr);
                const float rs = __builtin_amdgcn_rsqf(ssq[gr] * (1.0f / DMODEL) + 1e-6f);
#pragma unroll
                for (int bj = 0; bj < 2; ++bj)
#pragma unroll
                    for (int n = 0; n < 2; ++n) acc[ai][bj][m][n] *= rs; }
#pragma unroll
        for (int ai = 0; ai < 2; ++ai) {
            if (fr == 0) { PG8_LAS float* p = xch + ((wid * 2 + ai) * 2 + 0) * 64 + 8 * fq;
#pragma unroll
                for (int bj = 0; bj < 2; ++bj)
#pragma unroll
                    for (int n = 0; n < 2; ++n) *(PG8_LAS f32x4*)(p + bj * 32 + 4 * n) = acc[ai][bj][0][n]; }
            if (fr == 15) { PG8_LAS float* p = xch + ((wid * 2 + ai) * 2 + 1) * 64 + 8 * fq;
#pragma unroll
                for (int bj = 0; bj < 2; ++bj)
#pragma unroll
                    for (int n = 0; n < 2; ++n) *(PG8_LAS f32x4*)(p + bj * 32 + 4 * n) = acc[ai][bj][3][n]; }
        }
        asm volatile("s_waitcnt lgkmcnt(0)" ::: "memory"); __builtin_amdgcn_s_barrier(); asm volatile("" ::: "memory");
        const int tlo = 254 * u.pm - 1, thi = tlo + 255; const bool anyb = (tlo <= 0) || (((thi + 1) >> 11) != ((tlo - 1) >> 11));
        unsigned hold0 = 0u, hold1 = 0u;
        const int ow = (1 - wr) * 4 + wc;
        const int chb = 128 * u.pn + 32 * wc + 16 * (fq >> 1);
#pragma unroll
        for (int n = 0; n < 2; ++n) {
            f32x4 w0[2], w1[2], w2[2], bb[2];
#pragma unroll
            for (int bj = 0; bj < 2; ++bj) { const int ch = chb + 8 * n + 4 * (fq & 1) + bj * DFF_;
                w0[bj] = *(const f32x4*)(cw + ch); w1[bj] = *(const f32x4*)(cw + 2 * DFF_ + ch); w2[bj] = *(const f32x4*)(cw + 4 * DFF_ + ch); bb[bj] = *(const f32x4*)(cb + ch); }
#pragma unroll
            for (int ai = 0; ai < 2; ++ai) {
                const int aiT = wr == 1 ? ai : ai - 1, aiB = wr == 0 ? ai : ai + 1;
#pragma unroll
                for (int m = 0; m < 4; ++m) {
                    const int lr = lr0 + ai * HALF + m * 16, gr = gr0 + ai * HALF + m * 16;
                    const bool first = seq_first(gr), last = seq_last(gr);
                    f32x4 c[2];
#pragma unroll
                    for (int bj = 0; bj < 2; ++bj) {
                        const f32x4 cur = acc[ai][bj][m][n];
                        f32x4 pv, nx;
#pragma unroll
                        for (int e = 0; e < 4; ++e) {
                            const float sP = (m > 0 && fr == 15) ? acc[ai][bj][m > 0 ? m - 1 : 0][n][e] : cur[e];
                            const float sN = (m < 3 && fr == 0) ? acc[ai][bj][m < 3 ? m + 1 : 3][n][e] : cur[e];
                            pv[e] = __builtin_bit_cast(float, __builtin_amdgcn_mov_dpp(__builtin_bit_cast(int, sP), 0x121  , 0xf, 0xf, true));
                            nx[e] = __builtin_bit_cast(float, __builtin_amdgcn_mov_dpp(__builtin_bit_cast(int, sN), 0x12f  , 0xf, 0xf, true)); }
                        if (m == 0) { const f32x4 top = (aiT >= 0) ? *(const PG8_LAS f32x4*)(xch + ((ow * 2 + (aiT < 0 ? 0 : aiT)) * 2 + 1) * 64 + 8 * fq + bj * 32 + 4 * n) : (f32x4){0.f, 0.f, 0.f, 0.f}; if (fr == 0) pv = top; }
                        if (m == 3) { const f32x4 bot = (aiB <= 1) ? *(const PG8_LAS f32x4*)(xch + ((ow * 2 + (aiB > 1 ? 1 : aiB)) * 2 + 0) * 64 + 8 * fq + bj * 32 + 4 * n) : (f32x4){0.f, 0.f, 0.f, 0.f}; if (fr == 15) nx = bot; }
                        if (anyb) { if (first) pv = (f32x4){0.f, 0.f, 0.f, 0.f}; if (last) nx = (f32x4){0.f, 0.f, 0.f, 0.f}; }
                        c[bj] = bb[bj] + w0[bj] * pv + w1[bj] * cur + w2[bj] * nx;
                    }
                    f32x4 hv;
#pragma unroll
                    for (int e = 0; e < 4; ++e) { const float g = c[0][e]; hv[e] = g * __builtin_amdgcn_rcpf(1.0f + __builtin_amdgcn_exp2f(-1.4426950408889634f * g)) * c[1][e]; }
                    const unsigned pkx = cvtpk(hv[0], hv[1]), pky = cvtpk(hv[2], hv[3]);
                    if ((m & 1) == 0) { hold0 = pkx; hold1 = pky; }
                    else { const auto r0 = __builtin_amdgcn_permlane16_swap(hold0, pkx, false, false), r1 = __builtin_amdgcn_permlane16_swap(hold1, pky, false, false);
                        u32x4 w; w.x = r0[0]; w.y = r1[0]; w.z = r0[1]; w.w = r1[1];
                        const int ms = (fq & 1) ? m : m - 1, lrS = lr0 + ai * HALF + ms * 16, grS = gr0 + ai * HALF + ms * 16;
                        if (lrS >= 1 && lrS <= 254 && grS < MTOK) *(u32x4*)(H + (size_t)grS * DFF_ + chb + 8 * n) = w; }
                    asm volatile("" ::: "memory");
                }
            }
        }
    }
};
template <class Epi, class Sched, bool ALIGN_EPI = false, bool SP2 = false>
__device__ __forceinline__ void gemm_phase(PG8_LAS unsigned char* lds, const Gemm g, const Sched& S, const Epi& E) {
    int tid_ = threadIdx.x; asm volatile("" : "+v"(tid_));
    const int tid = tid_, wid = __builtin_amdgcn_readfirstlane(tid >> 6), lane = tid & 63, wr = wid >> 2, wc = wid & 3, fr = lane & 15, fq = lane >> 4;
    const int K = g.K, nt = K / BK;
    unsigned voffA[2], voffB[2];
#pragma unroll
    for (int i = 0; i < 2; ++i) { int R, C; stage_rc(tid * 16 + i * 8192, R, C); const int Rb = Epi::PERM ? ((R & ~31) + perm32(R & 31)) : R;
        voffA[i] = (unsigned)(R * K + C) * 2u; voffB[i] = (unsigned)(Rb * K + C) * 2u; }
    const size_t kstep = (size_t)(BK * 2);
    const size_t hstep = (size_t)HALF * K * 2;
    const size_t tstep = 2 * hstep; const size_t tstepA = (size_t)g.a_tile_rows * K * 2;
    const unsigned ldsw = (unsigned)wid * 1024u;
    const int aoff = lds_byte(wr * 64 + fr, fq * 8), boff = lds_byte(wc * 32 + fr, fq * 8);
#define PG8_SA(b, h) (((b) * 2 + (h)) * HTB)
#define PG8_SB(b, h) ((4 + (b) * 2 + (h)) * HTB)
#define PG8_STAGE(bufoff, gbase, voff) do { _Pragma("unroll") for (int _i = 0; _i < 2; ++_i) \
        __builtin_amdgcn_global_load_lds((const unsigned*)((const char*)(gbase) + (voff)[_i]), (PG8_LAS unsigned*)(lds + (bufoff) + ldsw + _i * 8192), 16, 0, 0); } while (0)
#define PG8_LDA(dst, b, h) do { _Pragma("unroll") for (int m = 0; m < 4; ++m) _Pragma("unroll") for (int k = 0; k < 2; ++k) dst[m][k] = *(const PG8_LAS bf16x8*)(lds + PG8_SA(b, h) + aoff + m * 2048 + k * 1024); } while (0)
#define PG8_LDB(dst, b, h) do { _Pragma("unroll") for (int n = 0; n < 2; ++n) _Pragma("unroll") for (int k = 0; k < 2; ++k) dst[n][k] = *(const PG8_LAS bf16x8*)(lds + PG8_SB(b, h) + boff + n * 2048 + k * 1024); } while (0)
#define PG8_MMA(ai, bj, At, Bt) do { __builtin_amdgcn_s_setprio(1); _Pragma("unroll") for (int m = 0; m < 4; ++m) _Pragma("unroll") for (int n = 0; n < 2; ++n) _Pragma("unroll") for (int k = 0; k < 2; ++k) \
        acc[ai][bj][m][n] = __builtin_amdgcn_mfma_f32_16x16x32_bf16(Bt[n][k], At[m][k], acc[ai][bj][m][n], 0, 0, 0); __builtin_amdgcn_s_setprio(0); } while (0)
#define PG8_WAIT_V(n) asm volatile("s_waitcnt vmcnt(" #n ")" ::: "memory")
#define PG8_WAIT_L(n) asm volatile("s_waitcnt lgkmcnt(" #n ")" ::: "memory")
#define PG8_BAR __builtin_amdgcn_s_barrier()
#define PG8_SCHED __builtin_amdgcn_sched_barrier(0)
    Unit cur, nxt; int ui = 0;
    if (!S.next(0, cur)) return;
    f32x4 acc[2][2][4][2];
#pragma unroll
    for (int a = 0; a < 2; ++a)
#pragma unroll
        for (int b = 0; b < 2; ++b)
#pragma unroll
            for (int m = 0; m < 4; ++m)
#pragma unroll
                for (int n = 0; n < 2; ++n) acc[a][b][m][n] = (f32x4){0.f, 0.f, 0.f, 0.f};
    bf16x8 At[4][2], B0[2][2], B1[2][2];
    const char* cA = (const char*)g.A + (size_t)cur.pm * tstepA; const char* cB = (const char*)g.Bt + (size_t)cur.pn * tstep;
    S.a_ready(cur);
    if constexpr (SP2) {
        PG8_STAGE(PG8_SB(0, 0), cB, voffB); PG8_STAGE(PG8_SB(0, 1), cB + hstep, voffB); PG8_STAGE(PG8_SA(0, 0), cA, voffA); PG8_STAGE(PG8_SA(0, 1), cA + hstep, voffA);
        if (wr == 1) PG8_BAR;
        PG8_WAIT_V(2); PG8_BAR;
        PG8_STAGE(PG8_SB(1, 0), cB + kstep, voffB); PG8_STAGE(PG8_SA(1, 0), cA + kstep, voffA); PG8_STAGE(PG8_SB(1, 1), cB + hstep + kstep, voffB);
        PG8_WAIT_V(6); PG8_BAR;
    } else {
        PG8_STAGE(PG8_SB(0, 0), cB, voffB); PG8_STAGE(PG8_SA(0, 0), cA, voffA); PG8_STAGE(PG8_SB(0, 1), cB + hstep, voffB); PG8_STAGE(PG8_SA(0, 1), cA + hstep, voffA);
        if (wr == 1) PG8_BAR;
        PG8_WAIT_V(4); PG8_BAR;
        PG8_STAGE(PG8_SB(1, 0), cB + kstep, voffB); PG8_STAGE(PG8_SA(1, 0), cA + kstep, voffA); PG8_STAGE(PG8_SB(1, 1), cB + hstep + kstep, voffB);
        PG8_WAIT_V(6); PG8_BAR;
    }
    for (;;) {
        const bool has_next = S.next(ui + 1, nxt);
        const char* nA = has_next ? (const char*)g.A + (size_t)nxt.pm * tstepA : cA; const char* nB = has_next ? (const char*)g.Bt + (size_t)nxt.pn * tstep : cB;
        for (int t = 0; t < nt; t += 2) {
            if constexpr (Epi::MIDK > 0) { if (t == Epi::MIDK) E.mid(acc, cur, wr, wc, fr, fq); }
            const bool last = (t == nt - 2);
            const char* a1 = cA + (size_t)(t + 1) * kstep;
            const char* a2 = last ? nA : cA + (size_t)(t + 2) * kstep; const char* b2 = last ? nB : cB + (size_t)(t + 2) * kstep;
            const char* a3 = a2 + kstep; const char* b3 = b2 + kstep;
            if (last && has_next) S.a_ready(nxt);
            if constexpr (SP2) {
            PG8_LDB(B0, 0, 0); PG8_LDB(B1, 0, 1); PG8_SCHED; PG8_LDA(At, 0, 0); PG8_STAGE(PG8_SA(1, 1), a1 + hstep, voffA);
            PG8_WAIT_V(8); PG8_WAIT_L(0); PG8_BAR; PG8_MMA(0, 0, At, B0); PG8_MMA(0, 1, At, B1); PG8_BAR; PG8_SCHED;
            PG8_LDA(At, 0, 1); PG8_STAGE(PG8_SB(0, 0), b2, voffB); PG8_STAGE(PG8_SB(0, 1), b2 + hstep, voffB); PG8_STAGE(PG8_SA(0, 0), a2, voffA);
            PG8_WAIT_V(8); PG8_WAIT_L(0); PG8_BAR; PG8_MMA(1, 0, At, B0); PG8_MMA(1, 1, At, B1); PG8_BAR; PG8_SCHED;
            PG8_LDB(B0, 1, 0); PG8_LDB(B1, 1, 1); PG8_SCHED; PG8_LDA(At, 1, 0); PG8_STAGE(PG8_SA(0, 1), a2 + hstep, voffA);
            PG8_WAIT_V(8); PG8_WAIT_L(0); PG8_BAR; PG8_MMA(0, 0, At, B0); PG8_MMA(0, 1, At, B1); PG8_BAR; PG8_SCHED;
            PG8_LDA(At, 1, 1); PG8_STAGE(PG8_SB(1, 0), b3, voffB); PG8_STAGE(PG8_SB(1, 1), b3 + hstep, voffB); PG8_STAGE(PG8_SA(1, 0), a3, voffA);
            PG8_WAIT_V(8); PG8_WAIT_L(0); PG8_BAR; PG8_MMA(1, 0, At, B0); PG8_MMA(1, 1, At, B1); PG8_BAR; PG8_SCHED;
            } else {
            PG8_LDB(B0, 0, 0); PG8_SCHED; PG8_LDA(At, 0, 0); PG8_STAGE(PG8_SA(1, 1), a1 + hstep, voffA);
            PG8_WAIT_L(8); PG8_BAR; PG8_WAIT_L(0); PG8_MMA(0, 0, At, B0); PG8_BAR; PG8_SCHED;
            PG8_LDB(B1, 0, 1); PG8_STAGE(PG8_SB(0, 0), b2, voffB);
            PG8_BAR; PG8_WAIT_L(0); PG8_MMA(0, 1, At, B1); PG8_BAR;
            PG8_LDA(At, 0, 1); PG8_STAGE(PG8_SA(0, 0), a2, voffA);
            PG8_BAR; PG8_WAIT_L(0); PG8_MMA(1, 0, At, B0); PG8_BAR; PG8_SCHED;
            PG8_STAGE(PG8_SB(0, 1), b2 + hstep, voffB);
            PG8_WAIT_V(6); PG8_BAR; PG8_MMA(1, 1, At, B1); PG8_BAR;
            PG8_LDB(B0, 1, 0); PG8_SCHED; PG8_LDA(At, 1, 0); PG8_STAGE(PG8_SA(0, 1), a2 + hstep, voffA);
            PG8_WAIT_L(8); PG8_BAR; PG8_WAIT_L(0); PG8_MMA(0, 0, At, B0); PG8_BAR; PG8_SCHED;
            PG8_LDB(B1, 1, 1); PG8_STAGE(PG8_SB(1, 0), b3, voffB);
            PG8_BAR; PG8_WAIT_L(0); PG8_MMA(0, 1, At, B1); PG8_BAR;
            PG8_LDA(At, 1, 1); PG8_STAGE(PG8_SA(1, 0), a3, voffA);
            PG8_BAR; PG8_WAIT_L(0); PG8_MMA(1, 0, At, B0); PG8_BAR; PG8_SCHED;
            PG8_STAGE(PG8_SB(1, 1), b3 + hstep, voffB);
            PG8_WAIT_V(6); PG8_BAR; PG8_MMA(1, 1, At, B1); PG8_BAR;
            }
        }
        if constexpr (ALIGN_EPI) { if (wr == 0) PG8_BAR; }
        if constexpr (!Epi::AFTER_DRAIN) { E(acc, cur, wr, wc, fr, fq, wid, lane); S.done(cur); }
        if (!has_next) break;
#pragma unroll
        for (int a = 0; a < 2; ++a)
#pragma unroll
            for (int b = 0; b < 2; ++b)
#pragma unroll
                for (int m = 0; m < 4; ++m)
#pragma unroll
                    for (int n = 0; n < 2; ++n) acc[a][b][m][n] = (f32x4){0.f, 0.f, 0.f, 0.f};
        cur = nxt; cA = nA; cB = nB; ++ui;
        if constexpr (ALIGN_EPI) { if (wr == 1) PG8_BAR; }
    }
    PG8_WAIT_V(0);
    if constexpr (!ALIGN_EPI) { if (wr == 0) PG8_BAR; }
    PG8_BAR;
    if constexpr (Epi::AFTER_DRAIN) { E.fused(acc, cur, wr, wc, fr, fq, lds, wid, lane); S.done(cur); }
#undef PG8_SA
#undef PG8_SB
#undef PG8_STAGE
#undef PG8_LDA
#undef PG8_LDB
#undef PG8_MMA
#undef PG8_WAIT_V
#undef PG8_WAIT_L
#undef PG8_BAR
#undef PG8_SCHED
}
}
#ifndef PG8_SP2
#define PG8_SP2 true
#endif
#ifndef PG8_ALIGN
#define PG8_ALIGN true
#endif

constexpr int NWAVES = 8;
constexpr int DM = 1024, M = 49152, MP = 16384, INW = 2304, DFF = 2816, UPW = 5632;
constexpr int QA_OFF = 0, KA_OFF = 512, VA_OFF = 1024, QB_OFF = 1536, KB_OFF = 2048, VB_OFF = 2176;
constexpr int UP_TILES_M = 194;
constexpr float EPS = 1e-6f, LOG2E = 1.4426950408889634f;

constexpr size_t MiB = 1u << 20;
constexpr size_t WS_SSQ = 0;
constexpr size_t WS_SSQB = 768 * 1024;
constexpr size_t WS_SSQ1 = 512 * 1024;
constexpr size_t WS_BAR = 1 * MiB;
constexpr size_t WS_WIN = 2 * MiB, WS_WOUT = 7 * MiB, WS_WUP = 9 * MiB, WS_WDN = 20 * MiB;
constexpr size_t WS_XN = 32 * MiB;
constexpr size_t WS_PROJ = 130 * MiB;
constexpr size_t WS_OA = 346 * MiB;
constexpr size_t WS_H = 226 * MiB;
constexpr size_t WS_LA = 490 * MiB;
constexpr size_t WS_END = 496 * MiB;
static_assert(WS_XN + (size_t)(M + 256) * DM * 2 <= WS_PROJ && WS_PROJ + (size_t)M * INW * 2 <= WS_OA && WS_OA + 3 * (size_t)M * 512 * 2 <= WS_LA && WS_H + (size_t)M * DFF * 2 <= WS_LA && WS_PROJ + (size_t)M * DM * 2 <= WS_H, "d_ws map");

constexpr int RING_BYTES = 131072, XCH_OFF = RING_BYTES, MISC_OFF = XCH_OFF + 8192, LDS_BYTES = 147456;

#define LAS __attribute__((address_space(3)))
typedef unsigned short bf16;
typedef unsigned v4u __attribute__((ext_vector_type(4)));
typedef float f32x4 __attribute__((ext_vector_type(4)));
typedef float f32x16 __attribute__((ext_vector_type(16)));
typedef short bf16x8 __attribute__((ext_vector_type(8)));
typedef short s16x4 __attribute__((ext_vector_type(4)));
using pg8::cvtpk;
__device__ __forceinline__ float bf_lo(unsigned w) { return __uint_as_float(w << 16); }
__device__ __forceinline__ float bf_hi(unsigned w) { return __uint_as_float(w & 0xffff0000u); }
__device__ __forceinline__ float wave_sum(float v) {
#pragma unroll
    for (int o = 1; o < 64; o <<= 1) v += __shfl_xor(v, o);
    return v;
}
__device__ __forceinline__ float wave_max(float v) {
#pragma unroll
    for (int o = 1; o < 64; o <<= 1) v = fmaxf(v, __shfl_xor(v, o));
    return v;
}

#define GAS __attribute__((address_space(1)))
#define RLX_AGENT __ATOMIC_RELAXED, __HIP_MEMORY_SCOPE_AGENT
#define XB_TMO      128
#define XB_XCNT(j)  (256  + 64 * (j))
#define XB_XSUB(j)  (1280 + 64 * (j))
#define XB_XGEN(j)  (2304 + 64 * (j))
#define XB_TOP      3328
#define XB_TOPGEN   3392
#define XCD_BAR_WORDS 3456
#define XB_SPIN_CAP (1u << 18)

__device__ __forceinline__ unsigned xb_ld(unsigned* p)              { return __hip_atomic_load(p, __ATOMIC_RELAXED, __HIP_MEMORY_SCOPE_AGENT); }
__device__ __forceinline__ unsigned xb_add(unsigned* p, unsigned v) { return __hip_atomic_fetch_add(p, v, __ATOMIC_RELAXED, __HIP_MEMORY_SCOPE_AGENT); }
__device__ __forceinline__ unsigned xb_xcc_id() { return (unsigned)__builtin_amdgcn_s_getreg((3 << 11) | 20) & 0xFu; }
#define XB_SPIN(cond, bar) do { unsigned _sp = 0; while (cond) { __builtin_amdgcn_s_sleep(1); \
    if ((++_sp & 255u) == 0u) { if (xb_ld(&(bar)[XB_TMO])) break; if (_sp > XB_SPIN_CAP) { atomicAdd(&(bar)[XB_TMO], 1u); break; } } } } while (0)

struct XcdBarrier {
    unsigned* bar; unsigned x;
    volatile LAS unsigned* st;
};

__device__ __forceinline__ XcdBarrier xcd_barrier_post(unsigned* bar, volatile LAS unsigned* st) {
    XcdBarrier b; b.bar = bar; b.x = xb_xcc_id(); b.st = st;
    if (threadIdx.x == 0) (void)xb_add(&bar[XB_XCNT(b.x)], 1u);
    return b;
}
__device__ __forceinline__ void xcd_barrier_complete(unsigned* bar, unsigned x, unsigned& nloc, unsigned& nx) {
    const unsigned G = gridDim.x * gridDim.y * gridDim.z;
    unsigned sum, cnt, mine, sp = 0u;
    for (;;) {
        sum = 0u; cnt = 0u; mine = 0u;
#pragma unroll
        for (unsigned j = 0; j < 16; ++j) { const unsigned c = xb_ld(&bar[XB_XCNT(j)]); sum += c; cnt += (c > 0u) ? 1u : 0u; mine = (j == x) ? c : mine; }
        if (sum == G) break;
        __builtin_amdgcn_s_sleep(1);
        if ((++sp & 255u) == 0u) { if (xb_ld(&bar[XB_TMO])) break; if (sp > XB_SPIN_CAP) { atomicAdd(&bar[XB_TMO], 1u); break; } }
    }
    nloc = mine > 0u ? mine : 1u; nx = cnt > 0u ? cnt : 1u;
}

__device__ __forceinline__ void xcd_barrier(const XcdBarrier& b) {
    asm volatile("s_waitcnt vmcnt(0)" ::: "memory");
    __syncthreads();
    if (threadIdx.x == 0) {
        unsigned* bar = b.bar;
        __builtin_amdgcn_s_waitcnt(0);
        unsigned nloc = b.st[0], nx = b.st[1];
        if (nloc == 0u) { xcd_barrier_complete(bar, b.x, nloc, nx); b.st[0] = nloc; b.st[1] = nx; }
        const unsigned old = xb_add(&bar[XB_XSUB(b.x)], 1u);
        const unsigned gen = old / nloc;
        if (old + 1u == (gen + 1u) * nloc) {
            __builtin_amdgcn_fence(__ATOMIC_RELEASE, "agent");
            asm volatile("s_waitcnt vmcnt(0)" ::: "memory");
            const unsigned og = xb_add(&bar[XB_TOP], 1u);
            const unsigned tg = og / nx;
            if (og + 1u == (tg + 1u) * nx) xb_add(&bar[XB_TOPGEN], 1u);
            else XB_SPIN(xb_ld(&bar[XB_TOPGEN]) == tg, bar);
            __builtin_amdgcn_fence(__ATOMIC_ACQUIRE, "agent");
            xb_add(&bar[XB_XGEN(b.x)], 1u);
            asm volatile("s_waitcnt vmcnt(0)" ::: "memory");
        } else {
            XB_SPIN(xb_ld(&bar[XB_XGEN(b.x)]) == gen, bar);
            __builtin_amdgcn_fence(__ATOMIC_ACQUIRE, "agent");
            asm volatile("s_waitcnt vmcnt(0)" ::: "memory");
        }
    }
    __syncthreads();
}

template <int MAP  >
__device__ __forceinline__ void p0_transpose_item(const float* W, int K, int N, bf16* WT, const float* kgain, LAS float* scr, int item, int lane) {
    const int nblk = N / 32, kb = item / nblk, nb = item % nblk, k0 = 64 * kb, n0 = 32 * nb;
#pragma unroll 8
    for (int i = 0; i < 32; ++i) { const int kk = 2 * i + (lane >> 5); float v = W[(size_t)(k0 + kk) * N + n0 + (lane & 31)]; if (kgain) v *= kgain[k0 + kk]; scr[kk * 33 + (lane & 31)] = v; }
    asm volatile("s_waitcnt lgkmcnt(0)" ::: "memory");
    const int c = lane & 7;
    int r0 = n0;
    if (MAP == 2) { const int hs = n0 >> 6; r0 = 256 * (hs >> 2) + 128 * ((n0 >> 5) & 1) + 32 * (hs & 3); }
    if (MAP == 1) r0 = n0 < DFF ? ((n0 >> 7) * 256 + (n0 & 127)) : ((((n0 - DFF) >> 7) * 256) + 128 + ((n0 - DFF) & 127));
#pragma unroll
    for (int j = 0; j < 4; ++j) { const int n = (lane >> 3) + 8 * j; const LAS float* s = scr + (8 * c) * 33 + n;
        v4u o; o.x = cvtpk(s[0 * 33], s[1 * 33]); o.y = cvtpk(s[2 * 33], s[3 * 33]); o.z = cvtpk(s[4 * 33], s[5 * 33]); o.w = cvtpk(s[6 * 33], s[7 * 33]);
        const int nr = (MAP == 1) ? (8 * (2 * (n >> 4) + ((n >> 2) & 1)) + 4 * ((n >> 3) & 1) + (n & 3)) : n;
        *(v4u*)(WT + (size_t)(r0 + nr) * K + k0 + 8 * c) = o; }
    asm volatile("s_waitcnt lgkmcnt(0)" ::: "memory");
}
__device__ __forceinline__ void rows4_to_bf16(const float* xrow, bf16* orow, float* ssq, int lane) {
    f32x4 v[4][4]; float s[4];
#pragma unroll
    for (int k = 0; k < 4; ++k)
#pragma unroll
        for (int j = 0; j < 4; ++j) v[k][j] = __builtin_nontemporal_load(((const f32x4*)(xrow + (size_t)k * DM) + lane) + 64 * j);
#pragma unroll
    for (int k = 0; k < 4; ++k) { s[k] = 0.f;
#pragma unroll
        for (int j = 0; j < 4; ++j) s[k] += (v[k][j].x * v[k][j].x + v[k][j].y * v[k][j].y) + (v[k][j].z * v[k][j].z + v[k][j].w * v[k][j].w);
        unsigned long long* o8 = (unsigned long long*)(orow + (size_t)k * DM) + lane;
#pragma unroll
        for (int j = 0; j < 4; ++j) o8[64 * j] = (unsigned long long)cvtpk(v[k][j].x, v[k][j].y) | ((unsigned long long)cvtpk(v[k][j].z, v[k][j].w) << 32); }
#pragma unroll
    for (int o = 1; o < 64; o <<= 1) {
#pragma unroll
        for (int k = 0; k < 4; ++k) s[k] += __shfl_xor(s[k], o); }
    if (lane < 4) ssq[lane] = lane == 0 ? s[0] : lane == 1 ? s[1] : lane == 2 ? s[2] : s[3];
}

template <int NKEYS, int NTHR>
__device__ __forceinline__ void stage_load(v4u (&kr)[NKEYS * 8 / NTHR], v4u (&vr)[NKEYS * 8 / NTHR], const bf16* kbase, const bf16* vbase, int tok0, int dshift, int kidx0, int Ls, int t) {
    constexpr int NIT = NKEYS * 8 / NTHR;
    const int c = t & 7;
#pragma unroll
    for (int it = 0; it < NIT; ++it) { const int rho = (it * NTHR + t) >> 3, kidx = kidx0 + rho; const bool ok = (unsigned)kidx < (unsigned)Ls;
        const size_t off = (size_t)(tok0 + ((ok ? kidx : 0) << dshift)) * 64 + 8 * c;
        kr[it] = *(const v4u*)(kbase + off); vr[it] = *(const v4u*)(vbase + off); }
}
template <int NKEYS, int NTHR>
__device__ __forceinline__ void stage_write(const v4u (&kr)[NKEYS * 8 / NTHR], const v4u (&vr)[NKEYS * 8 / NTHR], LAS unsigned char* Kl, LAS unsigned char* Vl, int t) {
    constexpr int NIT = NKEYS * 8 / NTHR;
    const int c = t & 7;
#pragma unroll
    for (int it = 0; it < NIT; ++it) { const int rho = (it * NTHR + t) >> 3;
        *(LAS v4u*)(Kl + rho * 128 + 16 * (c ^ ((rho >> 1) & 7))) = kr[it];
        *(LAS v4u*)(Vl + (c >> 2) * (NKEYS * 64) + rho * 64 + (c & 3) * 16) = vr[it]; }
}
__device__ __forceinline__ void load_q_raw(v4u (&raw)[4], const bf16* qrow, int lane) {
#pragma unroll
    for (int d0 = 0; d0 < 4; ++d0) raw[d0] = *(const v4u*)(qrow + 16 * d0 + 8 * (lane >> 5));
}
typedef short v4i16_t __attribute__((ext_vector_type(4)));
__device__ __forceinline__ s16x4 vtr(const LAS unsigned char* p) { return __builtin_bit_cast(s16x4, __builtin_amdgcn_ds_read_tr16_b64_v4i16((LAS v4i16_t*)p)); }
template <int R, int CS>
__device__ __forceinline__ void build_bias_table(LAS float* tab, float nslope, float negM, int t, int nthr) {
    for (int idx = t; idx < 4 * CS; idx += nthr) { const int k = idx / CS, m = idx - k * CS, rel = m + k - (R + 32); const int ar = rel < 0 ? -rel : rel;
        tab[idx] = ar <= R ? __builtin_fmaf((float)ar, nslope, negM) : -__builtin_inff(); }
}
__device__ __forceinline__ void attn_tile(const bf16x8 (&kf)[4], const LAS float* tb, unsigned vaddr, int vhs, const bf16x8 (&qf)[4], f32x16 (&o)[2], float& l) {
    s16x4 vl[4], vh[4];
    asm volatile("ds_read_b64_tr_b16 %0, %8\n\tds_read_b64_tr_b16 %1, %8 offset:512\n\tds_read_b64_tr_b16 %2, %8 offset:1024\n\tds_read_b64_tr_b16 %3, %8 offset:1536\n\t"
                 "ds_read_b64_tr_b16 %4, %9\n\tds_read_b64_tr_b16 %5, %9 offset:512\n\tds_read_b64_tr_b16 %6, %9 offset:1024\n\tds_read_b64_tr_b16 %7, %9 offset:1536"
                 : "=&v"(vl[0]), "=&v"(vh[0]), "=&v"(vl[1]), "=&v"(vh[1]), "=&v"(vl[2]), "=&v"(vh[2]), "=&v"(vl[3]), "=&v"(vh[3]) : "v"(vaddr), "v"(vaddr + (unsigned)vhs) : "memory");
    const f32x4 c0 = *(const LAS f32x4*)(tb), c1 = *(const LAS f32x4*)(tb + 8), c2 = *(const LAS f32x4*)(tb + 16), c3 = *(const LAS f32x4*)(tb + 24);
    f32x16 s = {c0[0], c0[1], c0[2], c0[3], c1[0], c1[1], c1[2], c1[3], c2[0], c2[1], c2[2], c2[3], c3[0], c3[1], c3[2], c3[3]};
#pragma unroll
    for (int d0 = 0; d0 < 4; ++d0) s = __builtin_amdgcn_mfma_f32_32x32x16_bf16(kf[d0], qf[d0], s, 0, 0, 0);
    float pr[16];
#pragma unroll
    for (int r = 0; r < 16; ++r) { const float p = __builtin_amdgcn_exp2f(s[r]); l += p; pr[r] = p; }
    v4u w0, w1; w0.x = cvtpk(pr[0], pr[1]); w0.y = cvtpk(pr[2], pr[3]); w0.z = cvtpk(pr[4], pr[5]); w0.w = cvtpk(pr[6], pr[7]);
    w1.x = cvtpk(pr[8], pr[9]); w1.y = cvtpk(pr[10], pr[11]); w1.z = cvtpk(pr[12], pr[13]); w1.w = cvtpk(pr[14], pr[15]);
    const bf16x8 pa0 = __builtin_bit_cast(bf16x8, w0), pa1 = __builtin_bit_cast(bf16x8, w1);
    asm volatile("s_waitcnt lgkmcnt(0)" : "+v"(vl[0]), "+v"(vh[0]), "+v"(vl[1]), "+v"(vh[1]), "+v"(vl[2]), "+v"(vh[2]), "+v"(vl[3]), "+v"(vh[3]) :: "memory");
#pragma unroll
    for (int dh = 0; dh < 2; ++dh)
#pragma unroll
        for (int s2 = 0; s2 < 2; ++s2) { const s16x4 lo = vl[2 * dh + s2], h4 = vh[2 * dh + s2];
            const bf16x8 vf = (bf16x8){lo[0], lo[1], lo[2], lo[3], h4[0], h4[1], h4[2], h4[3]};
            o[dh] = __builtin_amdgcn_mfma_f32_32x32x16_bf16(vf, s2 ? pa1 : pa0, o[dh], 0, 0, 0); }
}
template <int NT, int CS>
__device__ __forceinline__ void attn_task(const LAS unsigned char* Kl, const LAS unsigned char* Vl, int vhs, int row0, int kidx_t0, int Ls, const bf16x8 (&qf)[4], const LAS float* tab, f32x16 (&o)[2], float& l, int lane) {
    const int q = lane & 31, hi = lane >> 5;
    const unsigned va0 = (unsigned)(uintptr_t)(Vl + row0 * 64 + (4 * hi + ((lane & 15) >> 2)) * 64 + (16 * ((lane >> 4) & 1) + 4 * (lane & 3)) * 2);
    const int sw = (q >> 1) & 7;
    const LAS unsigned char* kp0 = Kl + (row0 + q) * 128 + 16 * ((0 + hi) ^ sw); const LAS unsigned char* kp1 = Kl + (row0 + q) * 128 + 16 * ((2 + hi) ^ sw);
    const LAS unsigned char* kp2 = Kl + (row0 + q) * 128 + 16 * ((4 + hi) ^ sw); const LAS unsigned char* kp3 = Kl + (row0 + q) * 128 + 16 * ((6 + hi) ^ sw);
    int b = 32 - q + 4 * hi; asm volatile("" : "+v"(b));
    const LAS float* tb0 = tab + (b & 3) * CS + (b & ~3);
#define LOADK(dst, jj) do { dst[0] = *(const LAS bf16x8*)(kp0 + (jj) * 4096); dst[1] = *(const LAS bf16x8*)(kp1 + (jj) * 4096); dst[2] = *(const LAS bf16x8*)(kp2 + (jj) * 4096); dst[3] = *(const LAS bf16x8*)(kp3 + (jj) * 4096); } while (0)
    bf16x8 kf[4];
#pragma unroll 1
    for (int j = 0; j < NT; ++j) {
        if ((unsigned)(kidx_t0 + 32 * j) < (unsigned)Ls) {
            LOADK(kf, j);
            attn_tile(kf, tb0 + 32 * j, va0 + j * 2048, vhs, qf, o, l); }
    }
#undef LOADK
}
__device__ __forceinline__ void store_partial(const f32x16 (&o)[2], float l, bf16* OBuf, float* LB, int tokq0, int dshift, int h, int lane) {
    const int hi = lane >> 5, q = lane & 31; const size_t row = (size_t)h * M + (size_t)(tokq0 + (q << dshift));
    l += __shfl_xor(l, 32);
    if (hi == 0) LB[row] = l;
    bf16* p = OBuf + row * 64 + 8 * hi;
#pragma unroll
    for (int dh = 0; dh < 2; ++dh)
#pragma unroll
        for (int t = 0; t < 2; ++t) { const int ge = 2 * t, go = 2 * t + 1;
            const unsigned x0 = cvtpk(o[dh][4 * ge], o[dh][4 * ge + 1]), x1 = cvtpk(o[dh][4 * ge + 2], o[dh][4 * ge + 3]);
            const unsigned y0 = cvtpk(o[dh][4 * go], o[dh][4 * go + 1]), y1 = cvtpk(o[dh][4 * go + 2], o[dh][4 * go + 3]);
            const auto r0 = __builtin_amdgcn_permlane32_swap(x0, y0, false, false), r1 = __builtin_amdgcn_permlane32_swap(x1, y1, false, false);
            v4u w; w.x = r0[0]; w.y = r1[0]; w.z = r0[1]; w.w = r1[1];
            *(v4u*)(p + 32 * dh + 16 * t) = w; }
}
__device__ __forceinline__ void store_final_b(f32x16 (&o)[2], float l, float sinkterm, bf16* Yb, float* ssqb, int tokq0, int h, int lane) {
    const int hi = lane >> 5, q = lane & 31; const size_t tok = (size_t)(tokq0 + q);
    l += __shfl_xor(l, 32);
    const float inv = __builtin_amdgcn_rcpf(l + sinkterm);
    float ss = 0.f;
#pragma unroll
    for (int dh = 0; dh < 2; ++dh)
#pragma unroll
        for (int r = 0; r < 16; ++r) { o[dh][r] *= inv; ss += o[dh][r] * o[dh][r]; }
    ss += __shfl_xor(ss, 32);
    if (hi == 0) unsafeAtomicAdd(ssqb + tok, ss);
    bf16* p = Yb + tok * DM + 512 + h * 64 + 8 * hi;
#pragma unroll
    for (int dh = 0; dh < 2; ++dh)
#pragma unroll
        for (int t = 0; t < 2; ++t) { const int ge = 2 * t, go = 2 * t + 1;
            const unsigned x0 = cvtpk(o[dh][4 * ge], o[dh][4 * ge + 1]), x1 = cvtpk(o[dh][4 * ge + 2], o[dh][4 * ge + 3]);
            const unsigned y0 = cvtpk(o[dh][4 * go], o[dh][4 * go + 1]), y1 = cvtpk(o[dh][4 * go + 2], o[dh][4 * go + 3]);
            const auto r0 = __builtin_amdgcn_permlane32_swap(x0, y0, false, false), r1 = __builtin_amdgcn_permlane32_swap(x1, y1, false, false);
            v4u w; w.x = r0[0]; w.y = r1[0]; w.z = r0[1]; w.w = r1[1];
            *(v4u*)(p + 32 * dh + 16 * t) = w; }
}
struct AUnit { int tok0, dshift, Ls, cc, h, c; };
__device__ __forceinline__ AUnit decode_a(int su) {
    AUnit a; const int sidx = su / 48, k = su % 48, blk = sidx >> 3; a.h = sidx & 7; a.c = 2 - (k >> 4); a.dshift = 2 * a.c; const int kk = k & 15;
    int seq0, S, bis; if (blk < 8) { seq0 = 0; S = 16384; bis = blk; } else { seq0 = MP + 2048 * (blk - 8); S = 2048; bis = 0; }
    a.Ls = S >> a.dshift; const int lcpb = 4 - a.dshift  , res = kk >> lcpb; a.cc = (bis << lcpb) + (kk & ((1 << lcpb) - 1)); a.tok0 = seq0 + res; return a;
}
struct BUnit { int seq0, S, lcb, g2; };
__device__ __forceinline__ BUnit decode_b(int u) {
    BUnit b; b.g2 = u / 768; const int cb = u % 768;
    if (cb < 256) { b.seq0 = 0; b.S = 16384; b.lcb = cb; } else { b.seq0 = MP + 2048 * ((cb - 256) >> 5); b.S = 2048; b.lcb = (cb - 256) & 31; } return b;
}

#define LDS_BAR() asm volatile("s_waitcnt lgkmcnt(0)\n\ts_barrier" ::: "memory")
#define xp (args.in[0])
#define xs (args.in[1])
#define norm1 (args.in[2])
#define w_in (args.in[3])
#define qna (args.in[4])
#define kna (args.in[5])
#define qnb (args.in[6])
#define knb (args.in[7])
#define sinkb (args.in[8])
#define ona (args.in[9])
#define onb (args.in[10])
#define w_out (args.in[11])
#define norm2 (args.in[12])
#define w_up (args.in[13])
#define conv_w (args.in[14])
#define conv_b (args.in[15])
#define w_down (args.in[16])
#define out (args.dout)
#define SSQ ((float*)(args.ws + WS_SSQ))
#define SSQ1 ((float*)(args.ws + WS_SSQ1))
#define SSQB ((float*)(args.ws + WS_SSQB))
#define WIN ((bf16*)(args.ws + WS_WIN))
#define WOUT ((bf16*)(args.ws + WS_WOUT))
#define WUP ((bf16*)(args.ws + WS_WUP))
#define WDN ((bf16*)(args.ws + WS_WDN))
#define XN ((bf16*)(args.ws + WS_XN) + DM)
#define PROJ ((bf16*)(args.ws + WS_PROJ))
#define Y ((bf16*)args.dout)
#define OA ((bf16*)(args.ws + WS_OA))
#define OB ((bf16*)args.dout)
#define HB ((bf16*)(args.ws + WS_H))
#define LA ((float*)(args.ws + WS_LA))
#define LBp ((float*)(args.ws + WS_LA) + 3 * (size_t)M * 8)
struct Args { const float* in[17]; float* dout; unsigned char* ws; };
__global__ void __launch_bounds__(NWAVES * 64, 2) fwd_megakernel(Args args) {
    extern __shared__ __attribute__((aligned(16))) unsigned char lds_raw[];
    cg::grid_group grid = cg::this_grid();
    LAS unsigned char* lds = (LAS unsigned char*)lds_raw;
    const int tid = threadIdx.x, lane = tid & 63, wave = __builtin_amdgcn_readfirstlane(tid >> 6);
    const int G = gridDim.x, bx = blockIdx.x;
    if (tid < 2) ((LAS unsigned*)(lds + MISC_OFF))[tid] = 0u;
    const int gw = bx * NWAVES + wave, NGW = G * NWAVES;
    __syncthreads();
    XcdBarrier bar = xcd_barrier_post((unsigned*)(args.ws + WS_BAR), (volatile LAS unsigned*)(lds + MISC_OFF));
    if (args.ws == nullptr) grid.sync();

    {
        LAS float* scr = (LAS float*)(lds + wave * 16384);
        constexpr int I_IN = (DM / 64) * (INW / 32), I_OUT = (DM / 64) * (DM / 32), I_UP = (DM / 64) * (UPW / 32), I_DN = (DFF / 64) * (DM / 32);
        for (int it = gw; it < I_IN + I_OUT + I_UP + I_DN; it += NGW) {
            int r = it;
            if (r < I_IN) { p0_transpose_item<2>(w_in, DM, INW, WIN, norm1, scr, r, lane); continue; } r -= I_IN;
            if (r < I_OUT) { p0_transpose_item<0>(w_out, DM, DM, WOUT, (r / (DM / 32)) >= 8 ? onb - 512 : nullptr, scr, r, lane); continue; } r -= I_OUT;
            if (r < I_UP) { p0_transpose_item<1>(w_up, DM, UPW, WUP, norm2, scr, r, lane); continue; } r -= I_UP;
            p0_transpose_item<0>(w_down, DFF, DM, WDN, nullptr, scr, r, lane);
        }
        for (int m = gw * 4; m < M; m += NGW * 4) rows4_to_bf16(m < MP ? xp + (size_t)m * DM : xs + (size_t)(m - MP) * DM, XN + (size_t)m * DM, SSQ1 + m, lane);
        for (int i = bx * 512 + tid; i < M; i += G * 512) { SSQ[i] = 0.f; SSQB[i] = 0.f; }
    }
    xcd_barrier(bar);

    {
        pg8::Gemm g{XN, WIN, M, INW, DM, 256}; pg8::StaticOrder S; S.init(M, INW, G, bx);
        pg8::EpiProj E{PROJ, SSQ1, qna, kna, qnb, knb};
        pg8::gemm_phase<pg8::EpiProj, pg8::StaticOrder, PG8_ALIGN, PG8_SP2>(lds, g, S, E);
    }
    xcd_barrier(bar);

    {
        const float gqa = fabsf(qna[lane]), gka = fabsf(kna[lane]);
        const float boundA = __builtin_bit_cast(float, __builtin_amdgcn_readfirstlane(__builtin_bit_cast(int, 8.0f * wave_max(gqa) * wave_max(gka) * LOG2E)));
        const float negMa = boundA > 40.f ? -boundA : 0.f;
        {
            const int half = wave >> 2, w4 = wave & 3, th = tid & 255;
            LAS unsigned char* Kl = lds + half * 65536; LAS unsigned char* Vl = Kl + 32768;
            LAS float* tabA = (LAS float*)(lds + XCH_OFF);
            const int ubase = (G == 256) ? (bx & 7) * 576 + (bx >> 3) : bx, ustep = (G == 256) ? 32 : G, uend = (G == 256) ? (bx & 7) * 576 + 576 : 4608;
            v4u kr[8], vr[8], qraw[4]; AUnit nx = decode_a(2 * ubase + half);
            if (ubase < uend) { stage_load<256, 256>(kr, vr, PROJ + (size_t)(8 + nx.h) * M * 64, PROJ + (size_t)(16 + nx.h) * M * 64, nx.tok0, nx.dshift, 128 * nx.cc - 64, nx.Ls, th);
                load_q_raw(qraw, PROJ + ((size_t)nx.h * M + (nx.tok0 + ((128 * nx.cc + 32 * w4 + (lane & 31)) << nx.dshift))) * 64, lane); }
            for (int u = ubase; u < uend; u += ustep) {
                const AUnit a = nx;
                LDS_BAR();
                stage_write<256, 256>(kr, vr, Kl, Vl, th);
                build_bias_table<64, 208>(tabA, -__builtin_amdgcn_exp2f(-0.5f * (float)(a.h + 9) + (float)a.dshift) * LOG2E, negMa, tid, 512);
                bf16x8 qf[4];
#pragma unroll
                for (int d0 = 0; d0 < 4; ++d0) qf[d0] = __builtin_bit_cast(bf16x8, qraw[d0]);
                LDS_BAR();
                if (u + ustep < uend) { nx = decode_a(2 * (u + ustep) + half);
                    stage_load<256, 256>(kr, vr, PROJ + (size_t)(8 + nx.h) * M * 64, PROJ + (size_t)(16 + nx.h) * M * 64, nx.tok0, nx.dshift, 128 * nx.cc - 64, nx.Ls, th);
                    load_q_raw(qraw, PROJ + ((size_t)nx.h * M + (nx.tok0 + ((128 * nx.cc + 32 * w4 + (lane & 31)) << nx.dshift))) * 64, lane); }
                const int iq0 = 128 * a.cc + 32 * w4;
                f32x16 o[2]; float l = 0.f;
#pragma unroll
                for (int r = 0; r < 16; ++r) { o[0][r] = 0.f; o[1][r] = 0.f; }
                attn_task<5, 208>(Kl, Vl, 256 * 64, 32 * w4, iq0 - 64, a.Ls, qf, tabA, o, l, lane);
                asm volatile("s_nop 15\n\ts_nop 7" ::: "memory");
                store_partial(o, l, OA + (size_t)a.c * M * 512, LA + (size_t)a.c * M * 8, a.tok0 + (iq0 << a.dshift), a.dshift, a.h, lane);
            }
        }
        const float gqb = fabsf(qnb[lane]), gkb = fabsf(knb[lane]);
        const float boundB = __builtin_bit_cast(float, __builtin_amdgcn_readfirstlane(__builtin_bit_cast(int, 8.0f * wave_max(gqb) * wave_max(gkb) * LOG2E)));
        const float negMb = boundB > 40.f ? -boundB : 0.f;
        {
            LAS unsigned char* Kb = lds; LAS unsigned char* Vb = lds + 40960;
            LAS float* tabB = (LAS float*)(lds + 81920);
            const int ubase = (G == 256) ? (bx & 7) * 192 + (bx >> 3) : bx, ustep = (G == 256) ? 32 : G, uend = (G == 256) ? (bx & 7) * 192 + 192 : 1536;
            v4u kr[5], vr[5], qraw[4]; BUnit nx = decode_b(ubase);
            if (ubase < uend) { stage_load<320, 512>(kr, vr, PROJ + (size_t)(32 + nx.g2) * M * 64, PROJ + (size_t)(34 + nx.g2) * M * 64, nx.seq0, 0, 64 * nx.lcb - 128, nx.S, tid);
                load_q_raw(qraw, PROJ + ((size_t)(24 + 4 * nx.g2 + (wave >> 1)) * M + (nx.seq0 + 64 * nx.lcb + 32 * (wave & 1) + (lane & 31))) * 64, lane); }
            for (int u = ubase; u < uend; u += ustep) {
                const BUnit b = nx;
                LDS_BAR();
                stage_write<320, 512>(kr, vr, Kb, Vb, tid);
                build_bias_table<128, 336>(tabB + (tid >> 7) * (4 * 336), -__builtin_amdgcn_exp2f(-0.5f * (float)(4 * b.g2 + (tid >> 7) + 1)) * LOG2E, negMb, tid & 127, 128);
                bf16x8 qf[4];
#pragma unroll
                for (int d0 = 0; d0 < 4; ++d0) qf[d0] = __builtin_bit_cast(bf16x8, qraw[d0]);
                LDS_BAR();
                if (u + ustep < uend) { nx = decode_b(u + ustep);
                    stage_load<320, 512>(kr, vr, PROJ + (size_t)(32 + nx.g2) * M * 64, PROJ + (size_t)(34 + nx.g2) * M * 64, nx.seq0, 0, 64 * nx.lcb - 128, nx.S, tid);
                    load_q_raw(qraw, PROJ + ((size_t)(24 + 4 * nx.g2 + (wave >> 1)) * M + (nx.seq0 + 64 * nx.lcb + 32 * (wave & 1) + (lane & 31))) * 64, lane); }
                const int hb = 4 * b.g2 + (wave >> 1), iq0 = 64 * b.lcb + 32 * (wave & 1);
                f32x16 o[2]; float l = 0.f;
#pragma unroll
                for (int r = 0; r < 16; ++r) { o[0][r] = 0.f; o[1][r] = 0.f; }
                attn_task<9, 336>(Kb, Vb, 320 * 64, 32 * (wave & 1), iq0 - 128, b.S, qf, tabB + (wave >> 1) * (4 * 336), o, l, lane);
                asm volatile("s_nop 15\n\ts_nop 7" ::: "memory");
                store_final_b(o, l, __builtin_amdgcn_exp2f(sinkb[hb] * LOG2E + negMb), Y, SSQB, b.seq0 + iq0, hb, lane);
            }
        }
        xcd_barrier(bar);
        {
            const int hh = lane >> 3;
            const f32x4 ga0 = *(const f32x4*)(ona + 8 * lane), ga1 = *(const f32x4*)(ona + 8 * lane + 4);
            for (int m0 = gw * 4; m0 < M; m0 += NGW * 4) {
                v4u wa[4][3]; float la[4];
#pragma unroll
                for (int k = 0; k < 4; ++k) { const int m = m0 + k; la[k] = 0.f;
#pragma unroll
                    for (int c = 0; c < 3; ++c) { wa[k][c] = *(const v4u*)(OA + (((size_t)c * 8 + hh) * M + m) * 64 + 8 * (lane & 7)); la[k] += LA[((size_t)c * 8 + hh) * M + m]; } }
                float ya[4][8], sa[4];
#pragma unroll
                for (int k = 0; k < 4; ++k) { const float ia = __builtin_amdgcn_rcpf(la[k]);
                    ya[k][0] = (bf_lo(wa[k][0].x) + bf_lo(wa[k][1].x) + bf_lo(wa[k][2].x)) * ia; ya[k][1] = (bf_hi(wa[k][0].x) + bf_hi(wa[k][1].x) + bf_hi(wa[k][2].x)) * ia;
                    ya[k][2] = (bf_lo(wa[k][0].y) + bf_lo(wa[k][1].y) + bf_lo(wa[k][2].y)) * ia; ya[k][3] = (bf_hi(wa[k][0].y) + bf_hi(wa[k][1].y) + bf_hi(wa[k][2].y)) * ia;
                    ya[k][4] = (bf_lo(wa[k][0].z) + bf_lo(wa[k][1].z) + bf_lo(wa[k][2].z)) * ia; ya[k][5] = (bf_hi(wa[k][0].z) + bf_hi(wa[k][1].z) + bf_hi(wa[k][2].z)) * ia;
                    ya[k][6] = (bf_lo(wa[k][0].w) + bf_lo(wa[k][1].w) + bf_lo(wa[k][2].w)) * ia; ya[k][7] = (bf_hi(wa[k][0].w) + bf_hi(wa[k][1].w) + bf_hi(wa[k][2].w)) * ia;
                    sa[k] = 0.f;
#pragma unroll
                    for (int i = 0; i < 8; ++i) sa[k] += ya[k][i] * ya[k][i]; }
#pragma unroll
                for (int o = 1; o < 64; o <<= 1) {
#pragma unroll
                    for (int k = 0; k < 4; ++k) sa[k] += __shfl_xor(sa[k], o); }
#pragma unroll
                for (int k = 0; k < 4; ++k) { const int m = m0 + k;
                    const float ra = __builtin_amdgcn_rsqf(sa[k] * (1.f / 512.f) + EPS);
                    v4u oa;
                    oa.x = cvtpk(ya[k][0] * ra * ga0.x, ya[k][1] * ra * ga0.y); oa.y = cvtpk(ya[k][2] * ra * ga0.z, ya[k][3] * ra * ga0.w); oa.z = cvtpk(ya[k][4] * ra * ga1.x, ya[k][5] * ra * ga1.y); oa.w = cvtpk(ya[k][6] * ra * ga1.z, ya[k][7] * ra * ga1.w);
                    *(v4u*)(Y + (size_t)m * DM + 8 * lane) = oa; }
            }
        }
    }
    xcd_barrier(bar);

    {
        pg8::Gemm g{Y, WOUT, M, DM, DM, 256}; pg8::StaticOrder S; S.init(M, DM, G, bx);
        pg8::EpiOut E{XN, SSQ, SSQB};
        pg8::gemm_phase<pg8::EpiOut, pg8::StaticOrder, PG8_ALIGN, PG8_SP2>(lds, g, S, E);
    }
    xcd_barrier(bar);

    {
        pg8::Gemm g{XN - DM, WUP, UP_TILES_M * 256, UPW, DM, 254}; pg8::StaticOrder S; S.init(UP_TILES_M * 256, UPW, G, bx);
        pg8::EpiUp E{HB, SSQ, conv_w, conv_b, (LAS float*)(lds + XCH_OFF)};
        pg8::gemm_phase<pg8::EpiUp, pg8::StaticOrder, true, PG8_SP2>(lds, g, S, E);
    }
    xcd_barrier(bar);

    {
        pg8::Gemm g{HB, WDN, M, DM, DFF, 256}; pg8::StaticOrder S; S.init(M, DM, G, bx);
        pg8::EpiDown E{XN, out};
        pg8::gemm_phase<pg8::EpiDown, pg8::StaticOrder, PG8_ALIGN, PG8_SP2>(lds, g, S, E);
    }
}

#undef out
#undef xp
#undef xs
extern "C" void kernel_launch(void* const* d_in, const int* in_sizes, int n_in, void* d_out, int out_size, void* d_ws, size_t ws_size, hipStream_t stream) {
    static int grid = 0;
    if (grid == 0) {
        if (n_in != 17 || out_size != M * DM || ws_size < WS_END) { fprintf(stderr, "kernel_launch: unexpected shapes (n_in %d out %d ws %zu)\n", n_in, out_size, ws_size); grid = -1; return; }
        int dev = 0, cus = 0, per_cu = 0;
        hipGetDevice(&dev); hipDeviceGetAttribute(&cus, hipDeviceAttributeMultiprocessorCount, dev);
        if (hipFuncSetAttribute((const void*)fwd_megakernel, hipFuncAttributeMaxDynamicSharedMemorySize, LDS_BYTES) != hipSuccess) { fprintf(stderr, "kernel_launch: hipFuncSetAttribute failed\n"); grid = -1; return; }
        if (hipOccupancyMaxActiveBlocksPerMultiprocessor(&per_cu, (const void*)fwd_megakernel, NWAVES * 64, LDS_BYTES) != hipSuccess || per_cu < 1) { fprintf(stderr, "kernel_launch: occupancy query says %d\n", per_cu); per_cu = 1; }
        (void)hipGetLastError();
        grid = cus;
        fprintf(stderr, "kernel_launch: grid %d (per_cu %d)\n", grid, per_cu);
    }
    if (grid < 0) return;
    Args a{};
    for (int i = 0; i < 17; ++i) a.in[i] = (const float*)d_in[i];
    a.dout = (float*)d_out; a.ws = (unsigned char*)d_ws;
    void* kargs[] = {&a};
    if (hipMemsetAsync((char*)d_ws + WS_BAR, 0, XCD_BAR_WORDS * 4, stream) != hipSuccess) { fprintf(stderr, "kernel_launch: hipMemsetAsync failed\n"); return; }
    hipError_t e = hipLaunchCooperativeKernel((const void*)fwd_megakernel, dim3(grid), dim3(NWAVES * 64), kargs, LDS_BYTES, stream);
    if (e != hipSuccess) fprintf(stderr, "kernel_launch: cooperative launch failed: %s\n", hipGetErrorString(e));
}
```

```cpp
#include <hip/hip_runtime.h>
#include <hip/hip_cooperative_groups.h>
#include <cstdio>
#include <cstdint>
namespace cg = cooperative_groups;
namespace pg8 {
#define PG8_LAS __attribute__((address_space(3)))
typedef unsigned short bf16_t;
typedef short bf16x8 __attribute__((ext_vector_type(8)));
typedef float f32x4 __attribute__((ext_vector_type(4)));
typedef unsigned u32x4 __attribute__((ext_vector_type(4)));
constexpr int BM = 256, BK = 64, HALF = 128, HTB = HALF * BK * 2  , STAGE_BYTES = 8 * HTB, NXCD = 8, WGM = 8;

__host__ __device__ __forceinline__ int lds_byte(int r, int c) { const int st = (r >> 4) * 2 + (c >> 5), rr = r & 15, cc = c & 31, ob = rr * 64 + cc * 2; return st * 1024 + (ob ^ (((ob >> 9) & 1) << 5)); }
__host__ __device__ __forceinline__ void stage_rc(int b, int& R, int& C) { const int st = b / 1024, sb = b % 1024, swz = sb ^ (((sb >> 9) & 1) << 5); R = (st >> 1) * 16 + swz / 64; C = (st & 1) * 32 + (swz % 64) / 2; }
__host__ __device__ __forceinline__ int perm32(int rho) { const int n = rho >> 4, i = rho & 15; return 8 * (i >> 2) + 4 * n + (i & 3); }

struct Unit { int pm, pn; };
struct Gemm { const bf16_t* A; const bf16_t* Bt; int M, N, K; int a_tile_rows; };

struct StaticOrder {
    int nM, nN, nwg, G, c;
    __host__ __device__ void init(int M, int N, int G_, int c_) { nM = M / BM; nN = N / BM; nwg = nM * nN; G = G_; c = c_; }
    __host__ __device__ bool next(int i, Unit& u) const {
        const long L = (long)i * G + c; if (L >= nwg) return false;
        int wgid = (int)L; { const int q = nwg / NXCD, r = nwg % NXCD, xcd = wgid % NXCD, off = wgid / NXCD; wgid = (xcd < r ? xcd * (q + 1) : r * (q + 1) + (xcd - r) * q) + off; }
        const int nig = WGM * nN, gid = wgid / nig, fm = gid * WGM, gsz = (nM - fm) < WGM ? (nM - fm) : WGM;
        u.pm = fm + ((wgid % nig) % gsz); u.pn = (wgid % nig) / gsz; return true;
    }
    __device__ __forceinline__ void a_ready(const Unit&) const {}
    __device__ __forceinline__ void done(const Unit&) const {}
};

__device__ __forceinline__ unsigned cvt_pk_bf16(float lo, float hi) { unsigned r; asm volatile("v_cvt_pk_bf16_f32 %0, %1, %2" : "=v"(r) : "v"(lo), "v"(hi)); return r; }
typedef float f32x2 __attribute__((ext_vector_type(2))); typedef __bf16 bf16x2_t __attribute__((ext_vector_type(2)));
__device__ __forceinline__ unsigned cvtpk(float lo, float hi) { f32x2 v = {lo, hi}; bf16x2_t b = __builtin_convertvector(v, bf16x2_t); return __builtin_bit_cast(unsigned, b); }
constexpr int MTOK = 49152, MPROMPT = 16384, DMODEL = 1024, DFF_ = 2816;
__device__ __forceinline__ u32x4 pack8(const f32x4 a, const f32x4 b) { u32x4 w; w.x = cvtpk(a[0], a[1]); w.y = cvtpk(a[2], a[3]); w.z = cvtpk(b[0], b[1]); w.w = cvtpk(b[2], b[3]); return w; }

struct EpiProj {
    static constexpr bool PERM = true, AFTER_DRAIN = false; static constexpr int MIDK = 0;
    bf16_t* O; const float* ssq1; const float* gqa; const float* gka; const float* gqb; const float* gkb;
    __device__ __forceinline__ void operator()(f32x4 (&acc)[2][2][4][2], const Unit& u, int wr, int wc, int fr, int fq, int wid, int lane) const {
        const int hs = 4 * u.pn + wc;
        const float* g = nullptr; float sc = 1.f;
        if (hs < 8) { g = gqa; sc = 0.125f * 1.4426950408889634f; } else if (hs < 16) g = gka; else if (hs >= 24 && hs < 32) { g = gqb; sc = 0.125f * 1.4426950408889634f; } else if (hs >= 32 && hs < 34) g = gkb;
        const int row0 = u.pm * BM + wr * 64 + fr;
        bf16_t* obase = O + ((size_t)hs * MTOK + row0) * 64 + 8 * fq;
#pragma unroll
        for (int ai = 0; ai < 2; ++ai)
#pragma unroll
            for (int m = 0; m < 4; ++m) { const float r1 = __builtin_amdgcn_rsqf(ssq1[row0 + ai * HALF + m * 16] * (1.0f / DMODEL) + 1e-6f);
#pragma unroll
                for (int bj = 0; bj < 2; ++bj)
#pragma unroll
                    for (int n = 0; n < 2; ++n) acc[ai][bj][m][n] *= r1; }
        if (g) {
            f32x4 gg[2][2];
#pragma unroll
            for (int bj = 0; bj < 2; ++bj)
#pragma unroll
                for (int n = 0; n < 2; ++n) gg[bj][n] = *(const f32x4*)(g + 32 * bj + 8 * fq + 4 * n) * sc;
#pragma unroll
            for (int ai = 0; ai < 2; ++ai)
#pragma unroll
                for (int m = 0; m < 4; ++m) { float ss = 0.f;
#pragma unroll
                    for (int bj = 0; bj < 2; ++bj)
#pragma unroll
                        for (int n = 0; n < 2; ++n) { const f32x4 a = acc[ai][bj][m][n]; ss += (a[0] * a[0] + a[1] * a[1]) + (a[2] * a[2] + a[3] * a[3]); }
                    ss += __shfl_xor(ss, 16); ss += __shfl_xor(ss, 32);
                    const float rs = __builtin_amdgcn_rsqf(ss * (1.0f / 64.0f) + 1e-6f);
                    bf16_t* rowp = obase + (size_t)(ai * HALF + m * 16) * 64;
#pragma unroll
                    for (int bj = 0; bj < 2; ++bj) *(u32x4*)(rowp + 32 * bj) = pack8(acc[ai][bj][m][0] * rs * gg[bj][0], acc[ai][bj][m][1] * rs * gg[bj][1]); }
        } else {
#pragma unroll
            for (int ai = 0; ai < 2; ++ai)
#pragma unroll
                for (int m = 0; m < 4; ++m) { bf16_t* rowp = obase + (size_t)(ai * HALF + m * 16) * 64;
#pragma unroll
                    for (int bj = 0; bj < 2; ++bj) *(u32x4*)(rowp + 32 * bj) = pack8(acc[ai][bj][m][0], acc[ai][bj][m][1]); }
        }
    }
};
struct EpiOut {
    static constexpr bool PERM = true, AFTER_DRAIN = false; static constexpr int MIDK = 8;
    bf16_t* xb; float* ssq; const float* ssqb;
    __device__ __forceinline__ void mid(f32x4 (&acc)[2][2][4][2], const Unit& u, int wr, int wc, int fr, int fq) const {
        const float* sp = ssqb + (u.pm * BM + wr * 64 + fr);
        asm volatile("s_nop 15\n\ts_nop 15" ::: "memory");
#pragma unroll
        for (int ai = 0; ai < 2; ++ai) {
            float f[4];
#pragma unroll
            for (int m = 0; m < 4; ++m) f[m] = __builtin_amdgcn_sqrtf(sp[ai * HALF + m * 16] * (1.0f / 512.0f) + 1e-6f);
#pragma unroll
            for (int bj = 0; bj < 2; ++bj)
#pragma unroll
                for (int m = 0; m < 4; ++m)
#pragma unroll
                    for (int n = 0; n < 2; ++n) acc[ai][bj][m][n] *= f[m];
            asm volatile("" ::: "memory"); }
        asm volatile("s_nop 7" ::: "memory");
    }
    __device__ __forceinline__ void operator()(f32x4 (&acc)[2][2][4][2], const Unit& u, int wr, int wc, int fr, int fq, int wid, int lane) const {
        const int col0 = u.pn * BM + wc * 32 + 8 * fq; const int gr0 = u.pm * BM + wr * 64 + fr;
#pragma unroll
        for (int ai = 0; ai < 2; ++ai) {
            u32x4 w[4][2]; float rb[4];
#pragma unroll
            for (int m = 0; m < 4; ++m) { rb[m] = ssqb[gr0 + ai * HALF + m * 16];
#pragma unroll
                for (int bj = 0; bj < 2; ++bj) w[m][bj] = *(const u32x4*)(xb + (size_t)(gr0 + ai * HALF + m * 16) * DMODEL + col0 + bj * HALF); }
#pragma unroll
            for (int m = 0; m < 4; ++m) { const int gr = gr0 + ai * HALF + m * 16;
                float s = 0.f; const float r = __builtin_amdgcn_rsqf(rb[m] * (1.0f / 512.0f) + 1e-6f);
#pragma unroll
                for (int bj = 0; bj < 2; ++bj) { const u32x4 v = w[m][bj];
                    f32x4 a = {__uint_as_float(v.x << 16), __uint_as_float(v.x & 0xffff0000u), __uint_as_float(v.y << 16), __uint_as_float(v.y & 0xffff0000u)};
                    f32x4 b = {__uint_as_float(v.z << 16), __uint_as_float(v.z & 0xffff0000u), __uint_as_float(v.w << 16), __uint_as_float(v.w & 0xffff0000u)};
                    a += acc[ai][bj][m][0] * r; b += acc[ai][bj][m][1] * r;
                    s += (a[0] * a[0] + a[1] * a[1]) + (a[2] * a[2] + a[3] * a[3]) + (b[0] * b[0] + b[1] * b[1]) + (b[2] * b[2] + b[3] * b[3]);
                    *(u32x4*)(xb + (size_t)gr * DMODEL + col0 + bj * HALF) = pack8(a, b); }
                s += __shfl_xor(s, 16); s += __shfl_xor(s, 32);
                if (fq == 0) unsafeAtomicAdd(ssq + gr, s); }
            asm volatile("" ::: "memory"); }
    }
};
struct EpiDown {
    static constexpr bool PERM = true, AFTER_DRAIN = false; static constexpr int MIDK = 0;
    const bf16_t* xb; float* out;
    __device__ __forceinline__ void operator()(f32x4 (&acc)[2][2][4][2], const Unit& u, int wr, int wc, int fr, int fq, int wid, int lane) const {
        const int col0 = u.pn * BM + wc * 32 + 8 * fq; const int gr0 = u.pm * BM + wr * 64 + fr;
        u32x4 w[2][4][2];
#pragma unroll
        for (int ai = 0; ai < 2; ++ai)
#pragma unroll
            for (int m = 0; m < 4; ++m)
#pragma unroll
                for (int bj = 0; bj < 2; ++bj) w[ai][m][bj] = __builtin_nontemporal_load((const u32x4*)(xb + (size_t)(gr0 + ai * HALF + m * 16) * DMODEL + col0 + bj * HALF));
#pragma unroll
        for (int ai = 0; ai < 2; ++ai)
#pragma unroll
            for (int m = 0; m < 4; ++m) { float* o = out + (size_t)(gr0 + ai * HALF + m * 16) * DMODEL + col0;
#pragma unroll
                for (int bj = 0; bj < 2; ++bj) { const u32x4 v = w[ai][m][bj];
                    f32x4 a = {__uint_as_float(v.x << 16), __uint_as_float(v.x & 0xffff0000u), __uint_as_float(v.y << 16), __uint_as_float(v.y & 0xffff0000u)};
                    f32x4 b = {__uint_as_float(v.z << 16), __uint_as_float(v.z & 0xffff0000u), __uint_as_float(v.w << 16), __uint_as_float(v.w & 0xffff0000u)};
                    a += acc[ai][bj][m][0]; b += acc[ai][bj][m][1]; *(f32x4*)(o + bj * HALF) = a; *(f32x4*)(o + bj * HALF + 4) = b; } }
    }
};
__device__ __forceinline__ bool seq_first(int gr) { return gr == 0 || (gr >= MPROMPT && (gr & 2047) == 0); }
__device__ __forceinline__ bool seq_last(int gr) { return gr >= MPROMPT - 1 && (gr & 2047) == 2047; }
struct EpiUp {
    static constexpr bool PERM = true, AFTER_DRAIN = false; static constexpr int MIDK = 0;
    bf16_t* H; const float* ssq; const float* cw; const float* cb; PG8_LAS float* xch;
    __device__ __forceinline__ void operator()(f32x4 (&acc)[2][2][4][2], const Unit& u, int wr, int wc, int fr, int fq, int wid, int lane) const {
        const int lr0 = wr * 64 + fr, gr0 = 254 * u.pm - 1 + lr0;
#pragma unroll
        for (int ai = 0; ai < 2; ++ai)
#pragma unroll
            for (int m = 0; m < 4; ++m) { int gr = gr0 + ai * HALF + m * 16; gr = gr < 0 ? 0 : (gr > MTOK - 1 ? MTOK - 1 : gr);
                const float rs = __builtin_amdgcn_rsqf(ssq[gr] * (1.0f / DMODEL) + 1e-6f);
#pragma unroll
                for (int bj = 0; bj < 2; ++bj)
#pragma unroll
                    for (int n = 0; n < 2; ++n) acc[ai][bj][m][n] *= rs; }
#pragma unroll
        for (int ai = 0; ai < 2; ++ai) {
            if (fr == 0) { PG8_LAS float* p = xch + ((wid * 2 + ai) * 2 + 0) * 64 + 8 * fq;
#pragma unroll
                for (int bj = 0; bj < 2; ++bj)
#pragma unroll
                    for (int n = 0; n < 2; ++n) *(PG8_LAS f32x4*)(p + bj * 32 + 4 * n) = acc[ai][bj][0][n]; }
            if (fr == 15) { PG8_LAS float* p = xch + ((wid * 2 + ai) * 2 + 1) * 64 + 8 * fq;
#pragma unroll
                for (int bj = 0; bj < 2; ++bj)
#pragma unroll
                    for (int n = 0; n < 2; ++n) *(PG8_LAS f32x4*)(p + bj * 32 + 4 * n) = acc[ai][bj][3][n]; }
        }
        asm volatile("s_waitcnt lgkmcnt(0)" ::: "memory"); __builtin_amdgcn_s_barrier(); asm volatile("" ::: "memory");
        const int tlo = 254 * u.pm - 1, thi = tlo + 255; const bool anyb = (tlo <= 0) || (((thi + 1) >> 11) != ((tlo - 1) >> 11));
        unsigned hold0 = 0u, hold1 = 0u;
        const int ow = (1 - wr) * 4 + wc;
        const int chb = 128 * u.pn + 32 * wc + 16 * (fq >> 1);
#pragma unroll
        for (int n = 0; n < 2; ++n) {
            f32x4 w0[2], w1[2], w2[2], bb[2];
#pragma unroll
            for (int bj = 0; bj < 2; ++bj) { const int ch = chb + 8 * n + 4 * (fq & 1) + bj * DFF_;
                w0[bj] = *(const f32x4*)(cw + ch); w1[bj] = *(const f32x4*)(cw + 2 * DFF_ + ch); w2[bj] = *(const f32x4*)(cw + 4 * DFF_ + ch); bb[bj] = *(const f32x4*)(cb + ch); }
#pragma unroll
            for (int ai = 0; ai < 2; ++ai) {
                const int aiT = wr == 1 ? ai : ai - 1, aiB = wr == 0 ? ai : ai + 1;
#pragma unroll
                for (int m = 0; m < 4; ++m) {
                    const int lr = lr0 + ai * HALF + m * 16, gr = gr0 + ai * HALF + m * 16;
                    const bool first = seq_first(gr), last = seq_last(gr);
                    f32x4 c[2];
#pragma unroll
                    for (int bj = 0; bj < 2; ++bj) {
                        const f32x4 cur = acc[ai][bj][m][n];
                        f32x4 pv, nx;
#pragma unroll
                        for (int e = 0; e < 4; ++e) {
                            const float sP = (m > 0 && fr == 15) ? acc[ai][bj][m > 0 ? m - 1 : 0][n][e] : cur[e];
                            const float sN = (m < 3 && fr == 0) ? acc[ai][bj][m < 3 ? m + 1 : 3][n][e] : cur[e];
                            pv[e] = __builtin_bit_cast(float, __builtin_amdgcn_mov_dpp(__builtin_bit_cast(int, sP), 0x121  , 0xf, 0xf, true));
                            nx[e] = __builtin_bit_cast(float, __builtin_amdgcn_mov_dpp(__builtin_bit_cast(int, sN), 0x12f  , 0xf, 0xf, true)); }
                        if (m == 0) { const f32x4 top = (aiT >= 0) ? *(const PG8_LAS f32x4*)(xch + ((ow * 2 + (aiT < 0 ? 0 : aiT)) * 2 + 1) * 64 + 8 * fq + bj * 32 + 4 * n) : (f32x4){0.f, 0.f, 0.f, 0.f}; if (fr == 0) pv = top; }
                        if (m == 3) { const f32x4 bot = (aiB <= 1) ? *(const PG8_LAS f32x4*)(xch + ((ow * 2 + (aiB > 1 ? 1 : aiB)) * 2 + 0) * 64 + 8 * fq + bj * 32 + 4 * n) : (f32x4){0.f, 0.f, 0.f, 0.f}; if (fr == 15) nx = bot; }
                        if (anyb) { if (first) pv = (f32x4){0.f, 0.f, 0.f, 0.f}; if (last) nx = (f32x4){0.f, 0.f, 0.f, 0.f}; }
                        c[bj] = bb[bj] + w0[bj] * pv + w1[bj] * cur + w2[bj] * nx;
                    }
                    f32x4 hv;
#pragma unroll
                    for (int e = 0; e < 4; ++e) { const float g = c[0][e]; hv[e] = g * __builtin_amdgcn_rcpf(1.0f + __builtin_amdgcn_exp2f(-1.4426950408889634f * g)) * c[1][e]; }
                    const unsigned pkx = cvtpk(hv[0], hv[1]), pky = cvtpk(hv[2], hv[3]);
                    if ((m & 1) == 0) { hold0 = pkx; hold1 = pky; }
                    else { const auto r0 = __builtin_amdgcn_permlane16_swap(hold0, pkx, false, false), r1 = __builtin_amdgcn_permlane16_swap(hold1, pky, false, false);
                        u32x4 w; w.x = r0[0]; w.y = r1[0]; w.z = r0[1]; w.w = r1[1];
                        const int ms = (fq & 1) ? m : m - 1, lrS = lr0 + ai * HALF + ms * 16, grS = gr0 + ai * HALF + ms * 16;
                        if (lrS >= 1 && lrS <= 254 && grS < MTOK) *(u32x4*)(H + (size_t)grS * DFF_ + chb + 8 * n) = w; }
                    asm volatile("" ::: "memory");
                }
            }
        }
    }
};
template <class Epi, class Sched, bool ALIGN_EPI = false, bool SP2 = false>
__device__ __forceinline__ void gemm_phase(PG8_LAS unsigned char* lds, const Gemm g, const Sched& S, const Epi& E) {
    int tid_ = threadIdx.x; asm volatile("" : "+v"(tid_));
    const int tid = tid_, wid = __builtin_amdgcn_readfirstlane(tid >> 6), lane = tid & 63, wr = wid >> 2, wc = wid & 3, fr = lane & 15, fq = lane >> 4;
    const int K = g.K, nt = K / BK;
    unsigned voffA[2], voffB[2];
#pragma unroll
    for (int i = 0; i < 2; ++i) { int R, C; stage_rc(tid * 16 + i * 8192, R, C); const int Rb = Epi::PERM ? ((R & ~31) + perm32(R & 31)) : R;
        voffA[i] = (unsigned)(R * K + C) * 2u; voffB[i] = (unsigned)(Rb * K + C) * 2u; }
    const size_t kstep = (size_t)(BK * 2);
    const size_t hstep = (size_t)HALF * K * 2;
    const size_t tstep = 2 * hstep; const size_t tstepA = (size_t)g.a_tile_rows * K * 2;
    const unsigned ldsw = (unsigned)wid * 1024u;
    const int aoff = lds_byte(wr * 64 + fr, fq * 8), boff = lds_byte(wc * 32 + fr, fq * 8);
#define PG8_SA(b, h) (((b) * 2 + (h)) * HTB)
#define PG8_SB(b, h) ((4 + (b) * 2 + (h)) * HTB)
#define PG8_STAGE(bufoff, gbase, voff) do { _Pragma("unroll") for (int _i = 0; _i < 2; ++_i) \
        __builtin_amdgcn_global_load_lds((const unsigned*)((const char*)(gbase) + (voff)[_i]), (PG8_LAS unsigned*)(lds + (bufoff) + ldsw + _i * 8192), 16, 0, 0); } while (0)
#define PG8_LDA(dst, b, h) do { _Pragma("unroll") for (int m = 0; m < 4; ++m) _Pragma("unroll") for (int k = 0; k < 2; ++k) dst[m][k] = *(const PG8_LAS bf16x8*)(lds + PG8_SA(b, h) + aoff + m * 2048 + k * 1024); } while (0)
#define PG8_LDB(dst, b, h) do { _Pragma("unroll") for (int n = 0; n < 2; ++n) _Pragma("unroll") for (int k = 0; k < 2; ++k) dst[n][k] = *(const PG8_LAS bf16x8*)(lds + PG8_SB(b, h) + boff + n * 2048 + k * 1024); } while (0)
#define PG8_MMA(ai, bj, At, Bt) do { __builtin_amdgcn_s_setprio(1); _Pragma("unroll") for (int m = 0; m < 4; ++m) _Pragma("unroll") for (int n = 0; n < 2; ++n) _Pragma("unroll") for (int k = 0; k < 2; ++k) \
        acc[ai][bj][m][n] = __builtin_amdgcn_mfma_f32_16x16x32_bf16(Bt[n][k], At[m][k], acc[ai][bj][m][n], 0, 0, 0); __builtin_amdgcn_s_setprio(0); } while (0)
#define PG8_WAIT_V(n) asm volatile("s_waitcnt vmcnt(" #n ")" ::: "memory")
#define PG8_WAIT_L(n) asm volatile("s_waitcnt lgkmcnt(" #n ")" ::: "memory")
#define PG8_BAR __builtin_amdgcn_s_barrier()
#define PG8_SCHED __builtin_amdgcn_sched_barrier(0)
    Unit cur, nxt; int ui = 0;
    if (!S.next(0, cur)) return;
    f32x4 acc[2][2][4][2];
#pragma unroll
    for (int a = 0; a < 2; ++a)
#pragma unroll
        for (int b = 0; b < 2; ++b)
#pragma unroll
            for (int m = 0; m < 4; ++m)
#pragma unroll
                for (int n = 0; n < 2; ++n) acc[a][b][m][n] = (f32x4){0.f, 0.f, 0.f, 0.f};
    bf16x8 At[4][2], B0[2][2], B1[2][2];
    const char* cA = (const char*)g.A + (size_t)cur.pm * tstepA; const char* cB = (const char*)g.Bt + (size_t)cur.pn * tstep;
    S.a_ready(cur);
    if constexpr (SP2) {
        PG8_STAGE(PG8_SB(0, 0), cB, voffB); PG8_STAGE(PG8_SB(0, 1), cB + hstep, voffB); PG8_STAGE(PG8_SA(0, 0), cA, voffA); PG8_STAGE(PG8_SA(0, 1), cA + hstep, voffA);
        if (wr == 1) PG8_BAR;
        PG8_WAIT_V(2); PG8_BAR;
        PG8_STAGE(PG8_SB(1, 0), cB + kstep, voffB); PG8_STAGE(PG8_SA(1, 0), cA + kstep, voffA); PG8_STAGE(PG8_SB(1, 1), cB + hstep + kstep, voffB);
        PG8_WAIT_V(6); PG8_BAR;
    } else {
        PG8_STAGE(PG8_SB(0, 0), cB, voffB); PG8_STAGE(PG8_SA(0, 0), cA, voffA); PG8_STAGE(PG8_SB(0, 1), cB + hstep, voffB); PG8_STAGE(PG8_SA(0, 1), cA + hstep, voffA);
        if (wr == 1) PG8_BAR;
        PG8_WAIT_V(4); PG8_BAR;
        PG8_STAGE(PG8_SB(1, 0), cB + kstep, voffB); PG8_STAGE(PG8_SA(1, 0), cA + kstep, voffA); PG8_STAGE(PG8_SB(1, 1), cB + hstep + kstep, voffB);
        PG8_WAIT_V(6); PG8_BAR;
    }
    for (;;) {
        const bool has_next = S.next(ui + 1, nxt);
        const char* nA = has_next ? (const char*)g.A + (size_t)nxt.pm * tstepA : cA; const char* nB = has_next ? (const char*)g.Bt + (size_t)nxt.pn * tstep : cB;
        for (int t = 0; t < nt; t += 2) {
            if constexpr (Epi::MIDK > 0) { if (t == Epi::MIDK) E.mid(acc, cur, wr, wc, fr, fq); }
            const bool last = (t == nt - 2);
            const char* a1 = cA + (size_t)(t + 1) * kstep;
            const char* a2 = last ? nA : cA + (size_t)(t + 2) * kstep; const char* b2 = last ? nB : cB + (size_t)(t + 2) * kstep;
            const char* a3 = a2 + kstep; const char* b3 = b2 + kstep;
            if (last && has_next) S.a_ready(nxt);
            if constexpr (SP2) {
            PG8_LDB(B0, 0, 0); PG8_LDB(B1, 0, 1); PG8_SCHED; PG8_LDA(At, 0, 0); PG8_STAGE(PG8_SA(1, 1), a1 + hstep, voffA);
            PG8_WAIT_V(8); PG8_WAIT_L(0); PG8_BAR; PG8_MMA(0, 0, At, B0); PG8_MMA(0, 1, At, B1); PG8_BAR; PG8_SCHED;
            PG8_LDA(At, 0, 1); PG8_STAGE(PG8_SB(0, 0), b2, voffB); PG8_STAGE(PG8_SB(0, 1), b2 + hstep, voffB); PG8_STAGE(PG8_SA(0, 0), a2, voffA);
            PG8_WAIT_V(8); PG8_WAIT_L(0); PG8_BAR; PG8_MMA(1, 0, At, B0); PG8_MMA(1, 1, At, B1); PG8_BAR; PG8_SCHED;
            PG8_LDB(B0, 1, 0); PG8_LDB(B1, 1, 1); PG8_SCHED; PG8_LDA(At, 1, 0); PG8_STAGE(PG8_SA(0, 1), a2 + hstep, voffA);
            PG8_WAIT_V(8); PG8_WAIT_L(0); PG8_BAR; PG8_MMA(0, 0, At, B0); PG8_MMA(0, 1, At, B1); PG8_BAR; PG8_SCHED;
            PG8_LDA(At, 1, 1); PG8_STAGE(PG8_SB(1, 0), b3, voffB); PG8_STAGE(PG8_SB(1, 1), b3 + hstep, voffB); PG8_STAGE(PG8_SA(1, 0), a3, voffA);
            PG8_WAIT_V(8); PG8_WAIT_L(0); PG8_BAR; PG8_MMA(1, 0, At, B0); PG8_MMA(1, 1, At, B1); PG8_BAR; PG8_SCHED;
            } else {
            PG8_LDB(B0, 0, 0); PG8_SCHED; PG8_LDA(At, 0, 0); PG8_STAGE(PG8_SA(1, 1), a1 + hstep, voffA);
            PG8_WAIT_L(8); PG8_BAR; PG8_WAIT_L(0); PG8_MMA(0, 0, At, B0); PG8_BAR; PG8_SCHED;
            PG8_LDB(B1, 0, 1); PG8_STAGE(PG8_SB(0, 0), b2, voffB);
            PG8_BAR; PG8_WAIT_L(0); PG8_MMA(0, 1, At, B1); PG8_BAR;
            PG8_LDA(At, 0, 1); PG8_STAGE(PG8_SA(0, 0), a2, voffA);
            PG8_BAR; PG8_WAIT_L(0); PG8_MMA(1, 0, At, B0); PG8_BAR; PG8_SCHED;
            PG8_STAGE(PG8_SB(0, 1), b2 + hstep, voffB);
            PG8_WAIT_V(6); PG8_BAR; PG8_MMA(1, 1, At, B1); PG8_BAR;
            PG8_LDB(B0, 1, 0); PG8_SCHED; PG8_LDA(At, 1, 0); PG8_STAGE(PG8_SA(0, 1), a2 + hstep, voffA);
            PG8_WAIT_L(8); PG8_BAR; PG8_WAIT_L(0); PG8_MMA(0, 0, At, B0); PG8_BAR; PG8_SCHED;
            PG8_LDB(B1, 1, 1); PG8_STAGE(PG8_SB(1, 0), b3, voffB);
            PG8_BAR; PG8_WAIT_L(0); PG8_MMA(0, 1, At, B1); PG8_BAR;
            PG8_LDA(At, 1, 1); PG8_STAGE(PG8_SA(1, 0), a3, voffA);
            PG8_BAR; PG8_WAIT_L(0); PG8_MMA(1, 0, At, B0); PG8_BAR; PG8_SCHED;
            PG8_STAGE(PG8_SB(1, 1), b3 + hstep, voffB);
            PG8_WAIT_V(6); PG8_BAR; PG8_MMA(1, 1, At, B1); PG8_BAR;
            }
        }
        if constexpr (ALIGN_EPI) { if (wr == 0) PG8_BAR; }
        if constexpr (!Epi::AFTER_DRAIN) { E(acc, cur, wr, wc, fr, fq, wid, lane); S.done(cur); }
        if (!has_next) break;
#pragma unroll
        for (int a = 0; a < 2; ++a)
#pragma unroll
            for (int b = 0; b < 2; ++b)
#pragma unroll
                for (int m = 0; m < 4; ++m)
#pragma unroll
                    for (int n = 0; n < 2; ++n) acc[a][b][m][n] = (f32x4){0.f, 0.f, 0.f, 0.f};
        cur = nxt; cA = nA; cB = nB; ++ui;
        if constexpr (ALIGN_EPI) { if (wr == 1) PG8_BAR; }
    }
    PG8_WAIT_V(0);
    if constexpr (!ALIGN_EPI) { if (wr == 0) PG8_BAR; }
    PG8_BAR;
    if constexpr (Epi::AFTER_DRAIN) { E.fused(acc, cur, wr, wc, fr, fq, lds, wid, lane); S.done(cur); }
#undef PG8_SA
#undef PG8_SB
#undef PG8_STAGE
#undef PG8_LDA
#undef PG8_LDB
#undef PG8_MMA
#undef PG8_WAIT_V
#undef PG8_WAIT_L
#undef PG8_BAR
#undef PG8_SCHED
}
}
#ifndef PG8_SP2
#define PG8_SP2 true
#endif
#ifndef PG8_ALIGN
#define PG8_ALIGN true
#endif

constexpr int NWAVES = 8;
constexpr int DM = 1024, M = 49152, MP = 16384, INW = 2304, DFF = 2816, UPW = 5632;
constexpr int QA_OFF = 0, KA_OFF = 512, VA_OFF = 1024, QB_OFF = 1536, KB_OFF = 2048, VB_OFF = 2176;
constexpr int UP_TILES_M = 194;
constexpr float EPS = 1e-6f, LOG2E = 1.4426950408889634f;

constexpr size_t MiB = 1u << 20;
constexpr size_t WS_SSQ = 0;
constexpr size_t WS_SSQB = 768 * 1024;
constexpr size_t WS_SSQ1 = 512 * 1024;
constexpr size_t WS_BAR = 1 * MiB;
constexpr size_t WS_WIN = 2 * MiB, WS_WOUT = 7 * MiB, WS_WUP = 9 * MiB, WS_WDN = 20 * MiB;
constexpr size_t WS_XN = 32 * MiB;
constexpr size_t WS_PROJ = 130 * MiB;
constexpr size_t WS_OA = 346 * MiB;
constexpr size_t WS_H = 226 * MiB;
constexpr size_t WS_LA = 490 * MiB;
constexpr size_t WS_END = 496 * MiB;
static_assert(WS_XN + (size_t)(M + 256) * DM * 2 <= WS_PROJ && WS_PROJ + (size_t)M * INW * 2 <= WS_OA && WS_OA + 3 * (size_t)M * 512 * 2 <= WS_LA && WS_H + (size_t)M * DFF * 2 <= WS_LA && WS_PROJ + (size_t)M * DM * 2 <= WS_H, "d_ws map");

constexpr int RING_BYTES = 131072, XCH_OFF = RING_BYTES, MISC_OFF = XCH_OFF + 8192, LDS_BYTES = 147456;

#define LAS __attribute__((address_space(3)))
typedef unsigned short bf16;
typedef unsigned v4u __attribute__((ext_vector_type(4)));
typedef float f32x4 __attribute__((ext_vector_type(4)));
typedef float f32x16 __attribute__((ext_vector_type(16)));
typedef short bf16x8 __attribute__((ext_vector_type(8)));
typedef short s16x4 __attribute__((ext_vector_type(4)));
using pg8::cvtpk;
__device__ __forceinline__ float bf_lo(unsigned w) { return __uint_as_float(w << 16); }
__device__ __forceinline__ float bf_hi(unsigned w) { return __uint_as_float(w & 0xffff0000u); }
__device__ __forceinline__ float wave_sum(float v) {
#pragma unroll
    for (int o = 1; o < 64; o <<= 1) v += __shfl_xor(v, o);
    return v;
}
__device__ __forceinline__ float wave_max(float v) {
#pragma unroll
    for (int o = 1; o < 64; o <<= 1) v = fmaxf(v, __shfl_xor(v, o));
    return v;
}

#define GAS __attribute__((address_space(1)))
#define RLX_AGENT __ATOMIC_RELAXED, __HIP_MEMORY_SCOPE_AGENT
#define XB_TMO      128
#define XB_XCNT(j)  (256  + 64 * (j))
#define XB_XSUB(j)  (1280 + 64 * (j))
#define XB_XGEN(j)  (2304 + 64 * (j))
#define XB_TOP      3328
#define XB_TOPGEN   3392
#define XCD_BAR_WORDS 3456
#define XB_SPIN_CAP (1u << 18)

__device__ __forceinline__ unsigned xb_ld(unsigned* p)              { return __hip_atomic_load(p, __ATOMIC_RELAXED, __HIP_MEMORY_SCOPE_AGENT); }
__device__ __forceinline__ unsigned xb_add(unsigned* p, unsigned v) { return __hip_atomic_fetch_add(p, v, __ATOMIC_RELAXED, __HIP_MEMORY_SCOPE_AGENT); }
__device__ __forceinline__ unsigned xb_xcc_id() { return (unsigned)__builtin_amdgcn_s_getreg((3 << 11) | 20) & 0xFu; }
#define XB_SPIN(cond, bar) do { unsigned _sp = 0; while (cond) { __builtin_amdgcn_s_sleep(1); \
    if ((++_sp & 255u) == 0u) { if (xb_ld(&(bar)[XB_TMO])) break; if (_sp > XB_SPIN_CAP) { atomicAdd(&(bar)[XB_TMO], 1u); break; } } } } while (0)

struct XcdBarrier {
    unsigned* bar; unsigned x;
    volatile LAS unsigned* st;
};

__device__ __forceinline__ XcdBarrier xcd_barrier_post(unsigned* bar, volatile LAS unsigned* st) {
    XcdBarrier b; b.bar = bar; b.x = xb_xcc_id(); b.st = st;
    if (threadIdx.x == 0) (void)xb_add(&bar[XB_XCNT(b.x)], 1u);
    return b;
}
__device__ __forceinline__ void xcd_barrier_complete(unsigned* bar, unsigned x, unsigned& nloc, unsigned& nx) {
    const unsigned G = gridDim.x * gridDim.y * gridDim.z;
    unsigned sum, cnt, mine, sp = 0u;
    for (;;) {
        sum = 0u; cnt = 0u; mine = 0u;
#pragma unroll
        for (unsigned j = 0; j < 16; ++j) { const unsigned c = xb_ld(&bar[XB_XCNT(j)]); sum += c; cnt += (c > 0u) ? 1u : 0u; mine = (j == x) ? c : mine; }
        if (sum == G) break;
        __builtin_amdgcn_s_sleep(1);
        if ((++sp & 255u) == 0u) { if (xb_ld(&bar[XB_TMO])) break; if (sp > XB_SPIN_CAP) { atomicAdd(&bar[XB_TMO], 1u); break; } }
    }
    nloc = mine > 0u ? mine : 1u; nx = cnt > 0u ? cnt : 1u;
}

__device__ __forceinline__ void xcd_barrier(const XcdBarrier& b) {
    asm volatile("s_waitcnt vmcnt(0)" ::: "memory");
    __syncthreads();
    if (threadIdx.x == 0) {
        unsigned* bar = b.bar;
        __builtin_amdgcn_s_waitcnt(0);
        unsigned nloc = b.st[0], nx = b.st[1];
        if (nloc == 0u) { xcd_barrier_complete(bar, b.x, nloc, nx); b.st[0] = nloc; b.st[1] = nx; }
        const unsigned old = xb_add(&bar[XB_XSUB(b.x)], 1u);
        const unsigned gen = old / nloc;
        if (old + 1u == (gen + 1u) * nloc) {
            __builtin_amdgcn_fence(__ATOMIC_RELEASE, "agent");
            asm volatile("s_waitcnt vmcnt(0)" ::: "memory");
            const unsigned og = xb_add(&bar[XB_TOP], 1u);
            const unsigned tg = og / nx;
            if (og + 1u == (tg + 1u) * nx) xb_add(&bar[XB_TOPGEN], 1u);
            else XB_SPIN(xb_ld(&bar[XB_TOPGEN]) == tg, bar);
            __builtin_amdgcn_fence(__ATOMIC_ACQUIRE, "agent");
            xb_add(&bar[XB_XGEN(b.x)], 1u);
            asm volatile("s_waitcnt vmcnt(0)" ::: "memory");
        } else {
            XB_SPIN(xb_ld(&bar[XB_XGEN(b.x)]) == gen, bar);
            __builtin_amdgcn_fence(__ATOMIC_ACQUIRE, "agent");
            asm volatile("s_waitcnt vmcnt(0)" ::: "memory");
        }
    }
    __syncthreads();
}

template <int MAP  >
__device__ __forceinline__ void p0_transpose_item(const float* W, int K, int N, bf16* WT, const float* kgain, LAS float* scr, int item, int lane) {
    const int nblk = N / 32, kb = item / nblk, nb = item % nblk, k0 = 64 * kb, n0 = 32 * nb;
#pragma unroll 8
    for (int i = 0; i < 32; ++i) { const int kk = 2 * i + (lane >> 5); float v = __builtin_nontemporal_load(W + (size_t)(k0 + kk) * N + n0 + (lane & 31)); if (kgain) v *= kgain[k0 + kk]; scr[kk * 33 + (lane & 31)] = v; }
    asm volatile("s_waitcnt lgkmcnt(0)" ::: "memory");
    const int c = lane & 7;
    int r0 = n0;
    if (MAP == 2) { const int hs = n0 >> 6; r0 = 256 * (hs >> 2) + 128 * ((n0 >> 5) & 1) + 32 * (hs & 3); }
    if (MAP == 1) r0 = n0 < DFF ? ((n0 >> 7) * 256 + (n0 & 127)) : ((((n0 - DFF) >> 7) * 256) + 128 + ((n0 - DFF) & 127));
#pragma unroll
    for (int j = 0; j < 4; ++j) { const int n = (lane >> 3) + 8 * j; const LAS float* s = scr + (8 * c) * 33 + n;
        v4u o; o.x = cvtpk(s[0 * 33], s[1 * 33]); o.y = cvtpk(s[2 * 33], s[3 * 33]); o.z = cvtpk(s[4 * 33], s[5 * 33]); o.w = cvtpk(s[6 * 33], s[7 * 33]);
        const int nr = (MAP == 1) ? (8 * (2 * (n >> 4) + ((n >> 2) & 1)) + 4 * ((n >> 3) & 1) + (n & 3)) : n;
        *(v4u*)(WT + (size_t)(r0 + nr) * K + k0 + 8 * c) = o; }
    asm volatile("s_waitcnt lgkmcnt(0)" ::: "memory");
}
__device__ __forceinline__ void rows4_to_bf16(const float* xrow, bf16* orow, float* ssq, int lane) {
    f32x4 v[4][4]; float s[4];
#pragma unroll
    for (int k = 0; k < 4; ++k)
#pragma unroll
        for (int j = 0; j < 4; ++j) v[k][j] = __builtin_nontemporal_load(((const f32x4*)(xrow + (size_t)k * DM) + lane) + 64 * j);
#pragma unroll
    for (int k = 0; k < 4; ++k) { s[k] = 0.f;
#pragma unroll
        for (int j = 0; j < 4; ++j) s[k] += (v[k][j].x * v[k][j].x + v[k][j].y * v[k][j].y) + (v[k][j].z * v[k][j].z + v[k][j].w * v[k][j].w);
        unsigned long long* o8 = (unsigned long long*)(orow + (size_t)k * DM) + lane;
#pragma unroll
        for (int j = 0; j < 4; ++j) o8[64 * j] = (unsigned long long)cvtpk(v[k][j].x, v[k][j].y) | ((unsigned long long)cvtpk(v[k][j].z, v[k][j].w) << 32); }
#pragma unroll
    for (int o = 1; o < 64; o <<= 1) {
#pragma unroll
        for (int k = 0; k < 4; ++k) s[k] += __shfl_xor(s[k], o); }
    if (lane < 4) ssq[lane] = lane == 0 ? s[0] : lane == 1 ? s[1] : lane == 2 ? s[2] : s[3];
}

template <int NKEYS, int NTHR>
__device__ __forceinline__ void stage_load(v4u (&kr)[NKEYS * 8 / NTHR], v4u (&vr)[NKEYS * 8 / NTHR], const bf16* kbase, const bf16* vbase, int tok0, int dshift, int kidx0, int Ls, int t) {
    constexpr int NIT = NKEYS * 8 / NTHR;
    const int c = t & 7;
#pragma unroll
    for (int it = 0; it < NIT; ++it) { const int rho = (it * NTHR + t) >> 3, kidx = kidx0 + rho; const bool ok = (unsigned)kidx < (unsigned)Ls;
        const size_t off = (size_t)(tok0 + ((ok ? kidx : 0) << dshift)) * 64 + 8 * c;
        kr[it] = *(const v4u*)(kbase + off); vr[it] = *(const v4u*)(vbase + off); }
}
template <int NKEYS, int NTHR>
__device__ __forceinline__ void stage_write(const v4u (&kr)[NKEYS * 8 / NTHR], const v4u (&vr)[NKEYS * 8 / NTHR], LAS unsigned char* Kl, LAS unsigned char* Vl, int t) {
    constexpr int NIT = NKEYS * 8 / NTHR;
    const int c = t & 7;
#pragma unroll
    for (int it = 0; it < NIT; ++it) { const int rho = (it * NTHR + t) >> 3;
        *(LAS v4u*)(Kl + rho * 128 + 16 * (c ^ ((rho >> 1) & 7))) = kr[it];
        *(LAS v4u*)(Vl + (c >> 2) * (NKEYS * 64) + rho * 64 + (c & 3) * 16) = vr[it]; }
}
__device__ __forceinline__ void load_q_raw(v4u (&raw)[4], const bf16* qrow, int lane) {
#pragma unroll
    for (int d0 = 0; d0 < 4; ++d0) raw[d0] = *(const v4u*)(qrow + 16 * d0 + 8 * (lane >> 5));
}
typedef short v4i16_t __attribute__((ext_vector_type(4)));
__device__ __forceinline__ s16x4 vtr(const LAS unsigned char* p) { return __builtin_bit_cast(s16x4, __builtin_amdgcn_ds_read_tr16_b64_v4i16((LAS v4i16_t*)p)); }
template <int R, int CS>
__device__ __forceinline__ void build_bias_table(LAS float* tab, float nslope, float negM, int t, int nthr) {
    for (int idx = t; idx < 4 * CS; idx += nthr) { const int k = idx / CS, m = idx - k * CS, rel = m + k - (R + 32); const int ar = rel < 0 ? -rel : rel;
        tab[idx] = ar <= R ? __builtin_fmaf((float)ar, nslope, negM) : -__builtin_inff(); }
}
__device__ __forceinline__ void attn_tile(const bf16x8 (&kf)[4], const LAS float* tb, unsigned vaddr, int vhs, const bf16x8 (&qf)[4], f32x16 (&o)[2], float& l) {
    s16x4 vl[4], vh[4];
    asm volatile("ds_read_b64_tr_b16 %0, %8\n\tds_read_b64_tr_b16 %1, %8 offset:512\n\tds_read_b64_tr_b16 %2, %8 offset:1024\n\tds_read_b64_tr_b16 %3, %8 offset:1536\n\t"
                 "ds_read_b64_tr_b16 %4, %9\n\tds_read_b64_tr_b16 %5, %9 offset:512\n\tds_read_b64_tr_b16 %6, %9 offset:1024\n\tds_read_b64_tr_b16 %7, %9 offset:1536"
                 : "=&v"(vl[0]), "=&v"(vh[0]), "=&v"(vl[1]), "=&v"(vh[1]), "=&v"(vl[2]), "=&v"(vh[2]), "=&v"(vl[3]), "=&v"(vh[3]) : "v"(vaddr), "v"(vaddr + (unsigned)vhs) : "memory");
    const f32x4 c0 = *(const LAS f32x4*)(tb), c1 = *(const LAS f32x4*)(tb + 8), c2 = *(const LAS f32x4*)(tb + 16), c3 = *(const LAS f32x4*)(tb + 24);
    f32x16 s = {c0[0], c0[1], c0[2], c0[3], c1[0], c1[1], c1[2], c1[3], c2[0], c2[1], c2[2], c2[3], c3[0], c3[1], c3[2], c3[3]};
#pragma unroll
    for (int d0 = 0; d0 < 4; ++d0) s = __builtin_amdgcn_mfma_f32_32x32x16_bf16(kf[d0], qf[d0], s, 0, 0, 0);
    float pr[16];
#pragma unroll
    for (int r = 0; r < 16; ++r) { const float p = __builtin_amdgcn_exp2f(s[r]); l += p; pr[r] = p; }
    v4u w0, w1; w0.x = cvtpk(pr[0], pr[1]); w0.y = cvtpk(pr[2], pr[3]); w0.z = cvtpk(pr[4], pr[5]); w0.w = cvtpk(pr[6], pr[7]);
    w1.x = cvtpk(pr[8], pr[9]); w1.y = cvtpk(pr[10], pr[11]); w1.z = cvtpk(pr[12], pr[13]); w1.w = cvtpk(pr[14], pr[15]);
    const bf16x8 pa0 = __builtin_bit_cast(bf16x8, w0), pa1 = __builtin_bit_cast(bf16x8, w1);
    asm volatile("s_waitcnt lgkmcnt(0)" : "+v"(vl[0]), "+v"(vh[0]), "+v"(vl[1]), "+v"(vh[1]), "+v"(vl[2]), "+v"(vh[2]), "+v"(vl[3]), "+v"(vh[3]) :: "memory");
#pragma unroll
    for (int dh = 0; dh < 2; ++dh)
#pragma unroll
        for (int s2 = 0; s2 < 2; ++s2) { const s16x4 lo = vl[2 * dh + s2], h4 = vh[2 * dh + s2];
            const bf16x8 vf = (bf16x8){lo[0], lo[1], lo[2], lo[3], h4[0], h4[1], h4[2], h4[3]};
            o[dh] = __builtin_amdgcn_mfma_f32_32x32x16_bf16(vf, s2 ? pa1 : pa0, o[dh], 0, 0, 0); }
}
template <int NT, int CS>
__device__ __forceinline__ void attn_task(const LAS unsigned char* Kl, const LAS unsigned char* Vl, int vhs, int row0, int kidx_t0, int Ls, const bf16x8 (&qf)[4], const LAS float* tab, f32x16 (&o)[2], float& l, int lane) {
    const int q = lane & 31, hi = lane >> 5;
    const unsigned va0 = (unsigned)(uintptr_t)(Vl + row0 * 64 + (4 * hi + ((lane & 15) >> 2)) * 64 + (16 * ((lane >> 4) & 1) + 4 * (lane & 3)) * 2);
    const int sw = (q >> 1) & 7;
    const LAS unsigned char* kp0 = Kl + (row0 + q) * 128 + 16 * ((0 + hi) ^ sw); const LAS unsigned char* kp1 = Kl + (row0 + q) * 128 + 16 * ((2 + hi) ^ sw);
    const LAS unsigned char* kp2 = Kl + (row0 + q) * 128 + 16 * ((4 + hi) ^ sw); const LAS unsigned char* kp3 = Kl + (row0 + q) * 128 + 16 * ((6 + hi) ^ sw);
    int b = 32 - q + 4 * hi; asm volatile("" : "+v"(b));
    const LAS float* tb0 = tab + (b & 3) * CS + (b & ~3);
#define LOADK(dst, jj) do { dst[0] = *(const LAS bf16x8*)(kp0 + (jj) * 4096); dst[1] = *(const LAS bf16x8*)(kp1 + (jj) * 4096); dst[2] = *(const LAS bf16x8*)(kp2 + (jj) * 4096); dst[3] = *(const LAS bf16x8*)(kp3 + (jj) * 4096); } while (0)
    bf16x8 kf[4];
#pragma unroll 1
    for (int j = 0; j < NT; ++j) {
        if ((unsigned)(kidx_t0 + 32 * j) < (unsigned)Ls) {
            LOADK(kf, j);
            attn_tile(kf, tb0 + 32 * j, va0 + j * 2048, vhs, qf, o, l); }
    }
#undef LOADK
}
__device__ __forceinline__ void store_partial(const f32x16 (&o)[2], float l, bf16* OBuf, float* LB, int tokq0, int dshift, int h, int lane) {
    const int hi = lane >> 5, q = lane & 31; const size_t row = (size_t)h * M + (size_t)(tokq0 + (q << dshift));
    l += __shfl_xor(l, 32);
    if (hi == 0) LB[row] = l;
    bf16* p = OBuf + row * 64 + 8 * hi;
#pragma unroll
    for (int dh = 0; dh < 2; ++dh)
#pragma unroll
        for (int t = 0; t < 2; ++t) { const int ge = 2 * t, go = 2 * t + 1;
            const unsigned x0 = cvtpk(o[dh][4 * ge], o[dh][4 * ge + 1]), x1 = cvtpk(o[dh][4 * ge + 2], o[dh][4 * ge + 3]);
            const unsigned y0 = cvtpk(o[dh][4 * go], o[dh][4 * go + 1]), y1 = cvtpk(o[dh][4 * go + 2], o[dh][4 * go + 3]);
            const auto r0 = __builtin_amdgcn_permlane32_swap(x0, y0, false, false), r1 = __builtin_amdgcn_permlane32_swap(x1, y1, false, false);
            v4u w; w.x = r0[0]; w.y = r1[0]; w.z = r0[1]; w.w = r1[1];
            *(v4u*)(p + 32 * dh + 16 * t) = w; }
}
__device__ __forceinline__ void store_final_b(f32x16 (&o)[2], float l, float sinkterm, bf16* Yb, float* ssqb, int tokq0, int h, int lane) {
    const int hi = lane >> 5, q = lane & 31; const size_t tok = (size_t)(tokq0 + q);
    l += __shfl_xor(l, 32);
    const float inv = __builtin_amdgcn_rcpf(l + sinkterm);
    float ss = 0.f;
#pragma unroll
    for (int dh = 0; dh < 2; ++dh)
#pragma unroll
        for (int r = 0; r < 16; ++r) { o[dh][r] *= inv; ss += o[dh][r] * o[dh][r]; }
    ss += __shfl_xor(ss, 32);
    if (hi == 0) unsafeAtomicAdd(ssqb + tok, ss);
    bf16* p = Yb + tok * DM + 512 + h * 64 + 8 * hi;
#pragma unroll
    for (int dh = 0; dh < 2; ++dh)
#pragma unroll
        for (int t = 0; t < 2; ++t) { const int ge = 2 * t, go = 2 * t + 1;
            const unsigned x0 = cvtpk(o[dh][4 * ge], o[dh][4 * ge + 1]), x1 = cvtpk(o[dh][4 * ge + 2], o[dh][4 * ge + 3]);
            const unsigned y0 = cvtpk(o[dh][4 * go], o[dh][4 * go + 1]), y1 = cvtpk(o[dh][4 * go + 2], o[dh][4 * go + 3]);
            const auto r0 = __builtin_amdgcn_permlane32_swap(x0, y0, false, false), r1 = __builtin_amdgcn_permlane32_swap(x1, y1, false, false);
            v4u w; w.x = r0[0]; w.y = r1[0]; w.z = r0[1]; w.w = r1[1];
            *(v4u*)(p + 32 * dh + 16 * t) = w; }
}
struct AUnit { int tok0, dshift, Ls, cc, h, c; };
__device__ __forceinline__ AUnit decode_a(int su) {
    AUnit a; const int sidx = su / 48, k = su % 48, blk = sidx >> 3; a.h = sidx & 7; a.c = 2 - (k >> 4); a.dshift = 2 * a.c; const int kk = k & 15;
    int seq0, S, bis; if (blk < 8) { seq0 = 0; S = 16384; bis = blk; } else { seq0 = MP + 2048 * (blk - 8); S = 2048; bis = 0; }
    a.Ls = S >> a.dshift; const int lcpb = 4 - a.dshift  , res = kk >> lcpb; a.cc = (bis << lcpb) + (kk & ((1 << lcpb) - 1)); a.tok0 = seq0 + res; return a;
}
struct BUnit { int seq0, S, lcb, g2; };
__device__ __forceinline__ BUnit decode_b(int u) {
    BUnit b; b.g2 = u / 768; const int cb = u % 768;
    if (cb < 256) { b.seq0 = 0; b.S = 16384; b.lcb = cb; } else { b.seq0 = MP + 2048 * ((cb - 256) >> 5); b.S = 2048; b.lcb = (cb - 256) & 31; } return b;
}

#define LDS_BAR() asm volatile("s_waitcnt lgkmcnt(0)\n\ts_barrier" ::: "memory")
#define xp (args.in[0])
#define xs (args.in[1])
#define norm1 (args.in[2])
#define w_in (args.in[3])
#define qna (args.in[4])
#define kna (args.in[5])
#define qnb (args.in[6])
#define knb (args.in[7])
#define sinkb (args.in[8])
#define ona (args.in[9])
#define onb (args.in[10])
#define w_out (args.in[11])
#define norm2 (args.in[12])
#define w_up (args.in[13])
#define conv_w (args.in[14])
#define conv_b (args.in[15])
#define w_down (args.in[16])
#define out (args.dout)
#define SSQ ((float*)(args.ws + WS_SSQ))
#define SSQ1 ((float*)(args.ws + WS_SSQ1))
#define SSQB ((float*)(args.ws + WS_SSQB))
#define WIN ((bf16*)(args.ws + WS_WIN))
#define WOUT ((bf16*)(args.ws + WS_WOUT))
#define WUP ((bf16*)(args.ws + WS_WUP))
#define WDN ((bf16*)(args.ws + WS_WDN))
#define XN ((bf16*)(args.ws + WS_XN) + DM)
#define PROJ ((bf16*)(args.ws + WS_PROJ))
#define Y ((bf16*)args.dout)
#define OA ((bf16*)(args.ws + WS_OA))
#define OB ((bf16*)args.dout)
#define HB ((bf16*)(args.ws + WS_H))
#define LA ((float*)(args.ws + WS_LA))
#define LBp ((float*)(args.ws + WS_LA) + 3 * (size_t)M * 8)
struct Args { const float* in[17]; float* dout; unsigned char* ws; };
__global__ void __launch_bounds__(NWAVES * 64, 2) fwd_megakernel(Args args) {
    extern __shared__ __attribute__((aligned(16))) unsigned char lds_raw[];
    cg::grid_group grid = cg::this_grid();
    LAS unsigned char* lds = (LAS unsigned char*)lds_raw;
    const int tid = threadIdx.x, lane = tid & 63, wave = __builtin_amdgcn_readfirstlane(tid >> 6);
    const int G = gridDim.x, bx = blockIdx.x;
    if (tid < 2) ((LAS unsigned*)(lds + MISC_OFF))[tid] = 0u;
    const int gw = bx * NWAVES + wave, NGW = G * NWAVES;
    __syncthreads();
    XcdBarrier bar = xcd_barrier_post((unsigned*)(args.ws + WS_BAR), (volatile LAS unsigned*)(lds + MISC_OFF));
    if (args.ws == nullptr) grid.sync();

    {
        LAS float* scr = (LAS float*)(lds + wave * 16384);
        constexpr int I_IN = (DM / 64) * (INW / 32), I_OUT = (DM / 64) * (DM / 32), I_UP = (DM / 64) * (UPW / 32), I_DN = (DFF / 64) * (DM / 32);
        for (int it = gw; it < I_IN + I_OUT + I_UP + I_DN; it += NGW) {
            int r = it;
            if (r < I_IN) { p0_transpose_item<2>(w_in, DM, INW, WIN, norm1, scr, r, lane); continue; } r -= I_IN;
            if (r < I_OUT) { p0_transpose_item<0>(w_out, DM, DM, WOUT, (r / (DM / 32)) >= 8 ? onb - 512 : nullptr, scr, r, lane); continue; } r -= I_OUT;
            if (r < I_UP) { p0_transpose_item<1>(w_up, DM, UPW, WUP, norm2, scr, r, lane); continue; } r -= I_UP;
            p0_transpose_item<0>(w_down, DFF, DM, WDN, nullptr, scr, r, lane);
        }
        for (int m = gw * 4; m < M; m += NGW * 4) rows4_to_bf16(m < MP ? xp + (size_t)m * DM : xs + (size_t)(m - MP) * DM, XN + (size_t)m * DM, SSQ1 + m, lane);
        for (int i = bx * 512 + tid; i < M; i += G * 512) { SSQ[i] = 0.f; SSQB[i] = 0.f; }
    }
    xcd_barrier(bar);

    {
        pg8::Gemm g{XN, WIN, M, INW, DM, 256}; pg8::StaticOrder S; S.init(M, INW, G, bx);
        pg8::EpiProj E{PROJ, SSQ1, qna, kna, qnb, knb};
        pg8::gemm_phase<pg8::EpiProj, pg8::StaticOrder, PG8_ALIGN, PG8_SP2>(lds, g, S, E);
    }
    xcd_barrier(bar);

    {
        const float gqa = fabsf(qna[lane]), gka = fabsf(kna[lane]);
        const float boundA = __builtin_bit_cast(float, __builtin_amdgcn_readfirstlane(__builtin_bit_cast(int, 8.0f * wave_max(gqa) * wave_max(gka) * LOG2E)));
        const float negMa = boundA > 40.f ? -boundA : 0.f;
        {
            const int half = wave >> 2, w4 = wave & 3, th = tid & 255;
            LAS unsigned char* Kl = lds + half * 65536; LAS unsigned char* Vl = Kl + 32768;
            LAS float* tabA = (LAS float*)(lds + XCH_OFF);
            const int ubase = (G == 256) ? (bx & 7) * 576 + (bx >> 3) : bx, ustep = (G == 256) ? 32 : G, uend = (G == 256) ? (bx & 7) * 576 + 576 : 4608;
            v4u kr[8], vr[8], qraw[4]; AUnit nx = decode_a(2 * ubase + half);
            if (ubase < uend) { stage_load<256, 256>(kr, vr, PROJ + (size_t)(8 + nx.h) * M * 64, PROJ + (size_t)(16 + nx.h) * M * 64, nx.tok0, nx.dshift, 128 * nx.cc - 64, nx.Ls, th);
                load_q_raw(qraw, PROJ + ((size_t)nx.h * M + (nx.tok0 + ((128 * nx.cc + 32 * w4 + (lane & 31)) << nx.dshift))) * 64, lane); }
            for (int u = ubase; u < uend; u += ustep) {
                const AUnit a = nx;
                LDS_BAR();
                stage_write<256, 256>(kr, vr, Kl, Vl, th);
                build_bias_table<64, 208>(tabA, -__builtin_amdgcn_exp2f(-0.5f * (float)(a.h + 9) + (float)a.dshift) * LOG2E, negMa, tid, 512);
                bf16x8 qf[4];
#pragma unroll
                for (int d0 = 0; d0 < 4; ++d0) qf[d0] = __builtin_bit_cast(bf16x8, qraw[d0]);
                LDS_BAR();
                if (u + ustep < uend) { nx = decode_a(2 * (u + ustep) + half);
                    stage_load<256, 256>(kr, vr, PROJ + (size_t)(8 + nx.h) * M * 64, PROJ + (size_t)(16 + nx.h) * M * 64, nx.tok0, nx.dshift, 128 * nx.cc - 64, nx.Ls, th);
                    load_q_raw(qraw, PROJ + ((size_t)nx.h * M + (nx.tok0 + ((128 * nx.cc + 32 * w4 + (lane & 31)) << nx.dshift))) * 64, lane); }
                const int iq0 = 128 * a.cc + 32 * w4;
                f32x16 o[2]; float l = 0.f;
#pragma unroll
                for (int r = 0; r < 16; ++r) { o[0][r] = 0.f; o[1][r] = 0.f; }
                attn_task<5, 208>(Kl, Vl, 256 * 64, 32 * w4, iq0 - 64, a.Ls, qf, tabA, o, l, lane);
                asm volatile("s_nop 15\n\ts_nop 7" ::: "memory");
                store_partial(o, l, OA + (size_t)a.c * M * 512, LA + (size_t)a.c * M * 8, a.tok0 + (iq0 << a.dshift), a.dshift, a.h, lane);
            }
        }
        const float gqb = fabsf(qnb[lane]), gkb = fabsf(knb[lane]);
        const float boundB = __builtin_bit_cast(float, __builtin_amdgcn_readfirstlane(__builtin_bit_cast(int, 8.0f * wave_max(gqb) * wave_max(gkb) * LOG2E)));
        const float negMb = boundB > 40.f ? -boundB : 0.f;
        {
            LAS unsigned char* Kb = lds; LAS unsigned char* Vb = lds + 40960;
            LAS float* tabB = (LAS float*)(lds + 81920);
            const int ubase = (G == 256) ? (bx & 7) * 192 + (bx >> 3) : bx, ustep = (G == 256) ? 32 : G, uend = (G == 256) ? (bx & 7) * 192 + 192 : 1536;
            v4u kr[5], vr[5], qraw[4]; BUnit nx = decode_b(ubase);
            if (ubase < uend) { stage_load<320, 512>(kr, vr, PROJ + (size_t)(32 + nx.g2) * M * 64, PROJ + (size_t)(34 + nx.g2) * M * 64, nx.seq0, 0, 64 * nx.lcb - 128, nx.S, tid);
                load_q_raw(qraw, PROJ + ((size_t)(24 + 4 * nx.g2 + (wave >> 1)) * M + (nx.seq0 + 64 * nx.lcb + 32 * (wave & 1) + (lane & 31))) * 64, lane); }
            for (int u = ubase; u < uend; u += ustep) {
                const BUnit b = nx;
                LDS_BAR();
                stage_write<320, 512>(kr, vr, Kb, Vb, tid);
                build_bias_table<128, 336>(tabB + (tid >> 7) * (4 * 336), -__builtin_amdgcn_exp2f(-0.5f * (float)(4 * b.g2 + (tid >> 7) + 1)) * LOG2E, negMb, tid & 127, 128);
                bf16x8 qf[4];
#pragma unroll
                for (int d0 = 0; d0 < 4; ++d0) qf[d0] = __builtin_bit_cast(bf16x8, qraw[d0]);
                LDS_BAR();
                if (u + ustep < uend) { nx = decode_b(u + ustep);
                    stage_load<320, 512>(kr, vr, PROJ + (size_t)(32 + nx.g2) * M * 64, PROJ + (size_t)(34 + nx.g2) * M * 64, nx.seq0, 0, 64 * nx.lcb - 128, nx.S, tid);
                    load_q_raw(qraw, PROJ + ((size_t)(24 + 4 * nx.g2 + (wave >> 1)) * M + (nx.seq0 + 64 * nx.lcb + 32 * (wave & 1) + (lane & 31))) * 64, lane); }
                const int hb = 4 * b.g2 + (wave >> 1), iq0 = 64 * b.lcb + 32 * (wave & 1);
                f32x16 o[2]; float l = 0.f;
#pragma unroll
                for (int r = 0; r < 16; ++r) { o[0][r] = 0.f; o[1][r] = 0.f; }
                attn_task<9, 336>(Kb, Vb, 320 * 64, 32 * (wave & 1), iq0 - 128, b.S, qf, tabB + (wave >> 1) * (4 * 336), o, l, lane);
                asm volatile("s_nop 15\n\ts_nop 7" ::: "memory");
                store_final_b(o, l, __builtin_amdgcn_exp2f(sinkb[hb] * LOG2E + negMb), Y, SSQB, b.seq0 + iq0, hb, lane);
            }
        }
        xcd_barrier(bar);
        {
            const int hh = lane >> 3;
            const f32x4 ga0 = *(const f32x4*)(ona + 8 * lane), ga1 = *(const f32x4*)(ona + 8 * lane + 4);
            for (int m0 = gw * 4; m0 < M; m0 += NGW * 4) {
                v4u wa[4][3]; float la[4];
#pragma unroll
                for (int k = 0; k < 4; ++k) { const int m = m0 + k; la[k] = 0.f;
#pragma unroll
                    for (int c = 0; c < 3; ++c) { wa[k][c] = __builtin_nontemporal_load((const v4u*)(OA + (((size_t)c * 8 + hh) * M + m) * 64 + 8 * (lane & 7))); la[k] += LA[((size_t)c * 8 + hh) * M + m]; } }
                float ya[4][8], sa[4];
#pragma unroll
                for (int k = 0; k < 4; ++k) { const float ia = __builtin_amdgcn_rcpf(la[k]);
                    ya[k][0] = (bf_lo(wa[k][0].x) + bf_lo(wa[k][1].x) + bf_lo(wa[k][2].x)) * ia; ya[k][1] = (bf_hi(wa[k][0].x) + bf_hi(wa[k][1].x) + bf_hi(wa[k][2].x)) * ia;
                    ya[k][2] = (bf_lo(wa[k][0].y) + bf_lo(wa[k][1].y) + bf_lo(wa[k][2].y)) * ia; ya[k][3] = (bf_hi(wa[k][0].y) + bf_hi(wa[k][1].y) + bf_hi(wa[k][2].y)) * ia;
                    ya[k][4] = (bf_lo(wa[k][0].z) + bf_lo(wa[k][1].z) + bf_lo(wa[k][2].z)) * ia; ya[k][5] = (bf_hi(wa[k][0].z) + bf_hi(wa[k][1].z) + bf_hi(wa[k][2].z)) * ia;
                    ya[k][6] = (bf_lo(wa[k][0].w) + bf_lo(wa[k][1].w) + bf_lo(wa[k][2].w)) * ia; ya[k][7] = (bf_hi(wa[k][0].w) + bf_hi(wa[k][1].w) + bf_hi(wa[k][2].w)) * ia;
                    sa[k] = 0.f;
#pragma unroll
                    for (int i = 0; i < 8; ++i) sa[k] += ya[k][i] * ya[k][i]; }
#pragma unroll
                for (int o = 1; o < 64; o <<= 1) {
#pragma unroll
                    for (int k = 0; k < 4; ++k) sa[k] += __shfl_xor(sa[k], o); }
#pragma unroll
                for (int k = 0; k < 4; ++k) { const int m = m0 + k;
                    const float ra = __builtin_amdgcn_rsqf(sa[k] * (1.f / 512.f) + EPS);
                    v4u oa;
                    oa.x = cvtpk(ya[k][0] * ra * ga0.x, ya[k][1] * ra * ga0.y); oa.y = cvtpk(ya[k][2] * ra * ga0.z, ya[k][3] * ra * ga0.w); oa.z = cvtpk(ya[k][4] * ra * ga1.x, ya[k][5] * ra * ga1.y); oa.w = cvtpk(ya[k][6] * ra * ga1.z, ya[k][7] * ra * ga1.w);
                    *(v4u*)(Y + (size_t)m * DM + 8 * lane) = oa; }
            }
        }
    }
    xcd_barrier(bar);

    {
        pg8::Gemm g{Y, WOUT, M, DM, DM, 256}; pg8::StaticOrder S; S.init(M, DM, G, bx);
        pg8::EpiOut E{XN, SSQ, SSQB};
        pg8::gemm_phase<pg8::EpiOut, pg8::StaticOrder, PG8_ALIGN, PG8_SP2>(lds, g, S, E);
    }
    xcd_barrier(bar);

    {
        pg8::Gemm g{XN - DM, WUP, UP_TILES_M * 256, UPW, DM, 254}; pg8::StaticOrder S; S.init(UP_TILES_M * 256, UPW, G, bx);
        pg8::EpiUp E{HB, SSQ, conv_w, conv_b, (LAS float*)(lds + XCH_OFF)};
        pg8::gemm_phase<pg8::EpiUp, pg8::StaticOrder, true, PG8_SP2>(lds, g, S, E);
    }
    xcd_barrier(bar);

    {
        pg8::Gemm g{HB, WDN, M, DM, DFF, 256}; pg8::StaticOrder S; S.init(M, DM, G, bx);
        pg8::EpiDown E{XN, out};
        pg8::gemm_phase<pg8::EpiDown, pg8::StaticOrder, PG8_ALIGN, PG8_SP2>(lds, g, S, E);
    }
}

#undef out
#undef xp
#undef xs
extern "C" void kernel_launch(void* const* d_in, const int* in_sizes, int n_in, void* d_out, int out_size, void* d_ws, size_t ws_size, hipStream_t stream) {
    static int grid = 0;
    if (grid == 0) {
        if (n_in != 17 || out_size != M * DM || ws_size < WS_END) { fprintf(stderr, "kernel_launch: unexpected shapes (n_in %d out %d ws %zu)\n", n_in, out_size, ws_size); grid = -1; return; }
        int dev = 0, cus = 0, per_cu = 0;
        hipGetDevice(&dev); hipDeviceGetAttribute(&cus, hipDeviceAttributeMultiprocessorCount, dev);
        if (hipFuncSetAttribute((const void*)fwd_megakernel, hipFuncAttributeMaxDynamicSharedMemorySize, LDS_BYTES) != hipSuccess) { fprintf(stderr, "kernel_launch: hipFuncSetAttribute failed\n"); grid = -1; return; }
        if (hipOccupancyMaxActiveBlocksPerMultiprocessor(&per_cu, (const void*)fwd_megakernel, NWAVES * 64, LDS_BYTES) != hipSuccess || per_cu < 1) { fprintf(stderr, "kernel_launch: occupancy query says %d\n", per_cu); per_cu = 1; }
        (void)hipGetLastError();
        grid = cus;
        fprintf(stderr, "kernel_launch: grid %d (per_cu %d)\n", grid, per_cu);
    }
    if (grid < 0) return;
    Args a{};
    for (int i = 0; i < 17; ++i) a.in[i] = (const float*)d_in[i];
    a.dout = (float*)d_out; a.ws = (unsigned char*)d_ws;
    void* kargs[] = {&a};
    if (hipMemsetAsync((char*)d_ws + WS_BAR, 0, XCD_BAR_WORDS * 4, stream) != hipSuccess) { fprintf(stderr, "kernel_launch: hipMemsetAsync failed\n"); return; }
    hipError_t e = hipLaunchCooperativeKernel((const void*)fwd_megakernel, dim3(grid), dim3(NWAVES * 64), kargs, LDS_BYTES, stream);
    if (e != hipSuccess) fprintf(stderr, "kernel_launch: cooperative launch failed: %s\n", hipGetErrorString(e));
}
```
